# Optimizing an MI355X kernel written in HIP

```python
import jax, jax.numpy as jnp
from jax import lax
import numpy as np

D_MODEL = 1024
BATCH = 32
SEQ = 256
DEPTH = 4
DEC_BATCH = 2
DEC_SEQ = 2048
PAST_LEN = 512

GRID_W = 64
N_MIXERS = 4
N_ATTN = (DEPTH + 3) // 4
N_SGU = (DEPTH + 2) // 4
N_SCONV = (DEPTH + 1) // 4
N_FOURIER = DEPTH // 4
N_HEADS = 16
N_KV_HEADS = 4
HEAD_DIM = 64
Q_PER_KV = N_HEADS // N_KV_HEADS
WINDOW = 128
BLOCK = 128
ROPE_THETA = 10000.0
SGU_CHUNK = 128
SGU_GROUPS = 8
SGU_GROUP_DIM = D_MODEL // SGU_GROUPS
FOURIER_GROUPS = 8
FOURIER_GROUP_DIM = D_MODEL // FOURIER_GROUPS
CONV_W = 3
D_FF = 2816
EPS = 1e-6
NEG_BIG = -1e30

kernel_name = 'hybrid_diffusion_prefix_step'


def rms_norm(x, g):
    xf = x.astype(jnp.float32)
    y = xf * lax.rsqrt(jnp.mean(xf * xf, axis=-1, keepdims=True) + EPS)
    return (y * g.astype(jnp.float32)).astype(x.dtype)


def layer_norm(x, g):
    xf = x.astype(jnp.float32)
    mu = jnp.mean(xf, axis=-1, keepdims=True)
    xc = xf - mu
    y = xc * lax.rsqrt(jnp.mean(xc * xc, axis=-1, keepdims=True) + EPS)
    return (y * g.astype(jnp.float32)).astype(x.dtype)


def modulate(x, g, shift, scale):
    return rms_norm(x, g) * (1 + scale) + shift


def conv3_centred(x, w):
    xp = jnp.pad(x, ((0, 0), (1, 1), (0, 0)))
    return xp[:, :-2] * w[0] + xp[:, 1:-1] * w[1] + xp[:, 2:] * w[2]


def _rotate(x, pos):
    half = x.shape[-1] // 2
    inv = ROPE_THETA ** (-jnp.arange(half, dtype=jnp.float32) / half)
    ang = pos.astype(jnp.float32)[:, None] * inv[None, :]
    cos = jnp.cos(ang)[None, :, None, :]
    sin = jnp.sin(ang)[None, :, None, :]
    x1 = x[..., :half].astype(jnp.float32)
    x2 = x[..., half:].astype(jnp.float32)
    return jnp.concatenate([x1 * cos - x2 * sin, x2 * cos + x1 * sin], axis=-1).astype(x.dtype)


def axial_rope(x):
    t = jnp.arange(x.shape[1])
    row, col = t // GRID_W, t % GRID_W
    h = x.shape[-1] // 2
    return jnp.concatenate([_rotate(x[..., :h], row), _rotate(x[..., h:], col)], axis=-1)


def split_qkv(h, wqkv):
    B, T, _ = h.shape
    qkv = h @ wqkv
    nq, nk = N_HEADS * HEAD_DIM, N_KV_HEADS * HEAD_DIM
    q = qkv[..., :nq].reshape(B, T, N_HEADS, HEAD_DIM)
    k = qkv[..., nq:nq + nk].reshape(B, T, N_KV_HEADS, HEAD_DIM)
    v = qkv[..., nq + nk:].reshape(B, T, N_KV_HEADS, HEAD_DIM)
    return q, k, v


def context_attention(q, k, v, sink):
    B, S = q.shape[:2]
    nq = S // BLOCK
    qb = q.reshape(B, nq, BLOCK, N_KV_HEADS, Q_PER_KV, HEAD_DIM).transpose(1, 0, 2, 3, 4, 5)
    sink_l = sink.astype(jnp.float32).reshape(N_KV_HEADS, Q_PER_KV)[None, :, :, None, None]
    scale = HEAD_DIM ** -0.5

    def one_block(qblk):
        s = jnp.einsum('bqkgd,bskd->bkgqs', qblk, k).astype(jnp.float32) * scale
        s = jnp.concatenate([s, jnp.broadcast_to(sink_l, s.shape[:-1] + (1,))], axis=-1)
        p = jax.nn.softmax(s, axis=-1)[..., :-1].astype(v.dtype)
        return jnp.einsum('bkgqs,bskd->bqkgd', p, v)

    o = lax.map(one_block, qb)
    return o.transpose(1, 0, 2, 3, 4, 5).reshape(B, S, N_HEADS * HEAD_DIM)


def latent_attention(q, k, v, ck, cv, sink):
    B, T = q.shape[:2]
    nb = T // BLOCK
    P = ck.shape[1]
    L = 3 * BLOCK
    qb = q.reshape(B, nb, BLOCK, N_KV_HEADS, Q_PER_KV, HEAD_DIM)

    def band(x):
        xp = jnp.pad(x, ((0, 0), (BLOCK, BLOCK), (0, 0), (0, 0)))
        xp = xp.reshape(B, nb + 2, BLOCK, N_KV_HEADS, HEAD_DIM)
        return jnp.concatenate([xp[:, :-2], xp[:, 1:-1], xp[:, 2:]], axis=2)

    kb, vb = band(k), band(v)
    qpos = jnp.arange(nb)[:, None] * BLOCK + jnp.arange(BLOCK)[None, :]
    kpos = jnp.arange(nb)[:, None] * BLOCK - BLOCK + jnp.arange(L)[None, :]
    rel = kpos[:, None, :] - qpos[:, :, None]
    valid = (jnp.abs(rel) <= WINDOW) & (kpos[:, None, :] >= 0) & (kpos[:, None, :] < T)
    scale = HEAD_DIM ** -0.5
    s_loc = jnp.einsum('bnqkgd,bnskd->bnkgqs', qb, kb).astype(jnp.float32) * scale
    s_loc = jnp.where(valid[None, :, None, None], s_loc, NEG_BIG)
    s_ctx = jnp.einsum('bnqkgd,bskd->bnkgqs', qb, ck).astype(jnp.float32) * scale
    sink_l = sink.astype(jnp.float32).reshape(N_KV_HEADS, Q_PER_KV)[None, None, :, :, None, None]
    s = jnp.concatenate([s_loc, s_ctx, jnp.broadcast_to(sink_l, s_loc.shape[:-1] + (1,))], axis=-1)
    p = jax.nn.softmax(s, axis=-1)
    p_loc = p[..., :L].astype(v.dtype)
    p_ctx = p[..., L:L + P].astype(v.dtype)
    o = (jnp.einsum('bnkgqs,bnskd->bnqkgd', p_loc, vb)
         + jnp.einsum('bnkgqs,bskd->bnqkgd', p_ctx, cv))
    return o.reshape(B, T, N_HEADS * HEAD_DIM)


def attn_mixer_context(h, wqkv, wo, sink):
    q, k, v = split_qkv(h, wqkv)
    return context_attention(q, k, v, sink) @ wo, k, v


def attn_mixer_latent(h, ck, cv, wqkv, wo, sink):
    q, k, v = split_qkv(h, wqkv)
    q, k = axial_rope(q), axial_rope(k)
    return latent_attention(q, k, v, ck, cv, sink) @ wo


def sgu_mixer(h, w_in, ln_g, w_s, b_s, w_out):
    B, T, _ = h.shape
    z = jax.nn.gelu(h @ w_in)
    u, v = z[..., :D_MODEL], z[..., D_MODEL:]
    v = layer_norm(v, ln_g)
    n = T // SGU_CHUNK
    vc = v.reshape(B, n, SGU_CHUNK, SGU_GROUPS, SGU_GROUP_DIM)
    mixed = jnp.einsum('gpr,bnrgc->bnpgc', w_s, vc) + b_s.T[None, None, :, :, None]
    return (u * mixed.reshape(B, T, D_MODEL)) @ w_out


def short_conv_mixer(h, w_in, conv_w, w_out):
    p = h @ w_in
    b, cg, xin = p[..., :D_MODEL], p[..., D_MODEL:2 * D_MODEL], p[..., 2 * D_MODEL:]
    y = conv3_centred(cg * xin, conv_w)
    return (b * y) @ w_out


def fourier_mixer(h, w_out):
    B, T, _ = h.shape
    hg = h.astype(jnp.float32).reshape(B, T, FOURIER_GROUPS, FOURIER_GROUP_DIM)
    f = jnp.fft.fft2(hg, axes=(1, 3), norm='ortho').real
    return f.reshape(B, T, D_MODEL).astype(h.dtype) @ w_out


def conv_ffn(h, w_up, conv_w, w_down):
    a = conv3_centred(h @ w_up, conv_w)
    g, u = a[..., :D_FF], a[..., D_FF:]
    return (jax.nn.silu(g) * u) @ w_down


def setup_inputs(seed: int = 0) -> dict:
    key = jax.random.key(seed)
    ks = jax.random.split(key, 32)
    D = D_MODEL
    qkv_out = (N_HEADS + 2 * N_KV_HEADS) * HEAD_DIM

    def nrm(k, shape, scale):
        return jax.random.normal(k, shape, jnp.float32) * scale

    return {
        'x_prompt': nrm(ks[0], (BATCH, SEQ, D), 1.0),
        'x_sample': nrm(ks[1], (DEC_BATCH, DEC_SEQ, D), 1.0),
        'cache_k': nrm(ks[2], (DEC_BATCH, N_ATTN, PAST_LEN, N_KV_HEADS, HEAD_DIM), 1.0),
        'cache_v': nrm(ks[3], (DEC_BATCH, N_ATTN, PAST_LEN, N_KV_HEADS, HEAD_DIM), 1.0),
        'c': nrm(ks[4], (DEC_BATCH, D), 1.0),
        'c_ctx': nrm(ks[5], (D,), 1.0),
        'ada_w': nrm(ks[6], (DEPTH, D, 6 * D), 0.5 * D ** -0.5),
        'ada_b': nrm(ks[7], (DEPTH, 6 * D), 0.02),
        'norm_mix_g': 1.0 + nrm(ks[8], (DEPTH, D), 0.02),
        'norm_ffn_g': 1.0 + nrm(ks[9], (DEPTH, D), 0.02),
        'final_g': 1.0 + nrm(ks[10], (D,), 0.02),
        'attn_wqkv': nrm(ks[11], (N_ATTN, D, qkv_out), D ** -0.5),
        'attn_wo': nrm(ks[12], (N_ATTN, N_HEADS * HEAD_DIM, D), (N_HEADS * HEAD_DIM) ** -0.5),
        'attn_sink': nrm(ks[13], (N_ATTN, N_HEADS), 0.5),
        'sgu_w_in': nrm(ks[14], (N_SGU, D, 2 * D), D ** -0.5),
        'sgu_ln_g': 1.0 + nrm(ks[15], (N_SGU, D), 0.02),
        'sgu_w_s': nrm(ks[16], (N_SGU, SGU_GROUPS, SGU_CHUNK, SGU_CHUNK), SGU_CHUNK ** -0.5),
        'sgu_b_s': 1.0 + nrm(ks[17], (N_SGU, SGU_GROUPS, SGU_CHUNK), 0.02),
        'sgu_w_out': nrm(ks[18], (N_SGU, D, D), D ** -0.5),
        'sc_w_in': nrm(ks[19], (N_SCONV, D, 3 * D), D ** -0.5),
        'sc_conv': nrm(ks[20], (N_SCONV, CONV_W, D), CONV_W ** -0.5),
        'sc_w_out': nrm(ks[21], (N_SCONV, D, D), D ** -0.5),
        'fn_w_out': nrm(ks[22], (N_FOURIER, D, D), D ** -0.5),
        'ffn_w_up': nrm(ks[23], (DEPTH, D, 2 * D_FF), D ** -0.5),
        'ffn_conv': nrm(ks[24], (DEPTH, CONV_W, 2 * D_FF), CONV_W ** -0.5),
        'ffn_w_down': nrm(ks[25], (DEPTH, D_FF, D), D_FF ** -0.5),
    }


def reference(x_prompt, x_sample, cache_k, cache_v, c, c_ctx, ada_w, ada_b, norm_mix_g,
              norm_ffn_g, final_g, attn_wqkv, attn_wo, attn_sink, sgu_w_in, sgu_ln_g, sgu_w_s,
              sgu_b_s, sgu_w_out, sc_w_in, sc_conv, sc_w_out, fn_w_out, ffn_w_up, ffn_conv,
              ffn_w_down):
    xp, xs = x_prompt, x_sample
    new_k, new_v = [], []
    for l in range(DEPTH):
        kind, j = l % N_MIXERS, l // N_MIXERS
        mod_p = (jax.nn.silu(c_ctx) @ ada_w[l] + ada_b[l])[None, None, :]
        mod_s = (jax.nn.silu(c) @ ada_w[l] + ada_b[l])[:, None, :]
        sh1p, sc1p, g1p, sh2p, sc2p, g2p = jnp.split(mod_p, 6, axis=-1)
        sh1s, sc1s, g1s, sh2s, sc2s, g2s = jnp.split(mod_s, 6, axis=-1)
        hp = modulate(xp, norm_mix_g[l], sh1p, sc1p)
        hs = modulate(xs, norm_mix_g[l], sh1s, sc1s)
        if kind == 0:
            dp, kp, vp = attn_mixer_context(hp, attn_wqkv[j], attn_wo[j], attn_sink[j])
            new_k.append(kp)
            new_v.append(vp)
            ds = attn_mixer_latent(hs, cache_k[:, j], cache_v[:, j], attn_wqkv[j], attn_wo[j],
                                   attn_sink[j])
        elif kind == 1:
            dp = sgu_mixer(hp, sgu_w_in[j], sgu_ln_g[j], sgu_w_s[j], sgu_b_s[j], sgu_w_out[j])
            ds = sgu_mixer(hs, sgu_w_in[j], sgu_ln_g[j], sgu_w_s[j], sgu_b_s[j], sgu_w_out[j])
        elif kind == 2:
            dp = short_conv_mixer(hp, sc_w_in[j], sc_conv[j], sc_w_out[j])
            ds = short_conv_mixer(hs, sc_w_in[j], sc_conv[j], sc_w_out[j])
        else:
            dp = fourier_mixer(hp, fn_w_out[j])
            ds = fourier_mixer(hs, fn_w_out[j])
        xp = xp + g1p * dp
        xs = xs + g1s * ds
        hp = modulate(xp, norm_ffn_g[l], sh2p, sc2p)
        hs = modulate(xs, norm_ffn_g[l], sh2s, sc2s)
        xp = xp + g2p * conv_ffn(hp, ffn_w_up[l], ffn_conv[l], ffn_w_down[l])
        xs = xs + g2s * conv_ffn(hs, ffn_w_up[l], ffn_conv[l], ffn_w_down[l])
    y_prompt = rms_norm(xp, final_g)
    y_sample = rms_norm(xs, final_g)
    new_cache_k = jnp.stack(new_k, axis=1)
    new_cache_v = jnp.stack(new_v, axis=1)
    return (y_prompt, y_sample, new_cache_k, new_cache_v)
```

```cpp
#include <hip/hip_runtime.h>
#include <math.h>

namespace slow {
constexpr int D = 1024, MP = 8192, MS = 4096, M = MP + MS, DFF = 2816;
constexpr float EPS = 1e-6f;

__global__ void k_mod(const float* c, const float* c_ctx, const float* ada_w, const float* ada_b, float* mod) {
    __shared__ float s[3][D];
    for (int i = threadIdx.x; i < D; i += blockDim.x) {
        float a = c_ctx[i], b = c[i], d = c[D + i];
        s[0][i] = a / (1.f + expf(-a)); s[1][i] = b / (1.f + expf(-b)); s[2][i] = d / (1.f + expf(-d));
    }
    __syncthreads();
    const int idx = blockIdx.x * blockDim.x + threadIdx.x;
    const int l = idx / (6 * D), n = idx % (6 * D);
    const float* w = ada_w + (size_t)l * D * 6 * D + n;
    float a0 = 0, a1 = 0, a2 = 0;
    for (int k = 0; k < D; ++k) { const float wv = w[(size_t)k * 6 * D]; a0 += s[0][k] * wv; a1 += s[1][k] * wv; a2 += s[2][k] * wv; }
    const float bb = ada_b[l * 6 * D + n];
    mod[(l * 3 + 0) * 6 * D + n] = a0 + bb; mod[(l * 3 + 1) * 6 * D + n] = a1 + bb; mod[(l * 3 + 2) * 6 * D + n] = a2 + bb;
}
__device__ __forceinline__ int vec_of_row(int row) { return row < MP ? 0 : 1 + (row - MP) / 2048; }
__global__ void k_norm(const float* x, const float* g, const float* modl, int sh_idx, float* h) {
    const int row = blockIdx.x; const float* xr = x + (size_t)row * D;
    __shared__ float red[256];
    float s = 0; for (int i = threadIdx.x; i < D; i += 256) s += xr[i] * xr[i];
    red[threadIdx.x] = s; __syncthreads();
    for (int o = 128; o > 0; o >>= 1) { if (threadIdx.x < o) red[threadIdx.x] += red[threadIdx.x + o]; __syncthreads(); }
    const float r = rsqrtf(red[0] / D + EPS);
    const float* mv = modl + vec_of_row(row) * 6 * D;
    for (int i = threadIdx.x; i < D; i += 256) h[(size_t)row * D + i] = xr[i] * r * g[i] * (1.f + mv[(sh_idx + 1) * D + i]) + mv[sh_idx * D + i];
}
__global__ void k_final(const float* x, const float* g, float* out) {
    const int row = blockIdx.x; const float* xr = x + (size_t)row * D;
    __shared__ float red[256];
    float s = 0; for (int i = threadIdx.x; i < D; i += 256) s += xr[i] * xr[i];
    red[threadIdx.x] = s; __syncthreads();
    for (int o = 128; o > 0; o >>= 1) { if (threadIdx.x < o) red[threadIdx.x] += red[threadIdx.x + o]; __syncthreads(); }
    const float r = rsqrtf(red[0] / D + EPS);
    for (int i = threadIdx.x; i < D; i += 256) out[(size_t)row * D + i] = xr[i] * r * g[i];
}
__global__ void __launch_bounds__(256) k_gemm(const float* A, int lda, size_t sA, const float* B, int ldb, size_t sB, float* C, int ldc, size_t sC, int K, float alpha, float beta) {
    __shared__ float As[16][64 + 4], Bs[16][64 + 4];
    A += blockIdx.z * sA; B += blockIdx.z * sB; C += blockIdx.z * sC;
    const int m0 = blockIdx.y * 64, n0 = blockIdx.x * 64, tx = threadIdx.x & 15, ty = threadIdx.x >> 4;
    float acc[4][4] = {};
    for (int k0 = 0; k0 < K; k0 += 16) {
        for (int i = threadIdx.x; i < 64 * 16; i += 256) { const int r = i >> 4, kk = i & 15; As[kk][r] = A[(size_t)(m0 + r) * lda + k0 + kk]; }
        for (int i = threadIdx.x; i < 16 * 64; i += 256) { const int kk = i >> 6, cc = i & 63; Bs[kk][cc] = B[(size_t)(k0 + kk) * ldb + n0 + cc]; }
        __syncthreads();
#pragma unroll
        for (int kk = 0; kk < 16; ++kk) {
            float a[4], b[4];
#pragma unroll
            for (int i = 0; i < 4; ++i) { a[i] = As[kk][ty * 4 + i]; b[i] = Bs[kk][tx * 4 + i]; }
#pragma unroll
            for (int i = 0; i < 4; ++i)
#pragma unroll
                for (int j = 0; j < 4; ++j) acc[i][j] += a[i] * b[j];
        }
        __syncthreads();
    }
    for (int i = 0; i < 4; ++i) for (int j = 0; j < 4; ++j) {
        float* p = C + (size_t)(m0 + ty * 4 + i) * ldc + n0 + tx * 4 + j;
        *p = alpha * acc[i][j] + (beta != 0.f ? beta * *p : 0.f);
    }
}
__global__ void k_resid(const float* xin, const float* d, const float* modl, int gate_idx, float* xout) {
    const size_t i = (size_t)blockIdx.x * 256 + threadIdx.x; const int row = i / D, col = i % D;
    xout[i] = xin[i] + modl[vec_of_row(row) * 6 * D + gate_idx * D + col] * d[i];
}
__global__ void k_rope(float* qkv) {
    const int i = blockIdx.x * 256 + threadIdx.x;
    const int fi = i & 15, half = (i >> 4) & 1, head = (i >> 5) % 20, r = i / (32 * 20);
    const int t = r % 2048; const int pos = half ? (t % 64) : (t / 64);
    const float inv = powf(10000.f, -(float)fi / 16.f), ang = (float)pos * inv, cs = cosf(ang), sn = sinf(ang);
    float* p = qkv + (size_t)(MP + r) * 1536 + head * 64 + half * 32 + fi;
    const float x1 = p[0], x2 = p[16];
    p[0] = x1 * cs - x2 * sn; p[16] = x2 * cs + x1 * sn;
}
__global__ void k_copy_kv(const float* qkv, float* outk, float* outv) {
    const int i = blockIdx.x * 256 + threadIdx.x; const int row = i / 256, c = i % 256;
    outk[i] = qkv[(size_t)row * 1536 + 1024 + c]; outv[i] = qkv[(size_t)row * 1536 + 1280 + c];
}
__global__ void k_attn(const float* qkv, const float* ck, const float* cv, const float* sink, float* o) {
    const int row = blockIdx.x, h = blockIdx.y, kvh = h / 4, tid = threadIdx.x;
    __shared__ float q[64], sc[1024], red[256], ov[4][64];
    if (tid < 64) q[tid] = qkv[(size_t)row * 1536 + h * 64 + tid];
    __syncthreads();
    int nk; const bool samp = row >= MP; int seq0, t, b = 0, lo = 0;
    if (!samp) { seq0 = (row / 256) * 256; t = row % 256; nk = 256; }
    else { b = (row - MP) / 2048; seq0 = MP + b * 2048; t = (row - MP) % 2048; lo = max(0, t - 128); const int hi = min(2047, t + 128); nk = (hi - lo + 1) + 512; }
    const int nloc = samp ? nk - 512 : nk;
    float mx = sink[h];
    for (int j = tid; j < nk; j += 256) {
        const float* kp = j < nloc ? qkv + (size_t)(seq0 + lo + j) * 1536 + 1024 + kvh * 64 : ck + ((size_t)(b * 512 + (j - nloc)) * 4 + kvh) * 64;
        float s = 0; for (int d = 0; d < 64; ++d) s += q[d] * kp[d];
        s *= 0.125f; sc[j] = s; mx = fmaxf(mx, s);
    }
    red[tid] = mx; __syncthreads();
    for (int of = 128; of > 0; of >>= 1) { if (tid < of) red[tid] = fmaxf(red[tid], red[tid + of]); __syncthreads(); }
    mx = red[0]; __syncthreads();
    float sum = 0;
    for (int j = tid; j < nk; j += 256) { const float p = expf(sc[j] - mx); sc[j] = p; sum += p; }
    red[tid] = sum; __syncthreads();
    for (int of = 128; of > 0; of >>= 1) { if (tid < of) red[tid] += red[tid + of]; __syncthreads(); }
    sum = red[0] + expf(sink[h] - mx);
    const int d = tid & 63, part = tid >> 6; float acc = 0;
    for (int j = part; j < nk; j += 4) {
        const float* vp = j < nloc ? qkv + (size_t)(seq0 + lo + j) * 1536 + 1280 + kvh * 64 : cv + ((size_t)(b * 512 + (j - nloc)) * 4 + kvh) * 64;
        acc += sc[j] * vp[d];
    }
    ov[part][d] = acc; __syncthreads();
    if (tid < 64) o[(size_t)row * D + h * 64 + tid] = (ov[0][tid] + ov[1][tid] + ov[2][tid] + ov[3][tid]) / sum;
}
__device__ __forceinline__ float gelu_tanh(float x) { return 0.5f * x * (1.f + tanhf(0.7978845608028654f * (x + 0.044715f * x * x * x))); }
__global__ void k_sgu_act(float* z, const float* ln_g) {
    const int row = blockIdx.x; float* zr = z + (size_t)row * 2048;
    __shared__ float red[256];
    for (int i = threadIdx.x; i < 2048; i += 256) zr[i] = gelu_tanh(zr[i]);
    __syncthreads();
    float s = 0; for (int i = threadIdx.x; i < D; i += 256) s += zr[D + i];
    red[threadIdx.x] = s; __syncthreads();
    for (int o = 128; o > 0; o >>= 1) { if (threadIdx.x < o) red[threadIdx.x] += red[threadIdx.x + o]; __syncthreads(); }
    const float mu = red[0] / D; __syncthreads();
    s = 0; for (int i = threadIdx.x; i < D; i += 256) { const float dd = zr[D + i] - mu; s += dd * dd; }
    red[threadIdx.x] = s; __syncthreads();
    for (int o = 128; o > 0; o >>= 1) { if (threadIdx.x < o) red[threadIdx.x] += red[threadIdx.x + o]; __syncthreads(); }
    const float r = rsqrtf(red[0] / D + EPS);
    for (int i = threadIdx.x; i < D; i += 256) zr[D + i] = (zr[D + i] - mu) * r * ln_g[i];
}
__global__ void k_sgu_mix(const float* z, const float* ws, const float* bs, float* um) {
    const size_t i = (size_t)blockIdx.x * 256 + threadIdx.x; const int row = i / D, col = i % D, g = col / 128, p = row % 128, r0 = row - p;
    float s = bs[g * 128 + p];
    for (int r = 0; r < 128; ++r) s += ws[(g * 128 + p) * 128 + r] * z[(size_t)(r0 + r) * 2048 + D + col];
    um[i] = z[(size_t)row * 2048 + col] * s;
}
__global__ void k_sc_act(const float* p, const float* cw, float* by) {
    const size_t i = (size_t)blockIdx.x * 256 + threadIdx.x; const int row = i / D, col = i % D;
    const int T = row < MP ? 256 : 2048, t = row < MP ? row % 256 : (row - MP) % 2048;
    float y = 0;
    for (int j = 0; j < 3; ++j) { const int tt = t + j - 1; if (tt < 0 || tt >= T) continue; const float* pr = p + (size_t)(row + j - 1) * 3072; y += pr[D + col] * pr[2 * D + col] * cw[j * D + col]; }
    by[i] = p[(size_t)row * 3072 + col] * y;
}
__global__ void k_ffn_act(const float* a, const float* cw, float* act, int row0) {
    const size_t i = (size_t)blockIdx.x * 256 + threadIdx.x; const int lr = i / DFF, col = i % DFF, row = row0 + lr;
    const int T = row < MP ? 256 : 2048, t = row < MP ? row % 256 : (row - MP) % 2048;
    float g = 0, u = 0;
    for (int j = 0; j < 3; ++j) { const int tt = t + j - 1; if (tt < 0 || tt >= T) continue; const float* pr = a + (size_t)(lr + j - 1) * 2 * DFF; g += pr[col] * cw[j * 2 * DFF + col]; u += pr[DFF + col] * cw[j * 2 * DFF + DFF + col]; }
    act[i] = g / (1.f + expf(-g)) * u;
}
__global__ void k_dft_ch(float* m) { const int i = blockIdx.x * 256 + threadIdx.x; const int c = i / 128, cp = i % 128; const float a = 2.f * (float)((c * cp) % 128) / 128.f;
    m[i] = cospif(a) * 0.08838834764831845f; m[128 * 128 + i] = sinpif(a) * 0.08838834764831845f; }
__global__ void k_dft_t(float* m, int T) { const size_t i = (size_t)blockIdx.x * 256 + threadIdx.x; const int tp = i / T, t = i % T; const float a = 2.f * (float)((tp * t) % T) / (float)T, sc = rsqrtf((float)T);
    m[(size_t)tp * 2 * T + t] = cospif(a) * sc; m[(size_t)tp * 2 * T + T + t] = -sinpif(a) * sc; }

static void gemm(hipStream_t st, const float* A, int lda, size_t sA, const float* B, int ldb, size_t sB, float* C, int ldc, size_t sC, int Mm, int Nn, int K, int batch, float alpha = 1.f, float beta = 0.f) {
    hipLaunchKernelGGL(k_gemm, dim3(Nn / 64, Mm / 64, batch), dim3(256), 0, st, A, lda, sA, B, ldb, sB, C, ldc, sC, K, alpha, beta);
}

static void run(void* const* d_in, void* d_out, void* d_ws, size_t ws_size, hipStream_t st) {
    const float* x_prompt = (const float*)d_in[0]; const float* x_sample = (const float*)d_in[1];
    const float* cache_k = (const float*)d_in[2]; const float* cache_v = (const float*)d_in[3];
    const float* c = (const float*)d_in[4]; const float* c_ctx = (const float*)d_in[5];
    const float* ada_w = (const float*)d_in[6]; const float* ada_b = (const float*)d_in[7];
    const float* norm_mix_g = (const float*)d_in[8]; const float* norm_ffn_g = (const float*)d_in[9]; const float* final_g = (const float*)d_in[10];
    const float* attn_wqkv = (const float*)d_in[11]; const float* attn_wo = (const float*)d_in[12]; const float* attn_sink = (const float*)d_in[13];
    const float* sgu_w_in = (const float*)d_in[14]; const float* sgu_ln_g = (const float*)d_in[15]; const float* sgu_w_s = (const float*)d_in[16]; const float* sgu_b_s = (const float*)d_in[17]; const float* sgu_w_out = (const float*)d_in[18];
    const float* sc_w_in = (const float*)d_in[19]; const float* sc_conv = (const float*)d_in[20]; const float* sc_w_out = (const float*)d_in[21];
    const float* fn_w_out = (const float*)d_in[22]; const float* ffn_w_up = (const float*)d_in[23]; const float* ffn_conv = (const float*)d_in[24]; const float* ffn_w_down = (const float*)d_in[25];
    float* out = (float*)d_out;
    float* ws = (float*)d_ws;
    if (ws_size < (size_t)90000000 * 4) return;
    float* X = ws;
    float* H = X + (size_t)M * D;
    float* Dl = H;
    float* MOD = H + (size_t)M * D;
    float* T1 = MOD + 4 * 3 * 6 * D;
    float* T2 = T1 + (size_t)M * 3072;
    float* DFTC = T2 + (size_t)M * D;
    float* DFT256 = DFTC + 2 * 128 * 128;
    float* DFT2048 = DFT256 + 256 * 512;
    hipMemcpyAsync(X, x_prompt, (size_t)MP * D * 4, hipMemcpyDeviceToDevice, st);
    hipMemcpyAsync(X + (size_t)MP * D, x_sample, (size_t)MS * D * 4, hipMemcpyDeviceToDevice, st);
    hipLaunchKernelGGL(k_mod, dim3(4 * 6 * D / 256), dim3(256), 0, st, c, c_ctx, ada_w, ada_b, MOD);
    for (int l = 0; l < 4; ++l) {
        const float* modl = MOD + l * 3 * 6 * D;
        hipLaunchKernelGGL(k_norm, dim3(M), dim3(256), 0, st, X, norm_mix_g + l * D, modl, 0, H);
        if (l == 0) {
            gemm(st, H, D, 0, attn_wqkv, 1536, 0, T1, 1536, 0, M, 1536, D, 1);
            hipLaunchKernelGGL(k_copy_kv, dim3(MP * 256 / 256), dim3(256), 0, st, T1, out + (size_t)M * D, out + (size_t)M * D + MP * 256);
            hipLaunchKernelGGL(k_rope, dim3(MS * 20 * 32 / 256), dim3(256), 0, st, T1);
            hipLaunchKernelGGL(k_attn, dim3(M, 16), dim3(256), 0, st, T1, cache_k, cache_v, attn_sink, T2);
            gemm(st, T2, D, 0, attn_wo, D, 0, Dl, D, 0, M, D, D, 1);
        } else if (l == 1) {
            gemm(st, H, D, 0, sgu_w_in, 2048, 0, T1, 2048, 0, M, 2048, D, 1);
            hipLaunchKernelGGL(k_sgu_act, dim3(M), dim3(256), 0, st, T1, sgu_ln_g);
            hipLaunchKernelGGL(k_sgu_mix, dim3(M * D / 256), dim3(256), 0, st, T1, sgu_w_s, sgu_b_s, T2);
            gemm(st, T2, D, 0, sgu_w_out, D, 0, Dl, D, 0, M, D, D, 1);
        } else if (l == 2) {
            gemm(st, H, D, 0, sc_w_in, 3072, 0, T1, 3072, 0, M, 3072, D, 1);
            hipLaunchKernelGGL(k_sc_act, dim3(M * D / 256), dim3(256), 0, st, T1, sc_conv, T2);
            gemm(st, T2, D, 0, sc_w_out, D, 0, Dl, D, 0, M, D, D, 1);
        } else {
            hipLaunchKernelGGL(k_dft_ch, dim3(128 * 128 / 256), dim3(256), 0, st, DFTC);
            hipLaunchKernelGGL(k_dft_t, dim3(256 * 256 / 256), dim3(256), 0, st, DFT256, 256);
            hipLaunchKernelGGL(k_dft_t, dim3(2048 * 2048 / 256), dim3(256), 0, st, DFT2048, 2048);
            float* Yc = T1; float* Ys = T1 + (size_t)M * D;
            gemm(st, H, D, 128, DFTC, 128, 0, Yc, D, 128, M, 128, 128, 8);
            gemm(st, H, D, 128, DFTC + 128 * 128, 128, 0, Ys, D, 128, M, 128, 128, 8);
            gemm(st, DFT256, 512, 0, Yc, D, (size_t)256 * D, T2, D, (size_t)256 * D, 256, D, 256, 32, 1.f, 0.f);
            gemm(st, DFT256 + 256, 512, 0, Ys, D, (size_t)256 * D, T2, D, (size_t)256 * D, 256, D, 256, 32, 1.f, 1.f);
            gemm(st, DFT2048, 4096, 0, Yc + (size_t)MP * D, D, (size_t)2048 * D, T2 + (size_t)MP * D, D, (size_t)2048 * D, 2048, D, 2048, 2, 1.f, 0.f);
            gemm(st, DFT2048 + 2048, 4096, 0, Ys + (size_t)MP * D, D, (size_t)2048 * D, T2 + (size_t)MP * D, D, (size_t)2048 * D, 2048, D, 2048, 2, 1.f, 1.f);
            gemm(st, T2, D, 0, fn_w_out, D, 0, Dl, D, 0, M, D, D, 1);
        }
        hipLaunchKernelGGL(k_resid, dim3(M * D / 256), dim3(256), 0, st, X, Dl, modl, 2, X);
        hipLaunchKernelGGL(k_norm, dim3(M), dim3(256), 0, st, X, norm_ffn_g + l * D, modl, 3, H);
        for (int ch = 0; ch < 3; ++ch) {
            const int r0 = ch * 4096;
            gemm(st, H + (size_t)r0 * D, D, 0, ffn_w_up + (size_t)l * D * 2 * DFF, 2 * DFF, 0, T1, 2 * DFF, 0, 4096, 2 * DFF, D, 1);
            hipLaunchKernelGGL(k_ffn_act, dim3(4096 * DFF / 256), dim3(256), 0, st, T1, ffn_conv + (size_t)l * 3 * 2 * DFF, T2, r0);
            gemm(st, T2, DFF, 0, ffn_w_down + (size_t)l * DFF * D, D, 0, Dl + (size_t)r0 * D, D, 0, 4096, D, DFF, 1);
        }
        hipLaunchKernelGGL(k_resid, dim3(M * D / 256), dim3(256), 0, st, X, Dl, modl, 5, X);
    }
    hipLaunchKernelGGL(k_final, dim3(M), dim3(256), 0, st, X, final_g, out);
}
}

extern "C" void kernel_launch(void* const* d_in, const int* in_sizes, int n_in, void* d_out, int out_size, void* d_ws, size_t ws_size, hipStream_t stream) {
    slow::run(d_in, d_out, d_ws, ws_size, stream);
}
```

```cpp
#include <hip/hip_runtime.h>
#include <cstdio>

#define LAS __attribute__((address_space(3)))
#define GAS __attribute__((address_space(1)))
typedef unsigned short bf16_t;
typedef short bf16x8 __attribute__((ext_vector_type(8)));
typedef float f32x4 __attribute__((ext_vector_type(4)));
typedef float f32x2 __attribute__((ext_vector_type(2)));
typedef unsigned u32x4 __attribute__((ext_vector_type(4)));
typedef unsigned u32x2 __attribute__((ext_vector_type(2)));

constexpr int D = 1024, MP = 8192, MS = 4096, M = MP + MS, DFF = 2816, TS = 2048, TP = 256;
constexpr float EPS = 1e-6f;
constexpr int NWAVES = 8;
#ifndef MK_PER_PHASE
#define MK_PER_PHASE 0
#endif
#ifndef MK_PH_LO
#define MK_PH_LO 0
#endif
#ifndef MK_PH_HI
#define MK_PH_HI 29
#endif
#ifndef MK_MASK
#define MK_MASK 0xffffffffu
#endif
#define EN(b) (((MK_MASK) >> (b)) & 1u)

namespace pg8 {
constexpr int BM = 256, BK = 64, HALF = 128, HTB = HALF * BK * 2, STAGE_BYTES = 8 * HTB, NXCD = 8, WGM = 8;
__host__ __device__ __forceinline__ int lds_byte(int r, int c) { const int st = (r >> 4) * 2 + (c >> 5), rr = r & 15, cc = c & 31, ob = rr * 64 + cc * 2; return st * 1024 + (ob ^ (((ob >> 9) & 1) << 5)); }
__host__ __device__ __forceinline__ void stage_rc(int b, int& R, int& C) { const int st = b / 1024, sb = b % 1024, swz = sb ^ (((sb >> 9) & 1) << 5); R = (st >> 1) * 16 + swz / 64; C = (st & 1) * 32 + (swz % 64) / 2; }
__host__ __device__ __forceinline__ int perm32(int rho) { const int n = rho >> 4, i = rho & 15; return 8 * (i >> 2) + 4 * n + (i & 3); }

struct Unit { int pm, pn, row0; const char* a; const char* b; };
struct Cfg { int lda, ldb, nt; };

__device__ __forceinline__ unsigned cvt_pk_bf16(float lo, float hi) { unsigned r; asm volatile("v_cvt_pk_bf16_f32 %0, %1, %2" : "=v"(r) : "v"(lo), "v"(hi)); return r; }

template <int LDA, int LDB, int NT, class Epi, class Sched>
__device__ __forceinline__ void gemm_phase(LAS unsigned char* lds, const Sched& S, const Epi& E) {
    constexpr Cfg g{LDA, LDB, NT};
    int tid_ = threadIdx.x; asm volatile("" : "+v"(tid_));
    const int tid = tid_, wid = __builtin_amdgcn_readfirstlane(tid >> 6), lane = tid & 63, wr = wid >> 2, wc = wid & 3, fr = lane & 15, fq = lane >> 4;
    const int nt = g.nt;
    unsigned voffA[2], voffB[2];
#pragma unroll
    for (int i = 0; i < 2; ++i) { int R, C; stage_rc(tid * 16 + i * 8192, R, C); const int Rb = Epi::PERM ? ((R & ~31) + perm32(R & 31)) : R;
        voffA[i] = (unsigned)(R * g.lda + C) * 2u; voffB[i] = (unsigned)(Rb * g.ldb + C) * 2u; }
    const size_t kstep = (size_t)(BK * 2);
    const size_t hstepA = (size_t)HALF * g.lda * 2, hstepB = (size_t)HALF * g.ldb * 2;
    const unsigned ldsw = (unsigned)wid * 1024u;
    const int aoff = lds_byte(wr * 64 + fr, fq * 8), boff = lds_byte(wc * 32 + fr, fq * 8);
#define PG8_SA(b, h) (((b) * 2 + (h)) * HTB)
#define PG8_SB(b, h) ((4 + (b) * 2 + (h)) * HTB)
#define PG8_STAGE(bufoff, gbase, voff) do { _Pragma("unroll") for (int _i = 0; _i < 2; ++_i) { unsigned _vo = (voff)[_i]; asm volatile("" : "+v"(_vo)); \
        __builtin_amdgcn_global_load_lds((const unsigned*)((const char*)(gbase) + _vo), (LAS unsigned*)(lds + (bufoff) + ldsw + _i * 8192), 16, 0, 0); } } while (0)
#define PG8_LDA(dst, b, h) do { _Pragma("unroll") for (int m = 0; m < 4; ++m) _Pragma("unroll") for (int k = 0; k < 2; ++k) dst[m][k] = *(const LAS bf16x8*)(lds + PG8_SA(b, h) + aoff + m * 2048 + k * 1024); } while (0)
#define PG8_LDB(dst, b, h) do { _Pragma("unroll") for (int n = 0; n < 2; ++n) _Pragma("unroll") for (int k = 0; k < 2; ++k) dst[n][k] = *(const LAS bf16x8*)(lds + PG8_SB(b, h) + boff + n * 2048 + k * 1024); } while (0)
#define PG8_MMA(ai, bj, At, Bt) do { __builtin_amdgcn_s_setprio(1); _Pragma("unroll") for (int m = 0; m < 4; ++m) _Pragma("unroll") for (int n = 0; n < 2; ++n) _Pragma("unroll") for (int k = 0; k < 2; ++k) \
        acc[ai][bj][m][n] = __builtin_amdgcn_mfma_f32_16x16x32_bf16(Bt[n][k], At[m][k], acc[ai][bj][m][n], 0, 0, 0); __builtin_amdgcn_s_setprio(0); } while (0)
#define PG8_WAIT_V(n) asm volatile("s_waitcnt vmcnt(" #n ")" ::: "memory")
#define PG8_WAIT_L(n) asm volatile("s_waitcnt lgkmcnt(" #n ")" ::: "memory")
#define PG8_BAR __builtin_amdgcn_s_barrier()
#define PG8_SCHED __builtin_amdgcn_sched_barrier(0)
    Unit cur, nxt; int ui = 0;
    if (!S.next(0, cur)) return;
    f32x4 acc[2][2][4][2];
#pragma unroll
    for (int a = 0; a < 2; ++a)
#pragma unroll
        for (int b = 0; b < 2; ++b)
#pragma unroll
            for (int m = 0; m < 4; ++m)
#pragma unroll
                for (int n = 0; n < 2; ++n) acc[a][b][m][n] = (f32x4){0.f, 0.f, 0.f, 0.f};
    bf16x8 At[4][2], B0[2][2], B1[2][2];
    const char* cA = cur.a; const char* cB = cur.b;
    PG8_STAGE(PG8_SB(0, 0), cB, voffB); PG8_STAGE(PG8_SB(0, 1), cB + hstepB, voffB); PG8_STAGE(PG8_SA(0, 0), cA, voffA); PG8_STAGE(PG8_SA(0, 1), cA + hstepA, voffA);
    if (wr == 1) PG8_BAR;
    PG8_WAIT_V(2); PG8_BAR;
    PG8_STAGE(PG8_SB(1, 0), cB + kstep, voffB); PG8_STAGE(PG8_SA(1, 0), cA + kstep, voffA); PG8_STAGE(PG8_SB(1, 1), cB + hstepB + kstep, voffB);
    PG8_WAIT_V(6); PG8_BAR;
    for (;;) {
        const bool has_next = S.next(ui + 1, nxt);
        const char* nA = has_next ? nxt.a : cA; const char* nB = has_next ? nxt.b : cB;
        for (int t = 0; t < nt; t += 2) {
            const bool last = (t == nt - 2);
            const char* a1 = cA + (size_t)(t + 1) * kstep;
            const char* a2 = last ? nA : cA + (size_t)(t + 2) * kstep; const char* b2 = last ? nB : cB + (size_t)(t + 2) * kstep;
            const char* a3 = a2 + kstep; const char* b3 = b2 + kstep;
            PG8_LDB(B0, 0, 0); PG8_LDB(B1, 0, 1); PG8_SCHED; PG8_LDA(At, 0, 0); PG8_STAGE(PG8_SA(1, 1), a1 + hstepA, voffA);
            PG8_WAIT_V(8); PG8_WAIT_L(0); PG8_BAR; PG8_MMA(0, 0, At, B0); PG8_MMA(0, 1, At, B1); PG8_BAR; PG8_SCHED;
            PG8_LDA(At, 0, 1); PG8_STAGE(PG8_SB(0, 0), b2, voffB); PG8_STAGE(PG8_SB(0, 1), b2 + hstepB, voffB); PG8_STAGE(PG8_SA(0, 0), a2, voffA);
            PG8_WAIT_V(8); PG8_WAIT_L(0); PG8_BAR; PG8_MMA(1, 0, At, B0); PG8_MMA(1, 1, At, B1); PG8_BAR; PG8_SCHED;
            PG8_LDB(B0, 1, 0); PG8_LDB(B1, 1, 1); PG8_SCHED; PG8_LDA(At, 1, 0); PG8_STAGE(PG8_SA(0, 1), a2 + hstepA, voffA);
            PG8_WAIT_V(8); PG8_WAIT_L(0); PG8_BAR; PG8_MMA(0, 0, At, B0); PG8_MMA(0, 1, At, B1); PG8_BAR; PG8_SCHED;
            PG8_LDA(At, 1, 1); PG8_STAGE(PG8_SB(1, 0), b3, voffB); PG8_STAGE(PG8_SB(1, 1), b3 + hstepB, voffB); PG8_STAGE(PG8_SA(1, 0), a3, voffA);
            PG8_WAIT_V(8); PG8_WAIT_L(0); PG8_BAR; PG8_MMA(1, 0, At, B0); PG8_MMA(1, 1, At, B1); PG8_BAR; PG8_SCHED;
        }
        if (wr == 0) PG8_BAR;
        E(acc, cur, wr, wc, fr, fq, ui);
        if (!has_next) break;
#pragma unroll
        for (int a = 0; a < 2; ++a)
#pragma unroll
            for (int b = 0; b < 2; ++b)
#pragma unroll
                for (int m = 0; m < 4; ++m)
#pragma unroll
                    for (int n = 0; n < 2; ++n) acc[a][b][m][n] = (f32x4){0.f, 0.f, 0.f, 0.f};
        cur = nxt; cA = nA; cB = nB; ++ui;
        if (wr == 1) PG8_BAR;
    }
    PG8_WAIT_V(0);
    PG8_BAR;
#undef PG8_SA
#undef PG8_SB
#undef PG8_STAGE
#undef PG8_LDA
#undef PG8_LDB
#undef PG8_MMA
#undef PG8_WAIT_V
#undef PG8_WAIT_L
#undef PG8_BAR
#undef PG8_SCHED
}
}
using pg8::Unit; using pg8::cvt_pk_bf16;

constexpr size_t MiB = 1u << 20;
constexpr size_t WS_CTL = 0, CTL_ZERO_BYTES = 64 * 1024;
constexpr size_t WS_MOD = 1 * MiB;
constexpr size_t WS_ROPE = WS_MOD + 512 * 1024;
constexpr size_t WS_STATS = WS_ROPE + 64 * 1024;
constexpr size_t WS_WQKV = 4 * MiB;
constexpr size_t WS_WO = WS_WQKV + 3 * MiB;
constexpr size_t WS_WSGI = WS_WO + 2 * MiB;
constexpr size_t WS_WSGO = WS_WSGI + 4 * MiB;
constexpr size_t WS_WSCI = WS_WSGO + 2 * MiB;
constexpr size_t WS_WSCO = WS_WSCI + 6 * MiB;
constexpr size_t WS_WFNO = WS_WSCO + 2 * MiB;
constexpr size_t WS_WUP = WS_WFNO + 2 * MiB;
constexpr size_t WUP_BYTES = (size_t)2 * DFF * D * 2;
constexpr size_t WS_WDN = WS_WUP + 4 * WUP_BYTES;
constexpr size_t WDN_BYTES = (size_t)D * DFF * 2;
constexpr size_t WS_WS = WS_WDN + 4 * WDN_BYTES;
constexpr size_t WS_A1 = WS_WS + 256 * 1024;
constexpr size_t WS_A2P = WS_A1 + 256 * 1024;
constexpr size_t WS_A2S = WS_A2P + 256 * 1024;
constexpr size_t WS_CK = WS_A2S + 16 * MiB;
constexpr size_t WS_CVT = WS_CK + 512 * 1024;
constexpr size_t WS_X = WS_CVT + 512 * 1024;
constexpr size_t WS_H = WS_X + (size_t)M * D * 4;
constexpr size_t WS_BIG = WS_H + (size_t)(M + 256) * D * 2;
constexpr size_t WS_END = WS_BIG + 72 * MiB;
constexpr size_t WS_ACT = WS_BIG;
constexpr size_t WS_Q = WS_BIG;
constexpr size_t WS_KB = WS_Q + 24 * MiB;
constexpr size_t WS_VT = WS_KB + 6 * MiB;
constexpr size_t WS_U = WS_BIG;
constexpr size_t WS_V = WS_BIG + 24 * MiB;
constexpr size_t WS_YB = WS_BIG;
constexpr size_t WS_YT = WS_BIG;
static_assert(WS_YB + (size_t)256 * 2 * 16 * 512 * 16 <= WS_END, "yb");
static_assert(WS_ACT + (size_t)M * DFF * 2 <= WS_END, "act");
constexpr size_t WS_H2 = WS_END;
constexpr size_t WS_TOTAL = WS_H2 + (size_t)M * D * 2;

constexpr size_t OUT_NK = (size_t)M * D, OUT_NV = OUT_NK + (size_t)MP * 256;

#define XB_TMO      128
#define XB_XCNT(j)  (256  + 64 * (j))
#define XB_XSUB(j)  (1280 + 64 * (j))
#define XB_XGEN(j)  (2304 + 64 * (j))
#define XB_TOP      3328
#define XB_TOPGEN   3392
#define XCD_BAR_WORDS 3456
#define XB_SPIN_CAP (1u << 22)
__device__ __forceinline__ unsigned xb_ld(unsigned* p)              { return __hip_atomic_load(p, __ATOMIC_RELAXED, __HIP_MEMORY_SCOPE_AGENT); }
__device__ __forceinline__ unsigned xb_add(unsigned* p, unsigned v) { return __hip_atomic_fetch_add(p, v, __ATOMIC_RELAXED, __HIP_MEMORY_SCOPE_AGENT); }
__device__ __forceinline__ unsigned xb_xcc_id() { return (unsigned)__builtin_amdgcn_s_getreg((3 << 11) | 20) & 0xFu; }
#define XB_SPIN(cond, bar) do { unsigned _sp = 0; while (cond) { __builtin_amdgcn_s_sleep(1); \
    if ((++_sp & 255u) == 0u) { if (xb_ld(&(bar)[XB_TMO])) break; if (_sp > XB_SPIN_CAP) { atomicAdd(&(bar)[XB_TMO], 1u); break; } } } } while (0)
struct XcdBarrier { unsigned* bar; unsigned x; volatile LAS unsigned* st; };
__device__ __forceinline__ XcdBarrier xcd_barrier_post(unsigned* bar, volatile LAS unsigned* st) {
    XcdBarrier b; b.bar = bar; b.x = xb_xcc_id(); b.st = st;
    if (threadIdx.x == 0) (void)xb_add(&bar[XB_XCNT(b.x)], 1u);
    return b;
}
__device__ __forceinline__ void xcd_barrier_complete(unsigned* bar, unsigned x, unsigned& nloc, unsigned& nx) {
    const unsigned G = gridDim.x * gridDim.y * gridDim.z;
    unsigned sum, cnt, mine, sp = 0u;
    for (;;) {
        sum = 0u; cnt = 0u; mine = 0u;
#pragma unroll
        for (unsigned j = 0; j < 16; ++j) { const unsigned c = xb_ld(&bar[XB_XCNT(j)]); sum += c; cnt += (c > 0u) ? 1u : 0u; mine = (j == x) ? c : mine; }
        if (sum == G) break;
        __builtin_amdgcn_s_sleep(1);
        if ((++sp & 255u) == 0u) { if (xb_ld(&bar[XB_TMO])) break; if (sp > XB_SPIN_CAP) { atomicAdd(&bar[XB_TMO], 1u); break; } }
    }
    nloc = mine > 0u ? mine : 1u; nx = cnt > 0u ? cnt : 1u;
}
__device__ __forceinline__ void xcd_barrier(const XcdBarrier& b) {
    asm volatile("s_waitcnt vmcnt(0)" ::: "memory");
    __syncthreads();
    if (threadIdx.x == 0) {
        unsigned* bar = b.bar;
        __builtin_amdgcn_s_waitcnt(0);
        unsigned nloc = b.st[0], nx = b.st[1];
        if (nloc == 0u) { xcd_barrier_complete(bar, b.x, nloc, nx); b.st[0] = nloc; b.st[1] = nx; }
        const unsigned old = xb_add(&bar[XB_XSUB(b.x)], 1u);
        const unsigned gen = old / nloc;
        if (old + 1u == (gen + 1u) * nloc) {
            __builtin_amdgcn_fence(__ATOMIC_RELEASE, "agent");
            asm volatile("s_waitcnt vmcnt(0)" ::: "memory");
            const unsigned og = xb_add(&bar[XB_TOP], 1u);
            const unsigned tg = og / nx;
            if (og + 1u == (tg + 1u) * nx) xb_add(&bar[XB_TOPGEN], 1u);
            else XB_SPIN(xb_ld(&bar[XB_TOPGEN]) == tg, bar);
            __builtin_amdgcn_fence(__ATOMIC_ACQUIRE, "agent");
            xb_add(&bar[XB_XGEN(b.x)], 1u);
            asm volatile("s_waitcnt vmcnt(0)" ::: "memory");
        } else {
            XB_SPIN(xb_ld(&bar[XB_XGEN(b.x)]) == gen, bar);
            __builtin_amdgcn_fence(__ATOMIC_ACQUIRE, "agent");
            asm volatile("s_waitcnt vmcnt(0)" ::: "memory");
        }
    }
    __syncthreads();
}

#define LDS_WAIT() asm volatile("s_waitcnt lgkmcnt(0)" ::: "memory")
__device__ __forceinline__ unsigned f2bf(float f) { unsigned u = __builtin_bit_cast(unsigned, f); return (u + 0x7fffu + ((u >> 16) & 1u)) >> 16; }
__device__ __forceinline__ unsigned pk2(float lo, float hi) { return f2bf(lo) | (f2bf(hi) << 16); }
__device__ __forceinline__ float bf2f(unsigned short b) { return __builtin_bit_cast(float, (unsigned)b << 16); }
__device__ __forceinline__ float wave_sum(float v) {
#pragma unroll
    for (int o = 1; o < 64; o <<= 1) v += __shfl_xor(v, o);
    return v;
}
__device__ __forceinline__ float fast_exp2(float x) { return __builtin_amdgcn_exp2f(x); }
__device__ __forceinline__ float fast_rcp(float x) { return __builtin_amdgcn_rcpf(x); }
__device__ __forceinline__ float silu_f(float x) { return x * fast_rcp(1.f + fast_exp2(-1.4426950408889634f * x)); }
__device__ __forceinline__ float gelu_f(float x) { const float u = x * (1.f + 0.044715f * x * x); return x * fast_rcp(1.f + fast_exp2(-2.302208198f * u)); }
__device__ __forceinline__ int conv_row0(int pm) { if (pm < 32) return 256 * pm; const int s = (pm - 32) / 9, i = (pm - 32) % 9; return MP + TS * s + 254 * i - 1; }
template <int CTRL> __device__ __forceinline__ float dpp(float v) { return __builtin_bit_cast(float, __builtin_amdgcn_update_dpp(0, __builtin_bit_cast(int, v), CTRL, 0xf, 0xf, false)); }
template <int CTRL> __device__ __forceinline__ f32x4 dpp4(f32x4 v) { return (f32x4){dpp<CTRL>(v[0]), dpp<CTRL>(v[1]), dpp<CTRL>(v[2]), dpp<CTRL>(v[3])}; }
#define DPP_ROR1 0x121
#define DPP_ROR15 0x12F

template <int NM, int NN, int CONV, int LDA, int LDB>
struct Order {
    int G, c; const char* A; const char* B;
    __device__ __forceinline__ void init(int G_, int c_, const void* A_, const void* B_) { G = G_; c = c_; A = (const char*)A_; B = (const char*)B_; }
    __device__ __forceinline__ bool next(int i, Unit& u) const {
        constexpr int nwg = NM * NN;
        const int L = i * G + c; if (L >= nwg) return false;
        int wgid = L; { constexpr int q = nwg / pg8::NXCD, r = nwg % pg8::NXCD; const int xcd = wgid % pg8::NXCD, off = wgid / pg8::NXCD; wgid = (xcd < r ? xcd * (q + 1) : r * (q + 1) + (xcd - r) * q) + off; }
        constexpr int nig = pg8::WGM * NN; const int gid = wgid / nig, fm = gid * pg8::WGM, gsz = (NM - fm) < pg8::WGM ? (NM - fm) : pg8::WGM;
        u.pm = fm + ((wgid % nig) % gsz); u.pn = (wgid % nig) / gsz;
        u.row0 = CONV ? conv_row0(u.pm) : 256 * u.pm;
        u.a = A + (long)u.row0 * (long)(LDA * 2); u.b = B + (size_t)u.pn * (size_t)(256 * LDB * 2); return true;
    }
};

typedef const GAS float* cfp_t;
struct Frame {
    LAS unsigned char* lds; int tid, lane, wave, G, blk;
    const __attribute__((address_space(4))) cfp_t* in; float* out; unsigned char* ws;
};
__device__ __forceinline__ void frame_refresh(Frame& F) {
    int t = threadIdx.x; asm volatile("" : "+v"(t)); F.tid = t; F.lane = t & 63; F.wave = __builtin_amdgcn_readfirstlane(t >> 6);
}
constexpr int RING_BYTES = 131072, XCH_OFF = RING_BYTES  , MISC_OFF = XCH_OFF + 8192 + 320, LDS_BYTES = 147456;
__device__ __forceinline__ int vec_plain(int pm) { return pm < 32 ? 0 : 1 + (pm - 32) / 8; }
__device__ __forceinline__ int vec_conv(int pm) { return pm < 32 ? 0 : 1 + (pm - 32) / 9; }

struct EpiRes {
    static constexpr bool PERM = false;
    const float* src0; const float* src1; float* X; const float* modl; int gate_idx;
    __device__ __forceinline__ void operator()(const f32x4 (&acc)[2][2][4][2], const Unit& u, int wr, int wc, int fr, int fq, int) const {
        const int col0 = u.pn * 256 + wc * 32 + 4 * fq;
        const float* gate = modl + vec_plain(u.pm) * 6 * D + gate_idx * D;
        const float* src = u.row0 < MP ? src0 + (size_t)u.row0 * D : src1 + (size_t)(u.row0 - MP) * D;
        f32x4 gv[2][2];
#pragma unroll
        for (int bj = 0; bj < 2; ++bj)
#pragma unroll
            for (int n = 0; n < 2; ++n) gv[bj][n] = *(const f32x4*)(gate + col0 + bj * 128 + n * 16);
#pragma unroll
        for (int ai = 0; ai < 2; ++ai)
#pragma unroll
            for (int m = 0; m < 4; ++m) { const int r = ai * 128 + wr * 64 + m * 16 + fr; const float* sp = src + (size_t)r * D + col0; float* xp = X + (size_t)(u.row0 + r) * D + col0;
#pragma unroll
                for (int bj = 0; bj < 2; ++bj)
#pragma unroll
                    for (int n = 0; n < 2; ++n) { const f32x4 s = *(const f32x4*)(sp + bj * 128 + n * 16); *(f32x4*)(xp + bj * 128 + n * 16) = s + gv[bj][n] * acc[ai][bj][m][n]; }
                asm volatile("" ::: "memory"); }
    }
};
struct EpiBf16 {
    static constexpr bool PERM = true;
    bf16_t* O; int ldc;
    __device__ __forceinline__ void operator()(const f32x4 (&acc)[2][2][4][2], const Unit& u, int wr, int wc, int fr, int fq, int) const {
        const int col0 = u.pn * 256 + wc * 32 + 8 * fq;
#pragma unroll
        for (int ai = 0; ai < 2; ++ai)
#pragma unroll
            for (int m = 0; m < 4; ++m) { bf16_t* rowp = O + (size_t)(u.row0 + ai * 128 + wr * 64 + m * 16 + fr) * ldc + col0;
#pragma unroll
                for (int bj = 0; bj < 2; ++bj) { const f32x4 v0 = acc[ai][bj][m][0], v1 = acc[ai][bj][m][1];
                    u32x4 w; w.x = cvt_pk_bf16(v0[0], v0[1]); w.y = cvt_pk_bf16(v0[2], v0[3]); w.z = cvt_pk_bf16(v1[0], v1[1]); w.w = cvt_pk_bf16(v1[2], v1[3]);
                    *(u32x4*)(rowp + bj * 128) = w; } }
    }
};
struct EpiQKV {
    static constexpr bool PERM = false;
    bf16_t* Q; bf16_t* KB; bf16_t* VT; float* outk; float* outv; const float* rope;
    __device__ __forceinline__ void operator()(f32x4 (&acc)[2][2][4][2], const Unit& u, int wr, int wc, int fr, int fq, int) const {
        const bool samp = u.pm >= 32;
        const int c0 = wc * 32 + 4 * fq;
        if (samp && u.pn <= 4) {
            const int half = wc & 1;
#pragma unroll
            for (int ai = 0; ai < 2; ++ai)
#pragma unroll
                for (int m = 0; m < 4; ++m) { const int t = (u.row0 - MP + ai * 128 + wr * 64 + m * 16 + fr) & (TS - 1); const int pos = half ? (t & 63) : (t >> 6);
                    const f32x4 cs = *(const f32x4*)(rope + pos * 16 + 4 * fq), sn = *(const f32x4*)(rope + 1024 + pos * 16 + 4 * fq);
#pragma unroll
                    for (int bj = 0; bj < 2; ++bj) { const f32x4 x1 = acc[ai][bj][m][0], x2 = acc[ai][bj][m][1]; acc[ai][bj][m][0] = x1 * cs - x2 * sn; acc[ai][bj][m][1] = x2 * cs + x1 * sn; } }
        }
        if (u.pn <= 4) {
            bf16_t* base = u.pn < 4 ? Q + u.pn * 256 : KB; const int ldc = u.pn < 4 ? D : 256;
#pragma unroll
            for (int ai = 0; ai < 2; ++ai)
#pragma unroll
                for (int m = 0; m < 4; ++m) { const int row = u.row0 + ai * 128 + wr * 64 + m * 16 + fr; bf16_t* rowp = base + (size_t)row * ldc + c0;
#pragma unroll
                    for (int bj = 0; bj < 2; ++bj)
#pragma unroll
                        for (int n = 0; n < 2; ++n) { const f32x4 v = acc[ai][bj][m][n]; u32x2 w; w.x = cvt_pk_bf16(v[0], v[1]); w.y = cvt_pk_bf16(v[2], v[3]); *(u32x2*)(rowp + bj * 128 + n * 16) = w;
                            if (u.pn == 4 && !samp) *(f32x4*)(outk + (size_t)row * 256 + c0 + bj * 128 + n * 16) = v; } }
        } else {
            const int T = samp ? TS : TP;
            bf16_t* vt = samp ? VT + (size_t)32 * 65536 + (size_t)((u.row0 - MP) / TS) * 256 * TS : VT + (size_t)(u.row0 / TP) * 65536;
#pragma unroll
            for (int ai = 0; ai < 2; ++ai)
#pragma unroll
                for (int m = 0; m < 4; ++m) { const int row = u.row0 + ai * 128 + wr * 64 + m * 16 + fr; const int t = samp ? ((row - MP) & (TS - 1)) : (row & (TP - 1));
                    unsigned vo = (unsigned)(c0 * T + t); asm volatile("" : "+v"(vo));
#pragma unroll
                    for (int bj = 0; bj < 2; ++bj)
#pragma unroll
                        for (int n = 0; n < 2; ++n) { const f32x4 v = acc[ai][bj][m][n]; const int c = c0 + bj * 128 + n * 16;
#pragma unroll
                            for (int j = 0; j < 4; ++j) vt[vo + (unsigned)((bj * 128 + n * 16 + j) * T)] = (bf16_t)f2bf(v[j]);
                            if (!samp) *(f32x4*)(outv + (size_t)row * 256 + c) = v; } }
        }
    }
};
__device__ __forceinline__ f32x4 conv_m(f32x4 cur, f32x4 pe, f32x4 ne, f32x4 w0, f32x4 w1, f32x4 w2, int fr) {
    const f32x4 up = dpp4<DPP_ROR1>(cur), dn = dpp4<DPP_ROR15>(cur);
    const f32x4 prev = fr > 0 ? up : pe, next = fr < 15 ? dn : ne;
    return w0 * prev + w1 * cur + w2 * next;
}
__device__ __forceinline__ void mask_rows(f32x4 (&acc)[2][2][4][2], const Unit& u, int wr, int fr) {
    if (u.pm < 32) return;
    const int i = (u.pm - 32) % 9; if (i != 0 && i != 8) return;
    const int t0 = 254 * i - 1;
#pragma unroll
    for (int ai = 0; ai < 2; ++ai)
#pragma unroll
        for (int m = 0; m < 4; ++m) { const int t = t0 + ai * 128 + wr * 64 + m * 16 + fr; if (t < 0 || t >= TS) {
#pragma unroll
            for (int bj = 0; bj < 2; ++bj)
#pragma unroll
                for (int n = 0; n < 2; ++n) acc[ai][bj][m][n] = (f32x4){0.f, 0.f, 0.f, 0.f}; } }
}
__device__ __forceinline__ bool row_valid(const Unit& u, int r) {
    if (u.pm < 32) return true;
    const int t = 254 * ((u.pm - 32) % 9) - 1 + r; return r >= 1 && r <= 254 && t >= 0 && t < TS;
}
__device__ __forceinline__ void xch_write(LAS float* X, const f32x4 (&acc)[2][2][4][2], int wr, int wc, int fr, int fq) {
#pragma unroll
    for (int ai = 0; ai < 2; ++ai)
#pragma unroll
        for (int bj = 0; bj < 2; ++bj)
#pragma unroll
            for (int n = 0; n < 2; ++n) { const int col = bj * 128 + wc * 32 + 8 * fq + 4 * n;
                if (fr == 0) *(LAS f32x4*)(X + ((2 * ai + wr) * 2 + 0) * 256 + col) = acc[ai][bj][0][n];
                if (fr == 15) *(LAS f32x4*)(X + ((2 * ai + wr) * 2 + 1) * 256 + col) = acc[ai][bj][3][n]; }
}
__device__ __forceinline__ f32x4 xch_top(const LAS float* X, int b, int col) { return b > 0 ? *(const LAS f32x4*)(X + ((b - 1) * 2 + 1) * 256 + col) : (f32x4){0.f, 0.f, 0.f, 0.f}; }
__device__ __forceinline__ f32x4 xch_bot(const LAS float* X, int b, int col) { return b < 3 ? *(const LAS f32x4*)(X + ((b + 1) * 2 + 0) * 256 + col) : (f32x4){0.f, 0.f, 0.f, 0.f}; }

struct EpiUp {
    static constexpr bool PERM = true;
    bf16_t* ACT; const float* cw; LAS float* X;
    __device__ __forceinline__ void operator()(f32x4 (&acc)[2][2][4][2], const Unit& u, int wr, int wc, int fr, int fq, int) const {
        asm volatile("" : "+v"(fr), "+v"(fq));
        mask_rows(acc, u, wr, fr);
        xch_write(X, acc, wr, wc, fr, fq);
        LDS_WAIT(); __builtin_amdgcn_s_barrier(); asm volatile("" ::: "memory");
        const int chl = wc * 32 + 8 * fq;
#pragma unroll
        for (int n = 0; n < 2; ++n) {
            const int ch = u.pn * 128 + chl + 4 * n;
            f32x4 wg[3], wu[3];
#pragma unroll
            for (int k = 0; k < 3; ++k) { wg[k] = *(const f32x4*)(cw + k * 2 * DFF + ch); wu[k] = *(const f32x4*)(cw + k * 2 * DFF + DFF + ch); }
#pragma unroll
            for (int ai = 0; ai < 2; ++ai) {
                const int b = 2 * ai + wr;
                f32x4 pg = xch_top(X, b, chl + 4 * n), pu = xch_top(X, b, 128 + chl + 4 * n);
#pragma unroll
                for (int m = 0; m < 4; ++m) { const int r = ai * 128 + wr * 64 + m * 16 + fr;
                    const f32x4 vg = acc[ai][0][m][n], vu = acc[ai][1][m][n];
                    const f32x4 ng = m < 3 ? dpp4<DPP_ROR15>(acc[ai][0][m < 3 ? m + 1 : 3][n]) : xch_bot(X, b, chl + 4 * n);
                    const f32x4 nu = m < 3 ? dpp4<DPP_ROR15>(acc[ai][1][m < 3 ? m + 1 : 3][n]) : xch_bot(X, b, 128 + chl + 4 * n);
                    const f32x4 og = conv_m(vg, pg, ng, wg[0], wg[1], wg[2], fr), ou = conv_m(vu, pu, nu, wu[0], wu[1], wu[2], fr);
                    pg = dpp4<DPP_ROR1>(vg); pu = dpp4<DPP_ROR1>(vu);
                    f32x4 a;
#pragma unroll
                    for (int j = 0; j < 4; ++j) a[j] = silu_f(og[j]) * ou[j];
                    if (row_valid(u, r)) { u32x2 w; w.x = cvt_pk_bf16(a[0], a[1]); w.y = cvt_pk_bf16(a[2], a[3]); *(u32x2*)(ACT + (size_t)(u.row0 + r) * DFF + ch) = w; } }
            }
        }
    }
};
struct EpiSgu {
    static constexpr bool PERM = true;
    bf16_t* U; bf16_t* V; f32x2* STATS;
    __device__ __forceinline__ void operator()(f32x4 (&acc)[2][2][4][2], const Unit& u, int wr, int wc, int fr, int fq, int) const {
        const bool isv = u.pn >= 4; bf16_t* O = isv ? V : U; const int col0 = (u.pn & 3) * 256 + wc * 32 + 8 * fq;
#pragma unroll
        for (int ai = 0; ai < 2; ++ai)
#pragma unroll
            for (int m = 0; m < 4; ++m) { const int row = u.row0 + ai * 128 + wr * 64 + m * 16 + fr; bf16_t* rowp = O + (size_t)row * D + col0; float s1 = 0.f, s2 = 0.f;
#pragma unroll
                for (int bj = 0; bj < 2; ++bj) { f32x4 v0 = acc[ai][bj][m][0], v1 = acc[ai][bj][m][1];
#pragma unroll
                    for (int j = 0; j < 4; ++j) { v0[j] = gelu_f(v0[j]); v1[j] = gelu_f(v1[j]); s1 += v0[j] + v1[j]; s2 += v0[j] * v0[j] + v1[j] * v1[j]; }
                    u32x4 w; w.x = cvt_pk_bf16(v0[0], v0[1]); w.y = cvt_pk_bf16(v0[2], v0[3]); w.z = cvt_pk_bf16(v1[0], v1[1]); w.w = cvt_pk_bf16(v1[2], v1[3]);
                    *(u32x4*)(rowp + bj * 128) = w; }
                if (isv) { s1 += __shfl_xor(s1, 16); s1 += __shfl_xor(s1, 32); s2 += __shfl_xor(s2, 16); s2 += __shfl_xor(s2, 32);
                    if (fq == 0) STATS[(size_t)row * 16 + (u.pn - 4) * 4 + wc] = (f32x2){s1, s2}; } }
    }
};
struct EpiSc {
    static constexpr bool PERM = true;
    f32x4* YB; bf16_t* BY; const float* cw; LAS float* X;
    __device__ __forceinline__ void operator()(f32x4 (&acc)[2][2][4][2], const Unit& u, int wr, int wc, int fr, int fq, int ui) const {
        asm volatile("" : "+v"(fr), "+v"(fq));
        const int q = u.pn / 3, s = u.pn % 3, chl = wc * 32 + 8 * fq;
        if (s < 2) {
            mask_rows(acc, u, wr, fr);
#pragma unroll
            for (int ai = 0; ai < 2; ++ai)
#pragma unroll
                for (int m = 0; m < 4; ++m)
#pragma unroll
                    for (int n = 0; n < 2; ++n) acc[ai][0][m][n] = acc[ai][0][m][n] * acc[ai][1][m][n];
            xch_write(X, acc, wr, wc, fr, fq);
            LDS_WAIT(); __builtin_amdgcn_s_barrier(); asm volatile("" ::: "memory");
#pragma unroll
            for (int n = 0; n < 2; ++n) {
                const int ch = q * 256 + s * 128 + chl + 4 * n;
                f32x4 w[3];
#pragma unroll
                for (int k = 0; k < 3; ++k) w[k] = *(const f32x4*)(cw + k * D + ch);
#pragma unroll
                for (int ai = 0; ai < 2; ++ai) { const int b = 2 * ai + wr;
                    f32x4 pp = xch_top(X, b, chl + 4 * n);
#pragma unroll
                    for (int m = 0; m < 4; ++m) { const f32x4 v = acc[ai][0][m][n];
                        const f32x4 nn = m < 3 ? dpp4<DPP_ROR15>(acc[ai][0][m < 3 ? m + 1 : 3][n]) : xch_bot(X, b, chl + 4 * n);
                        const f32x4 o = conv_m(v, pp, nn, w[0], w[1], w[2], fr); pp = dpp4<DPP_ROR1>(v);
                        unsigned yo = (unsigned)((s * 16 + (ai * 4 + m) * 2 + n) * 512) + threadIdx.x; asm volatile("" : "+v"(yo)); YB[yo] = o; } }
            }
        } else {
#pragma unroll
            for (int ai = 0; ai < 2; ++ai)
#pragma unroll
                for (int m = 0; m < 4; ++m) { const int r = ai * 128 + wr * 64 + m * 16 + fr; const bool ok = row_valid(u, r);
#pragma unroll
                    for (int bj = 0; bj < 2; ++bj) { unsigned yo = (unsigned)((bj * 16 + (ai * 4 + m) * 2) * 512) + threadIdx.x; asm volatile("" : "+v"(yo)); const f32x4 y0 = YB[yo], y1 = YB[yo + 512];
                        const f32x4 v0 = acc[ai][bj][m][0] * y0, v1 = acc[ai][bj][m][1] * y1;
                        u32x4 w; w.x = cvt_pk_bf16(v0[0], v0[1]); w.y = cvt_pk_bf16(v0[2], v0[3]); w.z = cvt_pk_bf16(v1[0], v1[1]); w.w = cvt_pk_bf16(v1[2], v1[3]);
                        if (ok) *(u32x4*)(BY + (size_t)(u.row0 + r) * D + q * 256 + bj * 128 + chl) = w; }
                    asm volatile("" ::: "memory"); }
        }
    }
};
struct OrderSc {
    int c; const char* A; const char* B;
    __device__ __forceinline__ bool next(int i, Unit& u) const {
        if (c >= 200 || i >= 3) return false;
        u.pm = c >> 2; u.pn = 3 * (c & 3) + i; u.row0 = conv_row0(u.pm); u.a = A + (long)u.row0 * (D * 2); u.b = B + (size_t)u.pn * 256 * D * 2; return true; }
};
struct EpiFn1 {
    static constexpr bool PERM = true;
    bf16_t* YT;
    __device__ __forceinline__ void operator()(const f32x4 (&acc)[2][2][4][2], const Unit& u, int wr, int wc, int fr, int fq, int) const {
        const int part = u.pm & 1, ch0 = (u.pm >> 1) * 256, tok0 = u.pn * 256;
        bf16_t* base; int T, t0;
        if (tok0 < MP) { T = TP; base = YT + (size_t)(tok0 / TP) * D * 2 * TP; t0 = 0; }
        else { T = TS; base = YT + (size_t)32 * D * 2 * TP + (size_t)((tok0 - MP) / TS) * D * 2 * TS; t0 = (tok0 - MP) % TS; }
        const int c0 = wc * 32 + 8 * fq;
#pragma unroll
        for (int ai = 0; ai < 2; ++ai)
#pragma unroll
            for (int m = 0; m < 4; ++m) { bf16_t* rowp = base + (size_t)(ch0 + ai * 128 + wr * 64 + m * 16 + fr) * 2 * T + part * T + t0 + c0;
#pragma unroll
                for (int bj = 0; bj < 2; ++bj) { const f32x4 v0 = acc[ai][bj][m][0], v1 = acc[ai][bj][m][1];
                    u32x4 w; w.x = cvt_pk_bf16(v0[0], v0[1]); w.y = cvt_pk_bf16(v0[2], v0[3]); w.z = cvt_pk_bf16(v1[0], v1[1]); w.w = cvt_pk_bf16(v1[2], v1[3]);
                    *(u32x4*)(rowp + bj * 128) = w; } }
    }
};
struct OrderFn1 {
    int G, c; const char* A1; const char* H;
    __device__ __forceinline__ bool next(int i, Unit& u) const {
        const int L = i * G + c; if (L >= 384) return false;
        u.pm = L & 7; u.pn = L >> 3; u.row0 = 0; u.a = A1 + (size_t)(u.pm & 1) * 256 * 256 * 2; u.b = H + (size_t)u.pn * 256 * D * 2 + (size_t)(u.pm >> 1) * 512; return true; }
};
struct OrderFn2 {
    int c; int samp; const char* A2; const char* YT;
    __device__ __forceinline__ bool next(int i, Unit& u) const {
        if (i > 0) return false;
        if (samp) { if (c >= 64) return false; const int b = c >> 5, tm = (c >> 2) & 7; u.pm = tm; u.pn = c & 3; u.row0 = MP + b * TS + 256 * tm;
            u.a = A2 + (size_t)tm * 256 * 2 * TS * 2; u.b = YT + (size_t)32 * D * 2 * TP * 2 + (size_t)b * D * 2 * TS * 2 + (size_t)u.pn * 256 * 2 * TS * 2; return true; }
        if (c < 64 || c >= 192) return false; const int j = c - 64, s = j >> 2; u.pm = 0; u.pn = j & 3; u.row0 = s * TP;
        u.a = A2; u.b = YT + (size_t)s * D * 2 * TP * 2 + (size_t)u.pn * 256 * 2 * TP * 2; return true; }
};

__device__ __forceinline__ void p0_transpose_item(const float* W, int K, int N, bf16_t* WT, int drow0, LAS float* scr, int kb, int n0, int lane) {
    const int k0 = 64 * kb;
#pragma unroll 8
    for (int i = 0; i < 32; ++i) { const int kk = 2 * i + (lane >> 5); scr[kk * 33 + (lane & 31)] = W[(size_t)(k0 + kk) * N + n0 + (lane & 31)]; }
    LDS_WAIT(); asm volatile("" ::: "memory");
    const int c = lane & 7;
#pragma unroll
    for (int j = 0; j < 4; ++j) { const int n = (lane >> 3) + 8 * j; const LAS float* s = scr + (8 * c) * 33 + n;
        u32x4 o; o.x = pk2(s[0 * 33], s[1 * 33]); o.y = pk2(s[2 * 33], s[3 * 33]); o.z = pk2(s[4 * 33], s[5 * 33]); o.w = pk2(s[6 * 33], s[7 * 33]);
        *(u32x4*)(WT + (size_t)(drow0 + n) * K + k0 + 8 * c) = o; }
    LDS_WAIT(); asm volatile("" ::: "memory");
}
__device__ __forceinline__ int map_plain(int n) { return n; }
__device__ __forceinline__ int map_up(int n) { return n < DFF ? 256 * (n >> 7) + (n & 127) : 256 * ((n - DFF) >> 7) + 128 + ((n - DFF) & 127); }
__device__ __forceinline__ int map_sc(int n) {
    if (n < D) return (3 * (n >> 8) + 2) * 256 + (n & 255);
    const int x = n >= 2 * D, ch = n - D - x * D; return (3 * (ch >> 8) + ((ch >> 7) & 1)) * 256 + x * 128 + (ch & 127);
}
__device__ __forceinline__ void p0_tjob(int& it, int NGW, LAS float* scr, int lane, const float* W, bf16_t* WT, int K, int N, int map) {
    const int nblk = N / 32, nitems = (K / 64) * nblk;
    for (; it < nitems; it += NGW) { const int kb = it / nblk, n0 = (it % nblk) * 32; const int dr = map == 0 ? n0 : (map == 1 ? map_up(n0) : map_sc(n0));
        p0_transpose_item(W, K, N, WT, dr, scr, kb, n0, lane); }
    it -= nitems;
}
__device__ __forceinline__ void p0_prologue(Frame& F) {
    unsigned char* ws = F.ws;
    {
        LAS float* scr = (LAS float*)(F.lds + F.wave * 16384);
        const int gw = F.blk * NWAVES + F.wave, NGW = F.G * NWAVES;
        int it = gw;
        p0_tjob(it, NGW, scr, F.lane, ((const float*)F.in[11]), (bf16_t*)(ws + WS_WQKV), D, 1536, 0);
        p0_tjob(it, NGW, scr, F.lane, ((const float*)F.in[12]), (bf16_t*)(ws + WS_WO), D, D, 0);
        p0_tjob(it, NGW, scr, F.lane, ((const float*)F.in[14]), (bf16_t*)(ws + WS_WSGI), D, 2048, 0);
        p0_tjob(it, NGW, scr, F.lane, ((const float*)F.in[18]), (bf16_t*)(ws + WS_WSGO), D, D, 0);
        p0_tjob(it, NGW, scr, F.lane, ((const float*)F.in[19]), (bf16_t*)(ws + WS_WSCI), D, 3072, 2);
        p0_tjob(it, NGW, scr, F.lane, ((const float*)F.in[21]), (bf16_t*)(ws + WS_WSCO), D, D, 0);
        p0_tjob(it, NGW, scr, F.lane, ((const float*)F.in[22]), (bf16_t*)(ws + WS_WFNO), D, D, 0);
#pragma unroll 1
        for (int l = 0; l < 4; ++l) p0_tjob(it, NGW, scr, F.lane, ((const float*)F.in[23]) + (size_t)l * D * 2 * DFF, (bf16_t*)(ws + WS_WUP + l * WUP_BYTES), D, 2 * DFF, 1);
#pragma unroll 1
        for (int l = 0; l < 4; ++l) p0_tjob(it, NGW, scr, F.lane, ((const float*)F.in[25]) + (size_t)l * DFF * D, (bf16_t*)(ws + WS_WDN + l * WDN_BYTES), DFF, D, 0);
    }
    __syncthreads();
    {
        LAS float* sv = (LAS float*)F.lds;
        LAS float* red = sv + 3 * D;
        for (int i = F.tid; i < D; i += 512) { const float a = ((const float*)F.in[5])[i], b = ((const float*)F.in[4])[i], d = ((const float*)F.in[4])[D + i];
            sv[i] = a / (1.f + expf(-a)); sv[D + i] = b / (1.f + expf(-b)); sv[2 * D + i] = d / (1.f + expf(-d)); }
        __syncthreads();
        float* MODp = (float*)(ws + WS_MOD);
        const int kg = F.tid >> 3, cq = F.tid & 7;
        for (int it = F.blk; it < 768; it += F.G) {
            const int l = it / 192, n0 = (it % 192) * 32;
            const float* w = ((const float*)F.in[6]) + (size_t)l * D * 6 * D + n0 + 4 * cq;
            f32x4 a0 = {0, 0, 0, 0}, a1 = a0, a2 = a0;
#pragma unroll 4
            for (int k = kg; k < D; k += 64) { const f32x4 wv = *(const f32x4*)(w + (size_t)k * 6 * D); a0 += sv[k] * wv; a1 += sv[D + k] * wv; a2 += sv[2 * D + k] * wv; }
            *(LAS f32x4*)(red + (kg * 3 + 0) * 32 + 4 * cq) = a0; *(LAS f32x4*)(red + (kg * 3 + 1) * 32 + 4 * cq) = a1; *(LAS f32x4*)(red + (kg * 3 + 2) * 32 + 4 * cq) = a2;
            __syncthreads();
            if (F.tid < 96) { const int v = F.tid >> 5, cc = F.tid & 31; float s = 0.f;
                for (int g = 0; g < 64; ++g) s += red[(g * 3 + v) * 32 + cc];
                MODp[(l * 3 + v) * 6 * D + n0 + cc] = s + ((const float*)F.in[7])[l * 6 * D + n0 + cc]; }
            __syncthreads();
        }
    }
    {
        const size_t gt = (size_t)F.blk * 512 + F.tid, NGT = (size_t)F.G * 512;
        bf16_t* CK = (bf16_t*)(ws + WS_CK); bf16_t* CVT = (bf16_t*)(ws + WS_CVT); bf16_t* WSb = (bf16_t*)(ws + WS_WS);
        for (size_t i = gt; i < 2 * 512 * 256; i += NGT) { CK[i] = (bf16_t)f2bf(((const float*)F.in[2])[i]);
            const int d = i & 63, kvh = (i >> 6) & 3, j = (i >> 8) & 511, b = i >> 17; CVT[((size_t)(b * 4 + kvh) * 64 + d) * 512 + j] = (bf16_t)f2bf(((const float*)F.in[3])[i]); }
        for (size_t i = gt; i < 8 * 128 * 128; i += NGT) WSb[i] = (bf16_t)f2bf(((const float*)F.in[16])[i]);
        float* rope = (float*)(ws + WS_ROPE);
        for (size_t i = gt; i < 1024; i += NGT) { const int pos = i >> 4, fi = i & 15; const float ang = (float)pos * powf(10000.f, -(float)fi / 16.f); rope[i] = cosf(ang); rope[1024 + i] = sinf(ang); }
        bf16_t* A1 = (bf16_t*)(ws + WS_A1);
        for (size_t i = gt; i < 2 * 256 * 256; i += NGT) { const int part = i >> 16, r = (i >> 8) & 255, k = i & 255; float v = 0.f;
            if ((r >> 7) == (k >> 7)) { const float a = 2.f * (float)(((r & 127) * (k & 127)) & 127) / 128.f; v = (part ? sinpif(a) : cospif(a)) * 0.08838834764831845f; }
            A1[i] = (bf16_t)f2bf(v); }
        bf16_t* A2P = (bf16_t*)(ws + WS_A2P);
        for (size_t i = gt; i < 256 * 512; i += NGT) { const int tp = i >> 9, k = i & 511, t = k & 255; const float a = 2.f * (float)((tp * t) & 255) / 256.f;
            A2P[i] = (bf16_t)f2bf((k < 256 ? cospif(a) : -sinpif(a)) * 0.0625f); }
        bf16_t* A2S = (bf16_t*)(ws + WS_A2S);
        for (size_t i = gt; i < (size_t)2048 * 4096; i += NGT) { const int tp = i >> 12, k = i & 4095, t = k & 2047; const float a = 2.f * (float)((tp * t) & 2047) / 2048.f;
            A2S[i] = (bf16_t)f2bf((k < 2048 ? cospif(a) : -sinpif(a)) * 0.022097086912079608f); }
    }
}

__device__ __forceinline__ void norm_phase(Frame& F, const float* src0, const float* src1, const float* g, const float* modl, int sh_idx, bf16_t* H) {
    const int gw = F.blk * NWAVES + F.wave, NGW = F.G * NWAVES;
    f32x4 gv[4];
#pragma unroll
    for (int j = 0; j < 4; ++j) gv[j] = *(const f32x4*)(g + 256 * j + 4 * F.lane);
    for (int row = gw; row < M; row += NGW) {
        const float* xr = row < MP ? src0 + (size_t)row * D : src1 + (size_t)(row - MP) * D;
        const float* mv = modl + (row < MP ? 0 : 1 + (row - MP) / TS) * 6 * D;
        f32x4 v[4]; float s = 0.f;
#pragma unroll
        for (int j = 0; j < 4; ++j) { v[j] = *(const f32x4*)(xr + 256 * j + 4 * F.lane); s += (v[j][0] * v[j][0] + v[j][1] * v[j][1]) + (v[j][2] * v[j][2] + v[j][3] * v[j][3]); }
        const float r = rsqrtf(wave_sum(s) * (1.f / D) + EPS);
#pragma unroll
        for (int j = 0; j < 4; ++j) { const f32x4 sh = *(const f32x4*)(mv + sh_idx * D + 256 * j + 4 * F.lane), sc = *(const f32x4*)(mv + (sh_idx + 1) * D + 256 * j + 4 * F.lane);
            const f32x4 o = v[j] * r * gv[j] * (1.f + sc) + sh;
            u32x2 w; w.x = pk2(o[0], o[1]); w.y = pk2(o[2], o[3]); *(u32x2*)(H + (size_t)row * D + 256 * j + 4 * F.lane) = w; }
    }
}
__device__ __forceinline__ void final_phase(Frame& F, const float* X, const float* g, float* out) {
    const int gw = F.blk * NWAVES + F.wave, NGW = F.G * NWAVES;
    f32x4 gv[4];
#pragma unroll
    for (int j = 0; j < 4; ++j) gv[j] = *(const f32x4*)(g + 256 * j + 4 * F.lane);
    for (int row = gw; row < M; row += NGW) {
        const float* xr = X + (size_t)row * D; f32x4 v[4]; float s = 0.f;
#pragma unroll
        for (int j = 0; j < 4; ++j) { v[j] = *(const f32x4*)(xr + 256 * j + 4 * F.lane); s += (v[j][0] * v[j][0] + v[j][1] * v[j][1]) + (v[j][2] * v[j][2] + v[j][3] * v[j][3]); }
        const float r = rsqrtf(wave_sum(s) * (1.f / D) + EPS);
#pragma unroll
        for (int j = 0; j < 4; ++j) *(f32x4*)(out + (size_t)row * D + 256 * j + 4 * F.lane) = v[j] * r * gv[j];
    }
}

struct AttnSrc { const bf16_t* K; int ldk; const bf16_t* V; int ldv; };
__device__ __forceinline__ void attn_step(const AttnSrc s, int k0, bool mask, int qpos, const bf16x8 (&Qf)[2], float& mrun, float& lrun, f32x4 (&O)[4], int fr, int g4) {
    bf16x8 Kf[2][2], Vf[4];
#pragma unroll
    for (int kb = 0; kb < 2; ++kb)
#pragma unroll
        for (int ds = 0; ds < 2; ++ds) Kf[kb][ds] = *(const bf16x8*)(s.K + (size_t)(k0 + 16 * kb + fr) * s.ldk + 32 * ds + 8 * g4);
#pragma unroll
    for (int db = 0; db < 4; ++db) { const bf16_t* vp = s.V + (size_t)(16 * db + fr) * s.ldv + k0 + 4 * g4; const u32x2 lo = *(const u32x2*)vp, hi = *(const u32x2*)(vp + 16);
        Vf[db] = __builtin_bit_cast(bf16x8, (u32x4){lo.x, lo.y, hi.x, hi.y}); }
    f32x4 S[2];
#pragma unroll
    for (int kb = 0; kb < 2; ++kb) { S[kb] = __builtin_amdgcn_mfma_f32_16x16x32_bf16(Kf[kb][0], Qf[0], (f32x4){0.f, 0.f, 0.f, 0.f}, 0, 0, 0); S[kb] = __builtin_amdgcn_mfma_f32_16x16x32_bf16(Kf[kb][1], Qf[1], S[kb], 0, 0, 0); }
    const float c = 0.125f * 1.4426950408889634f;
    float mx = -1e30f;
#pragma unroll
    for (int kb = 0; kb < 2; ++kb)
#pragma unroll
        for (int r = 0; r < 4; ++r) { float x = S[kb][r] * c; if (mask) { const int d = k0 + 16 * kb + 4 * g4 + r - qpos; if (d > 128 || d < -128) x = -1e30f; } S[kb][r] = x; mx = fmaxf(mx, x); }
    mx = fmaxf(mx, __shfl_xor(mx, 16)); mx = fmaxf(mx, __shfl_xor(mx, 32));
    const float mnew = fmaxf(mrun, mx), alpha = fast_exp2(mrun - mnew);
    float rs = 0.f;
#pragma unroll
    for (int kb = 0; kb < 2; ++kb)
#pragma unroll
        for (int r = 0; r < 4; ++r) { const float p = fast_exp2(S[kb][r] - mnew); S[kb][r] = p; rs += p; }
    rs += __shfl_xor(rs, 16); rs += __shfl_xor(rs, 32);
    lrun = lrun * alpha + rs; mrun = mnew;
    u32x4 pw; pw.x = cvt_pk_bf16(S[0][0], S[0][1]); pw.y = cvt_pk_bf16(S[0][2], S[0][3]); pw.z = cvt_pk_bf16(S[1][0], S[1][1]); pw.w = cvt_pk_bf16(S[1][2], S[1][3]);
    const bf16x8 Pf = __builtin_bit_cast(bf16x8, pw);
#pragma unroll
    for (int db = 0; db < 4; ++db) { O[db] = O[db] * alpha; O[db] = __builtin_amdgcn_mfma_f32_16x16x32_bf16(Vf[db], Pf, O[db], 0, 0, 0); }
}
__device__ __forceinline__ void attn_phase(Frame& F, const bf16_t* Q, const bf16_t* KB, const bf16_t* VT, const bf16_t* CK, const bf16_t* CVT, const float* sink, bf16_t* O) {
    const int fr = F.lane & 15, g4 = F.lane >> 4;
    for (int it = F.blk; it < 1536; it += F.G) {
        const bool lat = it < 512; int kvh, chunk, T, rowbase, b = 0; const bf16_t* vt;
        if (lat) { b = it >> 8; kvh = (it >> 6) & 3; chunk = it & 63; T = TS; rowbase = MP + b * TS; vt = VT + (size_t)32 * 65536 + (size_t)b * 256 * TS; }
        else { const int j = it - 512, s = j >> 5; kvh = (j >> 3) & 3; chunk = j & 7; T = TP; rowbase = s * TP; vt = VT + (size_t)s * 65536; }
        const int h = kvh * 4 + (F.wave & 3), q0 = chunk * 32 + (F.wave >> 2) * 16, qpos = q0 + fr;
        bf16x8 Qf[2];
#pragma unroll
        for (int ds = 0; ds < 2; ++ds) Qf[ds] = *(const bf16x8*)(Q + (size_t)(rowbase + qpos) * D + h * 64 + 32 * ds + 8 * g4);
        float mrun = sink[h] * 1.4426950408889634f, lrun = 1.f;
        f32x4 Oa[4] = {{0.f, 0.f, 0.f, 0.f}, {0.f, 0.f, 0.f, 0.f}, {0.f, 0.f, 0.f, 0.f}, {0.f, 0.f, 0.f, 0.f}};
        const AttnSrc loc{KB + (size_t)rowbase * 256 + kvh * 64, 256, vt + (size_t)(kvh * 64) * T, T};
        int klo = 0, khi = T;
        if (lat) { klo = q0 - 128; klo = klo < 0 ? 0 : (klo & ~31); khi = q0 + 16 + 128 + 31; khi = khi > T ? T : (khi & ~31); }
        for (int k0 = klo; k0 < khi; k0 += 32) attn_step(loc, k0, lat, qpos, Qf, mrun, lrun, Oa, fr, g4);
        if (lat) { const AttnSrc ctx{CK + (size_t)b * 512 * 256 + kvh * 64, 256, CVT + (size_t)((b * 4 + kvh) * 64) * 512, 512};
            for (int k0 = 0; k0 < 512; k0 += 32) attn_step(ctx, k0, false, qpos, Qf, mrun, lrun, Oa, fr, g4); }
        const float inv = 1.f / lrun;
#pragma unroll
        for (int db = 0; db < 4; ++db) { const f32x4 o = Oa[db] * inv; u32x2 w; w.x = cvt_pk_bf16(o[0], o[1]); w.y = cvt_pk_bf16(o[2], o[3]);
            *(u32x2*)(O + (size_t)(rowbase + qpos) * D + h * 64 + 16 * db + 4 * g4) = w; }
    }
}

__device__ __forceinline__ void sgu_phase(Frame& F, const bf16_t* U, const bf16_t* V, const f32x2* STATS, const float* ln_g, const bf16_t* WSb, const float* b_s, bf16_t* UM) {
    constexpr int LDT = 136;
    LAS bf16_t* LT = (LAS bf16_t*)F.lds;
    LAS f32x2* ST = (LAS f32x2*)(F.lds + 128 * LDT * 2);
    const int fr = F.lane & 15, g4 = F.lane >> 4;
    for (int it = F.blk; it < 768; it += F.G) {
        const int ch = it >> 3, g = it & 7, r0 = ch * 128;
        if (F.tid < 128) { const f32x2* sp = STATS + (size_t)(r0 + F.tid) * 16; float s1 = 0.f, s2 = 0.f;
#pragma unroll
            for (int k = 0; k < 16; ++k) { const f32x2 p = sp[k]; s1 += p.x; s2 += p.y; }
            const float mu = s1 * (1.f / D), var = s2 * (1.f / D) - mu * mu; ST[F.tid] = (f32x2){mu, rsqrtf(fmaxf(var, 0.f) + EPS)}; }
        __syncthreads();
#pragma unroll
        for (int i = 0; i < 4; ++i) { const int q = F.tid + 512 * i, r = q & 127, c8 = (q >> 7) * 8;
            const u32x4 raw = *(const u32x4*)(V + (size_t)(r0 + r) * D + g * 128 + c8); const f32x2 st = ST[r];
            const f32x4 ga = *(const f32x4*)(ln_g + g * 128 + c8), gb = *(const f32x4*)(ln_g + g * 128 + c8 + 4);
            const unsigned rw[4] = {raw.x, raw.y, raw.z, raw.w};
#pragma unroll
            for (int e = 0; e < 8; ++e) { const float x = bf2f((unsigned short)(e & 1 ? rw[e >> 1] >> 16 : rw[e >> 1] & 0xffff)); const float gg = e < 4 ? ga[e & 3] : gb[e & 3];
                LT[(c8 + e) * LDT + r] = (bf16_t)f2bf((x - st.x) * st.y * gg); } }
        __syncthreads();
        f32x4 acc[8];
#pragma unroll
        for (int cb = 0; cb < 8; ++cb) acc[cb] = (f32x4){0.f, 0.f, 0.f, 0.f};
        const int p = 16 * F.wave + fr;
#pragma unroll
        for (int ks = 0; ks < 4; ++ks) { const bf16x8 bw = *(const bf16x8*)(WSb + (size_t)(g * 128 + p) * 128 + 32 * ks + 8 * g4);
#pragma unroll
            for (int cb = 0; cb < 8; ++cb) { const bf16x8 av = *(const LAS bf16x8*)(LT + (16 * cb + fr) * LDT + 32 * ks + 8 * g4); acc[cb] = __builtin_amdgcn_mfma_f32_16x16x32_bf16(av, bw, acc[cb], 0, 0, 0); } }
        const float bsv = b_s[g * 128 + p];
#pragma unroll
        for (int cb = 0; cb < 8; ++cb) { const size_t off = (size_t)(r0 + p) * D + g * 128 + 16 * cb + 4 * g4; const u32x2 uw = *(const u32x2*)(U + off);
            const float u0 = bf2f((unsigned short)(uw.x & 0xffff)), u1 = bf2f((unsigned short)(uw.x >> 16)), u2 = bf2f((unsigned short)(uw.y & 0xffff)), u3 = bf2f((unsigned short)(uw.y >> 16));
            u32x2 w; w.x = cvt_pk_bf16(u0 * (acc[cb][0] + bsv), u1 * (acc[cb][1] + bsv)); w.y = cvt_pk_bf16(u2 * (acc[cb][2] + bsv), u3 * (acc[cb][3] + bsv)); *(u32x2*)(UM + off) = w; }
        __syncthreads();
    }
}

struct Args { const float* in[26]; float* out; unsigned char* ws; int ph_lo, ph_hi; };
__global__ void __launch_bounds__(NWAVES * 64, 2) mk_fwd(const Args args) {
    extern __shared__ __attribute__((aligned(16))) unsigned char lds_raw[];
    Frame F;
    F.lds = (LAS unsigned char*)lds_raw;
    F.tid = threadIdx.x; F.lane = F.tid & 63; F.wave = __builtin_amdgcn_readfirstlane(F.tid >> 6);
    F.G = gridDim.x; F.blk = blockIdx.x;
    F.in = (const __attribute__((address_space(4))) cfp_t*)__builtin_amdgcn_kernarg_segment_ptr();
    F.out = args.out; F.ws = args.ws;
    unsigned char* ws = args.ws;
    volatile LAS unsigned* MISC = (volatile LAS unsigned*)(F.lds + MISC_OFF);
    if (F.tid < 32) MISC[F.tid] = 0u;
    __syncthreads();
    const int lo = args.ph_lo, hi = args.ph_hi;
    XcdBarrier bar; bar.bar = (unsigned*)(ws + WS_CTL); bar.x = 0; bar.st = nullptr;
    if (hi - lo > 1) bar = xcd_barrier_post((unsigned*)(ws + WS_CTL), MISC + 8);
    LAS float* XCH = (LAS float*)(F.lds + XCH_OFF);
#define CASE_BEGIN() frame_refresh(F); unsigned long long ws_ = (unsigned long long)args.ws, in_ = (unsigned long long)__builtin_amdgcn_kernarg_segment_ptr(); asm volatile("" : "+s"(ws_), "+s"(in_)); \
        unsigned char* ws = (unsigned char*)(GAS unsigned char*)ws_; F.ws = ws; F.in = (const __attribute__((address_space(4))) cfp_t*)in_; \
        float* X = (float*)(ws + WS_X); bf16_t* H = (bf16_t*)(ws + WS_H); bf16_t* H2 = (bf16_t*)(ws + WS_H2); \
        const float* modl = (const float*)(ws + WS_MOD) + l * 3 * 6 * D; const float* xs0 = l == 0 ? ((const float*)F.in[0]) : X; const float* xs1 = l == 0 ? ((const float*)F.in[1]) : X + (size_t)MP * D; \
        (void)X; (void)H; (void)H2; (void)modl; (void)xs0; (void)xs1
#pragma unroll 1
    for (int ph = lo; ph < hi; ++ph) {
        int l = 0, kind;
        if (ph == 0) kind = 0; else if (ph == 28) kind = 12;
        else { l = ph < 8 ? 0 : ph < 15 ? 1 : ph < 21 ? 2 : 3; const int j = ph - (l == 0 ? 1 : l == 1 ? 8 : l == 2 ? 15 : 21), n = l == 2 ? 1 : 2;
            kind = j == 0 ? 1 : j <= n ? (l == 0 ? 1 + j : l == 1 ? 3 + j : l == 2 ? 6 : 6 + j) : j == n + 1 ? 9 : j == n + 2 ? 13 : j == n + 3 ? 10 : 11; }
        switch (kind) {
        case 0: if (EN(0)) { CASE_BEGIN(); p0_prologue(F); } break;
        case 1: if (EN(1)) { CASE_BEGIN(); norm_phase(F, xs0, xs1, ((const float*)F.in[8]) + l * D, modl, 0, H); } break;
        case 13: if (EN(1)) { CASE_BEGIN(); norm_phase(F, X, X + (size_t)MP * D, ((const float*)F.in[9]) + l * D, modl, 3, H); } break;
        case 2: if (EN(2)) { CASE_BEGIN(); Order<48, 6, 0, D, D> S; S.init(F.G, F.blk, H, ws + WS_WQKV);
                EpiQKV E{(bf16_t*)(ws + WS_Q), (bf16_t*)(ws + WS_KB), (bf16_t*)(ws + WS_VT), F.out + OUT_NK, F.out + OUT_NV, (const float*)(ws + WS_ROPE)};
                pg8::gemm_phase<D, D, D / 64>(F.lds, S, E); } break;
        case 3: if (EN(3)) { CASE_BEGIN(); attn_phase(F, (const bf16_t*)(ws + WS_Q), (const bf16_t*)(ws + WS_KB), (const bf16_t*)(ws + WS_VT), (const bf16_t*)(ws + WS_CK), (const bf16_t*)(ws + WS_CVT), ((const float*)F.in[13]), H); } break;
        case 4: if (EN(4)) { CASE_BEGIN(); Order<48, 8, 0, D, D> S; S.init(F.G, F.blk, H, ws + WS_WSGI);
                EpiSgu E{(bf16_t*)(ws + WS_U), (bf16_t*)(ws + WS_V), (f32x2*)(ws + WS_STATS)};
                pg8::gemm_phase<D, D, D / 64>(F.lds, S, E); } break;
        case 5: if (EN(5)) { CASE_BEGIN(); sgu_phase(F, (const bf16_t*)(ws + WS_U), (const bf16_t*)(ws + WS_V), (const f32x2*)(ws + WS_STATS), ((const float*)F.in[15]), (const bf16_t*)(ws + WS_WS), ((const float*)F.in[17]), H); } break;
        case 6: if (EN(6)) { CASE_BEGIN(); OrderSc S{F.blk, (const char*)H, (const char*)(ws + WS_WSCI)};
                EpiSc E{(f32x4*)(ws + WS_YB) + (size_t)F.blk * 2 * 16 * 512, H2, ((const float*)F.in[20]), XCH};
                pg8::gemm_phase<D, D, D / 64>(F.lds, S, E); } break;
        case 7: if (EN(7)) { CASE_BEGIN(); OrderFn1 S{F.G, F.blk, (const char*)(ws + WS_A1), (const char*)H};
                EpiFn1 E{(bf16_t*)(ws + WS_YT)};
                pg8::gemm_phase<256, D, 4>(F.lds, S, E); } break;
        case 8: if (EN(8)) { CASE_BEGIN(); EpiBf16 E{H, D};
                if (F.blk < 64) { OrderFn2 S{F.blk, 1, (const char*)(ws + WS_A2S), (const char*)(ws + WS_YT)}; pg8::gemm_phase<2 * TS, 2 * TS, 2 * TS / 64>(F.lds, S, E); }
                else { OrderFn2 S{F.blk, 0, (const char*)(ws + WS_A2P), (const char*)(ws + WS_YT)}; pg8::gemm_phase<2 * TP, 2 * TP, 2 * TP / 64>(F.lds, S, E); } } break;
        case 9: if (EN(9)) { CASE_BEGIN(); const bf16_t* mix_in = l == 2 ? H2 : H;
                const bf16_t* wout = (const bf16_t*)(ws + (l == 0 ? WS_WO : l == 1 ? WS_WSGO : l == 2 ? WS_WSCO : WS_WFNO));
                Order<48, 4, 0, D, D> S; S.init(F.G, F.blk, mix_in, wout);
                EpiRes E{xs0, xs1, X, modl, 2};
                pg8::gemm_phase<D, D, D / 64>(F.lds, S, E); } break;
        case 10: if (EN(11)) { CASE_BEGIN(); Order<50, 22, 1, D, D> S; S.init(F.G, F.blk, H, ws + WS_WUP + l * WUP_BYTES);
                EpiUp E{(bf16_t*)(ws + WS_ACT), ((const float*)F.in[24]) + (size_t)l * 3 * 2 * DFF, XCH};
                pg8::gemm_phase<D, D, D / 64>(F.lds, S, E); } break;
        case 11: if (EN(12)) { CASE_BEGIN(); Order<48, 4, 0, DFF, DFF> S; S.init(F.G, F.blk, ws + WS_ACT, ws + WS_WDN + l * WDN_BYTES);
                EpiRes E{X, X + (size_t)MP * D, X, modl, 5};
                pg8::gemm_phase<DFF, DFF, DFF / 64>(F.lds, S, E); } break;
        default: if (EN(13)) { CASE_BEGIN(); final_phase(F, X, ((const float*)F.in[10]), F.out); } break;
        }
        if (ph + 1 < hi) xcd_barrier(bar);
    }
}

extern "C" void kernel_launch(void* const* d_in, const int* in_sizes, int n_in, void* d_out, int out_size, void* d_ws, size_t ws_size, hipStream_t stream) {
    static int grid = 0;
    if (grid == 0) {
        if (n_in != 26 || ws_size < WS_TOTAL) { fprintf(stderr, "kernel_launch: unexpected n_in %d / ws %zu (need %zu)\n", n_in, ws_size, (size_t)WS_TOTAL); grid = -1; return; }
        int dev = 0, cus = 0;
        if (hipGetDevice(&dev) != hipSuccess || hipDeviceGetAttribute(&cus, hipDeviceAttributeMultiprocessorCount, dev) != hipSuccess) { grid = -1; return; }
        if (hipFuncSetAttribute((const void*)mk_fwd, hipFuncAttributeMaxDynamicSharedMemorySize, LDS_BYTES) != hipSuccess) { fprintf(stderr, "kernel_launch: hipFuncSetAttribute failed\n"); grid = -1; return; }
        (void)hipGetLastError();
        grid = cus;
    }
    if (grid < 0) return;
    (void)hipMemsetAsync((char*)d_ws + WS_CTL, 0, CTL_ZERO_BYTES, stream);
    Args a{};
    for (int i = 0; i < 26; ++i) a.in[i] = (const float*)d_in[i];
    a.out = (float*)d_out; a.ws = (unsigned char*)d_ws;
#if MK_PER_PHASE
    for (int p = MK_PH_LO; p < MK_PH_HI; ++p) { a.ph_lo = p; a.ph_hi = p + 1; hipLaunchKernelGGL(mk_fwd, dim3(grid), dim3(NWAVES * 64), LDS_BYTES, stream, a); }
#else
    a.ph_lo = MK_PH_LO; a.ph_hi = MK_PH_HI;
    hipLaunchKernelGGL(mk_fwd, dim3(grid), dim3(NWAVES * 64), LDS_BYTES, stream, a);
#endif
}
```

```cpp
#include <hip/hip_runtime.h>
#include <cstdio>

#define LAS __attribute__((address_space(3)))
#define GAS __attribute__((address_space(1)))
typedef unsigned short bf16_t;
typedef short bf16x8 __attribute__((ext_vector_type(8)));
typedef float f32x4 __attribute__((ext_vector_type(4)));
typedef float f32x2 __attribute__((ext_vector_type(2)));
typedef unsigned u32x4 __attribute__((ext_vector_type(4)));
typedef unsigned u32x2 __attribute__((ext_vector_type(2)));

constexpr int D = 1024, MP = 8192, MS = 4096, M = MP + MS, DFF = 2816, TS = 2048, TP = 256;
constexpr float EPS = 1e-6f;
constexpr int NWAVES = 8;
#ifndef MK_PER_PHASE
#define MK_PER_PHASE 0
#endif
#ifndef MK_PH_LO
#define MK_PH_LO 0
#endif
#ifndef MK_PH_HI
#define MK_PH_HI 29
#endif
#ifndef MK_MASK
#define MK_MASK 0xffffffffu
#endif
#define EN(b) (((MK_MASK) >> (b)) & 1u)
#ifndef MK_REP_KIND
#define MK_REP_KIND 4
#endif
#ifndef MK_REP_N
#define MK_REP_N 1
#endif

namespace pg8 {
constexpr int BM = 256, BK = 64, HALF = 128, HTB = HALF * BK * 2, STAGE_BYTES = 8 * HTB, NXCD = 8, WGM = 8;
__host__ __device__ __forceinline__ int lds_byte(int r, int c) { const int st = (r >> 4) * 2 + (c >> 5), rr = r & 15, cc = c & 31, ob = rr * 64 + cc * 2; return st * 1024 + (ob ^ (((ob >> 9) & 1) << 5)); }
__host__ __device__ __forceinline__ void stage_rc(int b, int& R, int& C) { const int st = b / 1024, sb = b % 1024, swz = sb ^ (((sb >> 9) & 1) << 5); R = (st >> 1) * 16 + swz / 64; C = (st & 1) * 32 + (swz % 64) / 2; }
__host__ __device__ __forceinline__ int perm32(int rho) { const int n = rho >> 4, i = rho & 15; return 8 * (i >> 2) + 4 * n + (i & 3); }

struct Unit { int pm, pn, row0; const char* a; const char* b; };
struct Cfg { int lda, ldb, nt; };

__device__ __forceinline__ unsigned cvt_pk_bf16(float lo, float hi) { unsigned r; asm volatile("v_cvt_pk_bf16_f32 %0, %1, %2" : "=v"(r) : "v"(lo), "v"(hi)); return r; }

template <int LDA, int LDB, int NT, class Epi, class Sched>
__device__ __forceinline__ void gemm_phase(LAS unsigned char* lds, const Sched& S, const Epi& E) {
    constexpr Cfg g{LDA, LDB, NT};
    int tid_ = threadIdx.x; asm volatile("" : "+v"(tid_));
    const int tid = tid_, wid = __builtin_amdgcn_readfirstlane(tid >> 6), lane = tid & 63, wr = wid >> 2, wc = wid & 3, fr = lane & 15, fq = lane >> 4;
    const int nt = g.nt;
    unsigned voffA[2], voffB[2];
#pragma unroll
    for (int i = 0; i < 2; ++i) { int R, C; stage_rc(tid * 16 + i * 8192, R, C); const int Rb = Epi::PERM ? ((R & ~31) + perm32(R & 31)) : R;
        voffA[i] = (unsigned)(R * g.lda + C) * 2u; voffB[i] = (unsigned)(Rb * g.ldb + C) * 2u; }
    const size_t kstep = (size_t)(BK * 2);
    const size_t hstepA = (size_t)HALF * g.lda * 2, hstepB = (size_t)HALF * g.ldb * 2;
    const unsigned ldsw = (unsigned)wid * 1024u;
    const int aoff = lds_byte(wr * 64 + fr, fq * 8), boff = lds_byte(wc * 32 + fr, fq * 8);
#define PG8_SA(b, h) (((b) * 2 + (h)) * HTB)
#define PG8_SB(b, h) ((4 + (b) * 2 + (h)) * HTB)
#define PG8_STAGE(bufoff, gbase, voff) do { _Pragma("unroll") for (int _i = 0; _i < 2; ++_i) { unsigned _vo = (voff)[_i]; asm volatile("" : "+v"(_vo)); \
        __builtin_amdgcn_global_load_lds((const unsigned*)((const char*)(gbase) + _vo), (LAS unsigned*)(lds + (bufoff) + ldsw + _i * 8192), 16, 0, 0); } } while (0)
#define PG8_LDA(dst, b, h) do { _Pragma("unroll") for (int m = 0; m < 4; ++m) _Pragma("unroll") for (int k = 0; k < 2; ++k) dst[m][k] = *(const LAS bf16x8*)(lds + PG8_SA(b, h) + aoff + m * 2048 + k * 1024); } while (0)
#define PG8_LDB(dst, b, h) do { _Pragma("unroll") for (int n = 0; n < 2; ++n) _Pragma("unroll") for (int k = 0; k < 2; ++k) dst[n][k] = *(const LAS bf16x8*)(lds + PG8_SB(b, h) + boff + n * 2048 + k * 1024); } while (0)
#define PG8_MMA(ai, bj, At, Bt) do { __builtin_amdgcn_s_setprio(1); _Pragma("unroll") for (int m = 0; m < 4; ++m) _Pragma("unroll") for (int n = 0; n < 2; ++n) _Pragma("unroll") for (int k = 0; k < 2; ++k) \
        acc[ai][bj][m][n] = __builtin_amdgcn_mfma_f32_16x16x32_bf16(Bt[n][k], At[m][k], acc[ai][bj][m][n], 0, 0, 0); __builtin_amdgcn_s_setprio(0); } while (0)
#define PG8_WAIT_V(n) asm volatile("s_waitcnt vmcnt(" #n ")" ::: "memory")
#define PG8_WAIT_L(n) asm volatile("s_waitcnt lgkmcnt(" #n ")" ::: "memory")
#define PG8_BAR __builtin_amdgcn_s_barrier()
#define PG8_SCHED __builtin_amdgcn_sched_barrier(0)
    Unit cur, nxt; int ui = 0;
    if (!S.next(0, cur)) return;
    f32x4 acc[2][2][4][2];
#pragma unroll
    for (int a = 0; a < 2; ++a)
#pragma unroll
        for (int b = 0; b < 2; ++b)
#pragma unroll
            for (int m = 0; m < 4; ++m)
#pragma unroll
                for (int n = 0; n < 2; ++n) acc[a][b][m][n] = (f32x4){0.f, 0.f, 0.f, 0.f};
    bf16x8 At[4][2], B0[2][2], B1[2][2];
    const char* cA = cur.a; const char* cB = cur.b;
    PG8_STAGE(PG8_SB(0, 0), cB, voffB); PG8_STAGE(PG8_SB(0, 1), cB + hstepB, voffB); PG8_STAGE(PG8_SA(0, 0), cA, voffA); PG8_STAGE(PG8_SA(0, 1), cA + hstepA, voffA);
    if (wr == 1) PG8_BAR;
    PG8_WAIT_V(2); PG8_BAR;
    PG8_STAGE(PG8_SB(1, 0), cB + kstep, voffB); PG8_STAGE(PG8_SA(1, 0), cA + kstep, voffA); PG8_STAGE(PG8_SB(1, 1), cB + hstepB + kstep, voffB);
    PG8_WAIT_V(6); PG8_BAR;
    for (;;) {
        const bool has_next = S.next(ui + 1, nxt);
        const char* nA = has_next ? nxt.a : cA; const char* nB = has_next ? nxt.b : cB;
        for (int t = 0; t < nt; t += 2) {
            const bool last = (t == nt - 2);
            const char* a1 = cA + (size_t)(t + 1) * kstep;
            const char* a2 = last ? nA : cA + (size_t)(t + 2) * kstep; const char* b2 = last ? nB : cB + (size_t)(t + 2) * kstep;
            const char* a3 = a2 + kstep; const char* b3 = b2 + kstep;
            PG8_LDB(B0, 0, 0); PG8_LDB(B1, 0, 1); PG8_SCHED; PG8_LDA(At, 0, 0); PG8_STAGE(PG8_SA(1, 1), a1 + hstepA, voffA);
            PG8_WAIT_V(8); PG8_WAIT_L(0); PG8_BAR; PG8_MMA(0, 0, At, B0); PG8_MMA(0, 1, At, B1); PG8_BAR; PG8_SCHED;
            PG8_LDA(At, 0, 1); PG8_STAGE(PG8_SB(0, 0), b2, voffB); PG8_STAGE(PG8_SB(0, 1), b2 + hstepB, voffB); PG8_STAGE(PG8_SA(0, 0), a2, voffA);
            PG8_WAIT_V(8); PG8_WAIT_L(0); PG8_BAR; PG8_MMA(1, 0, At, B0); PG8_MMA(1, 1, At, B1); PG8_BAR; PG8_SCHED;
            PG8_LDB(B0, 1, 0); PG8_LDB(B1, 1, 1); PG8_SCHED; PG8_LDA(At, 1, 0); PG8_STAGE(PG8_SA(0, 1), a2 + hstepA, voffA);
            PG8_WAIT_V(8); PG8_WAIT_L(0); PG8_BAR; PG8_MMA(0, 0, At, B0); PG8_MMA(0, 1, At, B1); PG8_BAR; PG8_SCHED;
            PG8_LDA(At, 1, 1); PG8_STAGE(PG8_SB(1, 0), b3, voffB); PG8_STAGE(PG8_SB(1, 1), b3 + hstepB, voffB); PG8_STAGE(PG8_SA(1, 0), a3, voffA);
            PG8_WAIT_V(8); PG8_WAIT_L(0); PG8_BAR; PG8_MMA(1, 0, At, B0); PG8_MMA(1, 1, At, B1); PG8_BAR; PG8_SCHED;
        }
        if (wr == 0) PG8_BAR;
        E(acc, cur, wr, wc, fr, fq, ui);
        if (!has_next) break;
#pragma unroll
        for (int a = 0; a < 2; ++a)
#pragma unroll
            for (int b = 0; b < 2; ++b)
#pragma unroll
                for (int m = 0; m < 4; ++m)
#pragma unroll
                    for (int n = 0; n < 2; ++n) acc[a][b][m][n] = (f32x4){0.f, 0.f, 0.f, 0.f};
        cur = nxt; cA = nA; cB = nB; ++ui;
        if (wr == 1) PG8_BAR;
    }
    PG8_WAIT_V(0);
    PG8_BAR;
#undef PG8_SA
#undef PG8_SB
#undef PG8_STAGE
#undef PG8_LDA
#undef PG8_LDB
#undef PG8_MMA
#undef PG8_WAIT_V
#undef PG8_WAIT_L
#undef PG8_BAR
#undef PG8_SCHED
}
}
using pg8::Unit; using pg8::cvt_pk_bf16;

constexpr size_t MiB = 1u << 20;
constexpr size_t WS_CTL = 0, CTL_ZERO_BYTES = 64 * 1024;
constexpr size_t WS_MOD = 1 * MiB;
constexpr size_t WS_ROPE = WS_MOD + 512 * 1024;
constexpr size_t WS_STATS = WS_ROPE + 64 * 1024;
constexpr size_t WS_WQKV = 4 * MiB;
constexpr size_t WS_WO = WS_WQKV + 3 * MiB;
constexpr size_t WS_WSGI = WS_WO + 2 * MiB;
constexpr size_t WS_WSGO = WS_WSGI + 4 * MiB;
constexpr size_t WS_WSCI = WS_WSGO + 2 * MiB;
constexpr size_t WS_WSCO = WS_WSCI + 6 * MiB;
constexpr size_t WS_WFNO = WS_WSCO + 2 * MiB;
constexpr size_t WS_WUP = WS_WFNO + 2 * MiB;
constexpr size_t WUP_BYTES = (size_t)2 * DFF * D * 2;
constexpr size_t WS_WDN = WS_WUP + 4 * WUP_BYTES;
constexpr size_t WDN_BYTES = (size_t)D * DFF * 2;
constexpr size_t WS_WS = WS_WDN + 4 * WDN_BYTES;
constexpr size_t WS_A1 = WS_WS + 256 * 1024;
constexpr size_t WS_A2P = WS_A1 + 256 * 1024;
constexpr size_t WS_A2S = WS_A2P + 256 * 1024;
constexpr size_t WS_CK = WS_A2S + 16 * MiB;
constexpr size_t WS_CVT = WS_CK + 512 * 1024;
constexpr size_t WS_X = WS_CVT + 512 * 1024;
constexpr size_t WS_H = WS_X + (size_t)M * D * 4;
constexpr size_t WS_BIG = WS_H + (size_t)(M + 256) * D * 2;
constexpr size_t WS_END = WS_BIG + 72 * MiB;
constexpr size_t WS_ACT = WS_BIG;
constexpr size_t WS_Q = WS_BIG;
constexpr size_t WS_KB = WS_Q + 24 * MiB;
constexpr size_t WS_VT = WS_KB + 6 * MiB;
constexpr size_t WS_U = WS_BIG;
constexpr size_t WS_V = WS_BIG + 24 * MiB;
constexpr size_t WS_YB = WS_BIG;
constexpr size_t WS_YT = WS_BIG;
static_assert(WS_YB + (size_t)256 * 2 * 16 * 512 * 16 <= WS_END, "yb");
static_assert(WS_ACT + (size_t)M * DFF * 2 <= WS_END, "act");
constexpr size_t WS_H2 = WS_END;
constexpr size_t WS_TOTAL = WS_H2 + (size_t)M * D * 2;

constexpr size_t OUT_NK = (size_t)M * D, OUT_NV = OUT_NK + (size_t)MP * 256;

#define XB_TMO      128
#define XB_XCNT(j)  (256  + 64 * (j))
#define XB_XSUB(j)  (1280 + 64 * (j))
#define XB_XGEN(j)  (2304 + 64 * (j))
#define XB_TOP      3328
#define XB_TOPGEN   3392
#define XCD_BAR_WORDS 3456
#define XB_SPIN_CAP (1u << 22)
__device__ __forceinline__ unsigned xb_ld(unsigned* p)              { return __hip_atomic_load(p, __ATOMIC_RELAXED, __HIP_MEMORY_SCOPE_AGENT); }
__device__ __forceinline__ unsigned xb_add(unsigned* p, unsigned v) { return __hip_atomic_fetch_add(p, v, __ATOMIC_RELAXED, __HIP_MEMORY_SCOPE_AGENT); }
__device__ __forceinline__ unsigned xb_xcc_id() { return (unsigned)__builtin_amdgcn_s_getreg((3 << 11) | 20) & 0xFu; }
#define XB_SPIN(cond, bar) do { unsigned _sp = 0; while (cond) { __builtin_amdgcn_s_sleep(1); \
    if ((++_sp & 255u) == 0u) { if (xb_ld(&(bar)[XB_TMO])) break; if (_sp > XB_SPIN_CAP) { atomicAdd(&(bar)[XB_TMO], 1u); break; } } } } while (0)
struct XcdBarrier { unsigned* bar; unsigned x; volatile LAS unsigned* st; };
__device__ __forceinline__ XcdBarrier xcd_barrier_post(unsigned* bar, volatile LAS unsigned* st) {
    XcdBarrier b; b.bar = bar; b.x = xb_xcc_id(); b.st = st;
    if (threadIdx.x == 0) (void)xb_add(&bar[XB_XCNT(b.x)], 1u);
    return b;
}
__device__ __forceinline__ void xcd_barrier_complete(unsigned* bar, unsigned x, unsigned& nloc, unsigned& nx) {
    const unsigned G = gridDim.x * gridDim.y * gridDim.z;
    unsigned sum, cnt, mine, sp = 0u;
    for (;;) {
        sum = 0u; cnt = 0u; mine = 0u;
#pragma unroll
        for (unsigned j = 0; j < 16; ++j) { const unsigned c = xb_ld(&bar[XB_XCNT(j)]); sum += c; cnt += (c > 0u) ? 1u : 0u; mine = (j == x) ? c : mine; }
        if (sum == G) break;
        __builtin_amdgcn_s_sleep(1);
        if ((++sp & 255u) == 0u) { if (xb_ld(&bar[XB_TMO])) break; if (sp > XB_SPIN_CAP) { atomicAdd(&bar[XB_TMO], 1u); break; } }
    }
    nloc = mine > 0u ? mine : 1u; nx = cnt > 0u ? cnt : 1u;
}
__device__ __forceinline__ void xcd_barrier(const XcdBarrier& b) {
    asm volatile("s_waitcnt vmcnt(0)" ::: "memory");
    __syncthreads();
    if (threadIdx.x == 0) {
        unsigned* bar = b.bar;
        __builtin_amdgcn_s_waitcnt(0);
        unsigned nloc = b.st[0], nx = b.st[1];
        if (nloc == 0u) { xcd_barrier_complete(bar, b.x, nloc, nx); b.st[0] = nloc; b.st[1] = nx; }
        const unsigned old = xb_add(&bar[XB_XSUB(b.x)], 1u);
        const unsigned gen = old / nloc;
        if (old + 1u == (gen + 1u) * nloc) {
            __builtin_amdgcn_fence(__ATOMIC_RELEASE, "agent");
            asm volatile("s_waitcnt vmcnt(0)" ::: "memory");
            const unsigned og = xb_add(&bar[XB_TOP], 1u);
            const unsigned tg = og / nx;
            if (og + 1u == (tg + 1u) * nx) xb_add(&bar[XB_TOPGEN], 1u);
            else XB_SPIN(xb_ld(&bar[XB_TOPGEN]) == tg, bar);
            __builtin_amdgcn_fence(__ATOMIC_ACQUIRE, "agent");
            xb_add(&bar[XB_XGEN(b.x)], 1u);
            asm volatile("s_waitcnt vmcnt(0)" ::: "memory");
        } else {
            XB_SPIN(xb_ld(&bar[XB_XGEN(b.x)]) == gen, bar);
            __builtin_amdgcn_fence(__ATOMIC_ACQUIRE, "agent");
            asm volatile("s_waitcnt vmcnt(0)" ::: "memory");
        }
    }
    __syncthreads();
}

#define LDS_WAIT() asm volatile("s_waitcnt lgkmcnt(0)" ::: "memory")
__device__ __forceinline__ unsigned f2bf(float f) { unsigned u = __builtin_bit_cast(unsigned, f); return (u + 0x7fffu + ((u >> 16) & 1u)) >> 16; }
__device__ __forceinline__ unsigned pk2(float lo, float hi) { return f2bf(lo) | (f2bf(hi) << 16); }
__device__ __forceinline__ float bf2f(unsigned short b) { return __builtin_bit_cast(float, (unsigned)b << 16); }
__device__ __forceinline__ float wave_sum(float v) {
#pragma unroll
    for (int o = 1; o < 64; o <<= 1) v += __shfl_xor(v, o);
    return v;
}
__device__ __forceinline__ float rows_max(float x) {
    auto s = __builtin_amdgcn_permlane16_swap(__float_as_uint(x), __float_as_uint(x), false, false); x = fmaxf(__uint_as_float(s[0]), __uint_as_float(s[1]));
    auto t = __builtin_amdgcn_permlane32_swap(__float_as_uint(x), __float_as_uint(x), false, false); return fmaxf(__uint_as_float(t[0]), __uint_as_float(t[1])); }
__device__ __forceinline__ float rows_sum(float x) {
    auto s = __builtin_amdgcn_permlane16_swap(__float_as_uint(x), __float_as_uint(x), false, false); x = __uint_as_float(s[0]) + __uint_as_float(s[1]);
    auto t = __builtin_amdgcn_permlane32_swap(__float_as_uint(x), __float_as_uint(x), false, false); return __uint_as_float(t[0]) + __uint_as_float(t[1]); }
__device__ __forceinline__ float fast_exp2(float x) { return __builtin_amdgcn_exp2f(x); }
__device__ __forceinline__ float fast_rcp(float x) { return __builtin_amdgcn_rcpf(x); }
__device__ __forceinline__ float silu_f(float x) { return x * fast_rcp(1.f + fast_exp2(-1.4426950408889634f * x)); }
__device__ __forceinline__ float gelu_f(float x) { const float u = x * (1.f + 0.044715f * x * x); return x * fast_rcp(1.f + fast_exp2(-2.302208198f * u)); }
__device__ __forceinline__ int conv_row0(int pm) { if (pm < 32) return 256 * pm; const int s = (pm - 32) / 9, i = (pm - 32) % 9; return MP + TS * s + 254 * i - 1; }
template <int CTRL> __device__ __forceinline__ float dpp(float v) { return __builtin_bit_cast(float, __builtin_amdgcn_update_dpp(0, __builtin_bit_cast(int, v), CTRL, 0xf, 0xf, false)); }
template <int CTRL> __device__ __forceinline__ f32x4 dpp4(f32x4 v) { return (f32x4){dpp<CTRL>(v[0]), dpp<CTRL>(v[1]), dpp<CTRL>(v[2]), dpp<CTRL>(v[3])}; }
#define DPP_ROR1 0x121
#define DPP_ROR15 0x12F

template <int NM, int NN, int CONV, int LDA, int LDB>
struct Order {
    int G, c; const char* A; const char* B;
    __device__ __forceinline__ void init(int G_, int c_, const void* A_, const void* B_) { G = G_; c = c_; A = (const char*)A_; B = (const char*)B_; }
    __device__ __forceinline__ bool next(int i, Unit& u) const {
        constexpr int nwg = NM * NN;
        const int L = i * G + c; if (L >= nwg) return false;
        int wgid = L; { constexpr int q = nwg / pg8::NXCD, r = nwg % pg8::NXCD; const int xcd = wgid % pg8::NXCD, off = wgid / pg8::NXCD; wgid = (xcd < r ? xcd * (q + 1) : r * (q + 1) + (xcd - r) * q) + off; }
        constexpr int nig = pg8::WGM * NN; const int gid = wgid / nig, fm = gid * pg8::WGM, gsz = (NM - fm) < pg8::WGM ? (NM - fm) : pg8::WGM;
        u.pm = fm + ((wgid % nig) % gsz); u.pn = (wgid % nig) / gsz;
        u.row0 = CONV ? conv_row0(u.pm) : 256 * u.pm;
        u.a = A + (long)u.row0 * (long)(LDA * 2); u.b = B + (size_t)u.pn * (size_t)(256 * LDB * 2); return true;
    }
};

typedef const GAS float* cfp_t;
struct Frame {
    LAS unsigned char* lds; int tid, lane, wave, G, blk;
    const __attribute__((address_space(4))) cfp_t* in; float* out; unsigned char* ws;
};
__device__ __forceinline__ void frame_refresh(Frame& F) {
    int t = threadIdx.x; asm volatile("" : "+v"(t)); F.tid = t; F.lane = t & 63; F.wave = __builtin_amdgcn_readfirstlane(t >> 6);
}
constexpr int RING_BYTES = 131072, XCH_OFF = RING_BYTES  , MISC_OFF = XCH_OFF + 8192 + 320, LDS_BYTES = 147456;
__device__ __forceinline__ int vec_plain(int pm) { return pm < 32 ? 0 : 1 + (pm - 32) / 8; }
__device__ __forceinline__ int vec_conv(int pm) { return pm < 32 ? 0 : 1 + (pm - 32) / 9; }

struct EpiRes {
    static constexpr bool PERM = false;
    const float* src0; const float* src1; float* X; const float* modl; int gate_idx;
    __device__ __forceinline__ void operator()(const f32x4 (&acc)[2][2][4][2], const Unit& u, int wr, int wc, int fr, int fq, int) const {
        const int col0 = u.pn * 256 + wc * 32 + 4 * fq;
        const float* gate = modl + vec_plain(u.pm) * 6 * D + gate_idx * D;
        const float* src = u.row0 < MP ? src0 + (size_t)u.row0 * D : src1 + (size_t)(u.row0 - MP) * D;
        f32x4 gv[2][2];
#pragma unroll
        for (int bj = 0; bj < 2; ++bj)
#pragma unroll
            for (int n = 0; n < 2; ++n) gv[bj][n] = *(const f32x4*)(gate + col0 + bj * 128 + n * 16);
#pragma unroll
        for (int ai = 0; ai < 2; ++ai)
#pragma unroll
            for (int m = 0; m < 4; ++m) { const int r = ai * 128 + wr * 64 + m * 16 + fr; const float* sp = src + (size_t)r * D + col0; float* xp = X + (size_t)(u.row0 + r) * D + col0;
#pragma unroll
                for (int bj = 0; bj < 2; ++bj)
#pragma unroll
                    for (int n = 0; n < 2; ++n) { const f32x4 s = *(const f32x4*)(sp + bj * 128 + n * 16); *(f32x4*)(xp + bj * 128 + n * 16) = s + gv[bj][n] * acc[ai][bj][m][n]; }
                asm volatile("" ::: "memory"); }
    }
};
struct EpiBf16 {
    static constexpr bool PERM = true;
    bf16_t* O; int ldc;
    __device__ __forceinline__ void operator()(const f32x4 (&acc)[2][2][4][2], const Unit& u, int wr, int wc, int fr, int fq, int) const {
        const int col0 = u.pn * 256 + wc * 32 + 8 * fq;
#pragma unroll
        for (int ai = 0; ai < 2; ++ai)
#pragma unroll
            for (int m = 0; m < 4; ++m) { bf16_t* rowp = O + (size_t)(u.row0 + ai * 128 + wr * 64 + m * 16 + fr) * ldc + col0;
#pragma unroll
                for (int bj = 0; bj < 2; ++bj) { const f32x4 v0 = acc[ai][bj][m][0], v1 = acc[ai][bj][m][1];
                    u32x4 w; w.x = cvt_pk_bf16(v0[0], v0[1]); w.y = cvt_pk_bf16(v0[2], v0[3]); w.z = cvt_pk_bf16(v1[0], v1[1]); w.w = cvt_pk_bf16(v1[2], v1[3]);
                    *(u32x4*)(rowp + bj * 128) = w; } }
    }
};
struct EpiQKV {
    static constexpr bool PERM = false;
    bf16_t* Q; bf16_t* KB; bf16_t* VT; float* outk; float* outv; const float* rope;
    __device__ __forceinline__ void operator()(f32x4 (&acc)[2][2][4][2], const Unit& u, int wr, int wc, int fr, int fq, int) const {
        const bool samp = u.pm >= 32;
        const int c0 = wc * 32 + 4 * fq;
        if (samp && u.pn <= 4) {
            const int half = wc & 1;
#pragma unroll
            for (int ai = 0; ai < 2; ++ai)
#pragma unroll
                for (int m = 0; m < 4; ++m) { const int t = (u.row0 - MP + ai * 128 + wr * 64 + m * 16 + fr) & (TS - 1); const int pos = half ? (t & 63) : (t >> 6);
                    const f32x4 cs = *(const f32x4*)(rope + pos * 16 + 4 * fq), sn = *(const f32x4*)(rope + 1024 + pos * 16 + 4 * fq);
#pragma unroll
                    for (int bj = 0; bj < 2; ++bj) { const f32x4 x1 = acc[ai][bj][m][0], x2 = acc[ai][bj][m][1]; acc[ai][bj][m][0] = x1 * cs - x2 * sn; acc[ai][bj][m][1] = x2 * cs + x1 * sn; } }
        }
        if (u.pn <= 4) {
            bf16_t* base = u.pn < 4 ? Q + u.pn * 256 : KB; const int ldc = u.pn < 4 ? D : 256;
#pragma unroll
            for (int ai = 0; ai < 2; ++ai)
#pragma unroll
                for (int m = 0; m < 4; ++m) { const int row = u.row0 + ai * 128 + wr * 64 + m * 16 + fr; bf16_t* rowp = base + (size_t)row * ldc + c0;
#pragma unroll
                    for (int bj = 0; bj < 2; ++bj)
#pragma unroll
                        for (int n = 0; n < 2; ++n) { const f32x4 v = acc[ai][bj][m][n]; u32x2 w; w.x = cvt_pk_bf16(v[0], v[1]); w.y = cvt_pk_bf16(v[2], v[3]); *(u32x2*)(rowp + bj * 128 + n * 16) = w;
                            if (u.pn == 4 && !samp) *(f32x4*)(outk + (size_t)row * 256 + c0 + bj * 128 + n * 16) = v; } }
        } else {
            const int T = samp ? TS : TP;
            bf16_t* vt = samp ? VT + (size_t)32 * 65536 + (size_t)((u.row0 - MP) / TS) * 256 * TS : VT + (size_t)(u.row0 / TP) * 65536;
#pragma unroll
            for (int ai = 0; ai < 2; ++ai)
#pragma unroll
                for (int m = 0; m < 4; ++m) { const int row = u.row0 + ai * 128 + wr * 64 + m * 16 + fr; const int t = samp ? ((row - MP) & (TS - 1)) : (row & (TP - 1));
                    unsigned vo = (unsigned)(c0 * T + t); asm volatile("" : "+v"(vo));
#pragma unroll
                    for (int bj = 0; bj < 2; ++bj)
#pragma unroll
                        for (int n = 0; n < 2; ++n) { const f32x4 v = acc[ai][bj][m][n]; const int c = c0 + bj * 128 + n * 16;
#pragma unroll
                            for (int j = 0; j < 4; ++j) vt[vo + (unsigned)((bj * 128 + n * 16 + j) * T)] = (bf16_t)f2bf(v[j]);
                            if (!samp) *(f32x4*)(outv + (size_t)row * 256 + c) = v; } }
        }
    }
};
__device__ __forceinline__ f32x4 conv_m(f32x4 cur, f32x4 pe, f32x4 ne, f32x4 w0, f32x4 w1, f32x4 w2, int fr) {
    const f32x4 up = dpp4<DPP_ROR1>(cur), dn = dpp4<DPP_ROR15>(cur);
    const f32x4 prev = fr > 0 ? up : pe, next = fr < 15 ? dn : ne;
    return w0 * prev + w1 * cur + w2 * next;
}
__device__ __forceinline__ void mask_rows(f32x4 (&acc)[2][2][4][2], const Unit& u, int wr, int fr) {
    if (u.pm < 32) return;
    const int i = (u.pm - 32) % 9; if (i != 0 && i != 8) return;
    const int t0 = 254 * i - 1;
#pragma unroll
    for (int ai = 0; ai < 2; ++ai)
#pragma unroll
        for (int m = 0; m < 4; ++m) { const int t = t0 + ai * 128 + wr * 64 + m * 16 + fr; if (t < 0 || t >= TS) {
#pragma unroll
            for (int bj = 0; bj < 2; ++bj)
#pragma unroll
                for (int n = 0; n < 2; ++n) acc[ai][bj][m][n] = (f32x4){0.f, 0.f, 0.f, 0.f}; } }
}
__device__ __forceinline__ bool row_valid(const Unit& u, int r) {
    if (u.pm < 32) return true;
    const int t = 254 * ((u.pm - 32) % 9) - 1 + r; return r >= 1 && r <= 254 && t >= 0 && t < TS;
}
__device__ __forceinline__ void xch_write(LAS float* X, const f32x4 (&acc)[2][2][4][2], int wr, int wc, int fr, int fq) {
#pragma unroll
    for (int ai = 0; ai < 2; ++ai)
#pragma unroll
        for (int bj = 0; bj < 2; ++bj)
#pragma unroll
            for (int n = 0; n < 2; ++n) { const int col = bj * 128 + wc * 32 + 8 * fq + 4 * n;
                if (fr == 0) *(LAS f32x4*)(X + ((2 * ai + wr) * 2 + 0) * 256 + col) = acc[ai][bj][0][n];
                if (fr == 15) *(LAS f32x4*)(X + ((2 * ai + wr) * 2 + 1) * 256 + col) = acc[ai][bj][3][n]; }
}
__device__ __forceinline__ f32x4 xch_top(const LAS float* X, int b, int col) { return b > 0 ? *(const LAS f32x4*)(X + ((b - 1) * 2 + 1) * 256 + col) : (f32x4){0.f, 0.f, 0.f, 0.f}; }
__device__ __forceinline__ f32x4 xch_bot(const LAS float* X, int b, int col) { return b < 3 ? *(const LAS f32x4*)(X + ((b + 1) * 2 + 0) * 256 + col) : (f32x4){0.f, 0.f, 0.f, 0.f}; }

struct EpiUp {
    static constexpr bool PERM = true;
    bf16_t* ACT; const float* cw; LAS float* X;
    __device__ __forceinline__ void operator()(f32x4 (&acc)[2][2][4][2], const Unit& u, int wr, int wc, int fr, int fq, int) const {
        asm volatile("" : "+v"(fr), "+v"(fq));
        mask_rows(acc, u, wr, fr);
        xch_write(X, acc, wr, wc, fr, fq);
        LDS_WAIT(); __builtin_amdgcn_s_barrier(); asm volatile("" ::: "memory");
        const int chl = wc * 32 + 8 * fq;
#pragma unroll
        for (int n = 0; n < 2; ++n) {
            const int ch = u.pn * 128 + chl + 4 * n;
            f32x4 wg[3], wu[3];
#pragma unroll
            for (int k = 0; k < 3; ++k) { wg[k] = *(const f32x4*)(cw + k * 2 * DFF + ch); wu[k] = *(const f32x4*)(cw + k * 2 * DFF + DFF + ch); }
#pragma unroll
            for (int ai = 0; ai < 2; ++ai) {
                const int b = 2 * ai + wr;
                f32x4 pg = xch_top(X, b, chl + 4 * n), pu = xch_top(X, b, 128 + chl + 4 * n);
#pragma unroll
                for (int m = 0; m < 4; ++m) { const int r = ai * 128 + wr * 64 + m * 16 + fr;
                    const f32x4 vg = acc[ai][0][m][n], vu = acc[ai][1][m][n];
                    const f32x4 ng = m < 3 ? dpp4<DPP_ROR15>(acc[ai][0][m < 3 ? m + 1 : 3][n]) : xch_bot(X, b, chl + 4 * n);
                    const f32x4 nu = m < 3 ? dpp4<DPP_ROR15>(acc[ai][1][m < 3 ? m + 1 : 3][n]) : xch_bot(X, b, 128 + chl + 4 * n);
                    const f32x4 og = conv_m(vg, pg, ng, wg[0], wg[1], wg[2], fr), ou = conv_m(vu, pu, nu, wu[0], wu[1], wu[2], fr);
                    pg = dpp4<DPP_ROR1>(vg); pu = dpp4<DPP_ROR1>(vu);
                    f32x4 a;
#pragma unroll
                    for (int j = 0; j < 4; ++j) a[j] = silu_f(og[j]) * ou[j];
                    if (row_valid(u, r)) { u32x2 w; w.x = cvt_pk_bf16(a[0], a[1]); w.y = cvt_pk_bf16(a[2], a[3]); *(u32x2*)(ACT + (size_t)(u.row0 + r) * DFF + ch) = w; } }
            }
        }
    }
};
struct EpiSgu {
    static constexpr bool PERM = true;
    bf16_t* U; bf16_t* V; f32x2* STATS;
    __device__ __forceinline__ void operator()(f32x4 (&acc)[2][2][4][2], const Unit& u, int wr, int wc, int fr, int fq, int) const {
        const bool isv = u.pn >= 4; bf16_t* O = isv ? V : U; const int col0 = (u.pn & 3) * 256 + wc * 32 + 8 * fq;
#pragma unroll
        for (int ai = 0; ai < 2; ++ai)
#pragma unroll
            for (int m = 0; m < 4; ++m) { const int row = u.row0 + ai * 128 + wr * 64 + m * 16 + fr; bf16_t* rowp = O + (size_t)row * D + col0; float s1 = 0.f, s2 = 0.f;
#pragma unroll
                for (int bj = 0; bj < 2; ++bj) { f32x4 v0 = acc[ai][bj][m][0], v1 = acc[ai][bj][m][1];
#pragma unroll
                    for (int j = 0; j < 4; ++j) { v0[j] = gelu_f(v0[j]); v1[j] = gelu_f(v1[j]); s1 += v0[j] + v1[j]; s2 += v0[j] * v0[j] + v1[j] * v1[j]; }
                    u32x4 w; w.x = cvt_pk_bf16(v0[0], v0[1]); w.y = cvt_pk_bf16(v0[2], v0[3]); w.z = cvt_pk_bf16(v1[0], v1[1]); w.w = cvt_pk_bf16(v1[2], v1[3]);
                    *(u32x4*)(rowp + bj * 128) = w; }
                if (isv) { s1 += __shfl_xor(s1, 16); s1 += __shfl_xor(s1, 32); s2 += __shfl_xor(s2, 16); s2 += __shfl_xor(s2, 32);
                    if (fq == 0) STATS[(size_t)row * 16 + (u.pn - 4) * 4 + wc] = (f32x2){s1, s2}; } }
    }
};
struct EpiSc {
    static constexpr bool PERM = true;
    f32x4* YB; bf16_t* BY; const float* cw; LAS float* X;
    __device__ __forceinline__ void operator()(f32x4 (&acc)[2][2][4][2], const Unit& u, int wr, int wc, int fr, int fq, int ui) const {
        asm volatile("" : "+v"(fr), "+v"(fq));
        const int q = u.pn / 3, s = u.pn % 3, chl = wc * 32 + 8 * fq;
        if (s < 2) {
            mask_rows(acc, u, wr, fr);
#pragma unroll
            for (int ai = 0; ai < 2; ++ai)
#pragma unroll
                for (int m = 0; m < 4; ++m)
#pragma unroll
                    for (int n = 0; n < 2; ++n) acc[ai][0][m][n] = acc[ai][0][m][n] * acc[ai][1][m][n];
            xch_write(X, acc, wr, wc, fr, fq);
            LDS_WAIT(); __builtin_amdgcn_s_barrier(); asm volatile("" ::: "memory");
#pragma unroll
            for (int n = 0; n < 2; ++n) {
                const int ch = q * 256 + s * 128 + chl + 4 * n;
                f32x4 w[3];
#pragma unroll
                for (int k = 0; k < 3; ++k) w[k] = *(const f32x4*)(cw + k * D + ch);
#pragma unroll
                for (int ai = 0; ai < 2; ++ai) { const int b = 2 * ai + wr;
                    f32x4 pp = xch_top(X, b, chl + 4 * n);
#pragma unroll
                    for (int m = 0; m < 4; ++m) { const f32x4 v = acc[ai][0][m][n];
                        const f32x4 nn = m < 3 ? dpp4<DPP_ROR15>(acc[ai][0][m < 3 ? m + 1 : 3][n]) : xch_bot(X, b, chl + 4 * n);
                        const f32x4 o = conv_m(v, pp, nn, w[0], w[1], w[2], fr); pp = dpp4<DPP_ROR1>(v);
                        unsigned yo = (unsigned)((s * 16 + (ai * 4 + m) * 2 + n) * 512) + threadIdx.x; asm volatile("" : "+v"(yo)); YB[yo] = o; } }
            }
        } else {
#pragma unroll
            for (int ai = 0; ai < 2; ++ai)
#pragma unroll
                for (int m = 0; m < 4; ++m) { const int r = ai * 128 + wr * 64 + m * 16 + fr; const bool ok = row_valid(u, r);
#pragma unroll
                    for (int bj = 0; bj < 2; ++bj) { unsigned yo = (unsigned)((bj * 16 + (ai * 4 + m) * 2) * 512) + threadIdx.x; asm volatile("" : "+v"(yo)); const f32x4 y0 = YB[yo], y1 = YB[yo + 512];
                        const f32x4 v0 = acc[ai][bj][m][0] * y0, v1 = acc[ai][bj][m][1] * y1;
                        u32x4 w; w.x = cvt_pk_bf16(v0[0], v0[1]); w.y = cvt_pk_bf16(v0[2], v0[3]); w.z = cvt_pk_bf16(v1[0], v1[1]); w.w = cvt_pk_bf16(v1[2], v1[3]);
                        if (ok) *(u32x4*)(BY + (size_t)(u.row0 + r) * D + q * 256 + bj * 128 + chl) = w; }
                    asm volatile("" ::: "memory"); }
        }
    }
};
struct OrderSc {
    int c; const char* A; const char* B;
    __device__ __forceinline__ bool next(int i, Unit& u) const {
        if (c >= 200 || i >= 3) return false;
        u.pm = c >> 2; u.pn = 3 * (c & 3) + i; u.row0 = conv_row0(u.pm); u.a = A + (long)u.row0 * (D * 2); u.b = B + (size_t)u.pn * 256 * D * 2; return true; }
};
struct EpiFn1 {
    static constexpr bool PERM = true;
    bf16_t* YT;
    __device__ __forceinline__ void operator()(const f32x4 (&acc)[2][2][4][2], const Unit& u, int wr, int wc, int fr, int fq, int) const {
        const int part = u.pm & 1, ch0 = (u.pm >> 1) * 256, tok0 = u.pn * 256;
        bf16_t* base; int T, t0;
        if (tok0 < MP) { T = TP; base = YT + (size_t)(tok0 / TP) * D * 2 * TP; t0 = 0; }
        else { T = TS; base = YT + (size_t)32 * D * 2 * TP + (size_t)((tok0 - MP) / TS) * D * 2 * TS; t0 = (tok0 - MP) % TS; }
        const int c0 = wc * 32 + 8 * fq;
#pragma unroll
        for (int ai = 0; ai < 2; ++ai)
#pragma unroll
            for (int m = 0; m < 4; ++m) { bf16_t* rowp = base + (size_t)(ch0 + ai * 128 + wr * 64 + m * 16 + fr) * 2 * T + part * T + t0 + c0;
#pragma unroll
                for (int bj = 0; bj < 2; ++bj) { const f32x4 v0 = acc[ai][bj][m][0], v1 = acc[ai][bj][m][1];
                    u32x4 w; w.x = cvt_pk_bf16(v0[0], v0[1]); w.y = cvt_pk_bf16(v0[2], v0[3]); w.z = cvt_pk_bf16(v1[0], v1[1]); w.w = cvt_pk_bf16(v1[2], v1[3]);
                    *(u32x4*)(rowp + bj * 128) = w; } }
    }
};
struct OrderFn1 {
    int G, c; const char* A1; const char* H;
    __device__ __forceinline__ bool next(int i, Unit& u) const {
        const int L = i * G + c; if (L >= 384) return false;
        u.pm = L & 7; u.pn = L >> 3; u.row0 = 0; u.a = A1 + (size_t)(u.pm & 1) * 256 * 256 * 2; u.b = H + (size_t)u.pn * 256 * D * 2 + (size_t)(u.pm >> 1) * 512; return true; }
};
struct OrderFn2 {
    int c; int samp; const char* A2; const char* YT;
    __device__ __forceinline__ bool next(int i, Unit& u) const {
        if (i > 0) return false;
        if (samp) { if (c >= 64) return false; const int b = c >> 5, tm = (c >> 2) & 7; u.pm = tm; u.pn = c & 3; u.row0 = MP + b * TS + 256 * tm;
            u.a = A2 + (size_t)tm * 256 * 2 * TS * 2; u.b = YT + (size_t)32 * D * 2 * TP * 2 + (size_t)b * D * 2 * TS * 2 + (size_t)u.pn * 256 * 2 * TS * 2; return true; }
        if (c < 64 || c >= 192) return false; const int j = c - 64, s = j >> 2; u.pm = 0; u.pn = j & 3; u.row0 = s * TP;
        u.a = A2; u.b = YT + (size_t)s * D * 2 * TP * 2 + (size_t)u.pn * 256 * 2 * TP * 2; return true; }
};

__device__ __forceinline__ void p0_transpose_item(const float* W, int K, int N, bf16_t* WT, int drow0, LAS float* scr, int kb, int n0, int lane) {
    const int k0 = 64 * kb;
#pragma unroll 8
    for (int i = 0; i < 32; ++i) { const int kk = 2 * i + (lane >> 5); scr[kk * 33 + (lane & 31)] = W[(size_t)(k0 + kk) * N + n0 + (lane & 31)]; }
    LDS_WAIT(); asm volatile("" ::: "memory");
    const int c = lane & 7;
#pragma unroll
    for (int j = 0; j < 4; ++j) { const int n = (lane >> 3) + 8 * j; const LAS float* s = scr + (8 * c) * 33 + n;
        u32x4 o; o.x = pk2(s[0 * 33], s[1 * 33]); o.y = pk2(s[2 * 33], s[3 * 33]); o.z = pk2(s[4 * 33], s[5 * 33]); o.w = pk2(s[6 * 33], s[7 * 33]);
        *(u32x4*)(WT + (size_t)(drow0 + n) * K + k0 + 8 * c) = o; }
    LDS_WAIT(); asm volatile("" ::: "memory");
}
__device__ __forceinline__ int map_plain(int n) { return n; }
__device__ __forceinline__ int map_up(int n) { return n < DFF ? 256 * (n >> 7) + (n & 127) : 256 * ((n - DFF) >> 7) + 128 + ((n - DFF) & 127); }
__device__ __forceinline__ int map_sc(int n) {
    if (n < D) return (3 * (n >> 8) + 2) * 256 + (n & 255);
    const int x = n >= 2 * D, ch = n - D - x * D; return (3 * (ch >> 8) + ((ch >> 7) & 1)) * 256 + x * 128 + (ch & 127);
}
__device__ __forceinline__ void p0_tjob(int& it, int NGW, LAS float* scr, int lane, const float* W, bf16_t* WT, int K, int N, int map) {
    const int nblk = N / 32, nitems = (K / 64) * nblk;
    for (; it < nitems; it += NGW) { const int kb = it / nblk, n0 = (it % nblk) * 32; const int dr = map == 0 ? n0 : (map == 1 ? map_up(n0) : map_sc(n0));
        p0_transpose_item(W, K, N, WT, dr, scr, kb, n0, lane); }
    it -= nitems;
}
__device__ __forceinline__ void p0_prologue(Frame& F) {
    unsigned char* ws = F.ws;
    {
        LAS float* scr = (LAS float*)(F.lds + F.wave * 16384);
        const int gw = F.blk * NWAVES + F.wave, NGW = F.G * NWAVES;
        int it = gw;
        p0_tjob(it, NGW, scr, F.lane, ((const float*)F.in[11]), (bf16_t*)(ws + WS_WQKV), D, 1536, 0);
        p0_tjob(it, NGW, scr, F.lane, ((const float*)F.in[12]), (bf16_t*)(ws + WS_WO), D, D, 0);
        p0_tjob(it, NGW, scr, F.lane, ((const float*)F.in[14]), (bf16_t*)(ws + WS_WSGI), D, 2048, 0);
        p0_tjob(it, NGW, scr, F.lane, ((const float*)F.in[18]), (bf16_t*)(ws + WS_WSGO), D, D, 0);
        p0_tjob(it, NGW, scr, F.lane, ((const float*)F.in[19]), (bf16_t*)(ws + WS_WSCI), D, 3072, 2);
        p0_tjob(it, NGW, scr, F.lane, ((const float*)F.in[21]), (bf16_t*)(ws + WS_WSCO), D, D, 0);
        p0_tjob(it, NGW, scr, F.lane, ((const float*)F.in[22]), (bf16_t*)(ws + WS_WFNO), D, D, 0);
#pragma unroll 1
        for (int l = 0; l < 4; ++l) p0_tjob(it, NGW, scr, F.lane, ((const float*)F.in[23]) + (size_t)l * D * 2 * DFF, (bf16_t*)(ws + WS_WUP + l * WUP_BYTES), D, 2 * DFF, 1);
#pragma unroll 1
        for (int l = 0; l < 4; ++l) p0_tjob(it, NGW, scr, F.lane, ((const float*)F.in[25]) + (size_t)l * DFF * D, (bf16_t*)(ws + WS_WDN + l * WDN_BYTES), DFF, D, 0);
    }
    __syncthreads();
    {
        LAS float* sv = (LAS float*)F.lds;
        LAS float* red = sv + 3 * D;
        for (int i = F.tid; i < D; i += 512) { const float a = ((const float*)F.in[5])[i], b = ((const float*)F.in[4])[i], d = ((const float*)F.in[4])[D + i];
            sv[i] = a / (1.f + expf(-a)); sv[D + i] = b / (1.f + expf(-b)); sv[2 * D + i] = d / (1.f + expf(-d)); }
        __syncthreads();
        float* MODp = (float*)(ws + WS_MOD);
        const int kg = F.tid >> 3, cq = F.tid & 7;
        for (int it = F.blk; it < 768; it += F.G) {
            const int l = it / 192, n0 = (it % 192) * 32;
            const float* w = ((const float*)F.in[6]) + (size_t)l * D * 6 * D + n0 + 4 * cq;
            f32x4 a0 = {0, 0, 0, 0}, a1 = a0, a2 = a0;
#pragma unroll 4
            for (int k = kg; k < D; k += 64) { const f32x4 wv = *(const f32x4*)(w + (size_t)k * 6 * D); a0 += sv[k] * wv; a1 += sv[D + k] * wv; a2 += sv[2 * D + k] * wv; }
            *(LAS f32x4*)(red + (kg * 3 + 0) * 32 + 4 * cq) = a0; *(LAS f32x4*)(red + (kg * 3 + 1) * 32 + 4 * cq) = a1; *(LAS f32x4*)(red + (kg * 3 + 2) * 32 + 4 * cq) = a2;
            __syncthreads();
            if (F.tid < 96) { const int v = F.tid >> 5, cc = F.tid & 31; float s = 0.f;
                for (int g = 0; g < 64; ++g) s += red[(g * 3 + v) * 32 + cc];
                MODp[(l * 3 + v) * 6 * D + n0 + cc] = s + ((const float*)F.in[7])[l * 6 * D + n0 + cc]; }
            __syncthreads();
        }
    }
    {
        const size_t gt = (size_t)F.blk * 512 + F.tid, NGT = (size_t)F.G * 512;
        bf16_t* CK = (bf16_t*)(ws + WS_CK); bf16_t* CVT = (bf16_t*)(ws + WS_CVT); bf16_t* WSb = (bf16_t*)(ws + WS_WS);
        for (size_t i = gt; i < 2 * 512 * 256; i += NGT) { CK[i] = (bf16_t)f2bf(((const float*)F.in[2])[i]);
            const int d = i & 63, kvh = (i >> 6) & 3, j = (i >> 8) & 511, b = i >> 17; CVT[((size_t)(b * 4 + kvh) * 64 + d) * 512 + j] = (bf16_t)f2bf(((const float*)F.in[3])[i]); }
        for (size_t i = gt; i < 8 * 128 * 128; i += NGT) WSb[i] = (bf16_t)f2bf(((const float*)F.in[16])[i]);
        float* rope = (float*)(ws + WS_ROPE);
        for (size_t i = gt; i < 1024; i += NGT) { const int pos = i >> 4, fi = i & 15; const float ang = (float)pos * powf(10000.f, -(float)fi / 16.f); rope[i] = cosf(ang); rope[1024 + i] = sinf(ang); }
        bf16_t* A1 = (bf16_t*)(ws + WS_A1);
        for (size_t i = gt; i < 2 * 256 * 256; i += NGT) { const int part = i >> 16, r = (i >> 8) & 255, k = i & 255; float v = 0.f;
            if ((r >> 7) == (k >> 7)) { const float a = 2.f * (float)(((r & 127) * (k & 127)) & 127) / 128.f; v = (part ? sinpif(a) : cospif(a)) * 0.08838834764831845f; }
            A1[i] = (bf16_t)f2bf(v); }
        bf16_t* A2P = (bf16_t*)(ws + WS_A2P);
        for (size_t i = gt; i < 256 * 512; i += NGT) { const int tp = i >> 9, k = i & 511, t = k & 255; const float a = 2.f * (float)((tp * t) & 255) / 256.f;
            A2P[i] = (bf16_t)f2bf((k < 256 ? cospif(a) : -sinpif(a)) * 0.0625f); }
        bf16_t* A2S = (bf16_t*)(ws + WS_A2S);
        for (size_t i = gt; i < (size_t)2048 * 4096; i += NGT) { const int tp = i >> 12, k = i & 4095, t = k & 2047; const float a = 2.f * (float)((tp * t) & 2047) / 2048.f;
            A2S[i] = (bf16_t)f2bf((k < 2048 ? cospif(a) : -sinpif(a)) * 0.022097086912079608f); }
    }
}

__device__ __forceinline__ void norm_phase(Frame& F, const float* src0, const float* src1, const float* g, const float* modl, int sh_idx, bf16_t* H) {
    const int gw = F.blk * NWAVES + F.wave, NGW = F.G * NWAVES;
    f32x4 gv[4];
#pragma unroll
    for (int j = 0; j < 4; ++j) gv[j] = *(const f32x4*)(g + 256 * j + 4 * F.lane);
    for (int row = gw; row < M; row += NGW) {
        const float* xr = row < MP ? src0 + (size_t)row * D : src1 + (size_t)(row - MP) * D;
        const float* mv = modl + (row < MP ? 0 : 1 + (row - MP) / TS) * 6 * D;
        f32x4 v[4]; float s = 0.f;
#pragma unroll
        for (int j = 0; j < 4; ++j) { v[j] = *(const f32x4*)(xr + 256 * j + 4 * F.lane); s += (v[j][0] * v[j][0] + v[j][1] * v[j][1]) + (v[j][2] * v[j][2] + v[j][3] * v[j][3]); }
        const float r = rsqrtf(wave_sum(s) * (1.f / D) + EPS);
#pragma unroll
        for (int j = 0; j < 4; ++j) { const f32x4 sh = *(const f32x4*)(mv + sh_idx * D + 256 * j + 4 * F.lane), sc = *(const f32x4*)(mv + (sh_idx + 1) * D + 256 * j + 4 * F.lane);
            const f32x4 o = v[j] * r * gv[j] * (1.f + sc) + sh;
            u32x2 w; w.x = pk2(o[0], o[1]); w.y = pk2(o[2], o[3]); *(u32x2*)(H + (size_t)row * D + 256 * j + 4 * F.lane) = w; }
    }
}
__device__ __forceinline__ void final_phase(Frame& F, const float* X, const float* g, float* out) {
    const int gw = F.blk * NWAVES + F.wave, NGW = F.G * NWAVES;
    f32x4 gv[4];
#pragma unroll
    for (int j = 0; j < 4; ++j) gv[j] = *(const f32x4*)(g + 256 * j + 4 * F.lane);
    for (int row = gw; row < M; row += NGW) {
        const float* xr = X + (size_t)row * D; f32x4 v[4]; float s = 0.f;
#pragma unroll
        for (int j = 0; j < 4; ++j) { v[j] = *(const f32x4*)(xr + 256 * j + 4 * F.lane); s += (v[j][0] * v[j][0] + v[j][1] * v[j][1]) + (v[j][2] * v[j][2] + v[j][3] * v[j][3]); }
        const float r = rsqrtf(wave_sum(s) * (1.f / D) + EPS);
#pragma unroll
        for (int j = 0; j < 4; ++j) *(f32x4*)(out + (size_t)row * D + 256 * j + 4 * F.lane) = v[j] * r * gv[j];
    }
}

constexpr int ATT_LDK = 144;
constexpr int ATT_TILE_BYTES = 2 * 64 * ATT_LDK;
struct AttTile { const bf16_t* K; const bf16_t* V; int ldk, ldv, k0, mask; };
__device__ __forceinline__ void att_tile_of(int t, bool lat, int nband, int kband0, const bf16_t* KBs, const bf16_t* VTs, int T, const bf16_t* CKs, const bf16_t* CVTs, AttTile& o) {
    if (t < nband) { const int k0 = kband0 + 64 * t; o.K = KBs + (size_t)k0 * 256; o.V = VTs + k0; o.ldk = 256; o.ldv = T; o.k0 = k0; o.mask = lat; }
    else { const int k0 = 64 * (t - nband); o.K = CKs + (size_t)k0 * 256; o.V = CVTs + k0; o.ldk = 256; o.ldv = 512; o.k0 = k0; o.mask = 0; }
}
__device__ __forceinline__ void attn_phase(Frame& F, const bf16_t* Q, const bf16_t* KB, const bf16_t* VT, const bf16_t* CK, const bf16_t* CVT, const float* sink, bf16_t* O) {
    const int fr = F.lane & 15, g4 = F.lane >> 4, tid = F.tid;
    const int lrow = tid >> 3, lchunk = tid & 7;
    LAS unsigned char* lds = F.lds;
    for (int it = F.blk; it < 768; it += F.G) {
        const bool lat = it < 256; int kvh, chunk, T, rowbase, b = 0; const bf16_t* vt;
        if (lat) { b = it >> 7; kvh = (it >> 5) & 3; chunk = it & 31; T = TS; rowbase = MP + b * TS; vt = VT + (size_t)32 * 65536 + (size_t)b * 256 * TS; }
        else { const int j = it - 256, s = j >> 4; kvh = (j >> 2) & 3; chunk = j & 3; T = TP; rowbase = s * TP; vt = VT + (size_t)s * 65536; }
        const int h = kvh * 4 + (F.wave & 3), q0 = chunk * 64 + (F.wave >> 2) * 32;
        int kband0 = 0, nband = T / 64;
        if (lat) { int lo = 64 * chunk - 128, hi = 64 * chunk + 192; lo = lo < 0 ? 0 : lo; hi = hi > T ? T : hi; kband0 = lo; nband = (hi - lo) / 64; }
        const int ntile = nband + (lat ? 8 : 0);
        const bf16_t* KBs = KB + (size_t)rowbase * 256 + kvh * 64; const bf16_t* VTs = vt + (size_t)(kvh * 64) * T;
        const bf16_t* CKs = CK + (size_t)b * 512 * 256 + kvh * 64; const bf16_t* CVTs = CVT + (size_t)((b * 4 + kvh) * 64) * 512;
        bf16x8 Qf[2][2];
#pragma unroll
        for (int qg = 0; qg < 2; ++qg)
#pragma unroll
            for (int ds = 0; ds < 2; ++ds) Qf[qg][ds] = *(const bf16x8*)(Q + (size_t)(rowbase + q0 + 16 * qg + fr) * D + h * 64 + 32 * ds + 8 * g4);
        float mrun[2], lrun[2]; f32x4 Oa[2][4];
#pragma unroll
        for (int qg = 0; qg < 2; ++qg) { mrun[qg] = sink[h] * 1.4426950408889634f; lrun[qg] = 1.f;
#pragma unroll
            for (int db = 0; db < 4; ++db) Oa[qg][db] = (f32x4){0.f, 0.f, 0.f, 0.f}; }
        AttTile tl; att_tile_of(0, lat, nband, kband0, KBs, VTs, T, CKs, CVTs, tl);
        u32x4 rk = *(const u32x4*)(tl.K + (size_t)lrow * tl.ldk + lchunk * 8), rv = *(const u32x4*)(tl.V + (size_t)lrow * tl.ldv + lchunk * 8);
        __syncthreads();
        *(LAS u32x4*)(lds + lrow * ATT_LDK + lchunk * 16) = rk; *(LAS u32x4*)(lds + 64 * ATT_LDK + lrow * ATT_LDK + lchunk * 16) = rv;
        __syncthreads();
#pragma unroll 1
        for (int t = 0; t < ntile; ++t) {
            const int cur_k0 = tl.k0, cur_mask = tl.mask;
            if (t + 1 < ntile) { att_tile_of(t + 1, lat, nband, kband0, KBs, VTs, T, CKs, CVTs, tl);
                rk = *(const u32x4*)(tl.K + (size_t)lrow * tl.ldk + lchunk * 8); rv = *(const u32x4*)(tl.V + (size_t)lrow * tl.ldv + lchunk * 8); }
            const LAS unsigned char* kb_ = lds + (t & 1) * ATT_TILE_BYTES; const LAS unsigned char* vb_ = kb_ + 64 * ATT_LDK;
#pragma unroll
            for (int sub = 0; sub < 2; ++sub) {
                bf16x8 Kf[2][2], Vf[4];
#pragma unroll
                for (int kb = 0; kb < 2; ++kb)
#pragma unroll
                    for (int ds = 0; ds < 2; ++ds) Kf[kb][ds] = *(const LAS bf16x8*)(kb_ + (32 * sub + 16 * kb + fr) * ATT_LDK + 64 * ds + 16 * g4);
#pragma unroll
                for (int db = 0; db < 4; ++db) { const LAS unsigned char* vp = vb_ + (16 * db + fr) * ATT_LDK + 64 * sub + 8 * g4; const u32x2 lo = *(const LAS u32x2*)vp, hi = *(const LAS u32x2*)(vp + 32);
                    Vf[db] = __builtin_bit_cast(bf16x8, (u32x4){lo.x, lo.y, hi.x, hi.y}); }
                const float c = 0.125f * 1.4426950408889634f;
#pragma unroll
                for (int qg = 0; qg < 2; ++qg) {
                    f32x4 S[2];
#pragma unroll
                    for (int kb = 0; kb < 2; ++kb) { S[kb] = __builtin_amdgcn_mfma_f32_16x16x32_bf16(Kf[kb][0], Qf[qg][0], (f32x4){0.f, 0.f, 0.f, 0.f}, 0, 0, 0); S[kb] = __builtin_amdgcn_mfma_f32_16x16x32_bf16(Kf[kb][1], Qf[qg][1], S[kb], 0, 0, 0); }
                    float mx = -1e30f; const int qpos = q0 + 16 * qg + fr;
#pragma unroll
                    for (int kb = 0; kb < 2; ++kb)
#pragma unroll
                        for (int r = 0; r < 4; ++r) { float x = S[kb][r] * c; if (cur_mask) { const int d = cur_k0 + 32 * sub + 16 * kb + 4 * g4 + r - qpos; if (d > 128 || d < -128) x = -1e30f; } S[kb][r] = x; mx = fmaxf(mx, x); }
                    mx = rows_max(mx);
                    const float mnew = fmaxf(mrun[qg], mx), alpha = fast_exp2(mrun[qg] - mnew);
                    float rs = 0.f;
#pragma unroll
                    for (int kb = 0; kb < 2; ++kb)
#pragma unroll
                        for (int r = 0; r < 4; ++r) { const float p = fast_exp2(S[kb][r] - mnew); S[kb][r] = p; rs += p; }
                    rs = rows_sum(rs);
                    lrun[qg] = lrun[qg] * alpha + rs; mrun[qg] = mnew;
                    u32x4 pw; pw.x = cvt_pk_bf16(S[0][0], S[0][1]); pw.y = cvt_pk_bf16(S[0][2], S[0][3]); pw.z = cvt_pk_bf16(S[1][0], S[1][1]); pw.w = cvt_pk_bf16(S[1][2], S[1][3]);
                    const bf16x8 Pf = __builtin_bit_cast(bf16x8, pw);
#pragma unroll
                    for (int db = 0; db < 4; ++db) { Oa[qg][db] = Oa[qg][db] * alpha; Oa[qg][db] = __builtin_amdgcn_mfma_f32_16x16x32_bf16(Vf[db], Pf, Oa[qg][db], 0, 0, 0); }
                }
            }
            if (t + 1 < ntile) { LAS unsigned char* nb = lds + ((t + 1) & 1) * ATT_TILE_BYTES;
                *(LAS u32x4*)(nb + lrow * ATT_LDK + lchunk * 16) = rk; *(LAS u32x4*)(nb + 64 * ATT_LDK + lrow * ATT_LDK + lchunk * 16) = rv; }
            __syncthreads();
        }
#pragma unroll
        for (int qg = 0; qg < 2; ++qg) { const float inv = 1.f / lrun[qg];
#pragma unroll
            for (int db = 0; db < 4; ++db) { const f32x4 o = Oa[qg][db] * inv; u32x2 w; w.x = cvt_pk_bf16(o[0], o[1]); w.y = cvt_pk_bf16(o[2], o[3]);
                *(u32x2*)(O + (size_t)(rowbase + q0 + 16 * qg + fr) * D + h * 64 + 16 * db + 4 * g4) = w; } }
    }
}

__device__ __forceinline__ void sgu_phase(Frame& F, const bf16_t* U, const bf16_t* V, const f32x2* STATS, const float* ln_g, const bf16_t* WSb, const float* b_s, bf16_t* UM) {
    constexpr int LDT = 136;
    LAS bf16_t* LT = (LAS bf16_t*)F.lds;
    LAS f32x2* ST = (LAS f32x2*)(F.lds + 128 * LDT * 2);
    const int fr = F.lane & 15, g4 = F.lane >> 4;
    for (int it = F.blk; it < 768; it += F.G) {
        const int ch = it >> 3, g = it & 7, r0 = ch * 128;
        if (F.tid < 128) { const f32x2* sp = STATS + (size_t)(r0 + F.tid) * 16; float s1 = 0.f, s2 = 0.f;
#pragma unroll
            for (int k = 0; k < 16; ++k) { const f32x2 p = sp[k]; s1 += p.x; s2 += p.y; }
            const float mu = s1 * (1.f / D), var = s2 * (1.f / D) - mu * mu; ST[F.tid] = (f32x2){mu, rsqrtf(fmaxf(var, 0.f) + EPS)}; }
        __syncthreads();
#pragma unroll
        for (int i = 0; i < 4; ++i) { const int q = F.tid + 512 * i, r = q & 127, c8 = (q >> 7) * 8;
            const u32x4 raw = *(const u32x4*)(V + (size_t)(r0 + r) * D + g * 128 + c8); const f32x2 st = ST[r];
            const f32x4 ga = *(const f32x4*)(ln_g + g * 128 + c8), gb = *(const f32x4*)(ln_g + g * 128 + c8 + 4);
            const unsigned rw[4] = {raw.x, raw.y, raw.z, raw.w};
#pragma unroll
            for (int e = 0; e < 8; ++e) { const float x = bf2f((unsigned short)(e & 1 ? rw[e >> 1] >> 16 : rw[e >> 1] & 0xffff)); const float gg = e < 4 ? ga[e & 3] : gb[e & 3];
                LT[(c8 + e) * LDT + r] = (bf16_t)f2bf((x - st.x) * st.y * gg); } }
        __syncthreads();
        f32x4 acc[8];
#pragma unroll
        for (int cb = 0; cb < 8; ++cb) acc[cb] = (f32x4){0.f, 0.f, 0.f, 0.f};
        const int p = 16 * F.wave + fr;
#pragma unroll
        for (int ks = 0; ks < 4; ++ks) { const bf16x8 bw = *(const bf16x8*)(WSb + (size_t)(g * 128 + p) * 128 + 32 * ks + 8 * g4);
#pragma unroll
            for (int cb = 0; cb < 8; ++cb) { const bf16x8 av = *(const LAS bf16x8*)(LT + (16 * cb + fr) * LDT + 32 * ks + 8 * g4); acc[cb] = __builtin_amdgcn_mfma_f32_16x16x32_bf16(av, bw, acc[cb], 0, 0, 0); } }
        const float bsv = b_s[g * 128 + p];
#pragma unroll
        for (int cb = 0; cb < 8; ++cb) { const size_t off = (size_t)(r0 + p) * D + g * 128 + 16 * cb + 4 * g4; const u32x2 uw = *(const u32x2*)(U + off);
            const float u0 = bf2f((unsigned short)(uw.x & 0xffff)), u1 = bf2f((unsigned short)(uw.x >> 16)), u2 = bf2f((unsigned short)(uw.y & 0xffff)), u3 = bf2f((unsigned short)(uw.y >> 16));
            u32x2 w; w.x = cvt_pk_bf16(u0 * (acc[cb][0] + bsv), u1 * (acc[cb][1] + bsv)); w.y = cvt_pk_bf16(u2 * (acc[cb][2] + bsv), u3 * (acc[cb][3] + bsv)); *(u32x2*)(UM + off) = w; }
        __syncthreads();
    }
}

struct Args { const float* in[26]; float* out; unsigned char* ws; int ph_lo, ph_hi; };
__global__ void __launch_bounds__(NWAVES * 64, 2) mk_fwd(const Args args) {
    extern __shared__ __attribute__((aligned(16))) unsigned char lds_raw[];
    Frame F;
    F.lds = (LAS unsigned char*)lds_raw;
    F.tid = threadIdx.x; F.lane = F.tid & 63; F.wave = __builtin_amdgcn_readfirstlane(F.tid >> 6);
    F.G = gridDim.x; F.blk = blockIdx.x;
    F.in = (const __attribute__((address_space(4))) cfp_t*)__builtin_amdgcn_kernarg_segment_ptr();
    F.out = args.out; F.ws = args.ws;
    unsigned char* ws = args.ws;
    volatile LAS unsigned* MISC = (volatile LAS unsigned*)(F.lds + MISC_OFF);
    if (F.tid < 32) MISC[F.tid] = 0u;
    __syncthreads();
    const int lo = args.ph_lo, hi = args.ph_hi;
    XcdBarrier bar; bar.bar = (unsigned*)(ws + WS_CTL); bar.x = 0; bar.st = nullptr;
    if (hi - lo > 1) bar = xcd_barrier_post((unsigned*)(ws + WS_CTL), MISC + 8);
    LAS float* XCH = (LAS float*)(F.lds + XCH_OFF);
#define CASE_BEGIN() frame_refresh(F); unsigned long long ws_ = (unsigned long long)args.ws, in_ = (unsigned long long)__builtin_amdgcn_kernarg_segment_ptr(); asm volatile("" : "+s"(ws_), "+s"(in_)); \
        unsigned char* ws = (unsigned char*)(GAS unsigned char*)ws_; F.ws = ws; F.in = (const __attribute__((address_space(4))) cfp_t*)in_; \
        float* X = (float*)(ws + WS_X); bf16_t* H = (bf16_t*)(ws + WS_H); bf16_t* H2 = (bf16_t*)(ws + WS_H2); \
        const float* modl = (const float*)(ws + WS_MOD) + l * 3 * 6 * D; const float* xs0 = l == 0 ? ((const float*)F.in[0]) : X; const float* xs1 = l == 0 ? ((const float*)F.in[1]) : X + (size_t)MP * D; \
        (void)X; (void)H; (void)H2; (void)modl; (void)xs0; (void)xs1
#pragma unroll 1
    for (int ph = lo; ph < hi; ++ph) {
        int l = 0, kind;
        if (ph == 0) kind = 0; else if (ph == 28) kind = 12;
        else { l = ph < 8 ? 0 : ph < 15 ? 1 : ph < 21 ? 2 : 3; const int j = ph - (l == 0 ? 1 : l == 1 ? 8 : l == 2 ? 15 : 21), n = l == 2 ? 1 : 2;
            kind = j == 0 ? 1 : j <= n ? (l == 0 ? 1 + j : l == 1 ? 3 + j : l == 2 ? 6 : 6 + j) : j == n + 1 ? 9 : j == n + 2 ? 13 : j == n + 3 ? 10 : 11; }
        const int reps = (kind == MK_REP_KIND || (MK_REP_KIND == 1 && kind == 13)) ? 1 + MK_REP_N : 1;
#pragma unroll 1
        for (int rep = 0; rep < reps; ++rep) {
        if (rep > 0) xcd_barrier(bar);
        switch (kind) {
        case 0: if (EN(0)) { CASE_BEGIN(); p0_prologue(F); } break;
        case 1: if (EN(1)) { CASE_BEGIN(); norm_phase(F, xs0, xs1, ((const float*)F.in[8]) + l * D, modl, 0, H); } break;
        case 13: if (EN(1)) { CASE_BEGIN(); norm_phase(F, X, X + (size_t)MP * D, ((const float*)F.in[9]) + l * D, modl, 3, H); } break;
        case 2: if (EN(2)) { CASE_BEGIN(); Order<48, 6, 0, D, D> S; S.init(F.G, F.blk, H, ws + WS_WQKV);
                EpiQKV E{(bf16_t*)(ws + WS_Q), (bf16_t*)(ws + WS_KB), (bf16_t*)(ws + WS_VT), F.out + OUT_NK, F.out + OUT_NV, (const float*)(ws + WS_ROPE)};
                pg8::gemm_phase<D, D, D / 64>(F.lds, S, E); } break;
        case 3: if (EN(3)) { CASE_BEGIN(); attn_phase(F, (const bf16_t*)(ws + WS_Q), (const bf16_t*)(ws + WS_KB), (const bf16_t*)(ws + WS_VT), (const bf16_t*)(ws + WS_CK), (const bf16_t*)(ws + WS_CVT), ((const float*)F.in[13]), H); } break;
        case 4: if (EN(4)) { CASE_BEGIN(); Order<48, 8, 0, D, D> S; S.init(F.G, F.blk, H, ws + WS_WSGI);
                EpiSgu E{(bf16_t*)(ws + WS_U), (bf16_t*)(ws + WS_V), (f32x2*)(ws + WS_STATS)};
                pg8::gemm_phase<D, D, D / 64>(F.lds, S, E); } break;
        case 5: if (EN(5)) { CASE_BEGIN(); sgu_phase(F, (const bf16_t*)(ws + WS_U), (const bf16_t*)(ws + WS_V), (const f32x2*)(ws + WS_STATS), ((const float*)F.in[15]), (const bf16_t*)(ws + WS_WS), ((const float*)F.in[17]), H); } break;
        case 6: if (EN(6)) { CASE_BEGIN(); OrderSc S{F.blk, (const char*)H, (const char*)(ws + WS_WSCI)};
                EpiSc E{(f32x4*)(ws + WS_YB) + (size_t)F.blk * 2 * 16 * 512, H2, ((const float*)F.in[20]), XCH};
                pg8::gemm_phase<D, D, D / 64>(F.lds, S, E); } break;
        case 7: if (EN(7)) { CASE_BEGIN(); OrderFn1 S{F.G, F.blk, (const char*)(ws + WS_A1), (const char*)H};
                EpiFn1 E{(bf16_t*)(ws + WS_YT)};
                pg8::gemm_phase<256, D, 4>(F.lds, S, E); } break;
        case 8: if (EN(8)) { CASE_BEGIN(); EpiBf16 E{H, D};
                if (F.blk < 64) { OrderFn2 S{F.blk, 1, (const char*)(ws + WS_A2S), (const char*)(ws + WS_YT)}; pg8::gemm_phase<2 * TS, 2 * TS, 2 * TS / 64>(F.lds, S, E); }
                else { OrderFn2 S{F.blk, 0, (const char*)(ws + WS_A2P), (const char*)(ws + WS_YT)}; pg8::gemm_phase<2 * TP, 2 * TP, 2 * TP / 64>(F.lds, S, E); } } break;
        case 9: if (EN(9)) { CASE_BEGIN(); const bf16_t* mix_in = l == 2 ? H2 : H;
                const bf16_t* wout = (const bf16_t*)(ws + (l == 0 ? WS_WO : l == 1 ? WS_WSGO : l == 2 ? WS_WSCO : WS_WFNO));
                Order<48, 4, 0, D, D> S; S.init(F.G, F.blk, mix_in, wout);
                EpiRes E{xs0, xs1, rep == 0 ? X : (float*)(ws + WS_TOTAL), modl, 2};
                pg8::gemm_phase<D, D, D / 64>(F.lds, S, E); } break;
        case 10: if (EN(11)) { CASE_BEGIN(); Order<50, 22, 1, D, D> S; S.init(F.G, F.blk, H, ws + WS_WUP + l * WUP_BYTES);
                EpiUp E{(bf16_t*)(ws + WS_ACT), ((const float*)F.in[24]) + (size_t)l * 3 * 2 * DFF, XCH};
                pg8::gemm_phase<D, D, D / 64>(F.lds, S, E); } break;
        case 11: if (EN(12)) { CASE_BEGIN(); Order<48, 4, 0, DFF, DFF> S; S.init(F.G, F.blk, ws + WS_ACT, ws + WS_WDN + l * WDN_BYTES);
                EpiRes E{X, X + (size_t)MP * D, rep == 0 ? X : (float*)(ws + WS_TOTAL), modl, 5};
                pg8::gemm_phase<DFF, DFF, DFF / 64>(F.lds, S, E); } break;
        default: if (EN(13)) { CASE_BEGIN(); final_phase(F, X, ((const float*)F.in[10]), F.out); } break;
        }
        }
        if (ph + 1 < hi) xcd_barrier(bar);
    }
}

extern "C" void kernel_launch(void* const* d_in, const int* in_sizes, int n_in, void* d_out, int out_size, void* d_ws, size_t ws_size, hipStream_t stream) {
    static int grid = 0;
    if (grid == 0) {
        if (n_in != 26 || ws_size < WS_TOTAL + (MK_REP_N ? (size_t)M * D * 4 : 0)) { fprintf(stderr, "kernel_launch: unexpected n_in %d / ws %zu (need %zu)\n", n_in, ws_size, (size_t)WS_TOTAL); grid = -1; return; }
        int dev = 0, cus = 0;
        if (hipGetDevice(&dev) != hipSuccess || hipDeviceGetAttribute(&cus, hipDeviceAttributeMultiprocessorCount, dev) != hipSuccess) { grid = -1; return; }
        if (hipFuncSetAttribute((const void*)mk_fwd, hipFuncAttributeMaxDynamicSharedMemorySize, LDS_BYTES) != hipSuccess) { fprintf(stderr, "kernel_launch: hipFuncSetAttribute failed\n"); grid = -1; return; }
        (void)hipGetLastError();
        grid = cus;
    }
    if (grid < 0) return;
    (void)hipMemsetAsync((char*)d_ws + WS_CTL, 0, CTL_ZERO_BYTES, stream);
    Args a{};
    for (int i = 0; i < 26; ++i) a.in[i] = (const float*)d_in[i];
    a.out = (float*)d_out; a.ws = (unsigned char*)d_ws;
#if MK_PER_PHASE
    for (int p = MK_PH_LO; p < MK_PH_HI; ++p) { a.ph_lo = p; a.ph_hi = p + 1; hipLaunchKernelGGL(mk_fwd, dim3(grid), dim3(NWAVES * 64), LDS_BYTES, stream, a); }
#else
    a.ph_lo = MK_PH_LO; a.ph_hi = MK_PH_HI;
    hipLaunchKernelGGL(mk_fwd, dim3(grid), dim3(NWAVES * 64), LDS_BYTES, stream, a);
#endif
}
```

```cpp
#include <hip/hip_runtime.h>
#include <cstdio>

#define LAS __attribute__((address_space(3)))
#define GAS __attribute__((address_space(1)))
typedef unsigned short bf16_t;
typedef short bf16x8 __attribute__((ext_vector_type(8)));
typedef float f32x4 __attribute__((ext_vector_type(4)));
typedef float f32x2 __attribute__((ext_vector_type(2)));
typedef unsigned u32x4 __attribute__((ext_vector_type(4)));
typedef unsigned u32x2 __attribute__((ext_vector_type(2)));

constexpr int D = 1024, MP = 8192, MS = 4096, M = MP + MS, DFF = 2816, TS = 2048, TP = 256;
constexpr float EPS = 1e-6f;
constexpr int NWAVES = 8;
#ifndef MK_PER_PHASE
#define MK_PER_PHASE 0
#endif
#ifndef MK_PH_LO
#define MK_PH_LO 0
#endif
#ifndef MK_PH_HI
#define MK_PH_HI 21
#endif
#ifndef MK_MASK
#define MK_MASK 0xffffffffu
#endif
#define EN(b) (((MK_MASK) >> (b)) & 1u)
#ifndef MK_REP_KIND
#define MK_REP_KIND -1
#endif
#ifndef MK_REP_N
#define MK_REP_N 0
#endif

namespace pg8 {
constexpr int BM = 256, BK = 64, HALF = 128, HTB = HALF * BK * 2, STAGE_BYTES = 8 * HTB, NXCD = 8, WGM = 8;
__host__ __device__ __forceinline__ int lds_byte(int r, int c) { const int st = (r >> 4) * 2 + (c >> 5), rr = r & 15, cc = c & 31, ob = rr * 64 + cc * 2; return st * 1024 + (ob ^ (((ob >> 9) & 1) << 5)); }
__host__ __device__ __forceinline__ void stage_rc(int b, int& R, int& C) { const int st = b / 1024, sb = b % 1024, swz = sb ^ (((sb >> 9) & 1) << 5); R = (st >> 1) * 16 + swz / 64; C = (st & 1) * 32 + (swz % 64) / 2; }
__host__ __device__ __forceinline__ int perm32(int rho) { const int n = rho >> 4, i = rho & 15; return 8 * (i >> 2) + 4 * n + (i & 3); }

struct Unit { int pm, pn, row0; const char* a; const char* b; };
struct Cfg { int lda, ldb, nt; };

__device__ __forceinline__ int lane_id() { return (int)__builtin_amdgcn_mbcnt_hi(~0u, __builtin_amdgcn_mbcnt_lo(~0u, 0u)); }
__device__ __forceinline__ unsigned cvt_pk_bf16(float lo, float hi) { unsigned r; asm volatile("v_cvt_pk_bf16_f32 %0, %1, %2" : "=v"(r) : "v"(lo), "v"(hi)); return r; }

template <int LDA, int LDB, int NT, class Epi, class Sched>
__device__ __forceinline__ void gemm_phase(LAS unsigned char* lds, const Sched& S, const Epi& E, int wid) {
    constexpr Cfg g{LDA, LDB, NT};
    int lane_ = lane_id(); asm volatile("" : "+v"(lane_));
    const int lane = lane_, tid = wid * 64 + lane, wr = wid >> 2, wc = wid & 3, fr = lane & 15, fq = lane >> 4;
    const int nt = g.nt;
    unsigned voffA[2], voffB[2];
#pragma unroll
    for (int i = 0; i < 2; ++i) { int R, C; stage_rc(tid * 16 + i * 8192, R, C); const int Rb = Epi::PERM ? ((R & ~31) + perm32(R & 31)) : R;
        voffA[i] = (unsigned)(R * g.lda + C) * 2u; voffB[i] = (unsigned)(Rb * g.ldb + C) * 2u; }
    const size_t kstep = (size_t)(BK * 2);
    const size_t hstepA = (size_t)HALF * g.lda * 2, hstepB = (size_t)HALF * g.ldb * 2;
    const unsigned ldsw = (unsigned)wid * 1024u;
    const int aoff = lds_byte(wr * 64 + fr, fq * 8), boff = lds_byte(wc * 32 + fr, fq * 8);
#define PG8_SA(b, h) (((b) * 2 + (h)) * HTB)
#define PG8_SB(b, h) ((4 + (b) * 2 + (h)) * HTB)
#define PG8_STAGE(bufoff, gbase, voff) do { _Pragma("unroll") for (int _i = 0; _i < 2; ++_i) { unsigned _vo = (voff)[_i]; asm volatile("" : "+v"(_vo)); \
        __builtin_amdgcn_global_load_lds((const unsigned*)((const char*)(gbase) + _vo), (LAS unsigned*)(lds + (bufoff) + ldsw + _i * 8192), 16, 0, 0); } } while (0)
#define PG8_LDA(dst, b, h) do { _Pragma("unroll") for (int m = 0; m < 4; ++m) _Pragma("unroll") for (int k = 0; k < 2; ++k) dst[m][k] = *(const LAS bf16x8*)(lds + PG8_SA(b, h) + aoff + m * 2048 + k * 1024); } while (0)
#define PG8_LDB(dst, b, h) do { _Pragma("unroll") for (int n = 0; n < 2; ++n) _Pragma("unroll") for (int k = 0; k < 2; ++k) dst[n][k] = *(const LAS bf16x8*)(lds + PG8_SB(b, h) + boff + n * 2048 + k * 1024); } while (0)
#define PG8_MMA(ai, bj, At, Bt) do { __builtin_amdgcn_s_setprio(1); _Pragma("unroll") for (int m = 0; m < 4; ++m) _Pragma("unroll") for (int n = 0; n < 2; ++n) _Pragma("unroll") for (int k = 0; k < 2; ++k) \
        acc[ai][bj][m][n] = __builtin_amdgcn_mfma_f32_16x16x32_bf16(Bt[n][k], At[m][k], acc[ai][bj][m][n], 0, 0, 0); __builtin_amdgcn_s_setprio(0); } while (0)
#define PG8_WAIT_V(n) asm volatile("s_waitcnt vmcnt(" #n ")" ::: "memory")
#define PG8_WAIT_L(n) asm volatile("s_waitcnt lgkmcnt(" #n ")" ::: "memory")
#define PG8_BAR __builtin_amdgcn_s_barrier()
#define PG8_SCHED __builtin_amdgcn_sched_barrier(0)
    Unit cur, nxt; int ui = 0;
    if (!S.next(0, cur)) return;
    f32x4 acc[2][2][4][2];
#pragma unroll
    for (int a = 0; a < 2; ++a)
#pragma unroll
        for (int b = 0; b < 2; ++b)
#pragma unroll
            for (int m = 0; m < 4; ++m)
#pragma unroll
                for (int n = 0; n < 2; ++n) acc[a][b][m][n] = (f32x4){0.f, 0.f, 0.f, 0.f};
    bf16x8 At[4][2], B0[2][2], B1[2][2];
    const char* cA = cur.a; const char* cB = cur.b;
    PG8_STAGE(PG8_SB(0, 0), cB, voffB); PG8_STAGE(PG8_SB(0, 1), cB + hstepB, voffB); PG8_STAGE(PG8_SA(0, 0), cA, voffA); PG8_STAGE(PG8_SA(0, 1), cA + hstepA, voffA);
    if (wr == 1) PG8_BAR;
    PG8_WAIT_V(2); PG8_BAR;
    PG8_STAGE(PG8_SB(1, 0), cB + kstep, voffB); PG8_STAGE(PG8_SA(1, 0), cA + kstep, voffA); PG8_STAGE(PG8_SB(1, 1), cB + hstepB + kstep, voffB);
    PG8_WAIT_V(6); PG8_BAR;
    for (;;) {
        const bool has_next = S.next(ui + 1, nxt);
        const char* nA = has_next ? nxt.a : cA; const char* nB = has_next ? nxt.b : cB;
        for (int t = 0; t < nt; t += 2) {
            const bool last = (t == nt - 2);
            const char* a1 = cA + (size_t)(t + 1) * kstep;
            const char* a2 = last ? nA : cA + (size_t)(t + 2) * kstep; const char* b2 = last ? nB : cB + (size_t)(t + 2) * kstep;
            const char* a3 = a2 + kstep; const char* b3 = b2 + kstep;
            PG8_LDB(B0, 0, 0); PG8_LDB(B1, 0, 1); PG8_SCHED; PG8_LDA(At, 0, 0); PG8_STAGE(PG8_SA(1, 1), a1 + hstepA, voffA);
            PG8_WAIT_V(8); PG8_WAIT_L(0); PG8_BAR; PG8_MMA(0, 0, At, B0); PG8_MMA(0, 1, At, B1); PG8_BAR; PG8_SCHED;
            PG8_LDA(At, 0, 1); PG8_STAGE(PG8_SB(0, 0), b2, voffB); PG8_STAGE(PG8_SB(0, 1), b2 + hstepB, voffB); PG8_STAGE(PG8_SA(0, 0), a2, voffA);
            PG8_WAIT_V(8); PG8_WAIT_L(0); PG8_BAR; PG8_MMA(1, 0, At, B0); PG8_MMA(1, 1, At, B1); PG8_BAR; PG8_SCHED;
            PG8_LDB(B0, 1, 0); PG8_LDB(B1, 1, 1); PG8_SCHED; PG8_LDA(At, 1, 0); PG8_STAGE(PG8_SA(0, 1), a2 + hstepA, voffA);
            PG8_WAIT_V(8); PG8_WAIT_L(0); PG8_BAR; PG8_MMA(0, 0, At, B0); PG8_MMA(0, 1, At, B1); PG8_BAR; PG8_SCHED;
            PG8_LDA(At, 1, 1); PG8_STAGE(PG8_SB(1, 0), b3, voffB); PG8_STAGE(PG8_SB(1, 1), b3 + hstepB, voffB); PG8_STAGE(PG8_SA(1, 0), a3, voffA);
            PG8_WAIT_V(8); PG8_WAIT_L(0); PG8_BAR; PG8_MMA(1, 0, At, B0); PG8_MMA(1, 1, At, B1); PG8_BAR; PG8_SCHED;
        }
        if (wr == 0) PG8_BAR;
        E(acc, cur, wid, ui);
        if (!has_next) break;
#pragma unroll
        for (int a = 0; a < 2; ++a)
#pragma unroll
            for (int b = 0; b < 2; ++b)
#pragma unroll
                for (int m = 0; m < 4; ++m)
#pragma unroll
                    for (int n = 0; n < 2; ++n) acc[a][b][m][n] = (f32x4){0.f, 0.f, 0.f, 0.f};
        cur = nxt; cA = nA; cB = nB; ++ui;
        if (wr == 1) PG8_BAR;
    }
    PG8_WAIT_V(0);
    PG8_BAR;
#undef PG8_SA
#undef PG8_SB
#undef PG8_STAGE
#undef PG8_LDA
#undef PG8_LDB
#undef PG8_MMA
#undef PG8_WAIT_V
#undef PG8_WAIT_L
#undef PG8_BAR
#undef PG8_SCHED
}
}
using pg8::Unit; using pg8::cvt_pk_bf16;

constexpr size_t MiB = 1u << 20;
constexpr size_t WS_CTL = 0, CTL_ZERO_BYTES = 128 * 1024;
constexpr size_t WS_MOD = 1 * MiB;
constexpr size_t WS_ROPE = WS_MOD + 512 * 1024;
constexpr size_t WS_STATS = WS_ROPE + 64 * 1024;
constexpr size_t WS_WQKV = 4 * MiB;
constexpr size_t WS_WO = WS_WQKV + 3 * MiB;
constexpr size_t WS_WSGI = WS_WO + 2 * MiB;
constexpr size_t WS_WSGO = WS_WSGI + 4 * MiB;
constexpr size_t WS_WSCI = WS_WSGO + 2 * MiB;
constexpr size_t WS_WSCO = WS_WSCI + 6 * MiB;
constexpr size_t WS_WFNO = WS_WSCO + 2 * MiB;
constexpr size_t WS_WUP = WS_WFNO + 2 * MiB;
constexpr size_t WUP_BYTES = (size_t)2 * DFF * D * 2;
constexpr size_t WS_WDN = WS_WUP + 4 * WUP_BYTES;
constexpr size_t WDN_BYTES = (size_t)D * DFF * 2;
constexpr size_t WS_WS = WS_WDN + 4 * WDN_BYTES;
constexpr size_t WS_A1 = WS_WS + 256 * 1024;
constexpr size_t WS_A2P = WS_A1 + 256 * 1024;
constexpr size_t WS_A2S = WS_A2P + 256 * 1024;
constexpr size_t WS_CK = WS_A2S + 16 * MiB;
constexpr size_t WS_CVT = WS_CK + 512 * 1024;
constexpr size_t WS_X = WS_CVT + 512 * 1024;
constexpr size_t WS_H = WS_X + (size_t)M * D * 4;
constexpr size_t WS_BIG = WS_H + (size_t)(M + 256) * D * 2;
constexpr size_t WS_END = WS_BIG + 72 * MiB;
constexpr size_t WS_ACT = WS_BIG;
constexpr size_t WS_Q = WS_BIG;
constexpr size_t WS_KB = WS_Q + 24 * MiB;
constexpr size_t WS_VT = WS_KB + 6 * MiB;
constexpr size_t WS_U = WS_BIG;
constexpr size_t WS_V = WS_BIG + 24 * MiB;
constexpr size_t WS_YB = WS_BIG;
constexpr size_t WS_YT = WS_BIG;
static_assert(WS_YB + (size_t)256 * 2 * 16 * 512 * 16 <= WS_END, "yb");
static_assert(WS_ACT + (size_t)M * DFF * 2 <= WS_END, "act");
constexpr size_t WS_H2 = WS_END;
constexpr size_t WS_HN = WS_H2 + (size_t)M * D * 2;
constexpr size_t WS_XS = WS_HN + (size_t)(M + 256) * D * 2;
constexpr size_t WS_TOTAL = WS_XS + (size_t)16 * M * 4 * 4;
constexpr size_t CTL_CNT = 16384;
constexpr size_t CTL_TMO = CTL_CNT + 16 * 48 * 64;

constexpr size_t OUT_NK = (size_t)M * D, OUT_NV = OUT_NK + (size_t)MP * 256;

#define XB_TMO      128
#define XB_XCNT(j)  (256  + 64 * (j))
#define XB_XSUB(j)  (1280 + 64 * (j))
#define XB_XGEN(j)  (2304 + 64 * (j))
#define XB_TOP      3328
#define XB_TOPGEN   3392
#define XCD_BAR_WORDS 3456
#define XB_SPIN_CAP (1u << 22)
__device__ __forceinline__ unsigned xb_ld(unsigned* p)              { return __hip_atomic_load(p, __ATOMIC_RELAXED, __HIP_MEMORY_SCOPE_AGENT); }
__device__ __forceinline__ unsigned xb_add(unsigned* p, unsigned v) { return __hip_atomic_fetch_add(p, v, __ATOMIC_RELAXED, __HIP_MEMORY_SCOPE_AGENT); }
__device__ __forceinline__ unsigned xb_xcc_id() { return (unsigned)__builtin_amdgcn_s_getreg((3 << 11) | 20) & 0xFu; }
#define XB_SPIN(cond, bar) do { unsigned _sp = 0; while (cond) { __builtin_amdgcn_s_sleep(1); \
    if ((++_sp & 255u) == 0u) { if (xb_ld(&(bar)[XB_TMO])) break; if (_sp > XB_SPIN_CAP) { atomicAdd(&(bar)[XB_TMO], 1u); break; } } } } while (0)
struct XcdBarrier { unsigned* bar; unsigned x; volatile LAS unsigned* st; };
__device__ __forceinline__ XcdBarrier xcd_barrier_post(unsigned* bar, volatile LAS unsigned* st, bool leader) {
    XcdBarrier b; b.bar = bar; b.x = xb_xcc_id(); b.st = st;
    if (leader) (void)xb_add(&bar[XB_XCNT(b.x)], 1u);
    return b;
}
__device__ __forceinline__ void xcd_barrier_complete(unsigned* bar, unsigned x, unsigned& nloc, unsigned& nx) {
    const unsigned G = gridDim.x * gridDim.y * gridDim.z;
    unsigned sum, cnt, mine, sp = 0u;
    for (;;) {
        sum = 0u; cnt = 0u; mine = 0u;
#pragma unroll
        for (unsigned j = 0; j < 16; ++j) { const unsigned c = xb_ld(&bar[XB_XCNT(j)]); sum += c; cnt += (c > 0u) ? 1u : 0u; mine = (j == x) ? c : mine; }
        if (sum == G) break;
        __builtin_amdgcn_s_sleep(1);
        if ((++sp & 255u) == 0u) { if (xb_ld(&bar[XB_TMO])) break; if (sp > XB_SPIN_CAP) { atomicAdd(&bar[XB_TMO], 1u); break; } }
    }
    nloc = mine > 0u ? mine : 1u; nx = cnt > 0u ? cnt : 1u;
}
__device__ __forceinline__ void xcd_barrier(const XcdBarrier& b, bool leader) {
    asm volatile("s_waitcnt vmcnt(0)" ::: "memory");
    __syncthreads();
    if (leader) {
        unsigned* bar = b.bar;
        __builtin_amdgcn_s_waitcnt(0);
        unsigned nloc = b.st[0], nx = b.st[1];
        if (nloc == 0u) { xcd_barrier_complete(bar, b.x, nloc, nx); b.st[0] = nloc; b.st[1] = nx; }
        const unsigned old = xb_add(&bar[XB_XSUB(b.x)], 1u);
        const unsigned gen = old / nloc;
        if (old + 1u == (gen + 1u) * nloc) {
            __builtin_amdgcn_fence(__ATOMIC_RELEASE, "agent");
            asm volatile("s_waitcnt vmcnt(0)" ::: "memory");
            const unsigned og = xb_add(&bar[XB_TOP], 1u);
            const unsigned tg = og / nx;
            if (og + 1u == (tg + 1u) * nx) xb_add(&bar[XB_TOPGEN], 1u);
            else XB_SPIN(xb_ld(&bar[XB_TOPGEN]) == tg, bar);
            __builtin_amdgcn_fence(__ATOMIC_ACQUIRE, "agent");
            xb_add(&bar[XB_XGEN(b.x)], 1u);
            asm volatile("s_waitcnt vmcnt(0)" ::: "memory");
        } else {
            XB_SPIN(xb_ld(&bar[XB_XGEN(b.x)]) == gen, bar);
            __builtin_amdgcn_fence(__ATOMIC_ACQUIRE, "agent");
            asm volatile("s_waitcnt vmcnt(0)" ::: "memory");
        }
    }
    __syncthreads();
}

#define LDS_WAIT() asm volatile("s_waitcnt lgkmcnt(0)" ::: "memory")
__device__ __forceinline__ unsigned f2bf(float f) { unsigned u = __builtin_bit_cast(unsigned, f); return (u + 0x7fffu + ((u >> 16) & 1u)) >> 16; }
__device__ __forceinline__ unsigned pk2(float lo, float hi) { return f2bf(lo) | (f2bf(hi) << 16); }
__device__ __forceinline__ float bf2f(unsigned short b) { return __builtin_bit_cast(float, (unsigned)b << 16); }
__device__ __forceinline__ float rows_max(float x) {
    auto s = __builtin_amdgcn_permlane16_swap(__float_as_uint(x), __float_as_uint(x), false, false); x = fmaxf(__uint_as_float(s[0]), __uint_as_float(s[1]));
    auto t = __builtin_amdgcn_permlane32_swap(__float_as_uint(x), __float_as_uint(x), false, false); return fmaxf(__uint_as_float(t[0]), __uint_as_float(t[1])); }
__device__ __forceinline__ float rows_sum(float x) {
    auto s = __builtin_amdgcn_permlane16_swap(__float_as_uint(x), __float_as_uint(x), false, false); x = __uint_as_float(s[0]) + __uint_as_float(s[1]);
    auto t = __builtin_amdgcn_permlane32_swap(__float_as_uint(x), __float_as_uint(x), false, false); return __uint_as_float(t[0]) + __uint_as_float(t[1]); }
template <int CTRL> __device__ __forceinline__ float dppx(float v) { return __builtin_bit_cast(float, __builtin_amdgcn_update_dpp(0, __builtin_bit_cast(int, v), CTRL, 0xf, 0xf, false)); }
__device__ __forceinline__ float wave_sum(float v) {
    v += dppx<0xB1>(v);
    v += dppx<0x4E>(v);
    v += dppx<0x141>(v);
    v += dppx<0x140>(v);
    return rows_sum(v);
}
__device__ __forceinline__ float fast_exp2(float x) { return __builtin_amdgcn_exp2f(x); }
__device__ __forceinline__ float fast_rcp(float x) { return __builtin_amdgcn_rcpf(x); }
__device__ __forceinline__ float silu_f(float x) { return x * fast_rcp(1.f + fast_exp2(-1.4426950408889634f * x)); }
__device__ __forceinline__ float gelu_f(float x) { const float u = x * (1.f + 0.044715f * x * x); return x * fast_rcp(1.f + fast_exp2(-2.302208198f * u)); }
__device__ __forceinline__ int conv_row0(int pm) { if (pm < 32) return 256 * pm; const int s = (pm - 32) / 9, i = (pm - 32) % 9; return MP + TS * s + 254 * i - 1; }
template <int CTRL> __device__ __forceinline__ float dpp(float v) { return __builtin_bit_cast(float, __builtin_amdgcn_update_dpp(0, __builtin_bit_cast(int, v), CTRL, 0xf, 0xf, false)); }
template <int CTRL> __device__ __forceinline__ f32x4 dpp4(f32x4 v) { return (f32x4){dpp<CTRL>(v[0]), dpp<CTRL>(v[1]), dpp<CTRL>(v[2]), dpp<CTRL>(v[3])}; }
#define DPP_ROR1 0x121
#define DPP_ROR15 0x12F

template <int NM, int NN, int CONV, int LDA, int LDB>
struct Order {
    int G, c; const char* A; const char* B;
    __device__ __forceinline__ void init(int G_, int c_, const void* A_, const void* B_) { G = G_; c = c_; A = (const char*)A_; B = (const char*)B_; }
    __device__ __forceinline__ bool next(int i, Unit& u) const {
        constexpr int nwg = NM * NN;
        const int L = i * G + c; if (L >= nwg) return false;
        int wgid = L; { constexpr int q = nwg / pg8::NXCD, r = nwg % pg8::NXCD; const int xcd = wgid % pg8::NXCD, off = wgid / pg8::NXCD; wgid = (xcd < r ? xcd * (q + 1) : r * (q + 1) + (xcd - r) * q) + off; }
        constexpr int nig = pg8::WGM * NN; const int gid = wgid / nig, fm = gid * pg8::WGM, gsz = (NM - fm) < pg8::WGM ? (NM - fm) : pg8::WGM;
        u.pm = fm + ((wgid % nig) % gsz); u.pn = (wgid % nig) / gsz;
        u.row0 = CONV ? conv_row0(u.pm) : 256 * u.pm;
        u.a = A + (long)u.row0 * (long)(LDA * 2); u.b = B + (size_t)u.pn * (size_t)(256 * LDB * 2); return true;
    }
};

typedef const GAS float* cfp_t;
struct Frame {
    LAS unsigned char* lds; int tid, lane, wave, G, blk;
    const __attribute__((address_space(4))) cfp_t* in; float* out; unsigned char* ws;
};
__device__ __forceinline__ void frame_refresh(Frame& F) {
    int ln = pg8::lane_id(); asm volatile("" : "+v"(ln)); F.lane = ln; F.tid = F.wave * 64 + ln;
}
constexpr int RING_BYTES = 131072, XCH_OFF = RING_BYTES  , MISC_OFF = XCH_OFF + 8192 + 320, LDS_BYTES = 147456;
__device__ __forceinline__ int vec_plain(int pm) { return pm < 32 ? 0 : 1 + (pm - 32) / 8; }
__device__ __forceinline__ int vec_conv(int pm) { return pm < 32 ? 0 : 1 + (pm - 32) / 9; }

struct EpiBase {
    unsigned char* ws_; int l, aux;
    __device__ __forceinline__ unsigned char* wsp() const { unsigned long long w = (unsigned long long)ws_; asm volatile("" : "+s"(w)); return (unsigned char*)(GAS unsigned char*)w; }
    __device__ __forceinline__ static const __attribute__((address_space(4))) cfp_t* kargs() { unsigned long long kp = (unsigned long long)__builtin_amdgcn_kernarg_segment_ptr(); asm volatile("" : "+s"(kp)); return (const __attribute__((address_space(4))) cfp_t*)kp; }
    __device__ __forceinline__ static const float* inp(const __attribute__((address_space(4))) cfp_t* ka, int k) { return (const float*)ka[k]; }
    __device__ __forceinline__ static float* outp(const __attribute__((address_space(4))) cfp_t* ka) { return (float*)(GAS float*)ka[26]; }
    __device__ __forceinline__ static LAS float* xch() { extern __shared__ __attribute__((aligned(16))) unsigned char lds_base_[]; return (LAS float*)((LAS unsigned char*)lds_base_ + XCH_OFF); }
};
template <bool FINAL>
struct EpiResNorm : EpiBase {
    static constexpr bool PERM = false;
    __device__ __forceinline__ void operator()(f32x4 (&acc)[2][2][4][2], const Unit& u, int wid, int ) const {
        int lane_ = pg8::lane_id(); asm volatile("" : "+v"(lane_));
        const int lane = lane_, wr = wid >> 2, wc = wid & 3, fr = lane & 15, fq = lane >> 4; (void)wr; (void)wc; (void)fr; (void)fq;
        unsigned char* ws = wsp(); const auto ka = kargs();
        const int isdn = aux & 1, rep = (aux >> 1) & 1, inst = 2 * l + isdn + 8 * rep;
        float* Xr = (float*)(ws + WS_X); float* X = rep ? (float*)(ws + WS_TOTAL) : Xr;
        const float* src0 = (!isdn && l == 0) ? inp(ka, 0) : Xr; const float* src1 = (!isdn && l == 0) ? inp(ka, 1) : Xr + (size_t)MP * D;
        const float* modl = (const float*)(ws + WS_MOD) + l * 3 * 6 * D; const int gate_idx = isdn ? 5 : 2;
        const float* gn = FINAL ? inp(ka, 10) : (isdn ? inp(ka, 8) + (l + 1) * D : inp(ka, 9) + l * D);
        const float* modn = isdn ? modl + 3 * 6 * D : modl; const int sh_idx = isdn ? 0 : 3;
        bf16_t* HN = (bf16_t*)(ws + WS_HN); float* Y = outp(ka);
        float* xs = (float*)(ws + WS_XS) + (size_t)inst * M * 4; unsigned* cnt = (unsigned*)(ws + WS_CTL + CTL_CNT) + inst * 48 * 16; unsigned* tmo = (unsigned*)(ws + WS_CTL + CTL_TMO);
        LAS float* L = xch();
        const int col0 = u.pn * 256 + wc * 32 + 4 * fq, vec = vec_plain(u.pm), tid = wid * 64 + lane;
        const float* gate = modl + vec * 6 * D + gate_idx * D;
        const float* src = u.row0 < MP ? src0 + (size_t)u.row0 * D : src1 + (size_t)(u.row0 - MP) * D;
        LAS float* P = L;
        LAS float* S = L + 1024;
        {
            f32x4 gv[2][2];
#pragma unroll
            for (int bj = 0; bj < 2; ++bj)
#pragma unroll
                for (int n = 0; n < 2; ++n) gv[bj][n] = *(const f32x4*)(gate + col0 + bj * 128 + n * 16);
#pragma unroll
            for (int ai = 0; ai < 2; ++ai)
#pragma unroll
                for (int m = 0; m < 4; ++m) { const int r = ai * 128 + wr * 64 + m * 16 + fr; const float* sp = src + (size_t)r * D + col0; float* xp = X + (size_t)(u.row0 + r) * D + col0; float ss = 0.f;
#pragma unroll
                    for (int bj = 0; bj < 2; ++bj)
#pragma unroll
                        for (int n = 0; n < 2; ++n) { const f32x4 sv = *(const f32x4*)(sp + bj * 128 + n * 16); const f32x4 x1 = sv + gv[bj][n] * acc[ai][bj][m][n]; acc[ai][bj][m][n] = x1;
                            if (!FINAL) *(f32x4*)(xp + bj * 128 + n * 16) = x1; ss += (x1[0] * x1[0] + x1[1] * x1[1]) + (x1[2] * x1[2] + x1[3] * x1[3]); }
                    ss = rows_sum(ss);
                    if (fq == 0) P[r * 4 + wc] = ss;
                    asm volatile("" ::: "memory"); }
        }
        LDS_WAIT(); __builtin_amdgcn_s_barrier(); asm volatile("" ::: "memory");
        if (tid < 256) { const f32x4 p = *(const LAS f32x4*)(P + tid * 4); const float tot = (p[0] + p[1]) + (p[2] + p[3]);
            __hip_atomic_store(xs + (size_t)(u.row0 + tid) * 4 + u.pn, tot, __ATOMIC_RELAXED, __HIP_MEMORY_SCOPE_AGENT); }
        asm volatile("s_waitcnt vmcnt(0)" ::: "memory");
        if (tid < 256 && (tid & 63) == 0) __hip_atomic_fetch_add(cnt + 16 * u.pm, 1u, __ATOMIC_RELAXED, __HIP_MEMORY_SCOPE_AGENT);
        if (tid < 64) { unsigned sp_ = 0;
            while ((unsigned)__builtin_amdgcn_readfirstlane(__hip_atomic_load(cnt + 16 * u.pm, __ATOMIC_RELAXED, __HIP_MEMORY_SCOPE_AGENT)) < 16u) {
                __builtin_amdgcn_s_sleep(1);
                if ((++sp_ & 1023u) == 0u) { if (__hip_atomic_load(tmo, __ATOMIC_RELAXED, __HIP_MEMORY_SCOPE_AGENT)) break; if (sp_ > (1u << 22)) { __hip_atomic_store(tmo, 1u, __ATOMIC_RELAXED, __HIP_MEMORY_SCOPE_AGENT); break; } } }
        }
        asm volatile("s_waitcnt vmcnt(0) lgkmcnt(0)" ::: "memory"); __builtin_amdgcn_s_barrier(); asm volatile("" ::: "memory");
        if (tid < 256) { const float* sl = xs + (size_t)(u.row0 + tid) * 4; float t = 0.f;
#pragma unroll
            for (int k = 0; k < 4; ++k) t += __hip_atomic_load(sl + k, __ATOMIC_RELAXED, __HIP_MEMORY_SCOPE_AGENT);
            S[tid] = rsqrtf(t * (1.f / D) + EPS); }
        LDS_WAIT(); __builtin_amdgcn_s_barrier(); asm volatile("" ::: "memory");
        {
            f32x4 gm[2][2], sh[2][2];
#pragma unroll
            for (int bj = 0; bj < 2; ++bj)
#pragma unroll
                for (int n = 0; n < 2; ++n) { const int c = col0 + bj * 128 + n * 16; gm[bj][n] = *(const f32x4*)(gn + c);
                    if (!FINAL) { const float* mv = modn + vec * 6 * D; gm[bj][n] = gm[bj][n] * (1.f + *(const f32x4*)(mv + (sh_idx + 1) * D + c)); sh[bj][n] = *(const f32x4*)(mv + sh_idx * D + c); } }
#pragma unroll
            for (int ai = 0; ai < 2; ++ai)
#pragma unroll
                for (int m = 0; m < 4; ++m) { const int r = ai * 128 + wr * 64 + m * 16 + fr; const float rs = S[r];
#pragma unroll
                    for (int bj = 0; bj < 2; ++bj)
#pragma unroll
                        for (int n = 0; n < 2; ++n) { const int c = col0 + bj * 128 + n * 16;
                            if (FINAL) { *(f32x4*)(Y + (size_t)(u.row0 + r) * D + c) = acc[ai][bj][m][n] * rs * gm[bj][n]; }
                            else { const f32x4 h = acc[ai][bj][m][n] * rs * gm[bj][n] + sh[bj][n]; u32x2 w; w.x = cvt_pk_bf16(h[0], h[1]); w.y = cvt_pk_bf16(h[2], h[3]); *(u32x2*)(HN + (size_t)(u.row0 + r) * D + c) = w; } } }
        }
    }
};
struct EpiBf16 : EpiBase {
    static constexpr bool PERM = true;
    __device__ __forceinline__ void operator()(const f32x4 (&acc)[2][2][4][2], const Unit& u, int wid, int ) const {
        int lane_ = pg8::lane_id(); asm volatile("" : "+v"(lane_));
        const int lane = lane_, wr = wid >> 2, wc = wid & 3, fr = lane & 15, fq = lane >> 4; (void)wr; (void)wc; (void)fr; (void)fq;
        bf16_t* O = (bf16_t*)(wsp() + WS_H); constexpr int ldc = D;
        const int col0 = u.pn * 256 + wc * 32 + 8 * fq;
#pragma unroll
        for (int ai = 0; ai < 2; ++ai)
#pragma unroll
            for (int m = 0; m < 4; ++m) { bf16_t* rowp = O + (size_t)(u.row0 + ai * 128 + wr * 64 + m * 16 + fr) * ldc + col0;
#pragma unroll
                for (int bj = 0; bj < 2; ++bj) { const f32x4 v0 = acc[ai][bj][m][0], v1 = acc[ai][bj][m][1];
                    u32x4 w; w.x = cvt_pk_bf16(v0[0], v0[1]); w.y = cvt_pk_bf16(v0[2], v0[3]); w.z = cvt_pk_bf16(v1[0], v1[1]); w.w = cvt_pk_bf16(v1[2], v1[3]);
                    *(u32x4*)(rowp + bj * 128) = w; } }
    }
};
struct EpiQKV : EpiBase {
    static constexpr bool PERM = false;
    __device__ __forceinline__ void operator()(f32x4 (&acc)[2][2][4][2], const Unit& u, int wid, int ) const {
        int lane_ = pg8::lane_id(); asm volatile("" : "+v"(lane_));
        const int lane = lane_, wr = wid >> 2, wc = wid & 3, fr = lane & 15, fq = lane >> 4; (void)wr; (void)wc; (void)fr; (void)fq;
        unsigned char* ws = wsp(); bf16_t* Q = (bf16_t*)(ws + WS_Q); bf16_t* KB = (bf16_t*)(ws + WS_KB); bf16_t* VT = (bf16_t*)(ws + WS_VT); const float* rope = (const float*)(ws + WS_ROPE);
        float* outk = outp(kargs()) + OUT_NK; float* outv = outk + (OUT_NV - OUT_NK);
        const bool samp = u.pm >= 32;
        const int c0 = wc * 32 + 4 * fq;
        if (samp && u.pn <= 4) {
            const int half = wc & 1;
#pragma unroll
            for (int ai = 0; ai < 2; ++ai)
#pragma unroll
                for (int m = 0; m < 4; ++m) { const int t = (u.row0 - MP + ai * 128 + wr * 64 + m * 16 + fr) & (TS - 1); const int pos = half ? (t & 63) : (t >> 6);
                    const f32x4 cs = *(const f32x4*)(rope + pos * 16 + 4 * fq), sn = *(const f32x4*)(rope + 1024 + pos * 16 + 4 * fq);
#pragma unroll
                    for (int bj = 0; bj < 2; ++bj) { const f32x4 x1 = acc[ai][bj][m][0], x2 = acc[ai][bj][m][1]; acc[ai][bj][m][0] = x1 * cs - x2 * sn; acc[ai][bj][m][1] = x2 * cs + x1 * sn; } }
        }
        if (u.pn <= 4) {
            bf16_t* base = u.pn < 4 ? Q + u.pn * 256 : KB; const int ldc = u.pn < 4 ? D : 256;
#pragma unroll
            for (int ai = 0; ai < 2; ++ai)
#pragma unroll
                for (int m = 0; m < 4; ++m) { const int row = u.row0 + ai * 128 + wr * 64 + m * 16 + fr; bf16_t* rowp = base + (size_t)row * ldc + c0;
#pragma unroll
                    for (int bj = 0; bj < 2; ++bj)
#pragma unroll
                        for (int n = 0; n < 2; ++n) { const f32x4 v = acc[ai][bj][m][n]; u32x2 w; w.x = cvt_pk_bf16(v[0], v[1]); w.y = cvt_pk_bf16(v[2], v[3]); *(u32x2*)(rowp + bj * 128 + n * 16) = w;
                            if (u.pn == 4 && !samp) *(f32x4*)(outk + (size_t)row * 256 + c0 + bj * 128 + n * 16) = v; } }
        } else {
            const int T = samp ? TS : TP;
            bf16_t* vt = samp ? VT + (size_t)32 * 65536 + (size_t)((u.row0 - MP) / TS) * 256 * TS : VT + (size_t)(u.row0 / TP) * 65536;
#pragma unroll
            for (int ai = 0; ai < 2; ++ai)
#pragma unroll
                for (int m = 0; m < 4; ++m) { const int row = u.row0 + ai * 128 + wr * 64 + m * 16 + fr; const int t = samp ? ((row - MP) & (TS - 1)) : (row & (TP - 1));
                    unsigned vo = (unsigned)(c0 * T + t); asm volatile("" : "+v"(vo));
#pragma unroll
                    for (int bj = 0; bj < 2; ++bj)
#pragma unroll
                        for (int n = 0; n < 2; ++n) { const f32x4 v = acc[ai][bj][m][n]; const int c = c0 + bj * 128 + n * 16;
#pragma unroll
                            for (int j = 0; j < 4; ++j) vt[vo + (unsigned)((bj * 128 + n * 16 + j) * T)] = (bf16_t)f2bf(v[j]);
                            if (!samp) *(f32x4*)(outv + (size_t)row * 256 + c) = v; } }
        }
    }
};
__device__ __forceinline__ f32x4 conv_m(f32x4 cur, f32x4 pe, f32x4 ne, f32x4 w0, f32x4 w1, f32x4 w2, int fr) {
    const f32x4 up = dpp4<DPP_ROR1>(cur), dn = dpp4<DPP_ROR15>(cur);
    const f32x4 prev = fr > 0 ? up : pe, next = fr < 15 ? dn : ne;
    return w0 * prev + w1 * cur + w2 * next;
}
__device__ __forceinline__ void mask_rows(f32x4 (&acc)[2][2][4][2], const Unit& u, int wr, int fr) {
    if (u.pm < 32) return;
    const int i = (u.pm - 32) % 9; if (i != 0 && i != 8) return;
    const int t0 = 254 * i - 1;
#pragma unroll
    for (int ai = 0; ai < 2; ++ai)
#pragma unroll
        for (int m = 0; m < 4; ++m) { const int t = t0 + ai * 128 + wr * 64 + m * 16 + fr; if (t < 0 || t >= TS) {
#pragma unroll
            for (int bj = 0; bj < 2; ++bj)
#pragma unroll
                for (int n = 0; n < 2; ++n) acc[ai][bj][m][n] = (f32x4){0.f, 0.f, 0.f, 0.f}; } }
}
__device__ __forceinline__ bool row_valid(const Unit& u, int r) {
    if (u.pm < 32) return true;
    const int t = 254 * ((u.pm - 32) % 9) - 1 + r; return r >= 1 && r <= 254 && t >= 0 && t < TS;
}
__device__ __forceinline__ void xch_write(LAS float* X, const f32x4 (&acc)[2][2][4][2], int wr, int wc, int fr, int fq) {
#pragma unroll
    for (int ai = 0; ai < 2; ++ai)
#pragma unroll
        for (int bj = 0; bj < 2; ++bj)
#pragma unroll
            for (int n = 0; n < 2; ++n) { const int col = bj * 128 + wc * 32 + 8 * fq + 4 * n;
                if (fr == 0) *(LAS f32x4*)(X + ((2 * ai + wr) * 2 + 0) * 256 + col) = acc[ai][bj][0][n];
                if (fr == 15) *(LAS f32x4*)(X + ((2 * ai + wr) * 2 + 1) * 256 + col) = acc[ai][bj][3][n]; }
}
__device__ __forceinline__ f32x4 xch_top(const LAS float* X, int b, int col) { return b > 0 ? *(const LAS f32x4*)(X + ((b - 1) * 2 + 1) * 256 + col) : (f32x4){0.f, 0.f, 0.f, 0.f}; }
__device__ __forceinline__ f32x4 xch_bot(const LAS float* X, int b, int col) { return b < 3 ? *(const LAS f32x4*)(X + ((b + 1) * 2 + 0) * 256 + col) : (f32x4){0.f, 0.f, 0.f, 0.f}; }

struct EpiUp : EpiBase {
    static constexpr bool PERM = true;
    __device__ __forceinline__ void operator()(f32x4 (&acc)[2][2][4][2], const Unit& u, int wid, int ) const {
        int lane_ = pg8::lane_id(); asm volatile("" : "+v"(lane_));
        const int lane = lane_, wr = wid >> 2, wc = wid & 3, fr = lane & 15, fq = lane >> 4; (void)wr; (void)wc; (void)fr; (void)fq;
        bf16_t* ACT = (bf16_t*)(wsp() + WS_ACT); const float* cw = inp(kargs(), 24) + (size_t)l * 3 * 2 * DFF; LAS float* X = xch();
        mask_rows(acc, u, wr, fr);
        xch_write(X, acc, wr, wc, fr, fq);
        LDS_WAIT(); __builtin_amdgcn_s_barrier(); asm volatile("" ::: "memory");
        const int chl = wc * 32 + 8 * fq;
#pragma unroll
        for (int n = 0; n < 2; ++n) {
            const int ch = u.pn * 128 + chl + 4 * n;
            f32x4 wg[3], wu[3];
#pragma unroll
            for (int k = 0; k < 3; ++k) { wg[k] = *(const f32x4*)(cw + k * 2 * DFF + ch); wu[k] = *(const f32x4*)(cw + k * 2 * DFF + DFF + ch); }
#pragma unroll
            for (int ai = 0; ai < 2; ++ai) {
                const int b = 2 * ai + wr;
                f32x4 pg = xch_top(X, b, chl + 4 * n), pu = xch_top(X, b, 128 + chl + 4 * n);
#pragma unroll
                for (int m = 0; m < 4; ++m) { const int r = ai * 128 + wr * 64 + m * 16 + fr;
                    const f32x4 vg = acc[ai][0][m][n], vu = acc[ai][1][m][n];
                    const f32x4 ng = m < 3 ? dpp4<DPP_ROR15>(acc[ai][0][m < 3 ? m + 1 : 3][n]) : xch_bot(X, b, chl + 4 * n);
                    const f32x4 nu = m < 3 ? dpp4<DPP_ROR15>(acc[ai][1][m < 3 ? m + 1 : 3][n]) : xch_bot(X, b, 128 + chl + 4 * n);
                    const f32x4 og = conv_m(vg, pg, ng, wg[0], wg[1], wg[2], fr), ou = conv_m(vu, pu, nu, wu[0], wu[1], wu[2], fr);
                    pg = dpp4<DPP_ROR1>(vg); pu = dpp4<DPP_ROR1>(vu);
                    f32x4 a;
#pragma unroll
                    for (int j = 0; j < 4; ++j) a[j] = silu_f(og[j]) * ou[j];
                    if (row_valid(u, r)) { u32x2 w; w.x = cvt_pk_bf16(a[0], a[1]); w.y = cvt_pk_bf16(a[2], a[3]); *(u32x2*)(ACT + (size_t)(u.row0 + r) * DFF + ch) = w; } }
            }
        }
    }
};
struct EpiSgu : EpiBase {
    static constexpr bool PERM = true;
    __device__ __forceinline__ void operator()(f32x4 (&acc)[2][2][4][2], const Unit& u, int wid, int ) const {
        int lane_ = pg8::lane_id(); asm volatile("" : "+v"(lane_));
        const int lane = lane_, wr = wid >> 2, wc = wid & 3, fr = lane & 15, fq = lane >> 4; (void)wr; (void)wc; (void)fr; (void)fq;
        unsigned char* ws = wsp(); bf16_t* U = (bf16_t*)(ws + WS_U); bf16_t* V = (bf16_t*)(ws + WS_V); f32x2* STATS = (f32x2*)(ws + WS_STATS);
        const bool isv = u.pn >= 4; bf16_t* O = isv ? V : U; const int col0 = (u.pn & 3) * 256 + wc * 32 + 8 * fq;
#pragma unroll
        for (int ai = 0; ai < 2; ++ai)
#pragma unroll
            for (int m = 0; m < 4; ++m) { const int row = u.row0 + ai * 128 + wr * 64 + m * 16 + fr; bf16_t* rowp = O + (size_t)row * D + col0; float s1 = 0.f, s2 = 0.f;
#pragma unroll
                for (int bj = 0; bj < 2; ++bj) { f32x4 v0 = acc[ai][bj][m][0], v1 = acc[ai][bj][m][1];
#pragma unroll
                    for (int j = 0; j < 4; ++j) { v0[j] = gelu_f(v0[j]); v1[j] = gelu_f(v1[j]); s1 += v0[j] + v1[j]; s2 += v0[j] * v0[j] + v1[j] * v1[j]; }
                    u32x4 w; w.x = cvt_pk_bf16(v0[0], v0[1]); w.y = cvt_pk_bf16(v0[2], v0[3]); w.z = cvt_pk_bf16(v1[0], v1[1]); w.w = cvt_pk_bf16(v1[2], v1[3]);
                    *(u32x4*)(rowp + bj * 128) = w; }
                if (isv) { s1 = rows_sum(s1); s2 = rows_sum(s2);
                    if (fq == 0) STATS[(size_t)row * 16 + (u.pn - 4) * 4 + wc] = (f32x2){s1, s2}; } }
    }
};
struct EpiSc : EpiBase {
    static constexpr bool PERM = true;
    __device__ __forceinline__ void operator()(f32x4 (&acc)[2][2][4][2], const Unit& u, int wid, int ui) const {
        int lane_ = pg8::lane_id(); asm volatile("" : "+v"(lane_));
        const int lane = lane_, wr = wid >> 2, wc = wid & 3, fr = lane & 15, fq = lane >> 4; (void)wr; (void)wc; (void)fr; (void)fq;
        unsigned char* ws = wsp(); f32x4* YB = (f32x4*)(ws + WS_YB) + (size_t)aux * 2 * 16 * 512; bf16_t* BY = (bf16_t*)(ws + WS_H2); const float* cw = inp(kargs(), 20); LAS float* X = xch();
        const int q = u.pn / 3, s = u.pn % 3, chl = wc * 32 + 8 * fq;
        if (s < 2) {
            mask_rows(acc, u, wr, fr);
#pragma unroll
            for (int ai = 0; ai < 2; ++ai)
#pragma unroll
                for (int m = 0; m < 4; ++m)
#pragma unroll
                    for (int n = 0; n < 2; ++n) acc[ai][0][m][n] = acc[ai][0][m][n] * acc[ai][1][m][n];
            xch_write(X, acc, wr, wc, fr, fq);
            LDS_WAIT(); __builtin_amdgcn_s_barrier(); asm volatile("" ::: "memory");
#pragma unroll
            for (int n = 0; n < 2; ++n) {
                const int ch = q * 256 + s * 128 + chl + 4 * n;
                f32x4 w[3];
#pragma unroll
                for (int k = 0; k < 3; ++k) w[k] = *(const f32x4*)(cw + k * D + ch);
#pragma unroll
                for (int ai = 0; ai < 2; ++ai) { const int b = 2 * ai + wr;
                    f32x4 pp = xch_top(X, b, chl + 4 * n);
#pragma unroll
                    for (int m = 0; m < 4; ++m) { const f32x4 v = acc[ai][0][m][n];
                        const f32x4 nn = m < 3 ? dpp4<DPP_ROR15>(acc[ai][0][m < 3 ? m + 1 : 3][n]) : xch_bot(X, b, chl + 4 * n);
                        const f32x4 o = conv_m(v, pp, nn, w[0], w[1], w[2], fr); pp = dpp4<DPP_ROR1>(v);
                        unsigned yo = (unsigned)((s * 16 + (ai * 4 + m) * 2 + n) * 512) + (unsigned)(wid * 64 + lane); asm volatile("" : "+v"(yo)); YB[yo] = o; } }
            }
        } else {
#pragma unroll
            for (int ai = 0; ai < 2; ++ai)
#pragma unroll
                for (int m = 0; m < 4; ++m) { const int r = ai * 128 + wr * 64 + m * 16 + fr; const bool ok = row_valid(u, r);
#pragma unroll
                    for (int bj = 0; bj < 2; ++bj) { unsigned yo = (unsigned)((bj * 16 + (ai * 4 + m) * 2) * 512) + (unsigned)(wid * 64 + lane); asm volatile("" : "+v"(yo)); const f32x4 y0 = YB[yo], y1 = YB[yo + 512];
                        const f32x4 v0 = acc[ai][bj][m][0] * y0, v1 = acc[ai][bj][m][1] * y1;
                        u32x4 w; w.x = cvt_pk_bf16(v0[0], v0[1]); w.y = cvt_pk_bf16(v0[2], v0[3]); w.z = cvt_pk_bf16(v1[0], v1[1]); w.w = cvt_pk_bf16(v1[2], v1[3]);
                        if (ok) *(u32x4*)(BY + (size_t)(u.row0 + r) * D + q * 256 + bj * 128 + chl) = w; }
                    asm volatile("" ::: "memory"); }
        }
    }
};
struct OrderSc {
    int c; const char* A; const char* B;
    __device__ __forceinline__ bool next(int i, Unit& u) const {
        if (c >= 200 || i >= 3) return false;
        u.pm = c >> 2; u.pn = 3 * (c & 3) + i; u.row0 = conv_row0(u.pm); u.a = A + (long)u.row0 * (D * 2); u.b = B + (size_t)u.pn * 256 * D * 2; return true; }
};
struct EpiFn1 : EpiBase {
    static constexpr bool PERM = true;
    __device__ __forceinline__ void operator()(const f32x4 (&acc)[2][2][4][2], const Unit& u, int wid, int ) const {
        int lane_ = pg8::lane_id(); asm volatile("" : "+v"(lane_));
        const int lane = lane_, wr = wid >> 2, wc = wid & 3, fr = lane & 15, fq = lane >> 4; (void)wr; (void)wc; (void)fr; (void)fq;
        bf16_t* YT = (bf16_t*)(wsp() + WS_YT);
        const int part = u.pm & 1, ch0 = (u.pm >> 1) * 256, tok0 = u.pn * 256;
        bf16_t* base; int T, t0;
        if (tok0 < MP) { T = TP; base = YT + (size_t)(tok0 / TP) * D * 2 * TP; t0 = 0; }
        else { T = TS; base = YT + (size_t)32 * D * 2 * TP + (size_t)((tok0 - MP) / TS) * D * 2 * TS; t0 = (tok0 - MP) % TS; }
        const int c0 = wc * 32 + 8 * fq;
#pragma unroll
        for (int ai = 0; ai < 2; ++ai)
#pragma unroll
            for (int m = 0; m < 4; ++m) { bf16_t* rowp = base + (size_t)(ch0 + ai * 128 + wr * 64 + m * 16 + fr) * 2 * T + part * T + t0 + c0;
#pragma unroll
                for (int bj = 0; bj < 2; ++bj) { const f32x4 v0 = acc[ai][bj][m][0], v1 = acc[ai][bj][m][1];
                    u32x4 w; w.x = cvt_pk_bf16(v0[0], v0[1]); w.y = cvt_pk_bf16(v0[2], v0[3]); w.z = cvt_pk_bf16(v1[0], v1[1]); w.w = cvt_pk_bf16(v1[2], v1[3]);
                    *(u32x4*)(rowp + bj * 128) = w; } }
    }
};
struct OrderFn1 {
    int G, c; const char* A1; const char* H;
    __device__ __forceinline__ bool next(int i, Unit& u) const {
        const int L = i * G + c; if (L >= 384) return false;
        u.pm = L & 7; u.pn = L >> 3; u.row0 = 0; u.a = A1 + (size_t)(u.pm & 1) * 256 * 256 * 2; u.b = H + (size_t)u.pn * 256 * D * 2 + (size_t)(u.pm >> 1) * 512; return true; }
};
struct OrderFn2 {
    int c; int samp; const char* A2; const char* YT;
    __device__ __forceinline__ bool next(int i, Unit& u) const {
        if (i > 0) return false;
        if (samp) { if (c >= 64) return false; const int b = c >> 5, tm = (c >> 2) & 7; u.pm = tm; u.pn = c & 3; u.row0 = MP + b * TS + 256 * tm;
            u.a = A2 + (size_t)tm * 256 * 2 * TS * 2; u.b = YT + (size_t)32 * D * 2 * TP * 2 + (size_t)b * D * 2 * TS * 2 + (size_t)u.pn * 256 * 2 * TS * 2; return true; }
        if (c < 64 || c >= 192) return false; const int j = c - 64, s = j >> 2; u.pm = 0; u.pn = j & 3; u.row0 = s * TP;
        u.a = A2; u.b = YT + (size_t)s * D * 2 * TP * 2 + (size_t)u.pn * 256 * 2 * TP * 2; return true; }
};

__device__ __forceinline__ void p0_transpose_item(const float* W, int K, int N, bf16_t* WT, int drow0, LAS float* scr, int kb, int n0, int lane) {
    const int k0 = 64 * kb;
#pragma unroll 8
    for (int i = 0; i < 32; ++i) { const int kk = 2 * i + (lane >> 5); scr[kk * 33 + (lane & 31)] = W[(size_t)(k0 + kk) * N + n0 + (lane & 31)]; }
    LDS_WAIT(); asm volatile("" ::: "memory");
    const int c = lane & 7;
#pragma unroll
    for (int j = 0; j < 4; ++j) { const int n = (lane >> 3) + 8 * j; const LAS float* s = scr + (8 * c) * 33 + n;
        u32x4 o; o.x = pk2(s[0 * 33], s[1 * 33]); o.y = pk2(s[2 * 33], s[3 * 33]); o.z = pk2(s[4 * 33], s[5 * 33]); o.w = pk2(s[6 * 33], s[7 * 33]);
        *(u32x4*)(WT + (size_t)(drow0 + n) * K + k0 + 8 * c) = o; }
    LDS_WAIT(); asm volatile("" ::: "memory");
}
__device__ __forceinline__ int map_plain(int n) { return n; }
__device__ __forceinline__ int map_up(int n) { return n < DFF ? 256 * (n >> 7) + (n & 127) : 256 * ((n - DFF) >> 7) + 128 + ((n - DFF) & 127); }
__device__ __forceinline__ int map_sc(int n) {
    if (n < D) return (3 * (n >> 8) + 2) * 256 + (n & 255);
    const int x = n >= 2 * D, ch = n - D - x * D; return (3 * (ch >> 8) + ((ch >> 7) & 1)) * 256 + x * 128 + (ch & 127);
}
__device__ __forceinline__ void p0_tjob(int& it, int NGW, LAS float* scr, int lane, const float* W, bf16_t* WT, int K, int N, int map) {
    const int nblk = N / 32, nitems = (K / 64) * nblk;
    for (; it < nitems; it += NGW) { const int kb = it / nblk, n0 = (it % nblk) * 32; const int dr = map == 0 ? n0 : (map == 1 ? map_up(n0) : map_sc(n0));
        p0_transpose_item(W, K, N, WT, dr, scr, kb, n0, lane); }
    it -= nitems;
}
__device__ __forceinline__ void p0_prologue(Frame& F) {
    unsigned char* ws = F.ws;
    {
        LAS float* scr = (LAS float*)(F.lds + F.wave * 16384);
        const int gw = F.blk * NWAVES + F.wave, NGW = F.G * NWAVES;
        int it = gw;
        p0_tjob(it, NGW, scr, F.lane, ((const float*)F.in[11]), (bf16_t*)(ws + WS_WQKV), D, 1536, 0);
        p0_tjob(it, NGW, scr, F.lane, ((const float*)F.in[12]), (bf16_t*)(ws + WS_WO), D, D, 0);
        p0_tjob(it, NGW, scr, F.lane, ((const float*)F.in[14]), (bf16_t*)(ws + WS_WSGI), D, 2048, 0);
        p0_tjob(it, NGW, scr, F.lane, ((const float*)F.in[18]), (bf16_t*)(ws + WS_WSGO), D, D, 0);
        p0_tjob(it, NGW, scr, F.lane, ((const float*)F.in[19]), (bf16_t*)(ws + WS_WSCI), D, 3072, 2);
        p0_tjob(it, NGW, scr, F.lane, ((const float*)F.in[21]), (bf16_t*)(ws + WS_WSCO), D, D, 0);
        p0_tjob(it, NGW, scr, F.lane, ((const float*)F.in[22]), (bf16_t*)(ws + WS_WFNO), D, D, 0);
#pragma unroll 1
        for (int l = 0; l < 4; ++l) p0_tjob(it, NGW, scr, F.lane, ((const float*)F.in[23]) + (size_t)l * D * 2 * DFF, (bf16_t*)(ws + WS_WUP + l * WUP_BYTES), D, 2 * DFF, 1);
#pragma unroll 1
        for (int l = 0; l < 4; ++l) p0_tjob(it, NGW, scr, F.lane, ((const float*)F.in[25]) + (size_t)l * DFF * D, (bf16_t*)(ws + WS_WDN + l * WDN_BYTES), DFF, D, 0);
    }
    __syncthreads();
    {
        LAS float* sv = (LAS float*)F.lds;
        LAS float* red = sv + 3 * D;
        for (int i = F.tid; i < D; i += 512) { const float a = ((const float*)F.in[5])[i], b = ((const float*)F.in[4])[i], d = ((const float*)F.in[4])[D + i];
            sv[i] = a / (1.f + expf(-a)); sv[D + i] = b / (1.f + expf(-b)); sv[2 * D + i] = d / (1.f + expf(-d)); }
        __syncthreads();
        float* MODp = (float*)(ws + WS_MOD);
        const int kg = F.tid >> 3, cq = F.tid & 7;
        for (int it = F.blk; it < 768; it += F.G) {
            const int l = it / 192, n0 = (it % 192) * 32;
            const float* w = ((const float*)F.in[6]) + (size_t)l * D * 6 * D + n0 + 4 * cq;
            f32x4 a0 = {0, 0, 0, 0}, a1 = a0, a2 = a0;
#pragma unroll 4
            for (int k = kg; k < D; k += 64) { const f32x4 wv = *(const f32x4*)(w + (size_t)k * 6 * D); a0 += sv[k] * wv; a1 += sv[D + k] * wv; a2 += sv[2 * D + k] * wv; }
            *(LAS f32x4*)(red + (kg * 3 + 0) * 32 + 4 * cq) = a0; *(LAS f32x4*)(red + (kg * 3 + 1) * 32 + 4 * cq) = a1; *(LAS f32x4*)(red + (kg * 3 + 2) * 32 + 4 * cq) = a2;
            __syncthreads();
            if (F.tid < 96) { const int v = F.tid >> 5, cc = F.tid & 31; float s = 0.f;
                for (int g = 0; g < 64; ++g) s += red[(g * 3 + v) * 32 + cc];
                MODp[(l * 3 + v) * 6 * D + n0 + cc] = s + ((const float*)F.in[7])[l * 6 * D + n0 + cc]; }
            __syncthreads();
        }
    }
    {
        const size_t gt = (size_t)F.blk * 512 + F.tid, NGT = (size_t)F.G * 512;
        bf16_t* CK = (bf16_t*)(ws + WS_CK); bf16_t* CVT = (bf16_t*)(ws + WS_CVT); bf16_t* WSb = (bf16_t*)(ws + WS_WS);
        for (size_t i = gt; i < 2 * 512 * 256; i += NGT) { CK[i] = (bf16_t)f2bf(((const float*)F.in[2])[i]);
            const int d = i & 63, kvh = (i >> 6) & 3, j = (i >> 8) & 511, b = i >> 17; CVT[((size_t)(b * 4 + kvh) * 64 + d) * 512 + j] = (bf16_t)f2bf(((const float*)F.in[3])[i]); }
        for (size_t i = gt; i < 8 * 128 * 128; i += NGT) WSb[i] = (bf16_t)f2bf(((const float*)F.in[16])[i]);
        float* rope = (float*)(ws + WS_ROPE);
        for (size_t i = gt; i < 1024; i += NGT) { const int pos = i >> 4, fi = i & 15; const float ang = (float)pos * powf(10000.f, -(float)fi / 16.f); rope[i] = cosf(ang); rope[1024 + i] = sinf(ang); }
        bf16_t* A1 = (bf16_t*)(ws + WS_A1);
        for (size_t i = gt; i < 2 * 256 * 256; i += NGT) { const int part = i >> 16, r = (i >> 8) & 255, k = i & 255; float v = 0.f;
            if ((r >> 7) == (k >> 7)) { const float a = 2.f * (float)(((r & 127) * (k & 127)) & 127) / 128.f; v = (part ? sinpif(a) : cospif(a)) * 0.08838834764831845f; }
            A1[i] = (bf16_t)f2bf(v); }
        bf16_t* A2P = (bf16_t*)(ws + WS_A2P);
        for (size_t i = gt; i < 256 * 512; i += NGT) { const int tp = i >> 9, k = i & 511, t = k & 255; const float a = 2.f * (float)((tp * t) & 255) / 256.f;
            A2P[i] = (bf16_t)f2bf((k < 256 ? cospif(a) : -sinpif(a)) * 0.0625f); }
        bf16_t* A2S = (bf16_t*)(ws + WS_A2S);
        for (size_t i = gt; i < (size_t)2048 * 4096; i += NGT) { const int tp = i >> 12, k = i & 4095, t = k & 2047; const float a = 2.f * (float)((tp * t) & 2047) / 2048.f;
            A2S[i] = (bf16_t)f2bf((k < 2048 ? cospif(a) : -sinpif(a)) * 0.022097086912079608f); }
    }
}

__device__ __forceinline__ void norm_phase(Frame& F, const float* src0, const float* src1, const float* g, const float* modl, int sh_idx, bf16_t* H) {
    const int gw = F.blk * NWAVES + F.wave, NGW = F.G * NWAVES;
    f32x4 gv[4];
#pragma unroll
    for (int j = 0; j < 4; ++j) gv[j] = *(const f32x4*)(g + 256 * j + 4 * F.lane);
    for (int row = gw; row < M; row += NGW) {
        const float* xr = row < MP ? src0 + (size_t)row * D : src1 + (size_t)(row - MP) * D;
        const float* mv = modl + (row < MP ? 0 : 1 + (row - MP) / TS) * 6 * D;
        f32x4 v[4]; float s = 0.f;
#pragma unroll
        for (int j = 0; j < 4; ++j) { v[j] = *(const f32x4*)(xr + 256 * j + 4 * F.lane); s += (v[j][0] * v[j][0] + v[j][1] * v[j][1]) + (v[j][2] * v[j][2] + v[j][3] * v[j][3]); }
        const float r = rsqrtf(wave_sum(s) * (1.f / D) + EPS);
#pragma unroll
        for (int j = 0; j < 4; ++j) { const f32x4 sh = *(const f32x4*)(mv + sh_idx * D + 256 * j + 4 * F.lane), sc = *(const f32x4*)(mv + (sh_idx + 1) * D + 256 * j + 4 * F.lane);
            const f32x4 o = v[j] * r * gv[j] * (1.f + sc) + sh;
            u32x2 w; w.x = pk2(o[0], o[1]); w.y = pk2(o[2], o[3]); *(u32x2*)(H + (size_t)row * D + 256 * j + 4 * F.lane) = w; }
    }
}
__device__ __forceinline__ void final_phase(Frame& F, const float* X, const float* g, float* out) {
    const int gw = F.blk * NWAVES + F.wave, NGW = F.G * NWAVES;
    f32x4 gv[4];
#pragma unroll
    for (int j = 0; j < 4; ++j) gv[j] = *(const f32x4*)(g + 256 * j + 4 * F.lane);
    for (int row = gw; row < M; row += NGW) {
        const float* xr = X + (size_t)row * D; f32x4 v[4]; float s = 0.f;
#pragma unroll
        for (int j = 0; j < 4; ++j) { v[j] = *(const f32x4*)(xr + 256 * j + 4 * F.lane); s += (v[j][0] * v[j][0] + v[j][1] * v[j][1]) + (v[j][2] * v[j][2] + v[j][3] * v[j][3]); }
        const float r = rsqrtf(wave_sum(s) * (1.f / D) + EPS);
#pragma unroll
        for (int j = 0; j < 4; ++j) *(f32x4*)(out + (size_t)row * D + 256 * j + 4 * F.lane) = v[j] * r * gv[j];
    }
}

constexpr int ATT_LDK = 144;
constexpr int ATT_TILE_BYTES = 2 * 64 * ATT_LDK;
struct AttTile { const bf16_t* K; const bf16_t* V; int ldk, ldv, k0, mask; };
__device__ __forceinline__ void att_tile_of(int t, bool lat, int nband, int kband0, const bf16_t* KBs, const bf16_t* VTs, int T, const bf16_t* CKs, const bf16_t* CVTs, AttTile& o) {
    if (t < nband) { const int k0 = kband0 + 64 * t; o.K = KBs + (size_t)k0 * 256; o.V = VTs + k0; o.ldk = 256; o.ldv = T; o.k0 = k0; o.mask = lat; }
    else { const int k0 = 64 * (t - nband); o.K = CKs + (size_t)k0 * 256; o.V = CVTs + k0; o.ldk = 256; o.ldv = 512; o.k0 = k0; o.mask = 0; }
}
__device__ __forceinline__ void attn_phase(Frame& F, const bf16_t* Q, const bf16_t* KB, const bf16_t* VT, const bf16_t* CK, const bf16_t* CVT, const float* sink, bf16_t* O) {
    const int fr = F.lane & 15, g4 = F.lane >> 4, tid = F.tid;
    const int lrow = tid >> 3, lchunk = tid & 7;
    LAS unsigned char* lds = F.lds;
    for (int it = F.blk; it < 768; it += F.G) {
        const bool lat = it < 256; int kvh, chunk, T, rowbase, b = 0; const bf16_t* vt;
        if (lat) { b = it >> 7; kvh = (it >> 5) & 3; chunk = it & 31; T = TS; rowbase = MP + b * TS; vt = VT + (size_t)32 * 65536 + (size_t)b * 256 * TS; }
        else { const int j = it - 256, s = j >> 4; kvh = (j >> 2) & 3; chunk = j & 3; T = TP; rowbase = s * TP; vt = VT + (size_t)s * 65536; }
        const int h = kvh * 4 + (F.wave & 3), q0 = chunk * 64 + (F.wave >> 2) * 32;
        int kband0 = 0, nband = T / 64;
        if (lat) { int lo = 64 * chunk - 128, hi = 64 * chunk + 192; lo = lo < 0 ? 0 : lo; hi = hi > T ? T : hi; kband0 = lo; nband = (hi - lo) / 64; }
        const int ntile = nband + (lat ? 8 : 0);
        const bf16_t* KBs = KB + (size_t)rowbase * 256 + kvh * 64; const bf16_t* VTs = vt + (size_t)(kvh * 64) * T;
        const bf16_t* CKs = CK + (size_t)b * 512 * 256 + kvh * 64; const bf16_t* CVTs = CVT + (size_t)((b * 4 + kvh) * 64) * 512;
        bf16x8 Qf[2][2];
#pragma unroll
        for (int qg = 0; qg < 2; ++qg)
#pragma unroll
            for (int ds = 0; ds < 2; ++ds) Qf[qg][ds] = *(const bf16x8*)(Q + (size_t)(rowbase + q0 + 16 * qg + fr) * D + h * 64 + 32 * ds + 8 * g4);
        float mrun[2], lrun[2]; f32x4 Oa[2][4];
#pragma unroll
        for (int qg = 0; qg < 2; ++qg) { mrun[qg] = sink[h] * 1.4426950408889634f; lrun[qg] = 1.f;
#pragma unroll
            for (int db = 0; db < 4; ++db) Oa[qg][db] = (f32x4){0.f, 0.f, 0.f, 0.f}; }
        AttTile tl; att_tile_of(0, lat, nband, kband0, KBs, VTs, T, CKs, CVTs, tl);
        u32x4 rk = *(const u32x4*)(tl.K + (size_t)lrow * tl.ldk + lchunk * 8), rv = *(const u32x4*)(tl.V + (size_t)lrow * tl.ldv + lchunk * 8);
        __syncthreads();
        *(LAS u32x4*)(lds + lrow * ATT_LDK + lchunk * 16) = rk; *(LAS u32x4*)(lds + 64 * ATT_LDK + lrow * ATT_LDK + lchunk * 16) = rv;
        __syncthreads();
#pragma unroll 1
        for (int t = 0; t < ntile; ++t) {
            const int cur_k0 = tl.k0, cur_mask = tl.mask;
            if (t + 1 < ntile) { att_tile_of(t + 1, lat, nband, kband0, KBs, VTs, T, CKs, CVTs, tl);
                rk = *(const u32x4*)(tl.K + (size_t)lrow * tl.ldk + lchunk * 8); rv = *(const u32x4*)(tl.V + (size_t)lrow * tl.ldv + lchunk * 8); }
            const LAS unsigned char* kb_ = lds + (t & 1) * ATT_TILE_BYTES; const LAS unsigned char* vb_ = kb_ + 64 * ATT_LDK;
#pragma unroll
            for (int sub = 0; sub < 2; ++sub) {
                bf16x8 Kf[2][2], Vf[4];
#pragma unroll
                for (int kb = 0; kb < 2; ++kb)
#pragma unroll
                    for (int ds = 0; ds < 2; ++ds) Kf[kb][ds] = *(const LAS bf16x8*)(kb_ + (32 * sub + 16 * kb + fr) * ATT_LDK + 64 * ds + 16 * g4);
#pragma unroll
                for (int db = 0; db < 4; ++db) { const LAS unsigned char* vp = vb_ + (16 * db + fr) * ATT_LDK + 64 * sub + 8 * g4; const u32x2 lo = *(const LAS u32x2*)vp, hi = *(const LAS u32x2*)(vp + 32);
                    Vf[db] = __builtin_bit_cast(bf16x8, (u32x4){lo.x, lo.y, hi.x, hi.y}); }
                const float c = 0.125f * 1.4426950408889634f;
#pragma unroll
                for (int qg = 0; qg < 2; ++qg) {
                    f32x4 S[2];
#pragma unroll
                    for (int kb = 0; kb < 2; ++kb) { S[kb] = __builtin_amdgcn_mfma_f32_16x16x32_bf16(Kf[kb][0], Qf[qg][0], (f32x4){0.f, 0.f, 0.f, 0.f}, 0, 0, 0); S[kb] = __builtin_amdgcn_mfma_f32_16x16x32_bf16(Kf[kb][1], Qf[qg][1], S[kb], 0, 0, 0); }
                    float mx = -1e30f; const int qpos = q0 + 16 * qg + fr;
#pragma unroll
                    for (int kb = 0; kb < 2; ++kb)
#pragma unroll
                        for (int r = 0; r < 4; ++r) { float x = S[kb][r] * c; if (cur_mask) { const int d = cur_k0 + 32 * sub + 16 * kb + 4 * g4 + r - qpos; if (d > 128 || d < -128) x = -1e30f; } S[kb][r] = x; mx = fmaxf(mx, x); }
                    mx = rows_max(mx);
                    const float mnew = fmaxf(mrun[qg], mx), alpha = fast_exp2(mrun[qg] - mnew);
                    float rs = 0.f;
#pragma unroll
                    for (int kb = 0; kb < 2; ++kb)
#pragma unroll
                        for (int r = 0; r < 4; ++r) { const float p = fast_exp2(S[kb][r] - mnew); S[kb][r] = p; rs += p; }
                    rs = rows_sum(rs);
                    lrun[qg] = lrun[qg] * alpha + rs; mrun[qg] = mnew;
                    u32x4 pw; pw.x = cvt_pk_bf16(S[0][0], S[0][1]); pw.y = cvt_pk_bf16(S[0][2], S[0][3]); pw.z = cvt_pk_bf16(S[1][0], S[1][1]); pw.w = cvt_pk_bf16(S[1][2], S[1][3]);
                    const bf16x8 Pf = __builtin_bit_cast(bf16x8, pw);
#pragma unroll
                    for (int db = 0; db < 4; ++db) { Oa[qg][db] = Oa[qg][db] * alpha; Oa[qg][db] = __builtin_amdgcn_mfma_f32_16x16x32_bf16(Vf[db], Pf, Oa[qg][db], 0, 0, 0); }
                }
            }
            if (t + 1 < ntile) { LAS unsigned char* nb = lds + ((t + 1) & 1) * ATT_TILE_BYTES;
                *(LAS u32x4*)(nb + lrow * ATT_LDK + lchunk * 16) = rk; *(LAS u32x4*)(nb + 64 * ATT_LDK + lrow * ATT_LDK + lchunk * 16) = rv; }
            __syncthreads();
        }
#pragma unroll
        for (int qg = 0; qg < 2; ++qg) { const float inv = 1.f / lrun[qg];
#pragma unroll
            for (int db = 0; db < 4; ++db) { const f32x4 o = Oa[qg][db] * inv; u32x2 w; w.x = cvt_pk_bf16(o[0], o[1]); w.y = cvt_pk_bf16(o[2], o[3]);
                *(u32x2*)(O + (size_t)(rowbase + q0 + 16 * qg + fr) * D + h * 64 + 16 * db + 4 * g4) = w; } }
    }
}

__device__ __forceinline__ void sgu_phase(Frame& F, const bf16_t* U, const bf16_t* V, const f32x2* STATS, const float* ln_g, const bf16_t* WSb, const float* b_s, bf16_t* UM) {
    constexpr int LDT = 136;
    LAS bf16_t* LT = (LAS bf16_t*)F.lds;
    LAS f32x2* ST = (LAS f32x2*)(F.lds + 128 * LDT * 2);
    const int fr = F.lane & 15, g4 = F.lane >> 4;
    for (int it = F.blk; it < 768; it += F.G) {
        const int ch = it >> 3, g = it & 7, r0 = ch * 128;
        if (F.tid < 128) { const f32x2* sp = STATS + (size_t)(r0 + F.tid) * 16; float s1 = 0.f, s2 = 0.f;
#pragma unroll
            for (int k = 0; k < 16; ++k) { const f32x2 p = sp[k]; s1 += p.x; s2 += p.y; }
            const float mu = s1 * (1.f / D), var = s2 * (1.f / D) - mu * mu; ST[F.tid] = (f32x2){mu, rsqrtf(fmaxf(var, 0.f) + EPS)}; }
        __syncthreads();
#pragma unroll
        for (int i = 0; i < 4; ++i) { const int q = F.tid + 512 * i, r = q & 127, c8 = (q >> 7) * 8;
            const u32x4 raw = *(const u32x4*)(V + (size_t)(r0 + r) * D + g * 128 + c8); const f32x2 st = ST[r];
            const f32x4 ga = *(const f32x4*)(ln_g + g * 128 + c8), gb = *(const f32x4*)(ln_g + g * 128 + c8 + 4);
            const unsigned rw[4] = {raw.x, raw.y, raw.z, raw.w};
#pragma unroll
            for (int e = 0; e < 8; ++e) { const float x = bf2f((unsigned short)(e & 1 ? rw[e >> 1] >> 16 : rw[e >> 1] & 0xffff)); const float gg = e < 4 ? ga[e & 3] : gb[e & 3];
                LT[(c8 + e) * LDT + r] = (bf16_t)f2bf((x - st.x) * st.y * gg); } }
        __syncthreads();
        f32x4 acc[8];
#pragma unroll
        for (int cb = 0; cb < 8; ++cb) acc[cb] = (f32x4){0.f, 0.f, 0.f, 0.f};
        const int p = 16 * F.wave + fr;
#pragma unroll
        for (int ks = 0; ks < 4; ++ks) { const bf16x8 bw = *(const bf16x8*)(WSb + (size_t)(g * 128 + p) * 128 + 32 * ks + 8 * g4);
#pragma unroll
            for (int cb = 0; cb < 8; ++cb) { const bf16x8 av = *(const LAS bf16x8*)(LT + (16 * cb + fr) * LDT + 32 * ks + 8 * g4); acc[cb] = __builtin_amdgcn_mfma_f32_16x16x32_bf16(av, bw, acc[cb], 0, 0, 0); } }
        const float bsv = b_s[g * 128 + p];
#pragma unroll
        for (int cb = 0; cb < 8; ++cb) { const size_t off = (size_t)(r0 + p) * D + g * 128 + 16 * cb + 4 * g4; const u32x2 uw = *(const u32x2*)(U + off);
            const float u0 = bf2f((unsigned short)(uw.x & 0xffff)), u1 = bf2f((unsigned short)(uw.x >> 16)), u2 = bf2f((unsigned short)(uw.y & 0xffff)), u3 = bf2f((unsigned short)(uw.y >> 16));
            u32x2 w; w.x = cvt_pk_bf16(u0 * (acc[cb][0] + bsv), u1 * (acc[cb][1] + bsv)); w.y = cvt_pk_bf16(u2 * (acc[cb][2] + bsv), u3 * (acc[cb][3] + bsv)); *(u32x2*)(UM + off) = w; }
        __syncthreads();
    }
}

struct Args { const float* in[26]; float* out; unsigned char* ws; int ph_lo, ph_hi; };
__global__ void __launch_bounds__(NWAVES * 64, 2) mk_fwd(const Args args) {
    extern __shared__ __attribute__((aligned(16))) unsigned char lds_raw[];
    Frame F;
    F.lds = (LAS unsigned char*)lds_raw;
    const int wave0 = __builtin_amdgcn_readfirstlane((int)threadIdx.x >> 6);
    F.wave = wave0; F.lane = pg8::lane_id(); F.tid = wave0 * 64 + F.lane;
    const int grid0 = gridDim.x, blk0 = blockIdx.x; F.G = grid0; F.blk = blk0;
    F.in = (const __attribute__((address_space(4))) cfp_t*)__builtin_amdgcn_kernarg_segment_ptr();
    F.out = args.out; F.ws = args.ws;
    unsigned char* ws = args.ws;
    volatile LAS unsigned* MISC = (volatile LAS unsigned*)(F.lds + MISC_OFF);
    if (F.tid < 32) MISC[F.tid] = 0u;
    __syncthreads();
    const int lo = args.ph_lo, hi = args.ph_hi;
    XcdBarrier bar; bar.bar = (unsigned*)(ws + WS_CTL); bar.x = 0; bar.st = nullptr;
    if (hi - lo > 1) bar = xcd_barrier_post((unsigned*)(ws + WS_CTL), MISC + 8, F.tid == 0);
    LAS float* XCH = (LAS float*)(F.lds + XCH_OFF);
#define CASE_BEGIN() { int b_ = blk0, w_ = wave0, g_ = grid0; asm volatile("" : "+s"(b_), "+s"(w_), "+s"(g_)); F.blk = b_; F.wave = w_; F.G = g_; } frame_refresh(F); unsigned long long ws_ = (unsigned long long)args.ws, in_ = (unsigned long long)__builtin_amdgcn_kernarg_segment_ptr(); asm volatile("" : "+s"(ws_), "+s"(in_)); \
        unsigned char* ws = (unsigned char*)(GAS unsigned char*)ws_; F.ws = ws; F.in = (const __attribute__((address_space(4))) cfp_t*)in_; \
        float* X = (float*)(ws + WS_X); bf16_t* H = (bf16_t*)(ws + WS_H); bf16_t* H2 = (bf16_t*)(ws + WS_H2); bf16_t* HN = (bf16_t*)(ws + WS_HN); (void)HN; \
        const float* modl = (const float*)(ws + WS_MOD) + l * 3 * 6 * D; const float* xs0 = l == 0 ? ((const float*)F.in[0]) : X; const float* xs1 = l == 0 ? ((const float*)F.in[1]) : X + (size_t)MP * D; \
        (void)X; (void)H; (void)H2; (void)modl; (void)xs0; (void)xs1
#pragma unroll 1
    for (int ph = lo; ph < hi; ++ph) {
        int l = 0, kind;
        if (ph == 0) kind = 0; else if (ph == 1) kind = 1;
        else { l = ph < 7 ? 0 : ph < 12 ? 1 : ph < 16 ? 2 : 3; const int j = ph - (l == 0 ? 2 : l == 1 ? 7 : l == 2 ? 12 : 16), n = l == 2 ? 1 : 2;
            kind = j < n ? (l == 0 ? 2 + j : l == 1 ? 4 + j : l == 2 ? 6 : 7 + j) : j == n ? 9 : j == n + 1 ? 10 : 11; }
        const int reps = (kind == MK_REP_KIND) ? 1 + MK_REP_N : 1;
#pragma unroll 1
        for (int rep = 0; rep < reps; ++rep) {
        if (rep > 0) xcd_barrier(bar, wave0 == 0 && pg8::lane_id() == 0);
        switch (kind) {
        case 0: if (EN(0)) { CASE_BEGIN(); p0_prologue(F); } break;
        case 1: if (EN(1)) { CASE_BEGIN(); norm_phase(F, xs0, xs1, ((const float*)F.in[8]), modl, 0, HN); } break;
        case 2: if (EN(2)) { CASE_BEGIN(); Order<48, 6, 0, D, D> S; S.init(F.G, F.blk, HN, ws + WS_WQKV);
                EpiQKV E{{ws, l, 0}};
                pg8::gemm_phase<D, D, D / 64>(F.lds, S, E, F.wave); } break;
        case 3: if (EN(3)) { CASE_BEGIN(); attn_phase(F, (const bf16_t*)(ws + WS_Q), (const bf16_t*)(ws + WS_KB), (const bf16_t*)(ws + WS_VT), (const bf16_t*)(ws + WS_CK), (const bf16_t*)(ws + WS_CVT), ((const float*)F.in[13]), H); } break;
        case 4: if (EN(4)) { CASE_BEGIN(); Order<48, 8, 0, D, D> S; S.init(F.G, F.blk, HN, ws + WS_WSGI);
                EpiSgu E{{ws, l, 0}};
                pg8::gemm_phase<D, D, D / 64>(F.lds, S, E, F.wave); } break;
        case 5: if (EN(5)) { CASE_BEGIN(); sgu_phase(F, (const bf16_t*)(ws + WS_U), (const bf16_t*)(ws + WS_V), (const f32x2*)(ws + WS_STATS), ((const float*)F.in[15]), (const bf16_t*)(ws + WS_WS), ((const float*)F.in[17]), H); } break;
        case 6: if (EN(6)) { CASE_BEGIN(); OrderSc S{F.blk, (const char*)HN, (const char*)(ws + WS_WSCI)};
                EpiSc E{{ws, l, F.blk}};
                pg8::gemm_phase<D, D, D / 64>(F.lds, S, E, F.wave); } break;
        case 7: if (EN(7)) { CASE_BEGIN(); OrderFn1 S{F.G, F.blk, (const char*)(ws + WS_A1), (const char*)HN};
                EpiFn1 E{{ws, l, 0}};
                pg8::gemm_phase<256, D, 4>(F.lds, S, E, F.wave); } break;
        case 8: if (EN(8)) { CASE_BEGIN(); EpiBf16 E{{ws, l, 0}};
                if (F.blk < 64) { OrderFn2 S{F.blk, 1, (const char*)(ws + WS_A2S), (const char*)(ws + WS_YT)}; pg8::gemm_phase<2 * TS, 2 * TS, 2 * TS / 64>(F.lds, S, E, F.wave); }
                else { OrderFn2 S{F.blk, 0, (const char*)(ws + WS_A2P), (const char*)(ws + WS_YT)}; pg8::gemm_phase<2 * TP, 2 * TP, 2 * TP / 64>(F.lds, S, E, F.wave); } } break;
        case 9: if (EN(9)) { CASE_BEGIN(); const bf16_t* mix_in = l == 2 ? H2 : H;
                const bf16_t* wout = (const bf16_t*)(ws + (l == 0 ? WS_WO : l == 1 ? WS_WSGO : l == 2 ? WS_WSCO : WS_WFNO));
                Order<48, 4, 0, D, D> S; S.init(F.G, F.blk, mix_in, wout);
                EpiResNorm<false> E{{ws, l, rep ? 2 : 0}};
                pg8::gemm_phase<D, D, D / 64>(F.lds, S, E, F.wave); } break;
        case 10: if (EN(11)) { CASE_BEGIN(); Order<50, 22, 1, D, D> S; S.init(F.G, F.blk, HN, ws + WS_WUP + l * WUP_BYTES);
                EpiUp E{{ws, l, 0}};
                pg8::gemm_phase<D, D, D / 64>(F.lds, S, E, F.wave); } break;
        default: if (EN(12)) { CASE_BEGIN(); Order<48, 4, 0, DFF, DFF> S; S.init(F.G, F.blk, ws + WS_ACT, ws + WS_WDN + l * WDN_BYTES);
                if (l < 3) { EpiResNorm<false> E{{ws, l, 1 | (rep ? 2 : 0)}}; pg8::gemm_phase<DFF, DFF, DFF / 64>(F.lds, S, E, F.wave); }
                else { EpiResNorm<true> E{{ws, l, 1 | (rep ? 2 : 0)}}; pg8::gemm_phase<DFF, DFF, DFF / 64>(F.lds, S, E, F.wave); } } break;
        }
        }
        if (ph + 1 < hi) xcd_barrier(bar, wave0 == 0 && pg8::lane_id() == 0);
    }
}

extern "C" void kernel_launch(void* const* d_in, const int* in_sizes, int n_in, void* d_out, int out_size, void* d_ws, size_t ws_size, hipStream_t stream) {
    static int grid = 0;
    if (grid == 0) {
        if (n_in != 26 || ws_size < WS_TOTAL + (MK_REP_N ? (size_t)M * D * 4 : 0)) { fprintf(stderr, "kernel_launch: unexpected n_in %d / ws %zu (need %zu)\n", n_in, ws_size, (size_t)WS_TOTAL); grid = -1; return; }
        int dev = 0, cus = 0;
        if (hipGetDevice(&dev) != hipSuccess || hipDeviceGetAttribute(&cus, hipDeviceAttributeMultiprocessorCount, dev) != hipSuccess) { grid = -1; return; }
        if (hipFuncSetAttribute((const void*)mk_fwd, hipFuncAttributeMaxDynamicSharedMemorySize, LDS_BYTES) != hipSuccess) { fprintf(stderr, "kernel_launch: hipFuncSetAttribute failed\n"); grid = -1; return; }
        (void)hipGetLastError();
        grid = cus;
    }
    if (grid < 0) return;
    (void)hipMemsetAsync((char*)d_ws + WS_CTL, 0, CTL_ZERO_BYTES, stream);
    Args a{};
    for (int i = 0; i < 26; ++i) a.in[i] = (const float*)d_in[i];
    a.out = (float*)d_out; a.ws = (unsigned char*)d_ws;
#if MK_PER_PHASE
    for (int p = MK_PH_LO; p < MK_PH_HI; ++p) { a.ph_lo = p; a.ph_hi = p + 1; hipLaunchKernelGGL(mk_fwd, dim3(grid), dim3(NWAVES * 64), LDS_BYTES, stream, a); }
#else
    a.ph_lo = MK_PH_LO; a.ph_hi = MK_PH_HI;
    hipLaunchKernelGGL(mk_fwd, dim3(grid), dim3(NWAVES * 64), LDS_BYTES, stream, a);
#endif
}
```

```cpp
#include <hip/hip_runtime.h>
#include <cstdio>

#define LAS __attribute__((address_space(3)))
#define GAS __attribute__((address_space(1)))
typedef unsigned short bf16_t;
typedef short bf16x8 __attribute__((ext_vector_type(8)));
typedef float f32x4 __attribute__((ext_vector_type(4)));
typedef float f32x2 __attribute__((ext_vector_type(2)));
typedef unsigned u32x4 __attribute__((ext_vector_type(4)));
typedef unsigned u32x2 __attribute__((ext_vector_type(2)));

constexpr int D = 1024, MP = 8192, MS = 4096, M = MP + MS, DFF = 2816, TS = 2048, TP = 256;
constexpr float EPS = 1e-6f;
constexpr int NWAVES = 8;
#ifndef MK_PER_PHASE
#define MK_PER_PHASE 0
#endif
#ifndef MK_PH_LO
#define MK_PH_LO 0
#endif
#ifndef MK_PH_HI
#define MK_PH_HI 21
#endif
#ifndef MK_MASK
#define MK_MASK 0xffffffffu
#endif
#define EN(b) (((MK_MASK) >> (b)) & 1u)
#ifndef MK_REP_KIND
#define MK_REP_KIND -1
#endif
#ifndef MK_REP_N
#define MK_REP_N 0
#endif

namespace pg8 {
constexpr int BM = 256, BK = 64, HALF = 128, HTB = HALF * BK * 2, STAGE_BYTES = 8 * HTB, NXCD = 8, WGM = 8;
__host__ __device__ __forceinline__ int lds_byte(int r, int c) { const int st = (r >> 4) * 2 + (c >> 5), rr = r & 15, cc = c & 31, ob = rr * 64 + cc * 2; return st * 1024 + (ob ^ (((ob >> 9) & 1) << 5)); }
__host__ __device__ __forceinline__ void stage_rc(int b, int& R, int& C) { const int st = b / 1024, sb = b % 1024, swz = sb ^ (((sb >> 9) & 1) << 5); R = (st >> 1) * 16 + swz / 64; C = (st & 1) * 32 + (swz % 64) / 2; }
__host__ __device__ __forceinline__ int perm32(int rho) { const int n = rho >> 4, i = rho & 15; return 8 * (i >> 2) + 4 * n + (i & 3); }

struct Unit { int pm, pn, row0; const char* a; const char* b; };
struct Cfg { int lda, ldb, nt; };

__device__ __forceinline__ int lane_id() { return (int)__builtin_amdgcn_mbcnt_hi(~0u, __builtin_amdgcn_mbcnt_lo(~0u, 0u)); }
__device__ __forceinline__ unsigned cvt_pk_bf16(float lo, float hi) { unsigned r; asm volatile("v_cvt_pk_bf16_f32 %0, %1, %2" : "=v"(r) : "v"(lo), "v"(hi)); return r; }

template <int LDA, int LDB, int NT, class Epi, class Sched>
__device__ __forceinline__ void gemm_phase(LAS unsigned char* lds, const Sched& S, const Epi& E, int wid) {
    constexpr Cfg g{LDA, LDB, NT};
    int lane_ = lane_id(); asm volatile("" : "+v"(lane_));
    const int lane = lane_, tid = wid * 64 + lane, wr = wid >> 2, wc = wid & 3, fr = lane & 15, fq = lane >> 4;
    const int nt = g.nt;
    unsigned voffA[2], voffB[2];
#pragma unroll
    for (int i = 0; i < 2; ++i) { int R, C; stage_rc(tid * 16 + i * 8192, R, C); const int Rb = Epi::PERM ? ((R & ~31) + perm32(R & 31)) : R;
        voffA[i] = (unsigned)(R * g.lda + C) * 2u; voffB[i] = (unsigned)(Rb * g.ldb + C) * 2u; }
    const size_t kstep = (size_t)(BK * 2);
    const size_t hstepA = (size_t)HALF * g.lda * 2, hstepB = (size_t)HALF * g.ldb * 2;
    const unsigned ldsw = (unsigned)wid * 1024u;
    const int aoff = lds_byte(wr * 64 + fr, fq * 8), boff = lds_byte(wc * 32 + fr, fq * 8);
#define PG8_SA(b, h) (((b) * 2 + (h)) * HTB)
#define PG8_SB(b, h) ((4 + (b) * 2 + (h)) * HTB)
#define PG8_STAGE(bufoff, gbase, voff) do { _Pragma("unroll") for (int _i = 0; _i < 2; ++_i) { unsigned _vo = (voff)[_i]; asm volatile("" : "+v"(_vo)); \
        __builtin_amdgcn_global_load_lds((const unsigned*)((const char*)(gbase) + _vo), (LAS unsigned*)(lds + (bufoff) + ldsw + _i * 8192), 16, 0, 0); } } while (0)
#define PG8_LDA(dst, b, h) do { _Pragma("unroll") for (int m = 0; m < 4; ++m) _Pragma("unroll") for (int k = 0; k < 2; ++k) dst[m][k] = *(const LAS bf16x8*)(lds + PG8_SA(b, h) + aoff + m * 2048 + k * 1024); } while (0)
#define PG8_LDB(dst, b, h) do { _Pragma("unroll") for (int n = 0; n < 2; ++n) _Pragma("unroll") for (int k = 0; k < 2; ++k) dst[n][k] = *(const LAS bf16x8*)(lds + PG8_SB(b, h) + boff + n * 2048 + k * 1024); } while (0)
#define PG8_MMA(ai, bj, At, Bt) do { __builtin_amdgcn_s_setprio(1); _Pragma("unroll") for (int m = 0; m < 4; ++m) _Pragma("unroll") for (int n = 0; n < 2; ++n) _Pragma("unroll") for (int k = 0; k < 2; ++k) \
        acc[ai][bj][m][n] = __builtin_amdgcn_mfma_f32_16x16x32_bf16(Bt[n][k], At[m][k], acc[ai][bj][m][n], 0, 0, 0); __builtin_amdgcn_s_setprio(0); } while (0)
#define PG8_WAIT_V(n) asm volatile("s_waitcnt vmcnt(" #n ")" ::: "memory")
#define PG8_WAIT_L(n) asm volatile("s_waitcnt lgkmcnt(" #n ")" ::: "memory")
#define PG8_BAR __builtin_amdgcn_s_barrier()
#define PG8_SCHED __builtin_amdgcn_sched_barrier(0)
    Unit cur, nxt; int ui = 0;
    if (!S.next(0, cur)) return;
    f32x4 acc[2][2][4][2];
#pragma unroll
    for (int a = 0; a < 2; ++a)
#pragma unroll
        for (int b = 0; b < 2; ++b)
#pragma unroll
            for (int m = 0; m < 4; ++m)
#pragma unroll
                for (int n = 0; n < 2; ++n) acc[a][b][m][n] = (f32x4){0.f, 0.f, 0.f, 0.f};
    bf16x8 At[4][2], B0[2][2], B1[2][2];
    const char* cA = cur.a; const char* cB = cur.b;
    PG8_STAGE(PG8_SB(0, 0), cB, voffB); PG8_STAGE(PG8_SB(0, 1), cB + hstepB, voffB); PG8_STAGE(PG8_SA(0, 0), cA, voffA); PG8_STAGE(PG8_SA(0, 1), cA + hstepA, voffA);
    if (wr == 1) PG8_BAR;
    PG8_WAIT_V(2); PG8_BAR;
    PG8_STAGE(PG8_SB(1, 0), cB + kstep, voffB); PG8_STAGE(PG8_SA(1, 0), cA + kstep, voffA); PG8_STAGE(PG8_SB(1, 1), cB + hstepB + kstep, voffB);
    PG8_WAIT_V(6); PG8_BAR;
    for (;;) {
        const bool has_next = S.next(ui + 1, nxt);
        const char* nA = has_next ? nxt.a : cA; const char* nB = has_next ? nxt.b : cB;
        for (int t = 0; t < nt; t += 2) {
            const bool last = (t == nt - 2);
            const char* a1 = cA + (size_t)(t + 1) * kstep;
            const char* a2 = last ? nA : cA + (size_t)(t + 2) * kstep; const char* b2 = last ? nB : cB + (size_t)(t + 2) * kstep;
            const char* a3 = a2 + kstep; const char* b3 = b2 + kstep;
            PG8_LDB(B0, 0, 0); PG8_LDB(B1, 0, 1); PG8_SCHED; PG8_LDA(At, 0, 0); PG8_STAGE(PG8_SA(1, 1), a1 + hstepA, voffA);
            PG8_WAIT_V(8); PG8_WAIT_L(0); PG8_BAR; PG8_MMA(0, 0, At, B0); PG8_MMA(0, 1, At, B1); PG8_BAR; PG8_SCHED;
            PG8_LDA(At, 0, 1); PG8_STAGE(PG8_SB(0, 0), b2, voffB); PG8_STAGE(PG8_SB(0, 1), b2 + hstepB, voffB); PG8_STAGE(PG8_SA(0, 0), a2, voffA);
            PG8_WAIT_V(8); PG8_WAIT_L(0); PG8_BAR; PG8_MMA(1, 0, At, B0); PG8_MMA(1, 1, At, B1); PG8_BAR; PG8_SCHED;
            PG8_LDB(B0, 1, 0); PG8_LDB(B1, 1, 1); PG8_SCHED; PG8_LDA(At, 1, 0); PG8_STAGE(PG8_SA(0, 1), a2 + hstepA, voffA);
            PG8_WAIT_V(8); PG8_WAIT_L(0); PG8_BAR; PG8_MMA(0, 0, At, B0); PG8_MMA(0, 1, At, B1); PG8_BAR; PG8_SCHED;
            PG8_LDA(At, 1, 1); PG8_STAGE(PG8_SB(1, 0), b3, voffB); PG8_STAGE(PG8_SB(1, 1), b3 + hstepB, voffB); PG8_STAGE(PG8_SA(1, 0), a3, voffA);
            PG8_WAIT_V(8); PG8_WAIT_L(0); PG8_BAR; PG8_MMA(1, 0, At, B0); PG8_MMA(1, 1, At, B1); PG8_BAR; PG8_SCHED;
        }
        if (wr == 0) PG8_BAR;
        E(acc, cur, wid, ui);
        if (!has_next) break;
#pragma unroll
        for (int a = 0; a < 2; ++a)
#pragma unroll
            for (int b = 0; b < 2; ++b)
#pragma unroll
                for (int m = 0; m < 4; ++m)
#pragma unroll
                    for (int n = 0; n < 2; ++n) acc[a][b][m][n] = (f32x4){0.f, 0.f, 0.f, 0.f};
        cur = nxt; cA = nA; cB = nB; ++ui;
        if (wr == 1) PG8_BAR;
    }
    PG8_WAIT_V(0);
    PG8_BAR;
#undef PG8_SA
#undef PG8_SB
#undef PG8_STAGE
#undef PG8_LDA
#undef PG8_LDB
#undef PG8_MMA
#undef PG8_WAIT_V
#undef PG8_WAIT_L
#undef PG8_BAR
#undef PG8_SCHED
}
}
using pg8::Unit; using pg8::cvt_pk_bf16;

constexpr size_t MiB = 1u << 20;
constexpr size_t WS_CTL = 0, CTL_ZERO_BYTES = 128 * 1024;
constexpr size_t WS_MOD = 1 * MiB;
constexpr size_t WS_ROPE = WS_MOD + 512 * 1024;
constexpr size_t WS_STATS = WS_ROPE + 64 * 1024;
constexpr size_t WS_WQKV = 4 * MiB;
constexpr size_t WS_WO = WS_WQKV + 3 * MiB;
constexpr size_t WS_WSGI = WS_WO + 2 * MiB;
constexpr size_t WS_WSGO = WS_WSGI + 4 * MiB;
constexpr size_t WS_WSCI = WS_WSGO + 2 * MiB;
constexpr size_t WS_WSCO = WS_WSCI + 6 * MiB;
constexpr size_t WS_WFNO = WS_WSCO + 2 * MiB;
constexpr size_t WS_WUP = WS_WFNO + 2 * MiB;
constexpr size_t WUP_BYTES = (size_t)2 * DFF * D * 2;
constexpr size_t WS_WDN = WS_WUP + 4 * WUP_BYTES;
constexpr size_t WDN_BYTES = (size_t)D * DFF * 2;
constexpr size_t WS_WS = WS_WDN + 4 * WDN_BYTES;
constexpr size_t WS_A1 = WS_WS + 256 * 1024;
constexpr size_t WS_A2P = WS_A1 + 256 * 1024;
constexpr size_t WS_A2S = WS_A2P + 256 * 1024;
constexpr size_t WS_CK = WS_A2S + 16 * MiB;
constexpr size_t WS_CVT = WS_CK + 512 * 1024;
constexpr size_t WS_X = WS_CVT + 512 * 1024;
constexpr size_t WS_H = WS_X + (size_t)M * D * 4;
constexpr size_t WS_BIG = WS_H + (size_t)(M + 256) * D * 2;
constexpr size_t WS_END = WS_BIG + 72 * MiB;
constexpr size_t WS_ACT = WS_BIG;
constexpr size_t WS_Q = WS_BIG;
constexpr size_t WS_KB = WS_Q + 24 * MiB;
constexpr size_t WS_VT = WS_KB + 6 * MiB;
constexpr size_t WS_U = WS_BIG;
constexpr size_t WS_V = WS_BIG + 24 * MiB;
constexpr size_t WS_YB = WS_BIG;
constexpr size_t WS_YT = WS_BIG;
static_assert(WS_YB + (size_t)256 * 2 * 16 * 512 * 16 <= WS_END, "yb");
static_assert(WS_ACT + (size_t)M * DFF * 2 <= WS_END, "act");
constexpr size_t WS_H2 = WS_END;
constexpr size_t WS_HN = WS_H2 + (size_t)M * D * 2;
constexpr size_t WS_XS = WS_HN + (size_t)(M + 256) * D * 2;
constexpr size_t WS_TOTAL = WS_XS + (size_t)16 * M * 4 * 4;
constexpr size_t CTL_CNT = 16384;
constexpr size_t CTL_TMO = CTL_CNT + 16 * 48 * 64;

constexpr size_t OUT_NK = (size_t)M * D, OUT_NV = OUT_NK + (size_t)MP * 256;

#define XB_TMO      128
#define XB_XCNT(j)  (256  + 64 * (j))
#define XB_XSUB(j)  (1280 + 64 * (j))
#define XB_XGEN(j)  (2304 + 64 * (j))
#define XB_TOP      3328
#define XB_TOPGEN   3392
#define XCD_BAR_WORDS 3456
#define XB_SPIN_CAP (1u << 22)
__device__ __forceinline__ unsigned xb_ld(unsigned* p)              { return __hip_atomic_load(p, __ATOMIC_RELAXED, __HIP_MEMORY_SCOPE_AGENT); }
__device__ __forceinline__ unsigned xb_add(unsigned* p, unsigned v) { return __hip_atomic_fetch_add(p, v, __ATOMIC_RELAXED, __HIP_MEMORY_SCOPE_AGENT); }
__device__ __forceinline__ unsigned xb_xcc_id() { return (unsigned)__builtin_amdgcn_s_getreg((3 << 11) | 20) & 0xFu; }
#define XB_SPIN(cond, bar) do { unsigned _sp = 0; while (cond) { __builtin_amdgcn_s_sleep(1); \
    if ((++_sp & 255u) == 0u) { if (xb_ld(&(bar)[XB_TMO])) break; if (_sp > XB_SPIN_CAP) { atomicAdd(&(bar)[XB_TMO], 1u); break; } } } } while (0)
struct XcdBarrier { unsigned* bar; unsigned x; volatile LAS unsigned* st; };
__device__ __forceinline__ XcdBarrier xcd_barrier_post(unsigned* bar, volatile LAS unsigned* st, bool leader) {
    XcdBarrier b; b.bar = bar; b.x = xb_xcc_id(); b.st = st;
    if (leader) (void)xb_add(&bar[XB_XCNT(b.x)], 1u);
    return b;
}
__device__ __forceinline__ void xcd_barrier_complete(unsigned* bar, unsigned x, unsigned& nloc, unsigned& nx) {
    const unsigned G = gridDim.x * gridDim.y * gridDim.z;
    unsigned sum, cnt, mine, sp = 0u;
    for (;;) {
        sum = 0u; cnt = 0u; mine = 0u;
#pragma unroll
        for (unsigned j = 0; j < 16; ++j) { const unsigned c = xb_ld(&bar[XB_XCNT(j)]); sum += c; cnt += (c > 0u) ? 1u : 0u; mine = (j == x) ? c : mine; }
        if (sum == G) break;
        __builtin_amdgcn_s_sleep(1);
        if ((++sp & 255u) == 0u) { if (xb_ld(&bar[XB_TMO])) break; if (sp > XB_SPIN_CAP) { atomicAdd(&bar[XB_TMO], 1u); break; } }
    }
    nloc = mine > 0u ? mine : 1u; nx = cnt > 0u ? cnt : 1u;
}
__device__ __forceinline__ void xcd_barrier(const XcdBarrier& b, bool leader) {
    asm volatile("s_waitcnt vmcnt(0)" ::: "memory");
    __syncthreads();
    if (leader) {
        unsigned* bar = b.bar;
        __builtin_amdgcn_s_waitcnt(0);
        unsigned nloc = b.st[0], nx = b.st[1];
        if (nloc == 0u) { xcd_barrier_complete(bar, b.x, nloc, nx); b.st[0] = nloc; b.st[1] = nx; }
        const unsigned old = xb_add(&bar[XB_XSUB(b.x)], 1u);
        const unsigned gen = old / nloc;
        if (old + 1u == (gen + 1u) * nloc) {
            __builtin_amdgcn_fence(__ATOMIC_RELEASE, "agent");
            asm volatile("s_waitcnt vmcnt(0)" ::: "memory");
            const unsigned og = xb_add(&bar[XB_TOP], 1u);
            const unsigned tg = og / nx;
            if (og + 1u == (tg + 1u) * nx) xb_add(&bar[XB_TOPGEN], 1u);
            else XB_SPIN(xb_ld(&bar[XB_TOPGEN]) == tg, bar);
            __builtin_amdgcn_fence(__ATOMIC_ACQUIRE, "agent");
            xb_add(&bar[XB_XGEN(b.x)], 1u);
            asm volatile("s_waitcnt vmcnt(0)" ::: "memory");
        } else {
            XB_SPIN(xb_ld(&bar[XB_XGEN(b.x)]) == gen, bar);
            __builtin_amdgcn_fence(__ATOMIC_ACQUIRE, "agent");
            asm volatile("s_waitcnt vmcnt(0)" ::: "memory");
        }
    }
    __syncthreads();
}

#define LDS_WAIT() asm volatile("s_waitcnt lgkmcnt(0)" ::: "memory")
__device__ __forceinline__ unsigned f2bf(float f) { unsigned u = __builtin_bit_cast(unsigned, f); return (u + 0x7fffu + ((u >> 16) & 1u)) >> 16; }
__device__ __forceinline__ unsigned pk2(float lo, float hi) { return f2bf(lo) | (f2bf(hi) << 16); }
__device__ __forceinline__ float bf2f(unsigned short b) { return __builtin_bit_cast(float, (unsigned)b << 16); }
__device__ __forceinline__ float rows_max(float x) {
    auto s = __builtin_amdgcn_permlane16_swap(__float_as_uint(x), __float_as_uint(x), false, false); x = fmaxf(__uint_as_float(s[0]), __uint_as_float(s[1]));
    auto t = __builtin_amdgcn_permlane32_swap(__float_as_uint(x), __float_as_uint(x), false, false); return fmaxf(__uint_as_float(t[0]), __uint_as_float(t[1])); }
__device__ __forceinline__ float rows_sum(float x) {
    auto s = __builtin_amdgcn_permlane16_swap(__float_as_uint(x), __float_as_uint(x), false, false); x = __uint_as_float(s[0]) + __uint_as_float(s[1]);
    auto t = __builtin_amdgcn_permlane32_swap(__float_as_uint(x), __float_as_uint(x), false, false); return __uint_as_float(t[0]) + __uint_as_float(t[1]); }
template <int CTRL> __device__ __forceinline__ float dppx(float v) { return __builtin_bit_cast(float, __builtin_amdgcn_update_dpp(0, __builtin_bit_cast(int, v), CTRL, 0xf, 0xf, false)); }
__device__ __forceinline__ float wave_sum(float v) {
    v += dppx<0xB1>(v);
    v += dppx<0x4E>(v);
    v += dppx<0x141>(v);
    v += dppx<0x140>(v);
    return rows_sum(v);
}
__device__ __forceinline__ float fast_exp2(float x) { return __builtin_amdgcn_exp2f(x); }
__device__ __forceinline__ float fast_rcp(float x) { return __builtin_amdgcn_rcpf(x); }
__device__ __forceinline__ float silu_f(float x) { return x * fast_rcp(1.f + fast_exp2(-1.4426950408889634f * x)); }
__device__ __forceinline__ float gelu_f(float x) { const float u = x * (1.f + 0.044715f * x * x); return x * fast_rcp(1.f + fast_exp2(-2.302208198f * u)); }
__device__ __forceinline__ int conv_row0(int pm) { if (pm < 32) return 256 * pm; const int s = (pm - 32) / 9, i = (pm - 32) % 9; return MP + TS * s + 254 * i - 1; }
template <int CTRL> __device__ __forceinline__ float dpp(float v) { return __builtin_bit_cast(float, __builtin_amdgcn_update_dpp(0, __builtin_bit_cast(int, v), CTRL, 0xf, 0xf, false)); }
template <int CTRL> __device__ __forceinline__ f32x4 dpp4(f32x4 v) { return (f32x4){dpp<CTRL>(v[0]), dpp<CTRL>(v[1]), dpp<CTRL>(v[2]), dpp<CTRL>(v[3])}; }
#define DPP_ROR1 0x121
#define DPP_ROR15 0x12F

template <int NM, int NN, int CONV, int LDA, int LDB>
struct Order {
    int G, c; const char* A; const char* B;
    __device__ __forceinline__ void init(int G_, int c_, const void* A_, const void* B_) { G = G_; c = c_; A = (const char*)A_; B = (const char*)B_; }
    __device__ __forceinline__ bool next(int i, Unit& u) const {
        constexpr int nwg = NM * NN;
        const int L = i * G + c; if (L >= nwg) return false;
        int wgid = L; { constexpr int q = nwg / pg8::NXCD, r = nwg % pg8::NXCD; const int xcd = wgid % pg8::NXCD, off = wgid / pg8::NXCD; wgid = (xcd < r ? xcd * (q + 1) : r * (q + 1) + (xcd - r) * q) + off; }
        constexpr int nig = pg8::WGM * NN; const int gid = wgid / nig, fm = gid * pg8::WGM, gsz = (NM - fm) < pg8::WGM ? (NM - fm) : pg8::WGM;
        u.pm = fm + ((wgid % nig) % gsz); u.pn = (wgid % nig) / gsz;
        u.row0 = CONV ? conv_row0(u.pm) : 256 * u.pm;
        u.a = A + (long)u.row0 * (long)(LDA * 2); u.b = B + (size_t)u.pn * (size_t)(256 * LDB * 2); return true;
    }
};

typedef const GAS float* cfp_t;
struct Frame {
    LAS unsigned char* lds; int tid, lane, wave, G, blk;
    const __attribute__((address_space(4))) cfp_t* in; float* out; unsigned char* ws;
};
__device__ __forceinline__ void frame_refresh(Frame& F) {
    int ln = pg8::lane_id(); asm volatile("" : "+v"(ln)); F.lane = ln; F.tid = F.wave * 64 + ln;
}
constexpr int RING_BYTES = 131072, XCH_OFF = RING_BYTES  , MISC_OFF = XCH_OFF + 8192 + 320, LDS_BYTES = 147456;
__device__ __forceinline__ int vec_plain(int pm) { return pm < 32 ? 0 : 1 + (pm - 32) / 8; }
__device__ __forceinline__ int vec_conv(int pm) { return pm < 32 ? 0 : 1 + (pm - 32) / 9; }

struct EpiBase {
    unsigned char* ws_; int l, aux;
    __device__ __forceinline__ unsigned char* wsp() const { unsigned long long w = (unsigned long long)ws_; asm volatile("" : "+s"(w)); return (unsigned char*)(GAS unsigned char*)w; }
    __device__ __forceinline__ static const __attribute__((address_space(4))) cfp_t* kargs() { unsigned long long kp = (unsigned long long)__builtin_amdgcn_kernarg_segment_ptr(); asm volatile("" : "+s"(kp)); return (const __attribute__((address_space(4))) cfp_t*)kp; }
    __device__ __forceinline__ static const float* inp(const __attribute__((address_space(4))) cfp_t* ka, int k) { return (const float*)ka[k]; }
    __device__ __forceinline__ static float* outp(const __attribute__((address_space(4))) cfp_t* ka) { return (float*)(GAS float*)ka[26]; }
    __device__ __forceinline__ static LAS float* xch() { extern __shared__ __attribute__((aligned(16))) unsigned char lds_base_[]; return (LAS float*)((LAS unsigned char*)lds_base_ + XCH_OFF); }
};
template <bool FINAL>
struct EpiResNorm : EpiBase {
    static constexpr bool PERM = false;
    __device__ __forceinline__ void operator()(f32x4 (&acc)[2][2][4][2], const Unit& u, int wid, int ) const {
        int lane_ = pg8::lane_id(); asm volatile("" : "+v"(lane_));
        const int lane = lane_, wr = wid >> 2, wc = wid & 3, fr = lane & 15, fq = lane >> 4; (void)wr; (void)wc; (void)fr; (void)fq;
        unsigned char* ws = wsp(); const auto ka = kargs();
        const int isdn = aux & 1, rep = (aux >> 1) & 1, inst = 2 * l + isdn + 8 * rep;
        float* Xr = (float*)(ws + WS_X); float* X = rep ? (float*)(ws + WS_TOTAL) : Xr;
        const float* src0 = (!isdn && l == 0) ? inp(ka, 0) : Xr; const float* src1 = (!isdn && l == 0) ? inp(ka, 1) : Xr + (size_t)MP * D;
        const float* modl = (const float*)(ws + WS_MOD) + l * 3 * 6 * D; const int gate_idx = isdn ? 5 : 2;
        const float* gn = FINAL ? inp(ka, 10) : (isdn ? inp(ka, 8) + (l + 1) * D : inp(ka, 9) + l * D);
        const float* modn = isdn ? modl + 3 * 6 * D : modl; const int sh_idx = isdn ? 0 : 3;
        bf16_t* HN = (bf16_t*)(ws + (rep ? WS_TOTAL + 48 * MiB : WS_HN)); float* Y = rep ? (float*)(ws + WS_TOTAL) : outp(ka);
        float* xs = (float*)(ws + WS_XS) + (size_t)inst * M * 4; unsigned* cnt = (unsigned*)(ws + WS_CTL + CTL_CNT) + inst * 48 * 16; unsigned* tmo = (unsigned*)(ws + WS_CTL + CTL_TMO);
        LAS float* L = xch();
        const int col0 = u.pn * 256 + wc * 32 + 4 * fq, vec = vec_plain(u.pm), tid = wid * 64 + lane;
        const float* gate = modl + vec * 6 * D + gate_idx * D;
        const float* src = u.row0 < MP ? src0 + (size_t)u.row0 * D : src1 + (size_t)(u.row0 - MP) * D;
        LAS float* P = L;
        LAS float* S = L + 1024;
        {
            f32x4 gv[2][2];
#pragma unroll
            for (int bj = 0; bj < 2; ++bj)
#pragma unroll
                for (int n = 0; n < 2; ++n) gv[bj][n] = *(const f32x4*)(gate + col0 + bj * 128 + n * 16);
#pragma unroll
            for (int ai = 0; ai < 2; ++ai) {
                f32x4 sv[4][2][2];
#pragma unroll
                for (int m = 0; m < 4; ++m) { const float* sp = src + (size_t)(ai * 128 + wr * 64 + m * 16 + fr) * D + col0;
#pragma unroll
                    for (int bj = 0; bj < 2; ++bj)
#pragma unroll
                        for (int n = 0; n < 2; ++n) sv[m][bj][n] = *(const f32x4*)(sp + bj * 128 + n * 16); }
#pragma unroll
                for (int m = 0; m < 4; ++m) { const int r = ai * 128 + wr * 64 + m * 16 + fr; float* xp = X + (size_t)(u.row0 + r) * D + col0; float ss = 0.f;
#pragma unroll
                    for (int bj = 0; bj < 2; ++bj)
#pragma unroll
                        for (int n = 0; n < 2; ++n) { const f32x4 x1 = sv[m][bj][n] + gv[bj][n] * acc[ai][bj][m][n]; acc[ai][bj][m][n] = x1;
                            if (!FINAL) *(f32x4*)(xp + bj * 128 + n * 16) = x1; ss += (x1[0] * x1[0] + x1[1] * x1[1]) + (x1[2] * x1[2] + x1[3] * x1[3]); }
                    ss = rows_sum(ss);
                    if (fq == 0) P[r * 4 + wc] = ss; }
                asm volatile("" ::: "memory"); }
        }
        LDS_WAIT(); __builtin_amdgcn_s_barrier(); asm volatile("" ::: "memory");
        if (tid < 256) { const f32x4 p = *(const LAS f32x4*)(P + tid * 4); const float tot = (p[0] + p[1]) + (p[2] + p[3]);
            __hip_atomic_store(xs + (size_t)(u.row0 + tid) * 4 + u.pn, tot, __ATOMIC_RELAXED, __HIP_MEMORY_SCOPE_AGENT); }
        asm volatile("s_waitcnt vmcnt(0)" ::: "memory");
        if (tid < 256 && (tid & 63) == 0) __hip_atomic_fetch_add(cnt + 16 * u.pm, 1u, __ATOMIC_RELAXED, __HIP_MEMORY_SCOPE_AGENT);
        if (tid < 64) { unsigned sp_ = 0;
            while ((unsigned)__builtin_amdgcn_readfirstlane(__hip_atomic_load(cnt + 16 * u.pm, __ATOMIC_RELAXED, __HIP_MEMORY_SCOPE_AGENT)) < 16u) {
                __builtin_amdgcn_s_sleep(1);
                if ((++sp_ & 1023u) == 0u) { if (__hip_atomic_load(tmo, __ATOMIC_RELAXED, __HIP_MEMORY_SCOPE_AGENT)) break; if (sp_ > (1u << 22)) { __hip_atomic_store(tmo, 1u, __ATOMIC_RELAXED, __HIP_MEMORY_SCOPE_AGENT); break; } } }
        }
        asm volatile("s_waitcnt vmcnt(0) lgkmcnt(0)" ::: "memory"); __builtin_amdgcn_s_barrier(); asm volatile("" ::: "memory");
        if (tid < 256) { const float* sl = xs + (size_t)(u.row0 + tid) * 4; float t = 0.f;
#pragma unroll
            for (int k = 0; k < 4; ++k) t += __hip_atomic_load(sl + k, __ATOMIC_RELAXED, __HIP_MEMORY_SCOPE_AGENT);
            S[tid] = rsqrtf(t * (1.f / D) + EPS); }
        LDS_WAIT(); __builtin_amdgcn_s_barrier(); asm volatile("" ::: "memory");
        {
            f32x4 gm[2][2], sh[2][2];
#pragma unroll
            for (int bj = 0; bj < 2; ++bj)
#pragma unroll
                for (int n = 0; n < 2; ++n) { const int c = col0 + bj * 128 + n * 16; gm[bj][n] = *(const f32x4*)(gn + c);
                    if (!FINAL) { const float* mv = modn + vec * 6 * D; gm[bj][n] = gm[bj][n] * (1.f + *(const f32x4*)(mv + (sh_idx + 1) * D + c)); sh[bj][n] = *(const f32x4*)(mv + sh_idx * D + c); } }
#pragma unroll
            for (int ai = 0; ai < 2; ++ai)
#pragma unroll
                for (int m = 0; m < 4; ++m) { const int r = ai * 128 + wr * 64 + m * 16 + fr; const float rs = S[r];
#pragma unroll
                    for (int bj = 0; bj < 2; ++bj)
#pragma unroll
                        for (int n = 0; n < 2; ++n) { const int c = col0 + bj * 128 + n * 16;
                            if (FINAL) { *(f32x4*)(Y + (size_t)(u.row0 + r) * D + c) = acc[ai][bj][m][n] * rs * gm[bj][n]; }
                            else { const f32x4 h = acc[ai][bj][m][n] * rs * gm[bj][n] + sh[bj][n]; u32x2 w; w.x = cvt_pk_bf16(h[0], h[1]); w.y = cvt_pk_bf16(h[2], h[3]); *(u32x2*)(HN + (size_t)(u.row0 + r) * D + c) = w; } } }
        }
    }
};
struct EpiBf16 : EpiBase {
    static constexpr bool PERM = true;
    __device__ __forceinline__ void operator()(const f32x4 (&acc)[2][2][4][2], const Unit& u, int wid, int ) const {
        int lane_ = pg8::lane_id(); asm volatile("" : "+v"(lane_));
        const int lane = lane_, wr = wid >> 2, wc = wid & 3, fr = lane & 15, fq = lane >> 4; (void)wr; (void)wc; (void)fr; (void)fq;
        bf16_t* O = (bf16_t*)(wsp() + WS_H); constexpr int ldc = D;
        const int col0 = u.pn * 256 + wc * 32 + 8 * fq;
#pragma unroll
        for (int ai = 0; ai < 2; ++ai)
#pragma unroll
            for (int m = 0; m < 4; ++m) { bf16_t* rowp = O + (size_t)(u.row0 + ai * 128 + wr * 64 + m * 16 + fr) * ldc + col0;
#pragma unroll
                for (int bj = 0; bj < 2; ++bj) { const f32x4 v0 = acc[ai][bj][m][0], v1 = acc[ai][bj][m][1];
                    u32x4 w; w.x = cvt_pk_bf16(v0[0], v0[1]); w.y = cvt_pk_bf16(v0[2], v0[3]); w.z = cvt_pk_bf16(v1[0], v1[1]); w.w = cvt_pk_bf16(v1[2], v1[3]);
                    *(u32x4*)(rowp + bj * 128) = w; } }
    }
};
struct EpiQKV : EpiBase {
    static constexpr bool PERM = false;
    __device__ __forceinline__ void operator()(f32x4 (&acc)[2][2][4][2], const Unit& u, int wid, int ) const {
        int lane_ = pg8::lane_id(); asm volatile("" : "+v"(lane_));
        const int lane = lane_, wr = wid >> 2, wc = wid & 3, fr = lane & 15, fq = lane >> 4; (void)wr; (void)wc; (void)fr; (void)fq;
        unsigned char* ws = wsp(); bf16_t* Q = (bf16_t*)(ws + WS_Q); bf16_t* KB = (bf16_t*)(ws + WS_KB); bf16_t* VT = (bf16_t*)(ws + WS_VT); const float* rope = (const float*)(ws + WS_ROPE);
        float* outk = outp(kargs()) + OUT_NK; float* outv = outk + (OUT_NV - OUT_NK);
        const bool samp = u.pm >= 32;
        const int c0 = wc * 32 + 4 * fq;
        if (samp && u.pn <= 4) {
            const int half = wc & 1;
#pragma unroll
            for (int ai = 0; ai < 2; ++ai)
#pragma unroll
                for (int m = 0; m < 4; ++m) { const int t = (u.row0 - MP + ai * 128 + wr * 64 + m * 16 + fr) & (TS - 1); const int pos = half ? (t & 63) : (t >> 6);
                    const f32x4 cs = *(const f32x4*)(rope + pos * 16 + 4 * fq), sn = *(const f32x4*)(rope + 1024 + pos * 16 + 4 * fq);
#pragma unroll
                    for (int bj = 0; bj < 2; ++bj) { const f32x4 x1 = acc[ai][bj][m][0], x2 = acc[ai][bj][m][1]; acc[ai][bj][m][0] = x1 * cs - x2 * sn; acc[ai][bj][m][1] = x2 * cs + x1 * sn; } }
        }
        if (u.pn <= 4) {
            bf16_t* base = u.pn < 4 ? Q + u.pn * 256 : KB; const int ldc = u.pn < 4 ? D : 256;
#pragma unroll
            for (int ai = 0; ai < 2; ++ai)
#pragma unroll
                for (int m = 0; m < 4; ++m) { const int row = u.row0 + ai * 128 + wr * 64 + m * 16 + fr; bf16_t* rowp = base + (size_t)row * ldc + c0;
#pragma unroll
                    for (int bj = 0; bj < 2; ++bj)
#pragma unroll
                        for (int n = 0; n < 2; ++n) { const f32x4 v = acc[ai][bj][m][n]; u32x2 w; w.x = cvt_pk_bf16(v[0], v[1]); w.y = cvt_pk_bf16(v[2], v[3]); *(u32x2*)(rowp + bj * 128 + n * 16) = w;
                            if (u.pn == 4 && !samp) *(f32x4*)(outk + (size_t)row * 256 + c0 + bj * 128 + n * 16) = v; } }
        } else {
            const int T = samp ? TS : TP;
            bf16_t* vt = samp ? VT + (size_t)32 * 65536 + (size_t)((u.row0 - MP) / TS) * 256 * TS : VT + (size_t)(u.row0 / TP) * 65536;
#pragma unroll
            for (int ai = 0; ai < 2; ++ai)
#pragma unroll
                for (int m = 0; m < 4; ++m) { const int row = u.row0 + ai * 128 + wr * 64 + m * 16 + fr; const int t = samp ? ((row - MP) & (TS - 1)) : (row & (TP - 1));
                    unsigned vo = (unsigned)(c0 * T + t); asm volatile("" : "+v"(vo));
#pragma unroll
                    for (int bj = 0; bj < 2; ++bj)
#pragma unroll
                        for (int n = 0; n < 2; ++n) { const f32x4 v = acc[ai][bj][m][n]; const int c = c0 + bj * 128 + n * 16;
#pragma unroll
                            for (int j = 0; j < 4; ++j) vt[vo + (unsigned)((bj * 128 + n * 16 + j) * T)] = (bf16_t)f2bf(v[j]);
                            if (!samp) *(f32x4*)(outv + (size_t)row * 256 + c) = v; } }
        }
    }
};
__device__ __forceinline__ f32x4 conv_m(f32x4 cur, f32x4 pe, f32x4 ne, f32x4 w0, f32x4 w1, f32x4 w2, int fr) {
    const f32x4 up = dpp4<DPP_ROR1>(cur), dn = dpp4<DPP_ROR15>(cur);
    const f32x4 prev = fr > 0 ? up : pe, next = fr < 15 ? dn : ne;
    return w0 * prev + w1 * cur + w2 * next;
}
__device__ __forceinline__ void mask_rows(f32x4 (&acc)[2][2][4][2], const Unit& u, int wr, int fr) {
    if (u.pm < 32) return;
    const int i = (u.pm - 32) % 9; if (i != 0 && i != 8) return;
    const int t0 = 254 * i - 1;
#pragma unroll
    for (int ai = 0; ai < 2; ++ai)
#pragma unroll
        for (int m = 0; m < 4; ++m) { const int t = t0 + ai * 128 + wr * 64 + m * 16 + fr; if (t < 0 || t >= TS) {
#pragma unroll
            for (int bj = 0; bj < 2; ++bj)
#pragma unroll
                for (int n = 0; n < 2; ++n) acc[ai][bj][m][n] = (f32x4){0.f, 0.f, 0.f, 0.f}; } }
}
__device__ __forceinline__ bool row_valid(const Unit& u, int r) {
    if (u.pm < 32) return true;
    const int t = 254 * ((u.pm - 32) % 9) - 1 + r; return r >= 1 && r <= 254 && t >= 0 && t < TS;
}
__device__ __forceinline__ void xch_write(LAS float* X, const f32x4 (&acc)[2][2][4][2], int wr, int wc, int fr, int fq) {
#pragma unroll
    for (int ai = 0; ai < 2; ++ai)
#pragma unroll
        for (int bj = 0; bj < 2; ++bj)
#pragma unroll
            for (int n = 0; n < 2; ++n) { const int col = bj * 128 + wc * 32 + 8 * fq + 4 * n;
                if (fr == 0) *(LAS f32x4*)(X + ((2 * ai + wr) * 2 + 0) * 256 + col) = acc[ai][bj][0][n];
                if (fr == 15) *(LAS f32x4*)(X + ((2 * ai + wr) * 2 + 1) * 256 + col) = acc[ai][bj][3][n]; }
}
__device__ __forceinline__ f32x4 xch_top(const LAS float* X, int b, int col) { return b > 0 ? *(const LAS f32x4*)(X + ((b - 1) * 2 + 1) * 256 + col) : (f32x4){0.f, 0.f, 0.f, 0.f}; }
__device__ __forceinline__ f32x4 xch_bot(const LAS float* X, int b, int col) { return b < 3 ? *(const LAS f32x4*)(X + ((b + 1) * 2 + 0) * 256 + col) : (f32x4){0.f, 0.f, 0.f, 0.f}; }

struct EpiUp : EpiBase {
    static constexpr bool PERM = true;
    __device__ __forceinline__ void operator()(f32x4 (&acc)[2][2][4][2], const Unit& u, int wid, int ) const {
        int lane_ = pg8::lane_id(); asm volatile("" : "+v"(lane_));
        const int lane = lane_, wr = wid >> 2, wc = wid & 3, fr = lane & 15, fq = lane >> 4; (void)wr; (void)wc; (void)fr; (void)fq;
        bf16_t* ACT = (bf16_t*)(wsp() + WS_ACT); const float* cw = inp(kargs(), 24) + (size_t)l * 3 * 2 * DFF; LAS float* X = xch();
        mask_rows(acc, u, wr, fr);
        xch_write(X, acc, wr, wc, fr, fq);
        LDS_WAIT(); __builtin_amdgcn_s_barrier(); asm volatile("" ::: "memory");
        const int chl = wc * 32 + 8 * fq;
#pragma unroll
        for (int n = 0; n < 2; ++n) {
            const int ch = u.pn * 128 + chl + 4 * n;
            f32x4 wg[3], wu[3];
#pragma unroll
            for (int k = 0; k < 3; ++k) { wg[k] = *(const f32x4*)(cw + k * 2 * DFF + ch); wu[k] = *(const f32x4*)(cw + k * 2 * DFF + DFF + ch); }
#pragma unroll
            for (int ai = 0; ai < 2; ++ai) {
                const int b = 2 * ai + wr;
                f32x4 pg = xch_top(X, b, chl + 4 * n), pu = xch_top(X, b, 128 + chl + 4 * n);
#pragma unroll
                for (int m = 0; m < 4; ++m) { const int r = ai * 128 + wr * 64 + m * 16 + fr;
                    const f32x4 vg = acc[ai][0][m][n], vu = acc[ai][1][m][n];
                    const f32x4 ng = m < 3 ? dpp4<DPP_ROR15>(acc[ai][0][m < 3 ? m + 1 : 3][n]) : xch_bot(X, b, chl + 4 * n);
                    const f32x4 nu = m < 3 ? dpp4<DPP_ROR15>(acc[ai][1][m < 3 ? m + 1 : 3][n]) : xch_bot(X, b, 128 + chl + 4 * n);
                    const f32x4 og = conv_m(vg, pg, ng, wg[0], wg[1], wg[2], fr), ou = conv_m(vu, pu, nu, wu[0], wu[1], wu[2], fr);
                    pg = dpp4<DPP_ROR1>(vg); pu = dpp4<DPP_ROR1>(vu);
                    f32x4 a;
#pragma unroll
                    for (int j = 0; j < 4; ++j) a[j] = silu_f(og[j]) * ou[j];
                    if (row_valid(u, r)) { u32x2 w; w.x = cvt_pk_bf16(a[0], a[1]); w.y = cvt_pk_bf16(a[2], a[3]); *(u32x2*)(ACT + (size_t)(u.row0 + r) * DFF + ch) = w; } }
            }
        }
    }
};
struct EpiSgu : EpiBase {
    static constexpr bool PERM = true;
    __device__ __forceinline__ void operator()(f32x4 (&acc)[2][2][4][2], const Unit& u, int wid, int ) const {
        int lane_ = pg8::lane_id(); asm volatile("" : "+v"(lane_));
        const int lane = lane_, wr = wid >> 2, wc = wid & 3, fr = lane & 15, fq = lane >> 4; (void)wr; (void)wc; (void)fr; (void)fq;
        unsigned char* ws = wsp(); bf16_t* U = (bf16_t*)(ws + WS_U); bf16_t* V = (bf16_t*)(ws + WS_V); f32x2* STATS = (f32x2*)(ws + WS_STATS);
        const bool isv = u.pn >= 4; bf16_t* O = isv ? V : U; const int col0 = (u.pn & 3) * 256 + wc * 32 + 8 * fq;
#pragma unroll
        for (int ai = 0; ai < 2; ++ai)
#pragma unroll
            for (int m = 0; m < 4; ++m) { const int row = u.row0 + ai * 128 + wr * 64 + m * 16 + fr; bf16_t* rowp = O + (size_t)row * D + col0; float s1 = 0.f, s2 = 0.f;
#pragma unroll
                for (int bj = 0; bj < 2; ++bj) { f32x4 v0 = acc[ai][bj][m][0], v1 = acc[ai][bj][m][1];
#pragma unroll
                    for (int j = 0; j < 4; ++j) { v0[j] = gelu_f(v0[j]); v1[j] = gelu_f(v1[j]); s1 += v0[j] + v1[j]; s2 += v0[j] * v0[j] + v1[j] * v1[j]; }
                    u32x4 w; w.x = cvt_pk_bf16(v0[0], v0[1]); w.y = cvt_pk_bf16(v0[2], v0[3]); w.z = cvt_pk_bf16(v1[0], v1[1]); w.w = cvt_pk_bf16(v1[2], v1[3]);
                    *(u32x4*)(rowp + bj * 128) = w; }
                if (isv) { s1 = rows_sum(s1); s2 = rows_sum(s2);
                    if (fq == 0) STATS[(size_t)row * 16 + (u.pn - 4) * 4 + wc] = (f32x2){s1, s2}; } }
    }
};
struct EpiSc : EpiBase {
    static constexpr bool PERM = true;
    __device__ __forceinline__ void operator()(f32x4 (&acc)[2][2][4][2], const Unit& u, int wid, int ui) const {
        int lane_ = pg8::lane_id(); asm volatile("" : "+v"(lane_));
        const int lane = lane_, wr = wid >> 2, wc = wid & 3, fr = lane & 15, fq = lane >> 4; (void)wr; (void)wc; (void)fr; (void)fq;
        unsigned char* ws = wsp(); f32x4* YB = (f32x4*)(ws + WS_YB) + (size_t)aux * 2 * 16 * 512; bf16_t* BY = (bf16_t*)(ws + WS_H2); const float* cw = inp(kargs(), 20); LAS float* X = xch();
        const int q = u.pn / 3, s = u.pn % 3, chl = wc * 32 + 8 * fq;
        if (s < 2) {
            mask_rows(acc, u, wr, fr);
#pragma unroll
            for (int ai = 0; ai < 2; ++ai)
#pragma unroll
                for (int m = 0; m < 4; ++m)
#pragma unroll
                    for (int n = 0; n < 2; ++n) acc[ai][0][m][n] = acc[ai][0][m][n] * acc[ai][1][m][n];
            xch_write(X, acc, wr, wc, fr, fq);
            LDS_WAIT(); __builtin_amdgcn_s_barrier(); asm volatile("" ::: "memory");
#pragma unroll
            for (int n = 0; n < 2; ++n) {
                const int ch = q * 256 + s * 128 + chl + 4 * n;
                f32x4 w[3];
#pragma unroll
                for (int k = 0; k < 3; ++k) w[k] = *(const f32x4*)(cw + k * D + ch);
#pragma unroll
                for (int ai = 0; ai < 2; ++ai) { const int b = 2 * ai + wr;
                    f32x4 pp = xch_top(X, b, chl + 4 * n);
#pragma unroll
                    for (int m = 0; m < 4; ++m) { const f32x4 v = acc[ai][0][m][n];
                        const f32x4 nn = m < 3 ? dpp4<DPP_ROR15>(acc[ai][0][m < 3 ? m + 1 : 3][n]) : xch_bot(X, b, chl + 4 * n);
                        const f32x4 o = conv_m(v, pp, nn, w[0], w[1], w[2], fr); pp = dpp4<DPP_ROR1>(v);
                        unsigned yo = (unsigned)((s * 16 + (ai * 4 + m) * 2 + n) * 512) + (unsigned)(wid * 64 + lane); asm volatile("" : "+v"(yo)); YB[yo] = o; } }
            }
        } else {
#pragma unroll
            for (int ai = 0; ai < 2; ++ai)
#pragma unroll
                for (int m = 0; m < 4; ++m) { const int r = ai * 128 + wr * 64 + m * 16 + fr; const bool ok = row_valid(u, r);
#pragma unroll
                    for (int bj = 0; bj < 2; ++bj) { unsigned yo = (unsigned)((bj * 16 + (ai * 4 + m) * 2) * 512) + (unsigned)(wid * 64 + lane); asm volatile("" : "+v"(yo)); const f32x4 y0 = YB[yo], y1 = YB[yo + 512];
                        const f32x4 v0 = acc[ai][bj][m][0] * y0, v1 = acc[ai][bj][m][1] * y1;
                        u32x4 w; w.x = cvt_pk_bf16(v0[0], v0[1]); w.y = cvt_pk_bf16(v0[2], v0[3]); w.z = cvt_pk_bf16(v1[0], v1[1]); w.w = cvt_pk_bf16(v1[2], v1[3]);
                        if (ok) *(u32x4*)(BY + (size_t)(u.row0 + r) * D + q * 256 + bj * 128 + chl) = w; }
                    asm volatile("" ::: "memory"); }
        }
    }
};
struct OrderSc {
    int c; const char* A; const char* B;
    __device__ __forceinline__ bool next(int i, Unit& u) const {
        if (c >= 200 || i >= 3) return false;
        u.pm = c >> 2; u.pn = 3 * (c & 3) + i; u.row0 = conv_row0(u.pm); u.a = A + (long)u.row0 * (D * 2); u.b = B + (size_t)u.pn * 256 * D * 2; return true; }
};
struct EpiFn1 : EpiBase {
    static constexpr bool PERM = true;
    __device__ __forceinline__ void operator()(const f32x4 (&acc)[2][2][4][2], const Unit& u, int wid, int ) const {
        int lane_ = pg8::lane_id(); asm volatile("" : "+v"(lane_));
        const int lane = lane_, wr = wid >> 2, wc = wid & 3, fr = lane & 15, fq = lane >> 4; (void)wr; (void)wc; (void)fr; (void)fq;
        bf16_t* YT = (bf16_t*)(wsp() + WS_YT);
        const int part = u.pm & 1, ch0 = (u.pm >> 1) * 256, tok0 = u.pn * 256;
        bf16_t* base; int T, t0;
        if (tok0 < MP) { T = TP; base = YT + (size_t)(tok0 / TP) * D * 2 * TP; t0 = 0; }
        else { T = TS; base = YT + (size_t)32 * D * 2 * TP + (size_t)((tok0 - MP) / TS) * D * 2 * TS; t0 = (tok0 - MP) % TS; }
        const int c0 = wc * 32 + 8 * fq;
#pragma unroll
        for (int ai = 0; ai < 2; ++ai)
#pragma unroll
            for (int m = 0; m < 4; ++m) { bf16_t* rowp = base + (size_t)(ch0 + ai * 128 + wr * 64 + m * 16 + fr) * 2 * T + part * T + t0 + c0;
#pragma unroll
                for (int bj = 0; bj < 2; ++bj) { const f32x4 v0 = acc[ai][bj][m][0], v1 = acc[ai][bj][m][1];
                    u32x4 w; w.x = cvt_pk_bf16(v0[0], v0[1]); w.y = cvt_pk_bf16(v0[2], v0[3]); w.z = cvt_pk_bf16(v1[0], v1[1]); w.w = cvt_pk_bf16(v1[2], v1[3]);
                    *(u32x4*)(rowp + bj * 128) = w; } }
    }
};
struct OrderFn1 {
    int G, c; const char* A1; const char* H;
    __device__ __forceinline__ bool next(int i, Unit& u) const {
        const int L = i * G + c; if (L >= 384) return false;
        u.pm = L & 7; u.pn = L >> 3; u.row0 = 0; u.a = A1 + (size_t)(u.pm & 1) * 256 * 256 * 2; u.b = H + (size_t)u.pn * 256 * D * 2 + (size_t)(u.pm >> 1) * 512; return true; }
};
struct OrderFn2 {
    int c; int samp; const char* A2; const char* YT;
    __device__ __forceinline__ bool next(int i, Unit& u) const {
        if (i > 0) return false;
        if (samp) { if (c >= 64) return false; const int b = c >> 5, tm = (c >> 2) & 7; u.pm = tm; u.pn = c & 3; u.row0 = MP + b * TS + 256 * tm;
            u.a = A2 + (size_t)tm * 256 * 2 * TS * 2; u.b = YT + (size_t)32 * D * 2 * TP * 2 + (size_t)b * D * 2 * TS * 2 + (size_t)u.pn * 256 * 2 * TS * 2; return true; }
        if (c < 64 || c >= 192) return false; const int j = c - 64, s = j >> 2; u.pm = 0; u.pn = j & 3; u.row0 = s * TP;
        u.a = A2; u.b = YT + (size_t)s * D * 2 * TP * 2 + (size_t)u.pn * 256 * 2 * TP * 2; return true; }
};

__device__ __forceinline__ void p0_transpose_item(const float* W, int K, int N, bf16_t* WT, int drow0, LAS float* scr, int kb, int n0, int lane) {
    const int k0 = 64 * kb;
    f32x4 v[8];
#pragma unroll
    for (int i = 0; i < 8; ++i) v[i] = *(const f32x4*)(W + (size_t)(k0 + 8 * i + (lane >> 3)) * N + n0 + 4 * (lane & 7));
#pragma unroll
    for (int i = 0; i < 8; ++i) { LAS float* d = scr + (8 * i + (lane >> 3)) * 33 + 4 * (lane & 7); d[0] = v[i][0]; d[1] = v[i][1]; d[2] = v[i][2]; d[3] = v[i][3]; }
    LDS_WAIT(); asm volatile("" ::: "memory");
    const int c = lane & 7;
#pragma unroll
    for (int j = 0; j < 4; ++j) { const int n = (lane >> 3) + 8 * j; const LAS float* s = scr + (8 * c) * 33 + n;
        u32x4 o; o.x = pk2(s[0 * 33], s[1 * 33]); o.y = pk2(s[2 * 33], s[3 * 33]); o.z = pk2(s[4 * 33], s[5 * 33]); o.w = pk2(s[6 * 33], s[7 * 33]);
        *(u32x4*)(WT + (size_t)(drow0 + n) * K + k0 + 8 * c) = o; }
    LDS_WAIT(); asm volatile("" ::: "memory");
}
__device__ __forceinline__ int map_plain(int n) { return n; }
__device__ __forceinline__ int map_up(int n) { return n < DFF ? 256 * (n >> 7) + (n & 127) : 256 * ((n - DFF) >> 7) + 128 + ((n - DFF) & 127); }
__device__ __forceinline__ int map_sc(int n) {
    if (n < D) return (3 * (n >> 8) + 2) * 256 + (n & 255);
    const int x = n >= 2 * D, ch = n - D - x * D; return (3 * (ch >> 8) + ((ch >> 7) & 1)) * 256 + x * 128 + (ch & 127);
}
__device__ __forceinline__ void p0_tjob(int& it, int NGW, LAS float* scr, int lane, const float* W, bf16_t* WT, int K, int N, int map) {
    const int nblk = N / 32, nitems = (K / 64) * nblk;
    for (; it < nitems; it += NGW) { const int kb = it / nblk, n0 = (it % nblk) * 32; const int dr = map == 0 ? n0 : (map == 1 ? map_up(n0) : map_sc(n0));
        p0_transpose_item(W, K, N, WT, dr, scr, kb, n0, lane); }
    it -= nitems;
}
__device__ __forceinline__ void convert_layer(Frame& F, int l, int b0, int nb) {
    unsigned char* ws = F.ws;
    LAS float* scr = (LAS float*)(F.lds + F.wave * 16384);
    const int gw = (F.blk - b0) * NWAVES + F.wave, NGW = nb * NWAVES;
    int it = gw;
    if (l == 0) { p0_tjob(it, NGW, scr, F.lane, ((const float*)F.in[11]), (bf16_t*)(ws + WS_WQKV), D, 1536, 0);
        p0_tjob(it, NGW, scr, F.lane, ((const float*)F.in[12]), (bf16_t*)(ws + WS_WO), D, D, 0); }
    else if (l == 1) { p0_tjob(it, NGW, scr, F.lane, ((const float*)F.in[14]), (bf16_t*)(ws + WS_WSGI), D, 2048, 0);
        p0_tjob(it, NGW, scr, F.lane, ((const float*)F.in[18]), (bf16_t*)(ws + WS_WSGO), D, D, 0); }
    else if (l == 2) { p0_tjob(it, NGW, scr, F.lane, ((const float*)F.in[19]), (bf16_t*)(ws + WS_WSCI), D, 3072, 2);
        p0_tjob(it, NGW, scr, F.lane, ((const float*)F.in[21]), (bf16_t*)(ws + WS_WSCO), D, D, 0); }
    else p0_tjob(it, NGW, scr, F.lane, ((const float*)F.in[22]), (bf16_t*)(ws + WS_WFNO), D, D, 0);
    p0_tjob(it, NGW, scr, F.lane, ((const float*)F.in[23]) + (size_t)l * D * 2 * DFF, (bf16_t*)(ws + WS_WUP + l * WUP_BYTES), D, 2 * DFF, 1);
    p0_tjob(it, NGW, scr, F.lane, ((const float*)F.in[25]) + (size_t)l * DFF * D, (bf16_t*)(ws + WS_WDN + l * WDN_BYTES), DFF, D, 0);
    const size_t gt = (size_t)(F.blk - b0) * 512 + F.tid, NGT = (size_t)nb * 512;
    if (l == 1) { bf16_t* WSb = (bf16_t*)(ws + WS_WS); for (size_t i = gt; i < 8 * 128 * 128; i += NGT) WSb[i] = (bf16_t)f2bf(((const float*)F.in[16])[i]); }
    if (l == 3) {
        bf16_t* A1 = (bf16_t*)(ws + WS_A1);
        for (size_t i = gt; i < 2 * 256 * 256; i += NGT) { const int part = i >> 16, r = (i >> 8) & 255, k = i & 255; float v = 0.f;
            if ((r >> 7) == (k >> 7)) { const float a = 2.f * (float)(((r & 127) * (k & 127)) & 127) / 128.f; v = (part ? sinpif(a) : cospif(a)) * 0.08838834764831845f; }
            A1[i] = (bf16_t)f2bf(v); }
        bf16_t* A2P = (bf16_t*)(ws + WS_A2P);
        for (size_t i = gt; i < 256 * 512; i += NGT) { const int tp = i >> 9, k = i & 511, t = k & 255; const float a = 2.f * (float)((tp * t) & 255) / 256.f;
            A2P[i] = (bf16_t)f2bf((k < 256 ? cospif(a) : -sinpif(a)) * 0.0625f); }
        __syncthreads();
        LAS bf16_t* tab = (LAS bf16_t*)F.lds;
        for (int j = F.tid; j < 2048; j += 512) { const float a = 2.f * (float)j / 2048.f; tab[j] = (bf16_t)f2bf(cospif(a) * 0.022097086912079608f); tab[2048 + j] = (bf16_t)f2bf(-sinpif(a) * 0.022097086912079608f); }
        __syncthreads();
        bf16_t* A2S = (bf16_t*)(ws + WS_A2S);
        for (size_t i8 = gt; i8 < (size_t)2048 * 4096 / 8; i8 += NGT) { const int tp = (int)(i8 >> 9), k0 = (int)(i8 & 511) * 8, part = k0 >> 11, t0 = k0 & 2047;
            unsigned w[4];
#pragma unroll
            for (int e = 0; e < 4; ++e) { const unsigned lo = tab[part * 2048 + ((tp * (t0 + 2 * e)) & 2047)], hi = tab[part * 2048 + ((tp * (t0 + 2 * e + 1)) & 2047)]; w[e] = lo | (hi << 16); }
            *(u32x4*)(A2S + i8 * 8) = (u32x4){w[0], w[1], w[2], w[3]}; }
        __syncthreads();
    }
}
__device__ __forceinline__ void p0_prologue(Frame& F) {
    unsigned char* ws = F.ws;
    convert_layer(F, 0, 0, F.G);
    __syncthreads();
    {
        LAS float* sv = (LAS float*)F.lds;
        LAS float* red = sv + 3 * D;
        for (int i = F.tid; i < D; i += 512) { const float a = ((const float*)F.in[5])[i], b = ((const float*)F.in[4])[i], d = ((const float*)F.in[4])[D + i];
            sv[i] = a / (1.f + expf(-a)); sv[D + i] = b / (1.f + expf(-b)); sv[2 * D + i] = d / (1.f + expf(-d)); }
        __syncthreads();
        float* MODp = (float*)(ws + WS_MOD);
        const int kg = F.tid >> 3, cq = F.tid & 7;
        for (int it = F.blk; it < 768; it += F.G) {
            const int l = it / 192, n0 = (it % 192) * 32;
            const float* w = ((const float*)F.in[6]) + (size_t)l * D * 6 * D + n0 + 4 * cq;
            f32x4 a0 = {0, 0, 0, 0}, a1 = a0, a2 = a0;
#pragma unroll 4
            for (int k = kg; k < D; k += 64) { const f32x4 wv = *(const f32x4*)(w + (size_t)k * 6 * D); a0 += sv[k] * wv; a1 += sv[D + k] * wv; a2 += sv[2 * D + k] * wv; }
            *(LAS f32x4*)(red + (kg * 3 + 0) * 32 + 4 * cq) = a0; *(LAS f32x4*)(red + (kg * 3 + 1) * 32 + 4 * cq) = a1; *(LAS f32x4*)(red + (kg * 3 + 2) * 32 + 4 * cq) = a2;
            __syncthreads();
            if (F.tid < 96) { const int v = F.tid >> 5, cc = F.tid & 31; float s = 0.f;
                for (int g = 0; g < 64; ++g) s += red[(g * 3 + v) * 32 + cc];
                MODp[(l * 3 + v) * 6 * D + n0 + cc] = s + ((const float*)F.in[7])[l * 6 * D + n0 + cc]; }
            __syncthreads();
        }
    }
    {
        const size_t gt = (size_t)F.blk * 512 + F.tid, NGT = (size_t)F.G * 512;
        bf16_t* CK = (bf16_t*)(ws + WS_CK); bf16_t* CVT = (bf16_t*)(ws + WS_CVT);
        for (size_t i = gt; i < 2 * 512 * 256; i += NGT) { CK[i] = (bf16_t)f2bf(((const float*)F.in[2])[i]);
            const int d = i & 63, kvh = (i >> 6) & 3, j = (i >> 8) & 511, b = i >> 17; CVT[((size_t)(b * 4 + kvh) * 64 + d) * 512 + j] = (bf16_t)f2bf(((const float*)F.in[3])[i]); }
        float* rope = (float*)(ws + WS_ROPE);
        for (size_t i = gt; i < 1024; i += NGT) { const int pos = i >> 4, fi = i & 15; const float ang = (float)pos * powf(10000.f, -(float)fi / 16.f); rope[i] = cosf(ang); rope[1024 + i] = sinf(ang); }
    }
}

__device__ __forceinline__ void norm_phase(Frame& F, const float* src0, const float* src1, const float* g, const float* modl, int sh_idx, bf16_t* H) {
    const int gw = F.blk * NWAVES + F.wave, NGW = F.G * NWAVES;
    f32x4 gv[4];
#pragma unroll
    for (int j = 0; j < 4; ++j) gv[j] = *(const f32x4*)(g + 256 * j + 4 * F.lane);
    for (int row = gw; row < M; row += NGW) {
        const float* xr = row < MP ? src0 + (size_t)row * D : src1 + (size_t)(row - MP) * D;
        const float* mv = modl + (row < MP ? 0 : 1 + (row - MP) / TS) * 6 * D;
        f32x4 v[4]; float s = 0.f;
#pragma unroll
        for (int j = 0; j < 4; ++j) { v[j] = *(const f32x4*)(xr + 256 * j + 4 * F.lane); s += (v[j][0] * v[j][0] + v[j][1] * v[j][1]) + (v[j][2] * v[j][2] + v[j][3] * v[j][3]); }
        const float r = rsqrtf(wave_sum(s) * (1.f / D) + EPS);
#pragma unroll
        for (int j = 0; j < 4; ++j) { const f32x4 sh = *(const f32x4*)(mv + sh_idx * D + 256 * j + 4 * F.lane), sc = *(const f32x4*)(mv + (sh_idx + 1) * D + 256 * j + 4 * F.lane);
            const f32x4 o = v[j] * r * gv[j] * (1.f + sc) + sh;
            u32x2 w; w.x = pk2(o[0], o[1]); w.y = pk2(o[2], o[3]); *(u32x2*)(H + (size_t)row * D + 256 * j + 4 * F.lane) = w; }
    }
}
__device__ __forceinline__ void final_phase(Frame& F, const float* X, const float* g, float* out) {
    const int gw = F.blk * NWAVES + F.wave, NGW = F.G * NWAVES;
    f32x4 gv[4];
#pragma unroll
    for (int j = 0; j < 4; ++j) gv[j] = *(const f32x4*)(g + 256 * j + 4 * F.lane);
    for (int row = gw; row < M; row += NGW) {
        const float* xr = X + (size_t)row * D; f32x4 v[4]; float s = 0.f;
#pragma unroll
        for (int j = 0; j < 4; ++j) { v[j] = *(const f32x4*)(xr + 256 * j + 4 * F.lane); s += (v[j][0] * v[j][0] + v[j][1] * v[j][1]) + (v[j][2] * v[j][2] + v[j][3] * v[j][3]); }
        const float r = rsqrtf(wave_sum(s) * (1.f / D) + EPS);
#pragma unroll
        for (int j = 0; j < 4; ++j) *(f32x4*)(out + (size_t)row * D + 256 * j + 4 * F.lane) = v[j] * r * gv[j];
    }
}

constexpr int ATT_LDK = 144;
constexpr int ATT_TILE_BYTES = 2 * 64 * ATT_LDK;
struct AttTile { const bf16_t* K; const bf16_t* V; int ldk, ldv, k0, mask; };
__device__ __forceinline__ void att_tile_of(int t, bool lat, int nband, int kband0, const bf16_t* KBs, const bf16_t* VTs, int T, const bf16_t* CKs, const bf16_t* CVTs, AttTile& o) {
    if (t < nband) { const int k0 = kband0 + 64 * t; o.K = KBs + (size_t)k0 * 256; o.V = VTs + k0; o.ldk = 256; o.ldv = T; o.k0 = k0; o.mask = lat; }
    else { const int k0 = 64 * (t - nband); o.K = CKs + (size_t)k0 * 256; o.V = CVTs + k0; o.ldk = 256; o.ldv = 512; o.k0 = k0; o.mask = 0; }
}
__device__ __forceinline__ void attn_phase(Frame& F, const bf16_t* Q, const bf16_t* KB, const bf16_t* VT, const bf16_t* CK, const bf16_t* CVT, const float* sink, bf16_t* O) {
    const int fr = F.lane & 15, g4 = F.lane >> 4, tid = F.tid;
    const int lrow = tid >> 3, lchunk = tid & 7;
    LAS unsigned char* lds = F.lds;
    for (int it = F.blk; it < 768; it += F.G) {
        const bool lat = it < 256; int kvh, chunk, T, rowbase, b = 0; const bf16_t* vt;
        if (lat) { b = it >> 7; kvh = (it >> 5) & 3; chunk = it & 31; T = TS; rowbase = MP + b * TS; vt = VT + (size_t)32 * 65536 + (size_t)b * 256 * TS; }
        else { const int j = it - 256, s = j >> 4; kvh = (j >> 2) & 3; chunk = j & 3; T = TP; rowbase = s * TP; vt = VT + (size_t)s * 65536; }
        const int h = kvh * 4 + (F.wave & 3), q0 = chunk * 64 + (F.wave >> 2) * 32;
        int kband0 = 0, nband = T / 64;
        if (lat) { int lo = 64 * chunk - 128, hi = 64 * chunk + 192; lo = lo < 0 ? 0 : lo; hi = hi > T ? T : hi; kband0 = lo; nband = (hi - lo) / 64; }
        const int ntile = nband + (lat ? 8 : 0);
        const bf16_t* KBs = KB + (size_t)rowbase * 256 + kvh * 64; const bf16_t* VTs = vt + (size_t)(kvh * 64) * T;
        const bf16_t* CKs = CK + (size_t)b * 512 * 256 + kvh * 64; const bf16_t* CVTs = CVT + (size_t)((b * 4 + kvh) * 64) * 512;
        bf16x8 Qf[2][2];
#pragma unroll
        for (int qg = 0; qg < 2; ++qg)
#pragma unroll
            for (int ds = 0; ds < 2; ++ds) Qf[qg][ds] = *(const bf16x8*)(Q + (size_t)(rowbase + q0 + 16 * qg + fr) * D + h * 64 + 32 * ds + 8 * g4);
        float mrun[2], lrun[2]; f32x4 Oa[2][4];
#pragma unroll
        for (int qg = 0; qg < 2; ++qg) { mrun[qg] = sink[h] * 1.4426950408889634f; lrun[qg] = 1.f;
#pragma unroll
            for (int db = 0; db < 4; ++db) Oa[qg][db] = (f32x4){0.f, 0.f, 0.f, 0.f}; }
        AttTile tl; att_tile_of(0, lat, nband, kband0, KBs, VTs, T, CKs, CVTs, tl);
        u32x4 rk = *(const u32x4*)(tl.K + (size_t)lrow * tl.ldk + lchunk * 8), rv = *(const u32x4*)(tl.V + (size_t)lrow * tl.ldv + lchunk * 8);
        __syncthreads();
        *(LAS u32x4*)(lds + lrow * ATT_LDK + lchunk * 16) = rk; *(LAS u32x4*)(lds + 64 * ATT_LDK + lrow * ATT_LDK + lchunk * 16) = rv;
        __syncthreads();
#pragma unroll 1
        for (int t = 0; t < ntile; ++t) {
            const int cur_k0 = tl.k0, cur_mask = tl.mask;
            if (t + 1 < ntile) { att_tile_of(t + 1, lat, nband, kband0, KBs, VTs, T, CKs, CVTs, tl);
                rk = *(const u32x4*)(tl.K + (size_t)lrow * tl.ldk + lchunk * 8); rv = *(const u32x4*)(tl.V + (size_t)lrow * tl.ldv + lchunk * 8); }
            const LAS unsigned char* kb_ = lds + (t & 1) * ATT_TILE_BYTES; const LAS unsigned char* vb_ = kb_ + 64 * ATT_LDK;
#pragma unroll
            for (int sub = 0; sub < 2; ++sub) {
                bf16x8 Kf[2][2], Vf[4];
#pragma unroll
                for (int kb = 0; kb < 2; ++kb)
#pragma unroll
                    for (int ds = 0; ds < 2; ++ds) Kf[kb][ds] = *(const LAS bf16x8*)(kb_ + (32 * sub + 16 * kb + fr) * ATT_LDK + 64 * ds + 16 * g4);
#pragma unroll
                for (int db = 0; db < 4; ++db) { const LAS unsigned char* vp = vb_ + (16 * db + fr) * ATT_LDK + 64 * sub + 8 * g4; const u32x2 lo = *(const LAS u32x2*)vp, hi = *(const LAS u32x2*)(vp + 32);
                    Vf[db] = __builtin_bit_cast(bf16x8, (u32x4){lo.x, lo.y, hi.x, hi.y}); }
                const float c = 0.125f * 1.4426950408889634f;
#pragma unroll
                for (int qg = 0; qg < 2; ++qg) {
                    f32x4 S[2];
#pragma unroll
                    for (int kb = 0; kb < 2; ++kb) { S[kb] = __builtin_amdgcn_mfma_f32_16x16x32_bf16(Kf[kb][0], Qf[qg][0], (f32x4){0.f, 0.f, 0.f, 0.f}, 0, 0, 0); S[kb] = __builtin_amdgcn_mfma_f32_16x16x32_bf16(Kf[kb][1], Qf[qg][1], S[kb], 0, 0, 0); }
                    float mx = -1e30f; const int qpos = q0 + 16 * qg + fr;
#pragma unroll
                    for (int kb = 0; kb < 2; ++kb)
#pragma unroll
                        for (int r = 0; r < 4; ++r) { float x = S[kb][r] * c; if (cur_mask) { const int d = cur_k0 + 32 * sub + 16 * kb + 4 * g4 + r - qpos; if (d > 128 || d < -128) x = -1e30f; } S[kb][r] = x; mx = fmaxf(mx, x); }
                    mx = rows_max(mx);
                    const float mnew = fmaxf(mrun[qg], mx), alpha = fast_exp2(mrun[qg] - mnew);
                    float rs = 0.f;
#pragma unroll
                    for (int kb = 0; kb < 2; ++kb)
#pragma unroll
                        for (int r = 0; r < 4; ++r) { const float p = fast_exp2(S[kb][r] - mnew); S[kb][r] = p; rs += p; }
                    rs = rows_sum(rs);
                    lrun[qg] = lrun[qg] * alpha + rs; mrun[qg] = mnew;
                    u32x4 pw; pw.x = cvt_pk_bf16(S[0][0], S[0][1]); pw.y = cvt_pk_bf16(S[0][2], S[0][3]); pw.z = cvt_pk_bf16(S[1][0], S[1][1]); pw.w = cvt_pk_bf16(S[1][2], S[1][3]);
                    const bf16x8 Pf = __builtin_bit_cast(bf16x8, pw);
#pragma unroll
                    for (int db = 0; db < 4; ++db) { Oa[qg][db] = Oa[qg][db] * alpha; Oa[qg][db] = __builtin_amdgcn_mfma_f32_16x16x32_bf16(Vf[db], Pf, Oa[qg][db], 0, 0, 0); }
                }
            }
            if (t + 1 < ntile) { LAS unsigned char* nb = lds + ((t + 1) & 1) * ATT_TILE_BYTES;
                *(LAS u32x4*)(nb + lrow * ATT_LDK + lchunk * 16) = rk; *(LAS u32x4*)(nb + 64 * ATT_LDK + lrow * ATT_LDK + lchunk * 16) = rv; }
            __syncthreads();
        }
#pragma unroll
        for (int qg = 0; qg < 2; ++qg) { const float inv = 1.f / lrun[qg];
#pragma unroll
            for (int db = 0; db < 4; ++db) { const f32x4 o = Oa[qg][db] * inv; u32x2 w; w.x = cvt_pk_bf16(o[0], o[1]); w.y = cvt_pk_bf16(o[2], o[3]);
                *(u32x2*)(O + (size_t)(rowbase + q0 + 16 * qg + fr) * D + h * 64 + 16 * db + 4 * g4) = w; } }
    }
}

__device__ __forceinline__ void sgu_phase(Frame& F, const bf16_t* U, const bf16_t* V, const f32x2* STATS, const float* ln_g, const bf16_t* WSb, const float* b_s, bf16_t* UM) {
    constexpr int LDT = 136;
    LAS bf16_t* LT = (LAS bf16_t*)F.lds;
    LAS f32x2* ST = (LAS f32x2*)(F.lds + 128 * LDT * 2);
    const int fr = F.lane & 15, g4 = F.lane >> 4;
    for (int it = F.blk; it < 768; it += F.G) {
        const int ch = it >> 3, g = it & 7, r0 = ch * 128;
        if (F.tid < 128) { const f32x2* sp = STATS + (size_t)(r0 + F.tid) * 16; float s1 = 0.f, s2 = 0.f;
#pragma unroll
            for (int k = 0; k < 16; ++k) { const f32x2 p = sp[k]; s1 += p.x; s2 += p.y; }
            const float mu = s1 * (1.f / D), var = s2 * (1.f / D) - mu * mu; ST[F.tid] = (f32x2){mu, rsqrtf(fmaxf(var, 0.f) + EPS)}; }
        __syncthreads();
#pragma unroll
        for (int i = 0; i < 4; ++i) { const int q = F.tid + 512 * i, r = q & 127, c8 = (q >> 7) * 8;
            const u32x4 raw = *(const u32x4*)(V + (size_t)(r0 + r) * D + g * 128 + c8); const f32x2 st = ST[r];
            const f32x4 ga = *(const f32x4*)(ln_g + g * 128 + c8), gb = *(const f32x4*)(ln_g + g * 128 + c8 + 4);
            const unsigned rw[4] = {raw.x, raw.y, raw.z, raw.w};
#pragma unroll
            for (int e = 0; e < 8; ++e) { const float x = bf2f((unsigned short)(e & 1 ? rw[e >> 1] >> 16 : rw[e >> 1] & 0xffff)); const float gg = e < 4 ? ga[e & 3] : gb[e & 3];
                LT[(c8 + e) * LDT + r] = (bf16_t)f2bf((x - st.x) * st.y * gg); } }
        __syncthreads();
        f32x4 acc[8];
#pragma unroll
        for (int cb = 0; cb < 8; ++cb) acc[cb] = (f32x4){0.f, 0.f, 0.f, 0.f};
        const int p = 16 * F.wave + fr;
#pragma unroll
        for (int ks = 0; ks < 4; ++ks) { const bf16x8 bw = *(const bf16x8*)(WSb + (size_t)(g * 128 + p) * 128 + 32 * ks + 8 * g4);
#pragma unroll
            for (int cb = 0; cb < 8; ++cb) { const bf16x8 av = *(const LAS bf16x8*)(LT + (16 * cb + fr) * LDT + 32 * ks + 8 * g4); acc[cb] = __builtin_amdgcn_mfma_f32_16x16x32_bf16(av, bw, acc[cb], 0, 0, 0); } }
        const float bsv = b_s[g * 128 + p];
#pragma unroll
        for (int cb = 0; cb < 8; ++cb) { const size_t off = (size_t)(r0 + p) * D + g * 128 + 16 * cb + 4 * g4; const u32x2 uw = *(const u32x2*)(U + off);
            const float u0 = bf2f((unsigned short)(uw.x & 0xffff)), u1 = bf2f((unsigned short)(uw.x >> 16)), u2 = bf2f((unsigned short)(uw.y & 0xffff)), u3 = bf2f((unsigned short)(uw.y >> 16));
            u32x2 w; w.x = cvt_pk_bf16(u0 * (acc[cb][0] + bsv), u1 * (acc[cb][1] + bsv)); w.y = cvt_pk_bf16(u2 * (acc[cb][2] + bsv), u3 * (acc[cb][3] + bsv)); *(u32x2*)(UM + off) = w; }
        __syncthreads();
    }
}

struct Args { const float* in[26]; float* out; unsigned char* ws; int ph_lo, ph_hi; };
__global__ void __launch_bounds__(NWAVES * 64, 2) mk_fwd(const Args args) {
    extern __shared__ __attribute__((aligned(16))) unsigned char lds_raw[];
    Frame F;
    F.lds = (LAS unsigned char*)lds_raw;
    const int wave0 = __builtin_amdgcn_readfirstlane((int)threadIdx.x >> 6);
    F.wave = wave0; F.lane = pg8::lane_id(); F.tid = wave0 * 64 + F.lane;
    const int grid0 = gridDim.x, blk0 = blockIdx.x; F.G = grid0; F.blk = blk0;
    F.in = (const __attribute__((address_space(4))) cfp_t*)__builtin_amdgcn_kernarg_segment_ptr();
    F.out = args.out; F.ws = args.ws;
    unsigned char* ws = args.ws;
    volatile LAS unsigned* MISC = (volatile LAS unsigned*)(F.lds + MISC_OFF);
    if (F.tid < 32) MISC[F.tid] = 0u;
    __syncthreads();
    const int lo = args.ph_lo, hi = args.ph_hi;
    XcdBarrier bar; bar.bar = (unsigned*)(ws + WS_CTL); bar.x = 0; bar.st = nullptr;
    if (hi - lo > 1) bar = xcd_barrier_post((unsigned*)(ws + WS_CTL), MISC + 8, F.tid == 0);
    LAS float* XCH = (LAS float*)(F.lds + XCH_OFF);
#define CASE_BEGIN() { int b_ = blk0, w_ = wave0, g_ = grid0; asm volatile("" : "+s"(b_), "+s"(w_), "+s"(g_)); F.blk = b_; F.wave = w_; F.G = g_; } frame_refresh(F); unsigned long long ws_ = (unsigned long long)args.ws, in_ = (unsigned long long)__builtin_amdgcn_kernarg_segment_ptr(); asm volatile("" : "+s"(ws_), "+s"(in_)); \
        unsigned char* ws = (unsigned char*)(GAS unsigned char*)ws_; F.ws = ws; F.in = (const __attribute__((address_space(4))) cfp_t*)in_; \
        float* X = (float*)(ws + WS_X); bf16_t* H = (bf16_t*)(ws + WS_H); bf16_t* H2 = (bf16_t*)(ws + WS_H2); bf16_t* HN = (bf16_t*)(ws + WS_HN); (void)HN; \
        const float* modl = (const float*)(ws + WS_MOD) + l * 3 * 6 * D; const float* xs0 = l == 0 ? ((const float*)F.in[0]) : X; const float* xs1 = l == 0 ? ((const float*)F.in[1]) : X + (size_t)MP * D; \
        (void)X; (void)H; (void)H2; (void)modl; (void)xs0; (void)xs1
#pragma unroll 1
    for (int ph = lo; ph < hi; ++ph) {
        int l = 0, kind;
        if (ph == 0) kind = 0; else if (ph == 1) kind = 1;
        else { l = ph < 7 ? 0 : ph < 12 ? 1 : ph < 16 ? 2 : 3; const int j = ph - (l == 0 ? 2 : l == 1 ? 7 : l == 2 ? 12 : 16), n = l == 2 ? 1 : 2;
            kind = j < n ? (l == 0 ? 2 + j : l == 1 ? 4 + j : l == 2 ? 6 : 7 + j) : j == n ? 9 : j == n + 1 ? 10 : 11; }
        const int reps = (kind == MK_REP_KIND) ? 1 + MK_REP_N : 1;
#pragma unroll 1
        for (int rep = 0; rep < reps; ++rep) {
        if (rep > 0) xcd_barrier(bar, wave0 == 0 && pg8::lane_id() == 0);
        switch (kind) {
        case 0: if (EN(0)) { CASE_BEGIN(); p0_prologue(F); } break;
        case 1: if (EN(1)) { CASE_BEGIN(); norm_phase(F, xs0, xs1, ((const float*)F.in[8]), modl, 0, HN); } break;
        case 2: if (EN(2)) { CASE_BEGIN(); Order<48, 6, 0, D, D> S; S.init(F.G, F.blk, HN, ws + WS_WQKV);
                EpiQKV E{{ws, l, 0}};
                pg8::gemm_phase<D, D, D / 64>(F.lds, S, E, F.wave);
                if (rep == 0 && F.blk >= 32) convert_layer(F, 1, 32, F.G - 32); } break;
        case 3: if (EN(3)) { CASE_BEGIN(); attn_phase(F, (const bf16_t*)(ws + WS_Q), (const bf16_t*)(ws + WS_KB), (const bf16_t*)(ws + WS_VT), (const bf16_t*)(ws + WS_CK), (const bf16_t*)(ws + WS_CVT), ((const float*)F.in[13]), H); } break;
        case 4: if (EN(4)) { CASE_BEGIN(); Order<48, 8, 0, D, D> S; S.init(F.G, F.blk, HN, ws + WS_WSGI);
                EpiSgu E{{ws, l, 0}};
                pg8::gemm_phase<D, D, D / 64>(F.lds, S, E, F.wave);
                if (rep == 0 && F.blk >= 128) convert_layer(F, 2, 128, F.G - 128); } break;
        case 5: if (EN(5)) { CASE_BEGIN(); sgu_phase(F, (const bf16_t*)(ws + WS_U), (const bf16_t*)(ws + WS_V), (const f32x2*)(ws + WS_STATS), ((const float*)F.in[15]), (const bf16_t*)(ws + WS_WS), ((const float*)F.in[17]), H); } break;
        case 6: if (EN(6)) { CASE_BEGIN(); OrderSc S{F.blk, (const char*)HN, (const char*)(ws + WS_WSCI)};
                EpiSc E{{ws, l, F.blk}};
                pg8::gemm_phase<D, D, D / 64>(F.lds, S, E, F.wave);
                if (rep == 0 && F.blk >= 200) convert_layer(F, 3, 200, F.G - 200); } break;
        case 7: if (EN(7)) { CASE_BEGIN(); OrderFn1 S{F.G, F.blk, (const char*)(ws + WS_A1), (const char*)HN};
                EpiFn1 E{{ws, l, 0}};
                pg8::gemm_phase<256, D, 4>(F.lds, S, E, F.wave); } break;
        case 8: if (EN(8)) { CASE_BEGIN(); EpiBf16 E{{ws, l, 0}};
                if (F.blk < 64) { OrderFn2 S{F.blk, 1, (const char*)(ws + WS_A2S), (const char*)(ws + WS_YT)}; pg8::gemm_phase<2 * TS, 2 * TS, 2 * TS / 64>(F.lds, S, E, F.wave); }
                else { OrderFn2 S{F.blk, 0, (const char*)(ws + WS_A2P), (const char*)(ws + WS_YT)}; pg8::gemm_phase<2 * TP, 2 * TP, 2 * TP / 64>(F.lds, S, E, F.wave); } } break;
        case 9: if (EN(9)) { CASE_BEGIN(); const bf16_t* mix_in = l == 2 ? H2 : H;
                const bf16_t* wout = (const bf16_t*)(ws + (l == 0 ? WS_WO : l == 1 ? WS_WSGO : l == 2 ? WS_WSCO : WS_WFNO));
                Order<48, 4, 0, D, D> S; S.init(F.G, F.blk, mix_in, wout);
                EpiResNorm<false> E{{ws, l, rep ? 2 : 0}};
                pg8::gemm_phase<D, D, D / 64>(F.lds, S, E, F.wave); } break;
        case 10: if (EN(11)) { CASE_BEGIN(); Order<50, 22, 1, D, D> S; S.init(F.G, F.blk, HN, ws + WS_WUP + l * WUP_BYTES);
                EpiUp E{{ws, l, 0}};
                pg8::gemm_phase<D, D, D / 64>(F.lds, S, E, F.wave); } break;
        default: if (EN(12)) { CASE_BEGIN(); Order<48, 4, 0, DFF, DFF> S; S.init(F.G, F.blk, ws + WS_ACT, ws + WS_WDN + l * WDN_BYTES);
                if (l < 3) { EpiResNorm<false> E{{ws, l, 1 | (rep ? 2 : 0)}}; pg8::gemm_phase<DFF, DFF, DFF / 64>(F.lds, S, E, F.wave); }
                else { EpiResNorm<true> E{{ws, l, 1 | (rep ? 2 : 0)}}; pg8::gemm_phase<DFF, DFF, DFF / 64>(F.lds, S, E, F.wave); } } break;
        }
        }
        if (ph + 1 < hi) xcd_barrier(bar, wave0 == 0 && pg8::lane_id() == 0);
    }
}

extern "C" void kernel_launch(void* const* d_in, const int* in_sizes, int n_in, void* d_out, int out_size, void* d_ws, size_t ws_size, hipStream_t stream) {
    static int grid = 0;
    if (grid == 0) {
        if (n_in != 26 || ws_size < WS_TOTAL + (MK_REP_N ? (size_t)73 * MiB : 0)) { fprintf(stderr, "kernel_launch: unexpected n_in %d / ws %zu (need %zu)\n", n_in, ws_size, (size_t)WS_TOTAL); grid = -1; return; }
        int dev = 0, cus = 0;
        if (hipGetDevice(&dev) != hipSuccess || hipDeviceGetAttribute(&cus, hipDeviceAttributeMultiprocessorCount, dev) != hipSuccess) { grid = -1; return; }
        if (hipFuncSetAttribute((const void*)mk_fwd, hipFuncAttributeMaxDynamicSharedMemorySize, LDS_BYTES) != hipSuccess) { fprintf(stderr, "kernel_launch: hipFuncSetAttribute failed\n"); grid = -1; return; }
        (void)hipGetLastError();
        grid = cus;
    }
    if (grid < 0) return;
    (void)hipMemsetAsync((char*)d_ws + WS_CTL, 0, CTL_ZERO_BYTES, stream);
    Args a{};
    for (int i = 0; i < 26; ++i) a.in[i] = (const float*)d_in[i];
    a.out = (float*)d_out; a.ws = (unsigned char*)d_ws;
#if MK_PER_PHASE
    for (int p = MK_PH_LO; p < MK_PH_HI; ++p) { a.ph_lo = p; a.ph_hi = p + 1; hipLaunchKernelGGL(mk_fwd, dim3(grid), dim3(NWAVES * 64), LDS_BYTES, stream, a); }
#else
    a.ph_lo = MK_PH_LO; a.ph_hi = MK_PH_HI;
    hipLaunchKernelGGL(mk_fwd, dim3(grid), dim3(NWAVES * 64), LDS_BYTES, stream, a);
#endif
}
```

```cpp
#include <hip/hip_runtime.h>
#include <cstdio>

#define LAS __attribute__((address_space(3)))
#define GAS __attribute__((address_space(1)))
typedef unsigned short bf16_t;
typedef short bf16x8 __attribute__((ext_vector_type(8)));
typedef float f32x4 __attribute__((ext_vector_type(4)));
typedef float f32x2 __attribute__((ext_vector_type(2)));
typedef unsigned u32x4 __attribute__((ext_vector_type(4)));
typedef unsigned u32x2 __attribute__((ext_vector_type(2)));

constexpr int D = 1024, MP = 8192, MS = 4096, M = MP + MS, DFF = 2816, TS = 2048, TP = 256;
constexpr float EPS = 1e-6f;
constexpr int NWAVES = 8;
#ifndef MK_PER_PHASE
#define MK_PER_PHASE 0
#endif
#ifndef MK_PH_LO
#define MK_PH_LO 0
#endif
#ifndef MK_PH_HI
#define MK_PH_HI 21
#endif
#ifndef MK_MASK
#define MK_MASK 0xffffffffu
#endif
#define EN(b) (((MK_MASK) >> (b)) & 1u)
#ifndef MK_REP_KIND
#define MK_REP_KIND -1
#endif
#ifndef MK_REP_N
#define MK_REP_N 0
#endif
#ifndef MK_REP_NULL
#define MK_REP_NULL 0
#endif
#ifndef MK_REP_SHORTK
#define MK_REP_SHORTK 0
#endif
#ifndef MK_PREFETCH
#define MK_PREFETCH 1
#endif
#ifndef MK_TP
#define MK_TP 0
#endif
#ifndef MK_TP_PH
#define MK_TP_PH 10
#endif

namespace pg8 {
constexpr int BM = 256, BK = 64, HALF = 128, HTB = HALF * BK * 2, STAGE_BYTES = 8 * HTB, NXCD = 8, WGM = 8;
__host__ __device__ __forceinline__ int lds_byte(int r, int c) { const int st = (r >> 4) * 2 + (c >> 5), rr = r & 15, cc = c & 31, ob = rr * 64 + cc * 2; return st * 1024 + (ob ^ (((ob >> 9) & 1) << 5)); }
__host__ __device__ __forceinline__ void stage_rc(int b, int& R, int& C) { const int st = b / 1024, sb = b % 1024, swz = sb ^ (((sb >> 9) & 1) << 5); R = (st >> 1) * 16 + swz / 64; C = (st & 1) * 32 + (swz % 64) / 2; }
__host__ __device__ __forceinline__ int perm32(int rho) { const int n = rho >> 4, i = rho & 15; return 8 * (i >> 2) + 4 * n + (i & 3); }

struct Unit { int pm, pn, row0; const char* a; const char* b; };
struct Cfg { int lda, ldb, nt; };

__device__ __forceinline__ int lane_id() { return (int)__builtin_amdgcn_mbcnt_hi(~0u, __builtin_amdgcn_mbcnt_lo(~0u, 0u)); }
__device__ __forceinline__ unsigned cvt_pk_bf16(float lo, float hi) { unsigned r; asm volatile("v_cvt_pk_bf16_f32 %0, %1, %2" : "=v"(r) : "v"(lo), "v"(hi)); return r; }

template <int LDA, int LDB, int NT, int ROWS = 256, class Epi, class Sched>
__device__ __forceinline__ void gemm_phase(LAS unsigned char* lds, const Sched& S, const Epi& E, int wid, bool tp_on = false) {
    constexpr Cfg g{LDA, LDB, NT};
    int lane_ = lane_id(); asm volatile("" : "+v"(lane_));
    const int lane = lane_, tid = wid * 64 + lane, wr = wid >> 2, wc = wid & 3, fr = lane & 15, fq = lane >> 4;
    const int nt = g.nt;
    unsigned voffA[2], voffB[2];
#pragma unroll
    for (int i = 0; i < 2; ++i) { int R, C; stage_rc(tid * 16 + i * 8192, R, C); const int Rb = Epi::PERM ? ((R & ~31) + perm32(R & 31)) : R;
        voffA[i] = (unsigned)(R * g.lda + C) * 2u; voffB[i] = (unsigned)(Rb * g.ldb + C) * 2u; }
    unsigned voffA1[2]; voffA1[0] = ROWS == 128 ? 0u : voffA[0]; voffA1[1] = ROWS == 256 ? voffA[1] : 0u;
    const size_t kstep = (size_t)(BK * 2);
    const size_t hstepA = (size_t)HALF * g.lda * 2, hstepB = (size_t)HALF * g.ldb * 2;
    const unsigned ldsw = (unsigned)wid * 1024u;
    constexpr int NM1 = ROWS == 192 ? 2 : ROWS == 128 ? 0 : 4;
    const int aoff = lds_byte(wr * 64 + fr, fq * 8), boff = lds_byte(wc * 32 + fr, fq * 8), aoff1 = ROWS == 192 ? lds_byte(wr * 32 + fr, fq * 8) : aoff;
#define PG8_SA(b, h) (((b) * 2 + (h)) * HTB)
#define PG8_SB(b, h) ((4 + (b) * 2 + (h)) * HTB)
#define PG8_STAGE(bufoff, gbase, voff) do { _Pragma("unroll") for (int _i = 0; _i < 2; ++_i) { unsigned _vo = (voff)[_i]; asm volatile("" : "+v"(_vo)); \
        __builtin_amdgcn_global_load_lds((const unsigned*)((const char*)(gbase) + _vo), (LAS unsigned*)(lds + (bufoff) + ldsw + _i * 8192), 16, 0, 0); } } while (0)
#define PG8_LDA(dst, b, h) do { _Pragma("unroll") for (int m = 0; m < 4; ++m) _Pragma("unroll") for (int k = 0; k < 2; ++k) dst[m][k] = *(const LAS bf16x8*)(lds + PG8_SA(b, h) + aoff + m * 2048 + k * 1024); } while (0)
#define PG8_LDA1(dst, b) do { _Pragma("unroll") for (int m = 0; m < NM1; ++m) _Pragma("unroll") for (int k = 0; k < 2; ++k) dst[m][k] = *(const LAS bf16x8*)(lds + PG8_SA(b, 1) + aoff1 + m * 2048 + k * 1024); } while (0)
#define PG8_LDB(dst, b, h) do { _Pragma("unroll") for (int n = 0; n < 2; ++n) _Pragma("unroll") for (int k = 0; k < 2; ++k) dst[n][k] = *(const LAS bf16x8*)(lds + PG8_SB(b, h) + boff + n * 2048 + k * 1024); } while (0)
#define PG8_MMA(ai, bj, At, Bt) do { __builtin_amdgcn_s_setprio(1); _Pragma("unroll") for (int m = 0; m < 4; ++m) _Pragma("unroll") for (int n = 0; n < 2; ++n) _Pragma("unroll") for (int k = 0; k < 2; ++k) \
        acc[ai][bj][m][n] = __builtin_amdgcn_mfma_f32_16x16x32_bf16(Bt[n][k], At[m][k], acc[ai][bj][m][n], 0, 0, 0); __builtin_amdgcn_s_setprio(0); } while (0)
#define PG8_MMA1(bj, At, Bt) do { __builtin_amdgcn_s_setprio(1); _Pragma("unroll") for (int m = 0; m < NM1; ++m) _Pragma("unroll") for (int n = 0; n < 2; ++n) _Pragma("unroll") for (int k = 0; k < 2; ++k) \
        acc[1][bj][m][n] = __builtin_amdgcn_mfma_f32_16x16x32_bf16(Bt[n][k], At[m][k], acc[1][bj][m][n], 0, 0, 0); __builtin_amdgcn_s_setprio(0); } while (0)
#define PG8_WAIT_V(n) asm volatile("s_waitcnt vmcnt(" #n ")" ::: "memory")
#define PG8_WAIT_L(n) asm volatile("s_waitcnt lgkmcnt(" #n ")" ::: "memory")
#define PG8_BAR __builtin_amdgcn_s_barrier()
#define PG8_SCHED __builtin_amdgcn_sched_barrier(0)
    Unit cur, nxt; int ui = 0;
    if (!S.next(0, cur)) return;
    f32x4 acc[2][2][4][2];
#pragma unroll
    for (int a = 0; a < 2; ++a)
#pragma unroll
        for (int b = 0; b < 2; ++b)
#pragma unroll
            for (int m = 0; m < 4; ++m)
#pragma unroll
                for (int n = 0; n < 2; ++n) acc[a][b][m][n] = (f32x4){0.f, 0.f, 0.f, 0.f};
    bf16x8 At[4][2], B0[2][2], B1[2][2];
    const char* cA = cur.a; const char* cB = cur.b;
    PG8_STAGE(PG8_SB(0, 0), cB, voffB); PG8_STAGE(PG8_SB(0, 1), cB + hstepB, voffB); PG8_STAGE(PG8_SA(0, 0), cA, voffA); PG8_STAGE(PG8_SA(0, 1), cA + hstepA, voffA1);
    if (wr == 1) PG8_BAR;
    PG8_WAIT_V(2); PG8_BAR;
    PG8_STAGE(PG8_SB(1, 0), cB + kstep, voffB); PG8_STAGE(PG8_SA(1, 0), cA + kstep, voffA); PG8_STAGE(PG8_SB(1, 1), cB + hstepB + kstep, voffB);
    PG8_WAIT_V(6); PG8_BAR;
    for (;;) {
        const bool has_next = S.next(ui + 1, nxt);
        const char* nA = has_next ? nxt.a : cA; const char* nB = has_next ? nxt.b : cB;
        for (int t = 0; t < nt; t += 2) {
            const bool last = (t == nt - 2);
            const char* a1 = cA + (size_t)(t + 1) * kstep;
            const char* a2 = last ? nA : cA + (size_t)(t + 2) * kstep; const char* b2 = last ? nB : cB + (size_t)(t + 2) * kstep;
            const char* a3 = a2 + kstep; const char* b3 = b2 + kstep;
            PG8_LDB(B0, 0, 0); PG8_LDB(B1, 0, 1); PG8_SCHED; PG8_LDA(At, 0, 0); PG8_STAGE(PG8_SA(1, 1), a1 + hstepA, voffA1);
            PG8_WAIT_V(8); PG8_WAIT_L(0); PG8_BAR; PG8_MMA(0, 0, At, B0); PG8_MMA(0, 1, At, B1); PG8_BAR; PG8_SCHED;
            PG8_LDA1(At, 0); PG8_STAGE(PG8_SB(0, 0), b2, voffB); PG8_STAGE(PG8_SB(0, 1), b2 + hstepB, voffB); PG8_STAGE(PG8_SA(0, 0), a2, voffA);
            PG8_WAIT_V(8); PG8_WAIT_L(0); PG8_BAR; PG8_MMA1(0, At, B0); PG8_MMA1(1, At, B1); PG8_BAR; PG8_SCHED;
            PG8_LDB(B0, 1, 0); PG8_LDB(B1, 1, 1); PG8_SCHED; PG8_LDA(At, 1, 0); PG8_STAGE(PG8_SA(0, 1), a2 + hstepA, voffA1);
            PG8_WAIT_V(8); PG8_WAIT_L(0); PG8_BAR; PG8_MMA(0, 0, At, B0); PG8_MMA(0, 1, At, B1); PG8_BAR; PG8_SCHED;
            PG8_LDA1(At, 1); PG8_STAGE(PG8_SB(1, 0), b3, voffB); PG8_STAGE(PG8_SB(1, 1), b3 + hstepB, voffB); PG8_STAGE(PG8_SA(1, 0), a3, voffA);
            PG8_WAIT_V(8); PG8_WAIT_L(0); PG8_BAR; PG8_MMA1(0, At, B0); PG8_MMA1(1, At, B1); PG8_BAR; PG8_SCHED;
        }
        if (wr == 0) PG8_BAR;
        if (MK_TP == 2) { const unsigned long long t0_ = __builtin_amdgcn_s_memrealtime(); E(acc, cur, wid, ui); const unsigned long long t1_ = __builtin_amdgcn_s_memrealtime();
            if (wid == 0 && lane == 0 && tp_on) *(volatile LAS unsigned*)(lds + 131072 + 8192 + 320 + 4 * 16) += (unsigned)(t1_ - t0_); }
        else E(acc, cur, wid, ui);
        if (!has_next) break;
#pragma unroll
        for (int a = 0; a < 2; ++a)
#pragma unroll
            for (int b = 0; b < 2; ++b)
#pragma unroll
                for (int m = 0; m < 4; ++m)
#pragma unroll
                    for (int n = 0; n < 2; ++n) acc[a][b][m][n] = (f32x4){0.f, 0.f, 0.f, 0.f};
        cur = nxt; cA = nA; cB = nB; ++ui;
        if (wr == 1) PG8_BAR;
    }
    PG8_WAIT_V(0);
    PG8_BAR;
#undef PG8_SA
#undef PG8_SB
#undef PG8_STAGE
#undef PG8_LDA
#undef PG8_LDA1
#undef PG8_MMA1
#undef PG8_LDB
#undef PG8_MMA
#undef PG8_WAIT_V
#undef PG8_WAIT_L
#undef PG8_BAR
#undef PG8_SCHED
}
}
using pg8::Unit; using pg8::cvt_pk_bf16;

constexpr size_t MiB = 1u << 20;
constexpr size_t WS_CTL = 0, CTL_ZERO_BYTES = 128 * 1024;
constexpr size_t WS_MOD = 1 * MiB;
constexpr size_t WS_ROPE = WS_MOD + 512 * 1024;
constexpr size_t WS_STATS = WS_ROPE + 64 * 1024;
constexpr size_t WS_WQKV = 4 * MiB;
constexpr size_t WS_WO = WS_WQKV + 3 * MiB;
constexpr size_t WS_WSGI = WS_WO + 2 * MiB;
constexpr size_t WS_WSGO = WS_WSGI + 4 * MiB;
constexpr size_t WS_WSCI = WS_WSGO + 2 * MiB;
constexpr size_t WS_WSCO = WS_WSCI + 6 * MiB;
constexpr size_t WS_WFNO = WS_WSCO + 2 * MiB;
constexpr size_t WS_WUP = WS_WFNO + 2 * MiB;
constexpr size_t WUP_BYTES = (size_t)2 * DFF * D * 2;
constexpr size_t WS_WDN = WS_WUP + 4 * WUP_BYTES;
constexpr size_t WDN_BYTES = (size_t)D * DFF * 2;
constexpr size_t WS_WS = WS_WDN + 4 * WDN_BYTES;
constexpr size_t WS_A1 = WS_WS + 256 * 1024;
constexpr size_t WS_A2P = WS_A1 + 256 * 1024;
constexpr size_t WS_A2S = WS_A2P + 256 * 1024;
constexpr size_t WS_CK = WS_A2S + 16 * MiB;
constexpr size_t WS_CVT = WS_CK + 512 * 1024;
constexpr size_t WS_X = WS_CVT + 512 * 1024;
constexpr size_t WS_H = WS_X + (size_t)M * D * 4;
constexpr size_t WS_BIG = WS_H + (size_t)(M + 256) * D * 2;
constexpr size_t WS_END = WS_BIG + 72 * MiB;
constexpr size_t WS_ACT = WS_BIG;
constexpr size_t WS_Q = WS_BIG;
constexpr size_t WS_KB = WS_Q + 24 * MiB;
constexpr size_t WS_VT = WS_KB + 6 * MiB;
constexpr size_t WS_U = WS_BIG;
constexpr size_t WS_V = WS_BIG + 24 * MiB;
constexpr size_t WS_YB = WS_BIG;
constexpr size_t WS_YT = WS_BIG;
static_assert(WS_YB + (size_t)256 * 2 * 16 * 512 * 16 <= WS_END, "yb");
static_assert(WS_ACT + (size_t)M * DFF * 2 <= WS_END, "act");
constexpr size_t WS_H2 = WS_END;
constexpr size_t WS_HN = WS_H2 + (size_t)M * D * 2;
constexpr size_t WS_XS = WS_HN + (size_t)(M + 256) * D * 2;
constexpr size_t WS_TOTAL = WS_XS + (size_t)16 * M * 4 * 4;
constexpr size_t CTL_CNT = 16384;
constexpr size_t CTL_TMO = CTL_CNT + 16 * 64 * 64;

constexpr size_t OUT_NK = (size_t)M * D, OUT_NV = OUT_NK + (size_t)MP * 256;

#define XB_TMO      128
#define XB_XCNT(j)  (256  + 64 * (j))
#define XB_XSUB(j)  (1280 + 64 * (j))
#define XB_XGEN(j)  (2304 + 64 * (j))
#define XB_TOP      3328
#define XB_TOPGEN   3392
#define XCD_BAR_WORDS 3456
#define XB_SPIN_CAP (1u << 22)
__device__ __forceinline__ unsigned xb_ld(unsigned* p)              { return __hip_atomic_load(p, __ATOMIC_RELAXED, __HIP_MEMORY_SCOPE_AGENT); }
__device__ __forceinline__ unsigned xb_add(unsigned* p, unsigned v) { return __hip_atomic_fetch_add(p, v, __ATOMIC_RELAXED, __HIP_MEMORY_SCOPE_AGENT); }
__device__ __forceinline__ unsigned xb_xcc_id() { return (unsigned)__builtin_amdgcn_s_getreg((3 << 11) | 20) & 0xFu; }
#define XB_SPIN(cond, bar) do { unsigned _sp = 0; while (cond) { __builtin_amdgcn_s_sleep(1); \
    if ((++_sp & 255u) == 0u) { if (xb_ld(&(bar)[XB_TMO])) break; if (_sp > XB_SPIN_CAP) { atomicAdd(&(bar)[XB_TMO], 1u); break; } } } } while (0)
struct XcdBarrier { unsigned* bar; unsigned x; volatile LAS unsigned* st; };
__device__ __forceinline__ XcdBarrier xcd_barrier_post(unsigned* bar, volatile LAS unsigned* st, bool leader) {
    XcdBarrier b; b.bar = bar; b.x = xb_xcc_id(); b.st = st;
    if (leader) (void)xb_add(&bar[XB_XCNT(b.x)], 1u);
    return b;
}
__device__ __forceinline__ void xcd_barrier_complete(unsigned* bar, unsigned x, unsigned& nloc, unsigned& nx) {
    const unsigned G = gridDim.x * gridDim.y * gridDim.z;
    unsigned sum, cnt, mine, sp = 0u;
    for (;;) {
        sum = 0u; cnt = 0u; mine = 0u;
#pragma unroll
        for (unsigned j = 0; j < 16; ++j) { const unsigned c = xb_ld(&bar[XB_XCNT(j)]); sum += c; cnt += (c > 0u) ? 1u : 0u; }
        mine = xb_ld(&bar[XB_XCNT(x)]);
        if (sum == G) break;
        __builtin_amdgcn_s_sleep(1);
        if ((++sp & 255u) == 0u) { if (xb_ld(&bar[XB_TMO])) break; if (sp > XB_SPIN_CAP) { atomicAdd(&bar[XB_TMO], 1u); break; } }
    }
    nloc = mine > 0u ? mine : 1u; nx = cnt > 0u ? cnt : 1u;
}
__device__ __forceinline__ void xcd_barrier(const XcdBarrier& b, bool leader) {
    asm volatile("s_waitcnt vmcnt(0)" ::: "memory");
    __syncthreads();
    if (leader) {
        unsigned* bar = b.bar; unsigned bx = b.x; asm volatile("" : "+s"(bx));
        __builtin_amdgcn_s_waitcnt(0);
        unsigned nloc = b.st[0], nx = b.st[1];
        if (nloc == 0u) { xcd_barrier_complete(bar, bx, nloc, nx); b.st[0] = nloc; b.st[1] = nx; }
        const unsigned old = xb_add(&bar[XB_XSUB(bx)], 1u);
        const unsigned gen = old / nloc;
        if (old + 1u == (gen + 1u) * nloc) {
            __builtin_amdgcn_fence(__ATOMIC_RELEASE, "agent");
            asm volatile("s_waitcnt vmcnt(0)" ::: "memory");
            const unsigned og = xb_add(&bar[XB_TOP], 1u);
            const unsigned tg = og / nx;
            if (og + 1u == (tg + 1u) * nx) xb_add(&bar[XB_TOPGEN], 1u);
            else XB_SPIN(xb_ld(&bar[XB_TOPGEN]) == tg, bar);
            __builtin_amdgcn_fence(__ATOMIC_ACQUIRE, "agent");
            xb_add(&bar[XB_XGEN(bx)], 1u);
            asm volatile("s_waitcnt vmcnt(0)" ::: "memory");
        } else {
            XB_SPIN(xb_ld(&bar[XB_XGEN(bx)]) == gen, bar);
            __builtin_amdgcn_fence(__ATOMIC_ACQUIRE, "agent");
            asm volatile("s_waitcnt vmcnt(0)" ::: "memory");
        }
    }
    __syncthreads();
}

#define LDS_WAIT() asm volatile("s_waitcnt lgkmcnt(0)" ::: "memory")
__device__ __forceinline__ unsigned f2bf(float f) { unsigned u = __builtin_bit_cast(unsigned, f); return (u + 0x7fffu + ((u >> 16) & 1u)) >> 16; }
__device__ __forceinline__ unsigned pk2(float lo, float hi) { return f2bf(lo) | (f2bf(hi) << 16); }
__device__ __forceinline__ float bf2f(unsigned short b) { return __builtin_bit_cast(float, (unsigned)b << 16); }
__device__ __forceinline__ float rows_max(float x) {
    auto s = __builtin_amdgcn_permlane16_swap(__float_as_uint(x), __float_as_uint(x), false, false); x = fmaxf(__uint_as_float(s[0]), __uint_as_float(s[1]));
    auto t = __builtin_amdgcn_permlane32_swap(__float_as_uint(x), __float_as_uint(x), false, false); return fmaxf(__uint_as_float(t[0]), __uint_as_float(t[1])); }
__device__ __forceinline__ float rows_sum(float x) {
    auto s = __builtin_amdgcn_permlane16_swap(__float_as_uint(x), __float_as_uint(x), false, false); x = __uint_as_float(s[0]) + __uint_as_float(s[1]);
    auto t = __builtin_amdgcn_permlane32_swap(__float_as_uint(x), __float_as_uint(x), false, false); return __uint_as_float(t[0]) + __uint_as_float(t[1]); }
template <int CTRL> __device__ __forceinline__ float dppx(float v) { return __builtin_bit_cast(float, __builtin_amdgcn_mov_dpp(__builtin_bit_cast(int, v), CTRL, 0xf, 0xf, true)); }
__device__ __forceinline__ float wave_sum(float v) {
    v += dppx<0xB1>(v);
    v += dppx<0x4E>(v);
    v += dppx<0x141>(v);
    v += dppx<0x140>(v);
    return rows_sum(v);
}
__device__ __forceinline__ float fast_exp2(float x) { return __builtin_amdgcn_exp2f(x); }
__device__ __forceinline__ float fast_rcp(float x) { return __builtin_amdgcn_rcpf(x); }
__device__ __forceinline__ float silu_f(float x) { return x * fast_rcp(1.f + fast_exp2(-1.4426950408889634f * x)); }
__device__ __forceinline__ float gelu_f(float x) { const float u = x * (1.f + 0.044715f * x * x); return x * fast_rcp(1.f + fast_exp2(-2.302208198f * u)); }
__device__ __forceinline__ int conv_row0(int pm) { if (pm < 32) return 256 * pm; const int s = (pm - 32) / 9, i = (pm - 32) % 9; return MP + TS * s + 254 * i - 1; }
template <int CTRL> __device__ __forceinline__ float dpp(float v) { return __builtin_bit_cast(float, __builtin_amdgcn_mov_dpp(__builtin_bit_cast(int, v), CTRL, 0xf, 0xf, true)); }
template <int CTRL> __device__ __forceinline__ f32x4 dpp4(f32x4 v) { return (f32x4){dpp<CTRL>(v[0]), dpp<CTRL>(v[1]), dpp<CTRL>(v[2]), dpp<CTRL>(v[3])}; }
#define DPP_ROR1 0x121
#define DPP_ROR15 0x12F

template <int NM, int NN, int CONV, int LDA, int LDB, int ROWS = 256>
struct Order {
    int G, c; const char* A; const char* B;
    __device__ __forceinline__ void init(int G_, int c_, const void* A_, const void* B_) { G = G_; c = c_; A = (const char*)A_; B = (const char*)B_; }
    __device__ __forceinline__ bool next(int i, Unit& u) const {
        constexpr int nwg = NM * NN;
        const int L = i * G + c; if (L >= nwg) return false;
        int wgid = L; { constexpr int q = nwg / pg8::NXCD, r = nwg % pg8::NXCD; const int xcd = wgid % pg8::NXCD, off = wgid / pg8::NXCD; wgid = (xcd < r ? xcd * (q + 1) : r * (q + 1) + (xcd - r) * q) + off; }
        constexpr int nig = pg8::WGM * NN; const int gid = wgid / nig, fm = gid * pg8::WGM, gsz = (NM - fm) < pg8::WGM ? (NM - fm) : pg8::WGM;
        u.pm = fm + ((wgid % nig) % gsz); u.pn = (wgid % nig) / gsz;
        u.row0 = CONV ? conv_row0(u.pm) : ROWS * u.pm;
        u.a = A + (long)u.row0 * (long)(LDA * 2); u.b = B + (size_t)u.pn * (size_t)(256 * LDB * 2); return true;
    }
};

typedef const GAS float* cfp_t;
struct Frame {
    LAS unsigned char* lds; int tid, lane, wave, G, blk;
    const __attribute__((address_space(4))) cfp_t* in; float* out; unsigned char* ws;
};
__device__ __forceinline__ void frame_refresh(Frame& F) {
    int ln = pg8::lane_id(); asm volatile("" : "+v"(ln)); F.lane = ln; F.tid = F.wave * 64 + ln;
}
constexpr int RING_BYTES = 131072, XCH_OFF = RING_BYTES  , MISC_OFF = XCH_OFF + 8192 + 320, LDS_BYTES = 147456;
__device__ __forceinline__ int vec_plain(int pm) { return pm < 32 ? 0 : 1 + (pm - 32) / 8; }
__device__ __forceinline__ int vec_conv(int pm) { return pm < 32 ? 0 : 1 + (pm - 32) / 9; }

__device__ __forceinline__ constexpr int r192_nm(int ai) { return ai ? 2 : 4; }
__device__ __forceinline__ int r192_base(int ai, int wr) { return ai ? 128 + 32 * wr : 64 * wr; }
struct EpiBase {
    unsigned char* ws_; int l, aux;
    __device__ __forceinline__ unsigned char* wsp() const { unsigned long long w = (unsigned long long)ws_; asm volatile("" : "+s"(w)); return (unsigned char*)(GAS unsigned char*)w; }
    __device__ __forceinline__ static const __attribute__((address_space(4))) cfp_t* kargs() { unsigned long long kp = (unsigned long long)__builtin_amdgcn_kernarg_segment_ptr(); asm volatile("" : "+s"(kp)); return (const __attribute__((address_space(4))) cfp_t*)kp; }
    __device__ __forceinline__ static const float* inp(const __attribute__((address_space(4))) cfp_t* ka, int k) { return (const float*)ka[k]; }
    __device__ __forceinline__ static float* outp(const __attribute__((address_space(4))) cfp_t* ka) { return (float*)(GAS float*)ka[26]; }
    __device__ __forceinline__ static LAS float* xch() { extern __shared__ __attribute__((aligned(16))) unsigned char lds_base_[]; return (LAS float*)((LAS unsigned char*)lds_base_ + XCH_OFF); }
};
template <bool FINAL>
struct EpiResNorm : EpiBase {
    static constexpr bool PERM = false;
    static constexpr int TR = 192;
    __device__ __forceinline__ static int nm(int ai) { return ai ? 2 : 4; }
    __device__ __forceinline__ static int rbase(int ai, int wr) { return ai ? 128 + 32 * wr : 64 * wr; }
    __device__ __forceinline__ void operator()(f32x4 (&acc)[2][2][4][2], const Unit& u, int wid, int ) const {
        int lane_ = pg8::lane_id(); asm volatile("" : "+v"(lane_));
        const int lane = lane_, wr = wid >> 2, wc = wid & 3, fr = lane & 15, fq = lane >> 4;
        unsigned char* ws = wsp(); const auto ka = kargs();
        const int isdn = aux & 1, rep = (aux >> 1) & 1, inst = 2 * l + isdn + 8 * rep;
        typedef _Float16 h4 __attribute__((ext_vector_type(4)));
        _Float16* Xr = (_Float16*)(ws + WS_X); _Float16* X = rep ? (_Float16*)(ws + WS_TOTAL) : Xr;
        const bool srcf32 = (!isdn && l == 0);
        const float* modl = (const float*)(ws + WS_MOD) + l * 3 * 6 * D; const int gate_idx = isdn ? 5 : 2;
        const float* gn = FINAL ? inp(ka, 10) : (isdn ? inp(ka, 8) + (l + 1) * D : inp(ka, 9) + l * D);
        const float* modn = isdn ? modl + 3 * 6 * D : modl; const int sh_idx = isdn ? 0 : 3;
        bf16_t* HN = (bf16_t*)(ws + (rep ? WS_TOTAL + 48 * MiB : WS_HN)); float* Y = rep ? (float*)(ws + WS_TOTAL) : outp(ka);
        float* xs = (float*)(ws + WS_XS) + (size_t)inst * M * 4; unsigned* cnt = (unsigned*)(ws + WS_CTL + CTL_CNT) + inst * 64 * 16; unsigned* tmo = (unsigned*)(ws + WS_CTL + CTL_TMO);
        LAS float* L = xch();
        const int col0 = u.pn * 256 + wc * 32 + 4 * fq, tid = wid * 64 + lane;
        LAS float* P = L;
        LAS float* S = L + 1024;
#pragma unroll
        for (int ai = 0; ai < 2; ++ai) {
            const int rb = u.row0 + rbase(ai, wr);
            const int vec = rb < MP ? 0 : 1 + (rb - MP) / TS;
            const float* gate = modl + vec * 6 * D + gate_idx * D;
            const float* src = rb < MP ? inp(ka, 0) + (size_t)rb * D : inp(ka, 1) + (size_t)(rb - MP) * D;
            f32x4 gv[2][2];
#pragma unroll
            for (int bj = 0; bj < 2; ++bj)
#pragma unroll
                for (int n = 0; n < 2; ++n) gv[bj][n] = *(const f32x4*)(gate + col0 + bj * 128 + n * 16);
            f32x4 sv[4][2][2];
#pragma unroll
            for (int m = 0; m < 4; ++m) if (m < nm(ai)) { const size_t ro = (size_t)(16 * m + fr) * D + col0;
#pragma unroll
                for (int bj = 0; bj < 2; ++bj)
#pragma unroll
                    for (int n = 0; n < 2; ++n) { if (srcf32) sv[m][bj][n] = *(const f32x4*)(src + ro + bj * 128 + n * 16);
                        else sv[m][bj][n] = __builtin_convertvector(*(const h4*)(Xr + (size_t)rb * D + ro + bj * 128 + n * 16), f32x4); } }
#pragma unroll
            for (int m = 0; m < 4; ++m) if (m < nm(ai)) { const int r = rbase(ai, wr) + 16 * m + fr; float ss = 0.f;
#pragma unroll
                for (int bj = 0; bj < 2; ++bj)
#pragma unroll
                    for (int n = 0; n < 2; ++n) { const f32x4 x1 = sv[m][bj][n] + gv[bj][n] * acc[ai][bj][m][n]; acc[ai][bj][m][n] = x1;
                        ss += (x1[0] * x1[0] + x1[1] * x1[1]) + (x1[2] * x1[2] + x1[3] * x1[3]); }
                ss = rows_sum(ss);
                if (fq == 0) P[r * 4 + wc] = ss; }
            asm volatile("" ::: "memory"); }
        LDS_WAIT(); __builtin_amdgcn_s_barrier(); asm volatile("" ::: "memory");
        if (tid < TR) { const f32x4 p = *(const LAS f32x4*)(P + tid * 4); const float tot = (p[0] + p[1]) + (p[2] + p[3]);
            __hip_atomic_store(xs + (size_t)(u.row0 + tid) * 4 + u.pn, tot, __ATOMIC_RELAXED, __HIP_MEMORY_SCOPE_AGENT); }
        asm volatile("s_waitcnt vmcnt(0)" ::: "memory");
        if (tid < TR && (tid & 63) == 0) __hip_atomic_fetch_add(cnt + 16 * u.pm, 1u, __ATOMIC_RELAXED, __HIP_MEMORY_SCOPE_AGENT);
        if (!FINAL) {
#pragma unroll
            for (int ai = 0; ai < 2; ++ai)
#pragma unroll
                for (int m = 0; m < 4; ++m) if (m < nm(ai)) { _Float16* xp = X + (size_t)(u.row0 + rbase(ai, wr) + 16 * m + fr) * D + col0;
#pragma unroll
                    for (int bj = 0; bj < 2; ++bj)
#pragma unroll
                        for (int n = 0; n < 2; ++n) *(h4*)(xp + bj * 128 + n * 16) = __builtin_convertvector(acc[ai][bj][m][n], h4); }
        }
        if (tid < 64) { unsigned sp_ = 0;
            while ((unsigned)__builtin_amdgcn_readfirstlane(__hip_atomic_load(cnt + 16 * u.pm, __ATOMIC_RELAXED, __HIP_MEMORY_SCOPE_AGENT)) < 12u) {
                __builtin_amdgcn_s_sleep(1);
                if ((++sp_ & 1023u) == 0u) { if (__hip_atomic_load(tmo, __ATOMIC_RELAXED, __HIP_MEMORY_SCOPE_AGENT)) break; if (sp_ > (1u << 22)) { __hip_atomic_store(tmo, 1u, __ATOMIC_RELAXED, __HIP_MEMORY_SCOPE_AGENT); break; } } }
        }
        asm volatile("s_waitcnt lgkmcnt(0)" ::: "memory"); __builtin_amdgcn_s_barrier(); asm volatile("" ::: "memory");
        if (tid < TR) { const float* sl = xs + (size_t)(u.row0 + tid) * 4; float t = 0.f;
#pragma unroll
            for (int k = 0; k < 4; ++k) t += __hip_atomic_load(sl + k, __ATOMIC_RELAXED, __HIP_MEMORY_SCOPE_AGENT);
            S[tid] = rsqrtf(t * (1.f / D) + EPS); }
        LDS_WAIT(); __builtin_amdgcn_s_barrier(); asm volatile("" ::: "memory");
#pragma unroll
        for (int ai = 0; ai < 2; ++ai) {
            const int rb = u.row0 + rbase(ai, wr); const int vec = rb < MP ? 0 : 1 + (rb - MP) / TS;
            f32x4 gm[2][2], sh[2][2];
#pragma unroll
            for (int bj = 0; bj < 2; ++bj)
#pragma unroll
                for (int n = 0; n < 2; ++n) { const int c = col0 + bj * 128 + n * 16; gm[bj][n] = *(const f32x4*)(gn + c);
                    if (!FINAL) { const float* mv = modn + vec * 6 * D; gm[bj][n] = gm[bj][n] * (1.f + *(const f32x4*)(mv + (sh_idx + 1) * D + c)); sh[bj][n] = *(const f32x4*)(mv + sh_idx * D + c); } }
#pragma unroll
            for (int m = 0; m < 4; ++m) if (m < nm(ai)) { const int r = rbase(ai, wr) + 16 * m + fr; const float rs = S[r];
#pragma unroll
                for (int bj = 0; bj < 2; ++bj)
#pragma unroll
                    for (int n = 0; n < 2; ++n) { const int c = col0 + bj * 128 + n * 16;
                        if (FINAL) { *(f32x4*)(Y + (size_t)(u.row0 + r) * D + c) = acc[ai][bj][m][n] * rs * gm[bj][n]; }
                        else { const f32x4 h = acc[ai][bj][m][n] * rs * gm[bj][n] + sh[bj][n]; u32x2 w; w.x = cvt_pk_bf16(h[0], h[1]); w.y = cvt_pk_bf16(h[2], h[3]); *(u32x2*)(HN + (size_t)(u.row0 + r) * D + c) = w; } } }
        }
    }
};
struct EpiNull : EpiBase {
    static constexpr bool PERM = true;
    __device__ __forceinline__ void operator()(f32x4 (&acc)[2][2][4][2], const Unit& u, int wid, int) const {
        f32x4 s = {0.f, 0.f, 0.f, 0.f};
#pragma unroll
        for (int ai = 0; ai < 2; ++ai)
#pragma unroll
            for (int bj = 0; bj < 2; ++bj)
#pragma unroll
                for (int m = 0; m < 4; ++m)
#pragma unroll
                    for (int n = 0; n < 2; ++n) s += acc[ai][bj][m][n];
        ((f32x4*)(wsp() + WS_TOTAL))[(size_t)(u.pm * 22 + u.pn) * 512 + wid * 64 + pg8::lane_id()] = s;
    }
};
template <int ROWS> struct EpiBf16 : EpiBase {
    static constexpr bool PERM = true;
    __device__ __forceinline__ void operator()(const f32x4 (&acc)[2][2][4][2], const Unit& u, int wid, int ) const {
        int lane_ = pg8::lane_id(); asm volatile("" : "+v"(lane_));
        const int lane = lane_, wr = wid >> 2, wc = wid & 3, fr = lane & 15, fq = lane >> 4; (void)wr; (void)wc; (void)fr; (void)fq;
        bf16_t* O = (bf16_t*)(wsp() + WS_H); constexpr int ldc = D;
        const int col0 = u.pn * 256 + wc * 32 + 8 * fq;
#pragma unroll
        for (int ai = 0; ai < (ROWS == 128 ? 1 : 2); ++ai)
#pragma unroll
            for (int m = 0; m < 4; ++m) { bf16_t* rowp = O + (size_t)(u.row0 + ai * 128 + wr * 64 + m * 16 + fr) * ldc + col0;
#pragma unroll
                for (int bj = 0; bj < 2; ++bj) { const f32x4 v0 = acc[ai][bj][m][0], v1 = acc[ai][bj][m][1];
                    u32x4 w; w.x = cvt_pk_bf16(v0[0], v0[1]); w.y = cvt_pk_bf16(v0[2], v0[3]); w.z = cvt_pk_bf16(v1[0], v1[1]); w.w = cvt_pk_bf16(v1[2], v1[3]);
                    *(u32x4*)(rowp + bj * 128) = w; } }
    }
};
struct EpiQKV : EpiBase {
    static constexpr bool PERM = false;
    __device__ __forceinline__ void operator()(f32x4 (&acc)[2][2][4][2], const Unit& u, int wid, int ) const {
        int lane_ = pg8::lane_id(); asm volatile("" : "+v"(lane_));
        const int lane = lane_, wr = wid >> 2, wc = wid & 3, fr = lane & 15, fq = lane >> 4;
        unsigned char* ws = wsp(); bf16_t* Q = (bf16_t*)(ws + WS_Q); bf16_t* KB = (bf16_t*)(ws + WS_KB); bf16_t* VT = (bf16_t*)(ws + WS_VT); const float* rope = (const float*)(ws + WS_ROPE);
        float* outk = outp(kargs()) + OUT_NK; float* outv = outk + (OUT_NV - OUT_NK);
        const int c0 = wc * 32 + 4 * fq;
#pragma unroll
        for (int ai = 0; ai < 2; ++ai) {
            const int rb = u.row0 + r192_base(ai, wr); const bool samp = rb >= MP;
            if (samp && u.pn <= 4) {
                const int half = wc & 1;
#pragma unroll
                for (int m = 0; m < 4; ++m) if (m < r192_nm(ai)) { const int t = (rb - MP + m * 16 + fr) & (TS - 1); const int pos = half ? (t & 63) : (t >> 6);
                    const f32x4 cs = *(const f32x4*)(rope + pos * 16 + 4 * fq), sn = *(const f32x4*)(rope + 1024 + pos * 16 + 4 * fq);
#pragma unroll
                    for (int bj = 0; bj < 2; ++bj) { const f32x4 x1 = acc[ai][bj][m][0], x2 = acc[ai][bj][m][1]; acc[ai][bj][m][0] = x1 * cs - x2 * sn; acc[ai][bj][m][1] = x2 * cs + x1 * sn; } }
            }
            if (u.pn <= 4) {
                bf16_t* base = u.pn < 4 ? Q + u.pn * 256 : KB; const int ldc = u.pn < 4 ? D : 256;
#pragma unroll
                for (int m = 0; m < 4; ++m) if (m < r192_nm(ai)) { const int row = rb + m * 16 + fr; bf16_t* rowp = base + (size_t)row * ldc + c0;
#pragma unroll
                    for (int bj = 0; bj < 2; ++bj)
#pragma unroll
                        for (int n = 0; n < 2; ++n) { const f32x4 v = acc[ai][bj][m][n]; u32x2 w; w.x = cvt_pk_bf16(v[0], v[1]); w.y = cvt_pk_bf16(v[2], v[3]); *(u32x2*)(rowp + bj * 128 + n * 16) = w;
                            if (u.pn == 4 && !samp) *(f32x4*)(outk + (size_t)row * 256 + c0 + bj * 128 + n * 16) = v; } }
            } else {
                const int T = samp ? TS : TP;
                bf16_t* vt = samp ? VT + (size_t)32 * 65536 + (size_t)((rb - MP) / TS) * 256 * TS : VT + (size_t)(rb / TP) * 65536;
#pragma unroll
                for (int m = 0; m < 4; ++m) if (m < r192_nm(ai)) { const int row = rb + m * 16 + fr; const int t = samp ? ((row - MP) & (TS - 1)) : (row & (TP - 1));
                    unsigned vo = (unsigned)(c0 * T + t); asm volatile("" : "+v"(vo));
#pragma unroll
                    for (int bj = 0; bj < 2; ++bj)
#pragma unroll
                        for (int n = 0; n < 2; ++n) { const f32x4 v = acc[ai][bj][m][n]; const int c = c0 + bj * 128 + n * 16;
#pragma unroll
                            for (int j = 0; j < 4; ++j) vt[vo + (unsigned)((bj * 128 + n * 16 + j) * T)] = (bf16_t)f2bf(v[j]);
                            if (!samp) *(f32x4*)(outv + (size_t)row * 256 + c) = v; } }
            }
        }
    }
};
__device__ __forceinline__ f32x4 conv_m(f32x4 cur, f32x4 pe, f32x4 ne, f32x4 w0, f32x4 w1, f32x4 w2, int fr) {
    const f32x4 up = dpp4<DPP_ROR1>(cur), dn = dpp4<DPP_ROR15>(cur);
    const f32x4 prev = fr > 0 ? up : pe, next = fr < 15 ? dn : ne;
    return w0 * prev + w1 * cur + w2 * next;
}
__device__ __forceinline__ void mask_rows(f32x4 (&acc)[2][2][4][2], const Unit& u, int wr, int fr) {
    if (u.pm < 32) return;
    const int i = (u.pm - 32) % 9; if (i != 0 && i != 8) return;
    const int t0 = 254 * i - 1;
#pragma unroll
    for (int ai = 0; ai < 2; ++ai)
#pragma unroll
        for (int m = 0; m < 4; ++m) { const int t = t0 + ai * 128 + wr * 64 + m * 16 + fr; if (t < 0 || t >= TS) {
#pragma unroll
            for (int bj = 0; bj < 2; ++bj)
#pragma unroll
                for (int n = 0; n < 2; ++n) acc[ai][bj][m][n] = (f32x4){0.f, 0.f, 0.f, 0.f}; } }
}
__device__ __forceinline__ bool row_valid(const Unit& u, int r) {
    if (u.pm < 32) return true;
    const int t = 254 * ((u.pm - 32) % 9) - 1 + r; return r >= 1 && r <= 254 && t >= 0 && t < TS;
}
__device__ __forceinline__ void xch_write(LAS float* X, const f32x4 (&acc)[2][2][4][2], int wr, int wc, int fr, int fq) {
#pragma unroll
    for (int ai = 0; ai < 2; ++ai)
#pragma unroll
        for (int bj = 0; bj < 2; ++bj)
#pragma unroll
            for (int n = 0; n < 2; ++n) { const int col = bj * 128 + wc * 32 + 8 * fq + 4 * n;
                if (fr == 0) *(LAS f32x4*)(X + ((2 * ai + wr) * 2 + 0) * 256 + col) = acc[ai][bj][0][n];
                if (fr == 15) *(LAS f32x4*)(X + ((2 * ai + wr) * 2 + 1) * 256 + col) = acc[ai][bj][3][n]; }
}
__device__ __forceinline__ f32x4 xch_top(const LAS float* X, int b, int col) { return b > 0 ? *(const LAS f32x4*)(X + ((b - 1) * 2 + 1) * 256 + col) : (f32x4){0.f, 0.f, 0.f, 0.f}; }
__device__ __forceinline__ f32x4 xch_bot(const LAS float* X, int b, int col) { return b < 3 ? *(const LAS f32x4*)(X + ((b + 1) * 2 + 0) * 256 + col) : (f32x4){0.f, 0.f, 0.f, 0.f}; }

struct EpiUp : EpiBase {
    static constexpr bool PERM = true;
    __device__ __forceinline__ void operator()(f32x4 (&acc)[2][2][4][2], const Unit& u, int wid, int ) const {
        int lane_ = pg8::lane_id(); asm volatile("" : "+v"(lane_));
        const int lane = lane_, wr = wid >> 2, wc = wid & 3, fr = lane & 15, fq = lane >> 4; (void)wr; (void)wc; (void)fr; (void)fq;
        bf16_t* ACT = (bf16_t*)(wsp() + WS_ACT); const float* cw = inp(kargs(), 24) + (size_t)l * 3 * 2 * DFF; LAS float* X = xch();
        mask_rows(acc, u, wr, fr);
        xch_write(X, acc, wr, wc, fr, fq);
        LDS_WAIT(); __builtin_amdgcn_s_barrier(); asm volatile("" ::: "memory");
        const int chl = wc * 32 + 8 * fq;
#pragma unroll
        for (int n = 0; n < 2; ++n) {
            const int ch = u.pn * 128 + chl + 4 * n;
            f32x4 wg[3], wu[3];
#pragma unroll
            for (int k = 0; k < 3; ++k) { wg[k] = *(const f32x4*)(cw + k * 2 * DFF + ch); wu[k] = *(const f32x4*)(cw + k * 2 * DFF + DFF + ch); }
#pragma unroll
            for (int ai = 0; ai < 2; ++ai) {
                const int b = 2 * ai + wr;
                f32x4 pg = xch_top(X, b, chl + 4 * n), pu = xch_top(X, b, 128 + chl + 4 * n);
#pragma unroll
                for (int m = 0; m < 4; ++m) { const int r = ai * 128 + wr * 64 + m * 16 + fr;
                    const f32x4 vg = acc[ai][0][m][n], vu = acc[ai][1][m][n];
                    const f32x4 ng = m < 3 ? dpp4<DPP_ROR15>(acc[ai][0][m < 3 ? m + 1 : 3][n]) : xch_bot(X, b, chl + 4 * n);
                    const f32x4 nu = m < 3 ? dpp4<DPP_ROR15>(acc[ai][1][m < 3 ? m + 1 : 3][n]) : xch_bot(X, b, 128 + chl + 4 * n);
                    const f32x4 og = conv_m(vg, pg, ng, wg[0], wg[1], wg[2], fr), ou = conv_m(vu, pu, nu, wu[0], wu[1], wu[2], fr);
                    pg = dpp4<DPP_ROR1>(vg); pu = dpp4<DPP_ROR1>(vu);
                    f32x4 a;
#pragma unroll
                    for (int j = 0; j < 4; ++j) a[j] = silu_f(og[j]) * ou[j];
                    if (row_valid(u, r)) { u32x2 w; w.x = cvt_pk_bf16(a[0], a[1]); w.y = cvt_pk_bf16(a[2], a[3]); *(u32x2*)(ACT + (size_t)(u.row0 + r) * DFF + ch) = w; } }
            }
        }
    }
};
struct EpiSgu : EpiBase {
    static constexpr bool PERM = true;
    __device__ __forceinline__ void operator()(f32x4 (&acc)[2][2][4][2], const Unit& u, int wid, int ) const {
        int lane_ = pg8::lane_id(); asm volatile("" : "+v"(lane_));
        const int lane = lane_, wr = wid >> 2, wc = wid & 3, fr = lane & 15, fq = lane >> 4;
        unsigned char* ws = wsp(); bf16_t* U = (bf16_t*)(ws + WS_U); bf16_t* V = (bf16_t*)(ws + WS_V); f32x2* STATS = (f32x2*)(ws + WS_STATS);
        const bool isv = u.pn >= 4; bf16_t* O = isv ? V : U; const int col0 = (u.pn & 3) * 256 + wc * 32 + 8 * fq;
#pragma unroll
        for (int ai = 0; ai < 2; ++ai)
#pragma unroll
            for (int m = 0; m < 4; ++m) if (m < r192_nm(ai)) { const int row = u.row0 + r192_base(ai, wr) + m * 16 + fr; bf16_t* rowp = O + (size_t)row * D + col0; float s1 = 0.f, s2 = 0.f;
#pragma unroll
                for (int bj = 0; bj < 2; ++bj) { f32x4 v0 = acc[ai][bj][m][0], v1 = acc[ai][bj][m][1];
#pragma unroll
                    for (int j = 0; j < 4; ++j) { v0[j] = gelu_f(v0[j]); v1[j] = gelu_f(v1[j]); s1 += v0[j] + v1[j]; s2 += v0[j] * v0[j] + v1[j] * v1[j]; }
                    u32x4 w; w.x = cvt_pk_bf16(v0[0], v0[1]); w.y = cvt_pk_bf16(v0[2], v0[3]); w.z = cvt_pk_bf16(v1[0], v1[1]); w.w = cvt_pk_bf16(v1[2], v1[3]);
                    *(u32x4*)(rowp + bj * 128) = w; }
                if (isv) { s1 = rows_sum(s1); s2 = rows_sum(s2);
                    if (fq == 0) STATS[(size_t)row * 16 + (u.pn - 4) * 4 + wc] = (f32x2){s1, s2}; } }
    }
};
struct EpiSc : EpiBase {
    static constexpr bool PERM = true;
    __device__ __forceinline__ void operator()(f32x4 (&acc)[2][2][4][2], const Unit& u, int wid, int ui) const {
        int lane_ = pg8::lane_id(); asm volatile("" : "+v"(lane_));
        const int lane = lane_, wr = wid >> 2, wc = wid & 3, fr = lane & 15, fq = lane >> 4; (void)wr; (void)wc; (void)fr; (void)fq;
        unsigned char* ws = wsp(); f32x4* YB = (f32x4*)(ws + WS_YB) + (size_t)aux * 2 * 16 * 512; bf16_t* BY = (bf16_t*)(ws + WS_H2); const float* cw = inp(kargs(), 20); LAS float* X = xch();
        const int q = u.pn / 3, s = u.pn % 3, chl = wc * 32 + 8 * fq;
        if (s < 2) {
            mask_rows(acc, u, wr, fr);
#pragma unroll
            for (int ai = 0; ai < 2; ++ai)
#pragma unroll
                for (int m = 0; m < 4; ++m)
#pragma unroll
                    for (int n = 0; n < 2; ++n) acc[ai][0][m][n] = acc[ai][0][m][n] * acc[ai][1][m][n];
            xch_write(X, acc, wr, wc, fr, fq);
            LDS_WAIT(); __builtin_amdgcn_s_barrier(); asm volatile("" ::: "memory");
#pragma unroll
            for (int n = 0; n < 2; ++n) {
                const int ch = q * 256 + s * 128 + chl + 4 * n;
                f32x4 w[3];
#pragma unroll
                for (int k = 0; k < 3; ++k) w[k] = *(const f32x4*)(cw + k * D + ch);
#pragma unroll
                for (int ai = 0; ai < 2; ++ai) { const int b = 2 * ai + wr;
                    f32x4 pp = xch_top(X, b, chl + 4 * n);
#pragma unroll
                    for (int m = 0; m < 4; ++m) { const f32x4 v = acc[ai][0][m][n];
                        const f32x4 nn = m < 3 ? dpp4<DPP_ROR15>(acc[ai][0][m < 3 ? m + 1 : 3][n]) : xch_bot(X, b, chl + 4 * n);
                        const f32x4 o = conv_m(v, pp, nn, w[0], w[1], w[2], fr); pp = dpp4<DPP_ROR1>(v);
                        unsigned yo = (unsigned)((s * 16 + (ai * 4 + m) * 2 + n) * 512) + (unsigned)(wid * 64 + lane); asm volatile("" : "+v"(yo)); YB[yo] = o; } }
            }
        } else {
#pragma unroll
            for (int ai = 0; ai < 2; ++ai) {
                f32x4 y[4][2][2];
#pragma unroll
                for (int m = 0; m < 4; ++m)
#pragma unroll
                    for (int bj = 0; bj < 2; ++bj) { unsigned yo = (unsigned)((bj * 16 + (ai * 4 + m) * 2) * 512) + (unsigned)(wid * 64 + lane); asm volatile("" : "+v"(yo)); y[m][bj][0] = YB[yo]; y[m][bj][1] = YB[yo + 512]; }
#pragma unroll
                for (int m = 0; m < 4; ++m) { const int r = ai * 128 + wr * 64 + m * 16 + fr; const bool ok = row_valid(u, r);
#pragma unroll
                    for (int bj = 0; bj < 2; ++bj) { const f32x4 v0 = acc[ai][bj][m][0] * y[m][bj][0], v1 = acc[ai][bj][m][1] * y[m][bj][1];
                        u32x4 w; w.x = cvt_pk_bf16(v0[0], v0[1]); w.y = cvt_pk_bf16(v0[2], v0[3]); w.z = cvt_pk_bf16(v1[0], v1[1]); w.w = cvt_pk_bf16(v1[2], v1[3]);
                        if (ok) *(u32x4*)(BY + (size_t)(u.row0 + r) * D + q * 256 + bj * 128 + chl) = w; } }
                asm volatile("" ::: "memory"); }
        }
    }
};
struct OrderSc {
    int c; const char* A; const char* B;
    __device__ __forceinline__ bool next(int i, Unit& u) const {
        if (c >= 200 || i >= 3) return false;
        u.pm = c >> 2; u.pn = 3 * (c & 3) + i; u.row0 = conv_row0(u.pm); u.a = A + (long)u.row0 * (D * 2); u.b = B + (size_t)u.pn * 256 * D * 2; return true; }
};
struct EpiFn1 : EpiBase {
    static constexpr bool PERM = true;
    __device__ __forceinline__ void operator()(const f32x4 (&acc)[2][2][4][2], const Unit& u, int wid, int ) const {
        int lane_ = pg8::lane_id(); asm volatile("" : "+v"(lane_));
        const int lane = lane_, wr = wid >> 2, wc = wid & 3, fr = lane & 15, fq = lane >> 4; (void)wr; (void)wc; (void)fr; (void)fq;
        bf16_t* YT = (bf16_t*)(wsp() + WS_YT);
        const int part = u.pm & 1, ch0 = (u.pm >> 1) * 256, tok0 = u.pn * 256;
        bf16_t* base; int T, t0;
        if (tok0 < MP) { T = TP; base = YT + (size_t)(tok0 / TP) * D * 2 * TP; t0 = 0; }
        else { T = TS; base = YT + (size_t)32 * D * 2 * TP + (size_t)((tok0 - MP) / TS) * D * 2 * TS; t0 = (tok0 - MP) % TS; }
        const int c0 = wc * 32 + 8 * fq;
#pragma unroll
        for (int ai = 0; ai < 2; ++ai)
#pragma unroll
            for (int m = 0; m < 4; ++m) { bf16_t* rowp = base + (size_t)(ch0 + ai * 128 + wr * 64 + m * 16 + fr) * 2 * T + part * T + t0 + c0;
#pragma unroll
                for (int bj = 0; bj < 2; ++bj) { const f32x4 v0 = acc[ai][bj][m][0], v1 = acc[ai][bj][m][1];
                    u32x4 w; w.x = cvt_pk_bf16(v0[0], v0[1]); w.y = cvt_pk_bf16(v0[2], v0[3]); w.z = cvt_pk_bf16(v1[0], v1[1]); w.w = cvt_pk_bf16(v1[2], v1[3]);
                    *(u32x4*)(rowp + bj * 128) = w; } }
    }
};
struct OrderFn1 {
    int G, c; const char* A1; const char* H;
    __device__ __forceinline__ bool next(int i, Unit& u) const {
        const int L = i * G + c; if (L >= 384) return false;
        u.pm = L & 7; u.pn = L >> 3; u.row0 = 0; u.a = A1 + (size_t)(u.pm & 1) * 256 * 256 * 2; u.b = H + (size_t)u.pn * 256 * D * 2 + (size_t)(u.pm >> 1) * 512; return true; }
};
struct OrderFn2 {
    int c; int samp; const char* A2; const char* YT;
    __device__ __forceinline__ bool next(int i, Unit& u) const {
        if (i > 0) return false;
        if (samp) { if (c >= 128) return false; const int b = c >> 6, tm = (c >> 2) & 15; u.pm = tm; u.pn = c & 3; u.row0 = MP + b * TS + 128 * tm;
            u.a = A2 + (size_t)tm * 128 * 2 * TS * 2; u.b = YT + (size_t)32 * D * 2 * TP * 2 + (size_t)b * D * 2 * TS * 2 + (size_t)u.pn * 256 * 2 * TS * 2; return true; }
        if (c < 128) return false; const int j = c - 128, s = j >> 2; u.pm = 0; u.pn = j & 3; u.row0 = s * TP;
        u.a = A2; u.b = YT + (size_t)s * D * 2 * TP * 2 + (size_t)u.pn * 256 * 2 * TP * 2; return true; }
};

__device__ __forceinline__ void p0_transpose_item(const float* W, int K, int N, bf16_t* WT, int drow0, LAS float* scr, int kb, int n0, int lane) {
    const int k0 = 64 * kb;
    f32x4 v[8];
#pragma unroll
    for (int i = 0; i < 8; ++i) v[i] = *(const f32x4*)(W + (size_t)(k0 + 8 * i + (lane >> 3)) * N + n0 + 4 * (lane & 7));
#pragma unroll
    for (int i = 0; i < 8; ++i) { LAS float* d = scr + (8 * i + (lane >> 3)) * 33 + 4 * (lane & 7); d[0] = v[i][0]; d[1] = v[i][1]; d[2] = v[i][2]; d[3] = v[i][3]; }
    LDS_WAIT(); asm volatile("" ::: "memory");
    const int c = lane & 7;
#pragma unroll
    for (int j = 0; j < 4; ++j) { const int n = (lane >> 3) + 8 * j; const LAS float* s = scr + (8 * c) * 33 + n;
        u32x4 o; o.x = pk2(s[0 * 33], s[1 * 33]); o.y = pk2(s[2 * 33], s[3 * 33]); o.z = pk2(s[4 * 33], s[5 * 33]); o.w = pk2(s[6 * 33], s[7 * 33]);
        *(u32x4*)(WT + (size_t)(drow0 + n) * K + k0 + 8 * c) = o; }
    LDS_WAIT(); asm volatile("" ::: "memory");
}
__device__ __forceinline__ int map_plain(int n) { return n; }
__device__ __forceinline__ int map_up(int n) { return n < DFF ? 256 * (n >> 7) + (n & 127) : 256 * ((n - DFF) >> 7) + 128 + ((n - DFF) & 127); }
__device__ __forceinline__ int map_sc(int n) {
    if (n < D) return (3 * (n >> 8) + 2) * 256 + (n & 255);
    const int x = n >= 2 * D, ch = n - D - x * D; return (3 * (ch >> 8) + ((ch >> 7) & 1)) * 256 + x * 128 + (ch & 127);
}
__device__ __forceinline__ void p0_tjob(int& it, int NGW, LAS float* scr, int lane, const float* W, bf16_t* WT, int K, int N, int map) {
    const int nblk = N / 32, nitems = (K / 64) * nblk;
    for (; it < nitems; it += NGW) { const int kb = it / nblk, n0 = (it % nblk) * 32; const int dr = map == 0 ? n0 : (map == 1 ? map_up(n0) : map_sc(n0));
        p0_transpose_item(W, K, N, WT, dr, scr, kb, n0, lane); }
    it -= nitems;
}
__device__ __forceinline__ void convert_layer(Frame& F, int l, int b0, int nb) {
    unsigned char* ws = F.ws;
    LAS float* scr = (LAS float*)(F.lds + F.wave * 16384);
    const int gw = (F.blk - b0) * NWAVES + F.wave, NGW = nb * NWAVES;
    int it = gw;
    if (l == 0) { p0_tjob(it, NGW, scr, F.lane, ((const float*)F.in[11]), (bf16_t*)(ws + WS_WQKV), D, 1536, 0);
        p0_tjob(it, NGW, scr, F.lane, ((const float*)F.in[12]), (bf16_t*)(ws + WS_WO), D, D, 0); }
    else if (l == 1) { p0_tjob(it, NGW, scr, F.lane, ((const float*)F.in[14]), (bf16_t*)(ws + WS_WSGI), D, 2048, 0);
        p0_tjob(it, NGW, scr, F.lane, ((const float*)F.in[18]), (bf16_t*)(ws + WS_WSGO), D, D, 0); }
    else if (l == 2) { p0_tjob(it, NGW, scr, F.lane, ((const float*)F.in[19]), (bf16_t*)(ws + WS_WSCI), D, 3072, 2);
        p0_tjob(it, NGW, scr, F.lane, ((const float*)F.in[21]), (bf16_t*)(ws + WS_WSCO), D, D, 0); }
    else p0_tjob(it, NGW, scr, F.lane, ((const float*)F.in[22]), (bf16_t*)(ws + WS_WFNO), D, D, 0);
    p0_tjob(it, NGW, scr, F.lane, ((const float*)F.in[23]) + (size_t)l * D * 2 * DFF, (bf16_t*)(ws + WS_WUP + l * WUP_BYTES), D, 2 * DFF, 1);
    p0_tjob(it, NGW, scr, F.lane, ((const float*)F.in[25]) + (size_t)l * DFF * D, (bf16_t*)(ws + WS_WDN + l * WDN_BYTES), DFF, D, 0);
    const size_t gt = (size_t)(F.blk - b0) * 512 + F.tid, NGT = (size_t)nb * 512;
    if (l == 1) { bf16_t* WSb = (bf16_t*)(ws + WS_WS); for (size_t i = gt; i < 8 * 128 * 128; i += NGT) WSb[i] = (bf16_t)f2bf(((const float*)F.in[16])[i]); }
    if (l == 3) {
        bf16_t* A1 = (bf16_t*)(ws + WS_A1);
        for (size_t i = gt; i < 2 * 256 * 256; i += NGT) { const int part = i >> 16, r = (i >> 8) & 255, k = i & 255; float v = 0.f;
            if ((r >> 7) == (k >> 7)) { const float a = 2.f * (float)(((r & 127) * (k & 127)) & 127) / 128.f; v = (part ? sinpif(a) : cospif(a)) * 0.08838834764831845f; }
            A1[i] = (bf16_t)f2bf(v); }
        bf16_t* A2P = (bf16_t*)(ws + WS_A2P);
        for (size_t i = gt; i < 256 * 512; i += NGT) { const int tp = i >> 9, k = i & 511, t = k & 255; const float a = 2.f * (float)((tp * t) & 255) / 256.f;
            A2P[i] = (bf16_t)f2bf((k < 256 ? cospif(a) : -sinpif(a)) * 0.0625f); }
        __syncthreads();
        LAS bf16_t* tab = (LAS bf16_t*)F.lds;
        for (int j = F.tid; j < 2048; j += 512) { const float a = 2.f * (float)j / 2048.f; tab[j] = (bf16_t)f2bf(cospif(a) * 0.022097086912079608f); tab[2048 + j] = (bf16_t)f2bf(-sinpif(a) * 0.022097086912079608f); }
        __syncthreads();
        bf16_t* A2S = (bf16_t*)(ws + WS_A2S);
        for (size_t i8 = gt; i8 < (size_t)2048 * 4096 / 8; i8 += NGT) { const int tp = (int)(i8 >> 9), k0 = (int)(i8 & 511) * 8, part = k0 >> 11, t0 = k0 & 2047;
            unsigned w[4];
#pragma unroll
            for (int e = 0; e < 4; ++e) { const unsigned lo = tab[part * 2048 + ((tp * (t0 + 2 * e)) & 2047)], hi = tab[part * 2048 + ((tp * (t0 + 2 * e + 1)) & 2047)]; w[e] = lo | (hi << 16); }
            *(u32x4*)(A2S + i8 * 8) = (u32x4){w[0], w[1], w[2], w[3]}; }
        __syncthreads();
    }
}
__device__ __forceinline__ void prefetch_region(Frame& F, const void* p, size_t bytes, int b0, int nb) {
    const size_t gt = (size_t)(F.blk - b0) * 512 + F.tid, NGT = (size_t)nb * 512; unsigned acc = 0;
    for (size_t i = gt * 128; i < bytes; i += NGT * 128) { const u32x4 v = *(const u32x4*)((const char*)p + i); acc += v.x ^ v.w; }
    if (acc == 0x9e3779b9u) *(volatile unsigned*)(F.ws + WS_CTL + CTL_TMO + 64) = acc;
}
__device__ __forceinline__ void mod_items(Frame& F, int lo, int hi, int b0, int nb) {
    unsigned char* ws = F.ws;
    LAS float* sv = (LAS float*)F.lds;
    LAS float* red = sv + 3 * D;
    __syncthreads();
    for (int i = F.tid; i < D; i += 512) { const float a = ((const float*)F.in[5])[i], b = ((const float*)F.in[4])[i], d = ((const float*)F.in[4])[D + i];
        sv[i] = a / (1.f + expf(-a)); sv[D + i] = b / (1.f + expf(-b)); sv[2 * D + i] = d / (1.f + expf(-d)); }
    __syncthreads();
    float* MODp = (float*)(ws + WS_MOD);
    const int kg = F.tid >> 3, cq = F.tid & 7;
    for (int it = lo + F.blk - b0; it < hi; it += nb) {
        const int l = it / 192, n0 = (it % 192) * 32;
        const float* w = ((const float*)F.in[6]) + (size_t)l * D * 6 * D + n0 + 4 * cq;
        f32x4 wv[16];
#pragma unroll
        for (int i = 0; i < 16; ++i) wv[i] = *(const f32x4*)(w + (size_t)(kg + 64 * i) * 6 * D);
        f32x4 a[3] = {{0, 0, 0, 0}, {0, 0, 0, 0}, {0, 0, 0, 0}};
#pragma unroll
        for (int i = 0; i < 16; ++i) { const int k = kg + 64 * i; a[0] += sv[k] * wv[i]; a[1] += sv[D + k] * wv[i]; a[2] += sv[2 * D + k] * wv[i]; }
#pragma unroll
        for (int v = 0; v < 3; ++v)
#pragma unroll
            for (int j = 0; j < 4; ++j) { float x = a[v][j]; x += dppx<0x128>(x); a[v][j] = rows_sum(x); }
        if (F.lane < 8) {
#pragma unroll
            for (int v = 0; v < 3; ++v) *(LAS f32x4*)(red + (F.wave * 3 + v) * 32 + 4 * cq) = a[v]; }
        __syncthreads();
        if (F.tid < 96) { const int v = F.tid >> 5, cc = F.tid & 31; float s = 0.f;
#pragma unroll
            for (int g = 0; g < 8; ++g) s += red[(g * 3 + v) * 32 + cc];
            MODp[(l * 3 + v) * 6 * D + n0 + cc] = s + ((const float*)F.in[7])[l * 6 * D + n0 + cc]; }
        __syncthreads();
    }
}
__device__ __forceinline__ void p0_prologue(Frame& F) {
    unsigned char* ws = F.ws;
    mod_items(F, 0, 192, 0, F.G);
    {
        const size_t gt = (size_t)F.blk * 512 + F.tid, NGT = (size_t)F.G * 512;
        bf16_t* CK = (bf16_t*)(ws + WS_CK); bf16_t* CVT = (bf16_t*)(ws + WS_CVT);
        for (size_t i = gt; i < 2 * 512 * 256; i += NGT) { CK[i] = (bf16_t)f2bf(((const float*)F.in[2])[i]);
            const int d = i & 63, kvh = (i >> 6) & 3, j = (i >> 8) & 511, b = i >> 17; CVT[((size_t)(b * 4 + kvh) * 64 + d) * 512 + j] = (bf16_t)f2bf(((const float*)F.in[3])[i]); }
        float* rope = (float*)(ws + WS_ROPE);
        for (size_t i = gt; i < 1024; i += NGT) { const int pos = i >> 4, fi = i & 15; const float ang = (float)pos * powf(10000.f, -(float)fi / 16.f); rope[i] = cosf(ang); rope[1024 + i] = sinf(ang); }
    }
}

__device__ __forceinline__ void norm_phase(Frame& F, const float* src0, const float* src1, const float* g, const float* modl, int sh_idx, bf16_t* H) {
    const int gw = F.blk * NWAVES + F.wave, NGW = F.G * NWAVES;
    f32x4 gv[4];
#pragma unroll
    for (int j = 0; j < 4; ++j) gv[j] = *(const f32x4*)(g + 256 * j + 4 * F.lane);
    for (int row = gw; row < M; row += NGW) {
        const float* xr = row < MP ? src0 + (size_t)row * D : src1 + (size_t)(row - MP) * D;
        const float* mv = modl + (row < MP ? 0 : 1 + (row - MP) / TS) * 6 * D;
        f32x4 v[4]; float s = 0.f;
#pragma unroll
        for (int j = 0; j < 4; ++j) { v[j] = *(const f32x4*)(xr + 256 * j + 4 * F.lane); s += (v[j][0] * v[j][0] + v[j][1] * v[j][1]) + (v[j][2] * v[j][2] + v[j][3] * v[j][3]); }
        const float r = rsqrtf(wave_sum(s) * (1.f / D) + EPS);
#pragma unroll
        for (int j = 0; j < 4; ++j) { const f32x4 sh = *(const f32x4*)(mv + sh_idx * D + 256 * j + 4 * F.lane), sc = *(const f32x4*)(mv + (sh_idx + 1) * D + 256 * j + 4 * F.lane);
            const f32x4 o = v[j] * r * gv[j] * (1.f + sc) + sh;
            u32x2 w; w.x = pk2(o[0], o[1]); w.y = pk2(o[2], o[3]); *(u32x2*)(H + (size_t)row * D + 256 * j + 4 * F.lane) = w; }
    }
}
__device__ __forceinline__ void final_phase(Frame& F, const float* X, const float* g, float* out) {
    const int gw = F.blk * NWAVES + F.wave, NGW = F.G * NWAVES;
    f32x4 gv[4];
#pragma unroll
    for (int j = 0; j < 4; ++j) gv[j] = *(const f32x4*)(g + 256 * j + 4 * F.lane);
    for (int row = gw; row < M; row += NGW) {
        const float* xr = X + (size_t)row * D; f32x4 v[4]; float s = 0.f;
#pragma unroll
        for (int j = 0; j < 4; ++j) { v[j] = *(const f32x4*)(xr + 256 * j + 4 * F.lane); s += (v[j][0] * v[j][0] + v[j][1] * v[j][1]) + (v[j][2] * v[j][2] + v[j][3] * v[j][3]); }
        const float r = rsqrtf(wave_sum(s) * (1.f / D) + EPS);
#pragma unroll
        for (int j = 0; j < 4; ++j) *(f32x4*)(out + (size_t)row * D + 256 * j + 4 * F.lane) = v[j] * r * gv[j];
    }
}

constexpr int ATT_LDK = 144;
constexpr int ATT_TILE_BYTES = 2 * 64 * ATT_LDK;
struct AttTile { const bf16_t* K; const bf16_t* V; int ldk, ldv, k0, mask; };
__device__ __forceinline__ void att_tile_of(int t, bool lat, int nband, int kband0, int qc0, const bf16_t* KBs, const bf16_t* VTs, int T, const bf16_t* CKs, const bf16_t* CVTs, AttTile& o) {
    if (t < nband) { const int k0 = kband0 + 64 * t; o.K = KBs + (size_t)k0 * 256; o.V = VTs + k0; o.ldk = 256; o.ldv = T; o.k0 = k0; const int dk = k0 - qc0; o.mask = lat && (dk < -64 || dk > 64); }
    else { const int k0 = 64 * (t - nband); o.K = CKs + (size_t)k0 * 256; o.V = CVTs + k0; o.ldk = 256; o.ldv = 512; o.k0 = k0; o.mask = 0; }
}
__device__ __forceinline__ void attn_phase(Frame& F, const bf16_t* Q, const bf16_t* KB, const bf16_t* VT, const bf16_t* CK, const bf16_t* CVT, const float* sink, bf16_t* O) {
    const int fr = F.lane & 15, g4 = F.lane >> 4, tid = F.tid;
    const int lrow = tid >> 3, lchunk = tid & 7;
    LAS unsigned char* lds = F.lds;
    for (int it = F.blk; it < 768; it += F.G) {
        const bool lat = it < 256; int kvh, chunk, T, rowbase, b = 0; const bf16_t* vt;
        if (lat) { b = it >> 7; kvh = (it >> 5) & 3; chunk = it & 31; T = TS; rowbase = MP + b * TS; vt = VT + (size_t)32 * 65536 + (size_t)b * 256 * TS; }
        else { const int j = it - 256, s = j >> 4; kvh = (j >> 2) & 3; chunk = j & 3; T = TP; rowbase = s * TP; vt = VT + (size_t)s * 65536; }
        const int h = kvh * 4 + (F.wave & 3), q0 = chunk * 64 + (F.wave >> 2) * 32;
        int kband0 = 0, nband = T / 64;
        if (lat) { int lo = 64 * chunk - 128, hi = 64 * chunk + 192; lo = lo < 0 ? 0 : lo; hi = hi > T ? T : hi; kband0 = lo; nband = (hi - lo) / 64; }
        const int ntile = nband + (lat ? 8 : 0);
        const bf16_t* KBs = KB + (size_t)rowbase * 256 + kvh * 64; const bf16_t* VTs = vt + (size_t)(kvh * 64) * T;
        const bf16_t* CKs = CK + (size_t)b * 512 * 256 + kvh * 64; const bf16_t* CVTs = CVT + (size_t)((b * 4 + kvh) * 64) * 512;
        bf16x8 Qf[2][2];
#pragma unroll
        for (int qg = 0; qg < 2; ++qg)
#pragma unroll
            for (int ds = 0; ds < 2; ++ds) Qf[qg][ds] = *(const bf16x8*)(Q + (size_t)(rowbase + q0 + 16 * qg + fr) * D + h * 64 + 32 * ds + 8 * g4);
        float mrun[2], lrun[2]; f32x4 Oa[2][4];
#pragma unroll
        for (int qg = 0; qg < 2; ++qg) { mrun[qg] = sink[h] * 1.4426950408889634f; lrun[qg] = 1.f;
#pragma unroll
            for (int db = 0; db < 4; ++db) Oa[qg][db] = (f32x4){0.f, 0.f, 0.f, 0.f}; }
        AttTile tl; att_tile_of(0, lat, nband, kband0, 64 * chunk, KBs, VTs, T, CKs, CVTs, tl);
        u32x4 rk = *(const u32x4*)(tl.K + (size_t)lrow * tl.ldk + lchunk * 8), rv = *(const u32x4*)(tl.V + (size_t)lrow * tl.ldv + lchunk * 8);
        __syncthreads();
        *(LAS u32x4*)(lds + lrow * ATT_LDK + lchunk * 16) = rk; *(LAS u32x4*)(lds + 64 * ATT_LDK + lrow * ATT_LDK + lchunk * 16) = rv;
        __syncthreads();
#pragma unroll 1
        for (int t = 0; t < ntile; ++t) {
            const int cur_k0 = tl.k0, cur_mask = tl.mask;
            if (t + 1 < ntile) { att_tile_of(t + 1, lat, nband, kband0, 64 * chunk, KBs, VTs, T, CKs, CVTs, tl);
                rk = *(const u32x4*)(tl.K + (size_t)lrow * tl.ldk + lchunk * 8); rv = *(const u32x4*)(tl.V + (size_t)lrow * tl.ldv + lchunk * 8); }
            const LAS unsigned char* kb_ = lds + (t & 1) * ATT_TILE_BYTES; const LAS unsigned char* vb_ = kb_ + 64 * ATT_LDK;
            {
                bf16x8 Kf[2][2][2], Vf[2][4];
#pragma unroll
                for (int sub = 0; sub < 2; ++sub) {
#pragma unroll
                    for (int kb = 0; kb < 2; ++kb)
#pragma unroll
                        for (int ds = 0; ds < 2; ++ds) Kf[sub][kb][ds] = *(const LAS bf16x8*)(kb_ + (32 * sub + 16 * kb + fr) * ATT_LDK + 64 * ds + 16 * g4);
#pragma unroll
                    for (int db = 0; db < 4; ++db) { const LAS unsigned char* vp = vb_ + (16 * db + fr) * ATT_LDK + 64 * sub + 8 * g4; const u32x2 lo = *(const LAS u32x2*)vp, hi = *(const LAS u32x2*)(vp + 32);
                        Vf[sub][db] = __builtin_bit_cast(bf16x8, (u32x4){lo.x, lo.y, hi.x, hi.y}); }
                }
                const float c = 0.125f * 1.4426950408889634f;
                f32x4 S[2][2][2];
#pragma unroll
                for (int qg = 0; qg < 2; ++qg)
#pragma unroll
                    for (int sub = 0; sub < 2; ++sub)
#pragma unroll
                        for (int kb = 0; kb < 2; ++kb) { S[qg][sub][kb] = __builtin_amdgcn_mfma_f32_16x16x32_bf16(Kf[sub][kb][0], Qf[qg][0], (f32x4){0.f, 0.f, 0.f, 0.f}, 0, 0, 0);
                            S[qg][sub][kb] = __builtin_amdgcn_mfma_f32_16x16x32_bf16(Kf[sub][kb][1], Qf[qg][1], S[qg][sub][kb], 0, 0, 0); }
                float mnew[2], rs[2];
#pragma unroll
                for (int qg = 0; qg < 2; ++qg) {
                    const int qpos = q0 + 16 * qg + fr;
                    if (cur_mask) {
#pragma unroll
                        for (int sub = 0; sub < 2; ++sub)
#pragma unroll
                            for (int kb = 0; kb < 2; ++kb)
#pragma unroll
                                for (int r = 0; r < 4; ++r) { const int d = cur_k0 + 32 * sub + 16 * kb + 4 * g4 + r - qpos; if (d > 128 || d < -128) S[qg][sub][kb][r] = -1e30f; }
                    }
                    float mx = -1e30f;
#pragma unroll
                    for (int sub = 0; sub < 2; ++sub)
#pragma unroll
                        for (int kb = 0; kb < 2; ++kb) mx = fmaxf(fmaxf(mx, fmaxf(S[qg][sub][kb][0], S[qg][sub][kb][1])), fmaxf(S[qg][sub][kb][2], S[qg][sub][kb][3]));
                    mx = rows_max(mx) * c;
                    mnew[qg] = fmaxf(mrun[qg], mx);
                    float r_ = 0.f;
#pragma unroll
                    for (int sub = 0; sub < 2; ++sub)
#pragma unroll
                        for (int kb = 0; kb < 2; ++kb)
#pragma unroll
                            for (int r = 0; r < 4; ++r) { const float p = fast_exp2(__builtin_fmaf(S[qg][sub][kb][r], c, -mnew[qg])); S[qg][sub][kb][r] = p; r_ += p; }
                    rs[qg] = rows_sum(r_);
                }
                if (__builtin_amdgcn_ballot_w64(mnew[0] > mrun[0] || mnew[1] > mrun[1]) != 0ull) {
#pragma unroll
                    for (int qg = 0; qg < 2; ++qg) { const float alpha = fast_exp2(mrun[qg] - mnew[qg]); lrun[qg] *= alpha;
#pragma unroll
                        for (int db = 0; db < 4; ++db) Oa[qg][db] = Oa[qg][db] * alpha; }
                }
#pragma unroll
                for (int qg = 0; qg < 2; ++qg) { lrun[qg] += rs[qg]; mrun[qg] = mnew[qg];
#pragma unroll
                    for (int sub = 0; sub < 2; ++sub) {
                        u32x4 pw; pw.x = cvt_pk_bf16(S[qg][sub][0][0], S[qg][sub][0][1]); pw.y = cvt_pk_bf16(S[qg][sub][0][2], S[qg][sub][0][3]); pw.z = cvt_pk_bf16(S[qg][sub][1][0], S[qg][sub][1][1]); pw.w = cvt_pk_bf16(S[qg][sub][1][2], S[qg][sub][1][3]);
                        const bf16x8 Pf = __builtin_bit_cast(bf16x8, pw);
#pragma unroll
                        for (int db = 0; db < 4; ++db) Oa[qg][db] = __builtin_amdgcn_mfma_f32_16x16x32_bf16(Vf[sub][db], Pf, Oa[qg][db], 0, 0, 0); } }
            }
            if (t + 1 < ntile) { LAS unsigned char* nb = lds + ((t + 1) & 1) * ATT_TILE_BYTES;
                *(LAS u32x4*)(nb + lrow * ATT_LDK + lchunk * 16) = rk; *(LAS u32x4*)(nb + 64 * ATT_LDK + lrow * ATT_LDK + lchunk * 16) = rv; }
            __syncthreads();
        }
#pragma unroll
        for (int qg = 0; qg < 2; ++qg) { const float inv = 1.f / lrun[qg];
#pragma unroll
            for (int db = 0; db < 4; ++db) { const f32x4 o = Oa[qg][db] * inv; u32x2 w; w.x = cvt_pk_bf16(o[0], o[1]); w.y = cvt_pk_bf16(o[2], o[3]);
                *(u32x2*)(O + (size_t)(rowbase + q0 + 16 * qg + fr) * D + h * 64 + 16 * db + 4 * g4) = w; } }
    }
}

__device__ __forceinline__ void sgu_phase(Frame& F, const bf16_t* U, const bf16_t* V, const f32x2* STATS, const float* ln_g, const bf16_t* WSb, const float* b_s, bf16_t* UM) {
    constexpr int LDT = 136;
    LAS bf16_t* LT = (LAS bf16_t*)F.lds;
    LAS f32x2* ST = (LAS f32x2*)(F.lds + 128 * LDT * 2);
    const int fr = F.lane & 15, g4 = F.lane >> 4;
    for (int it = F.blk; it < 768; it += F.G) {
        const int ch = it >> 3, g = it & 7, r0 = ch * 128;
        if (F.tid < 128) { const f32x2* sp = STATS + (size_t)(r0 + F.tid) * 16; float s1 = 0.f, s2 = 0.f;
#pragma unroll
            for (int k = 0; k < 16; ++k) { const f32x2 p = sp[k]; s1 += p.x; s2 += p.y; }
            const float mu = s1 * (1.f / D), var = s2 * (1.f / D) - mu * mu; ST[F.tid] = (f32x2){mu, rsqrtf(fmaxf(var, 0.f) + EPS)}; }
        __syncthreads();
#pragma unroll
        for (int i = 0; i < 4; ++i) { const int q = F.tid + 512 * i, r = q & 127, c8 = (q >> 7) * 8;
            const u32x4 raw = *(const u32x4*)(V + (size_t)(r0 + r) * D + g * 128 + c8); const f32x2 st = ST[r];
            const f32x4 ga = *(const f32x4*)(ln_g + g * 128 + c8), gb = *(const f32x4*)(ln_g + g * 128 + c8 + 4);
            const unsigned rw[4] = {raw.x, raw.y, raw.z, raw.w};
#pragma unroll
            for (int e = 0; e < 8; ++e) { const float x = bf2f((unsigned short)(e & 1 ? rw[e >> 1] >> 16 : rw[e >> 1] & 0xffff)); const float gg = e < 4 ? ga[e & 3] : gb[e & 3];
                LT[(c8 + e) * LDT + r] = (bf16_t)f2bf((x - st.x) * st.y * gg); } }
        __syncthreads();
        f32x4 acc[8];
#pragma unroll
        for (int cb = 0; cb < 8; ++cb) acc[cb] = (f32x4){0.f, 0.f, 0.f, 0.f};
        const int p = 16 * F.wave + fr;
#pragma unroll
        for (int ks = 0; ks < 4; ++ks) { const bf16x8 bw = *(const bf16x8*)(WSb + (size_t)(g * 128 + p) * 128 + 32 * ks + 8 * g4);
#pragma unroll
            for (int cb = 0; cb < 8; ++cb) { const bf16x8 av = *(const LAS bf16x8*)(LT + (16 * cb + fr) * LDT + 32 * ks + 8 * g4); acc[cb] = __builtin_amdgcn_mfma_f32_16x16x32_bf16(av, bw, acc[cb], 0, 0, 0); } }
        const float bsv = b_s[g * 128 + p];
#pragma unroll
        for (int cb = 0; cb < 8; ++cb) { const size_t off = (size_t)(r0 + p) * D + g * 128 + 16 * cb + 4 * g4; const u32x2 uw = *(const u32x2*)(U + off);
            const float u0 = bf2f((unsigned short)(uw.x & 0xffff)), u1 = bf2f((unsigned short)(uw.x >> 16)), u2 = bf2f((unsigned short)(uw.y & 0xffff)), u3 = bf2f((unsigned short)(uw.y >> 16));
            u32x2 w; w.x = cvt_pk_bf16(u0 * (acc[cb][0] + bsv), u1 * (acc[cb][1] + bsv)); w.y = cvt_pk_bf16(u2 * (acc[cb][2] + bsv), u3 * (acc[cb][3] + bsv)); *(u32x2*)(UM + off) = w; }
        __syncthreads();
    }
}

struct Args { const float* in[26]; float* out; unsigned char* ws; int ph_lo, ph_hi; };
__global__ void __launch_bounds__(NWAVES * 64, 2) mk_fwd(const Args args) {
    extern __shared__ __attribute__((aligned(16))) unsigned char lds_raw[];
    Frame F;
    F.lds = (LAS unsigned char*)lds_raw;
    const int wave0 = __builtin_amdgcn_readfirstlane((int)threadIdx.x >> 6);
    F.wave = wave0; F.lane = pg8::lane_id(); F.tid = wave0 * 64 + F.lane;
    const int grid0 = gridDim.x, blk0 = blockIdx.x; F.G = grid0; F.blk = blk0;
    F.in = (const __attribute__((address_space(4))) cfp_t*)__builtin_amdgcn_kernarg_segment_ptr();
    F.out = args.out; F.ws = args.ws;
    unsigned char* ws = args.ws;
    volatile LAS unsigned* MISC = (volatile LAS unsigned*)(F.lds + MISC_OFF);
    if (F.tid < 32) MISC[F.tid] = 0u;
    __syncthreads();
    const int lo = args.ph_lo, hi = args.ph_hi;
    XcdBarrier bar; bar.bar = (unsigned*)(ws + WS_CTL); bar.x = 0; bar.st = nullptr;
    if (hi - lo > 1) bar = xcd_barrier_post((unsigned*)(ws + WS_CTL), MISC + 8, F.tid == 0);
    LAS float* XCH = (LAS float*)(F.lds + XCH_OFF);
#define CASE_BEGIN() { int b_ = blk0, w_ = wave0, g_ = grid0; asm volatile("" : "+s"(b_), "+s"(w_), "+s"(g_)); F.blk = b_; F.wave = w_; F.G = g_; } frame_refresh(F); unsigned long long ws_ = (unsigned long long)args.ws, in_ = (unsigned long long)__builtin_amdgcn_kernarg_segment_ptr(); asm volatile("" : "+s"(ws_), "+s"(in_)); \
        unsigned char* ws = (unsigned char*)(GAS unsigned char*)ws_; F.ws = ws; F.in = (const __attribute__((address_space(4))) cfp_t*)in_; \
        float* X = (float*)(ws + WS_X); bf16_t* H = (bf16_t*)(ws + WS_H); bf16_t* H2 = (bf16_t*)(ws + WS_H2); bf16_t* HN = (bf16_t*)(ws + WS_HN); (void)HN; \
        const float* modl = (const float*)(ws + WS_MOD) + l * 3 * 6 * D; const float* xs0 = l == 0 ? ((const float*)F.in[0]) : X; const float* xs1 = l == 0 ? ((const float*)F.in[1]) : X + (size_t)MP * D; \
        (void)X; (void)H; (void)H2; (void)modl; (void)xs0; (void)xs1
#pragma unroll 1
    for (int ph = lo; ph < hi; ++ph) {
        int l = 0, kind;
        if (ph == 0) kind = 0; else if (ph == 1) kind = 1;
        else { l = ph < 7 ? 0 : ph < 12 ? 1 : ph < 16 ? 2 : 3; const int j = ph - (l == 0 ? 2 : l == 1 ? 7 : l == 2 ? 12 : 16), n = l == 2 ? 1 : 2;
            kind = j < n ? (l == 0 ? 2 + j : l == 1 ? 4 + j : l == 2 ? 6 : 7 + j) : j == n ? 9 : j == n + 1 ? 10 : 11; }
        const int reps = (kind == MK_REP_KIND) ? 1 + MK_REP_N : 1;
        const bool tp_here = MK_TP && ph == MK_TP_PH && blk0 == 0;
        unsigned long long tp_r0 = 0, tp_c0 = 0; if (tp_here) { tp_r0 = __builtin_amdgcn_s_memrealtime(); tp_c0 = __builtin_amdgcn_s_memtime(); }
#pragma unroll 1
        for (int rep = 0; rep < reps; ++rep) {
        if (rep > 0) xcd_barrier(bar, wave0 == 0 && pg8::lane_id() == 0);
        switch (kind) {
        case 0: if (EN(0)) { CASE_BEGIN(); p0_prologue(F); } break;
        case 1: if (EN(1)) { CASE_BEGIN(); norm_phase(F, xs0, xs1, ((const float*)F.in[8]), modl, 0, HN);
                if (rep == 0) convert_layer(F, 0, 0, F.G); } break;
        case 2: if (EN(2)) { CASE_BEGIN(); Order<64, 6, 0, D, D, 192> S; S.init(F.G, F.blk, HN, ws + WS_WQKV);
                EpiQKV E{{ws, l, 0}};
                pg8::gemm_phase<D, D, D / 64, 192>(F.lds, S, E, F.wave, tp_here);
                if (MK_PREFETCH && rep == 0 && F.blk >= 128) { frame_refresh(F); prefetch_region(F, ws + WS_WO, 2 * MiB, 128, F.G - 128); prefetch_region(F, ws + WS_WUP, WUP_BYTES, 128, F.G - 128); } } break;
        case 3: if (EN(3)) { CASE_BEGIN(); attn_phase(F, (const bf16_t*)(ws + WS_Q), (const bf16_t*)(ws + WS_KB), (const bf16_t*)(ws + WS_VT), (const bf16_t*)(ws + WS_CK), (const bf16_t*)(ws + WS_CVT), ((const float*)F.in[13]), H); } break;
        case 4: if (EN(4)) { CASE_BEGIN(); Order<64, 8, 0, D, D, 192> S; S.init(F.G, F.blk, HN, ws + WS_WSGI);
                EpiSgu E{{ws, l, 0}};
                pg8::gemm_phase<D, D, D / 64, 192>(F.lds, S, E, F.wave, tp_here);
                } break;
        case 5: if (EN(5)) { CASE_BEGIN(); sgu_phase(F, (const bf16_t*)(ws + WS_U), (const bf16_t*)(ws + WS_V), (const f32x2*)(ws + WS_STATS), ((const float*)F.in[15]), (const bf16_t*)(ws + WS_WS), ((const float*)F.in[17]), H); } break;
        case 6: if (EN(6)) { CASE_BEGIN(); OrderSc S{F.blk, (const char*)HN, (const char*)(ws + WS_WSCI)};
                EpiSc E{{ws, l, F.blk}};
                pg8::gemm_phase<D, D, D / 64>(F.lds, S, E, F.wave, tp_here);
                if (MK_PREFETCH && rep == 0 && F.blk >= 200) { frame_refresh(F); prefetch_region(F, ws + WS_WSCO, 2 * MiB, 200, F.G - 200); prefetch_region(F, ws + WS_WUP + 2 * WUP_BYTES, WUP_BYTES, 200, F.G - 200); } } break;
        case 7: if (EN(7)) { CASE_BEGIN(); OrderFn1 S{F.G, F.blk, (const char*)(ws + WS_A1), (const char*)HN};
                EpiFn1 E{{ws, l, 0}};
                pg8::gemm_phase<256, D, 4>(F.lds, S, E, F.wave, tp_here);
                if (MK_PREFETCH && F.blk >= 128) { frame_refresh(F); prefetch_region(F, ws + WS_A2S, 16 * MiB, 128, F.G - 128); prefetch_region(F, ws + WS_WUP + 3 * WUP_BYTES, WUP_BYTES, 128, F.G - 128); } } break;
        case 8: if (EN(8)) { CASE_BEGIN();
                if (F.blk < 128) { EpiBf16<128> E{{ws, l, 0}}; OrderFn2 S{F.blk, 1, (const char*)(ws + WS_A2S), (const char*)(ws + WS_YT)}; pg8::gemm_phase<2 * TS, 2 * TS, 2 * TS / 64, 128>(F.lds, S, E, F.wave, tp_here); }
                else { EpiBf16<256> E{{ws, l, 0}}; OrderFn2 S{F.blk, 0, (const char*)(ws + WS_A2P), (const char*)(ws + WS_YT)}; pg8::gemm_phase<2 * TP, 2 * TP, 2 * TP / 64>(F.lds, S, E, F.wave, tp_here);
                    if (MK_PREFETCH) { frame_refresh(F); prefetch_region(F, ws + WS_WFNO, 2 * MiB, 128, F.G - 128); } } } break;
        case 9: if (EN(9)) { CASE_BEGIN(); const bf16_t* mix_in = l == 2 ? H2 : H;
                const bf16_t* wout = (const bf16_t*)(ws + (l == 0 ? WS_WO : l == 1 ? WS_WSGO : l == 2 ? WS_WSCO : WS_WFNO));
                Order<64, 4, 0, D, D, 192> S; S.init(F.G, F.blk, mix_in, wout);
                EpiResNorm<false> E{{ws, l, rep ? 2 : 0}};
                if (MK_REP_SHORTK && MK_REP_KIND == 9 && rep > 0) { pg8::gemm_phase<D, D, 4, 192>(F.lds, S, E, F.wave, tp_here); break; }
                pg8::gemm_phase<D, D, D / 64, 192>(F.lds, S, E, F.wave, tp_here);
                } break;
        case 10: if (EN(11)) { CASE_BEGIN(); Order<50, 22, 1, D, D> S; S.init(F.G, F.blk, HN, ws + WS_WUP + l * WUP_BYTES);
                if (MK_REP_NULL && rep > 0) { EpiNull E{{ws, l, 0}}; pg8::gemm_phase<D, D, D / 64>(F.lds, S, E, F.wave, tp_here); }
                else if (MK_REP_SHORTK && MK_REP_KIND == 10 && rep > 0) { EpiUp E{{ws, l, 0}}; pg8::gemm_phase<D, D, 4>(F.lds, S, E, F.wave, tp_here); }
                else { EpiUp E{{ws, l, 0}};
                pg8::gemm_phase<D, D, D / 64>(F.lds, S, E, F.wave, tp_here); }
                if (rep == 0 && F.blk >= 76) { frame_refresh(F);
                    if (l < 3) { mod_items(F, 192 * (l + 1), 192 * (l + 2), 76, F.G - 76); convert_layer(F, l + 1, 76, F.G - 76); }
                    if (MK_PREFETCH) { prefetch_region(F, ws + WS_WDN + l * WDN_BYTES, WDN_BYTES, 76, F.G - 76); } } } break;
        default: if (EN(12)) { CASE_BEGIN(); Order<64, 4, 0, DFF, DFF, 192> S; S.init(F.G, F.blk, ws + WS_ACT, ws + WS_WDN + l * WDN_BYTES);
                if (l < 3) { EpiResNorm<false> E{{ws, l, 1 | (rep ? 2 : 0)}}; pg8::gemm_phase<DFF, DFF, DFF / 64, 192>(F.lds, S, E, F.wave, tp_here); }
                else { EpiResNorm<true> E{{ws, l, 1 | (rep ? 2 : 0)}}; pg8::gemm_phase<DFF, DFF, DFF / 64, 192>(F.lds, S, E, F.wave, tp_here); } } break;
        }
        }
        if (tp_here && wave0 == 0 && pg8::lane_id() == 0) { const unsigned long long r1 = __builtin_amdgcn_s_memrealtime(), c1 = __builtin_amdgcn_s_memtime();
            if (MK_TP == 1) MISC[16] = (unsigned)(r1 - tp_r0);
            if (MK_TP == 3) MISC[16] = (unsigned)((c1 - tp_c0) * 10ull / (r1 - tp_r0)) * 10u; }
        if (ph + 1 < hi) xcd_barrier(bar, wave0 == 0 && pg8::lane_id() == 0);
    }
    if (MK_TP && blk0 == 0 && wave0 == 0) { const unsigned v = MISC[16] * (MK_TP == 2 ? 4u : 1u); const unsigned long long t0 = __builtin_amdgcn_s_memrealtime();
        while (__builtin_amdgcn_s_memrealtime() - t0 < v) __builtin_amdgcn_s_sleep(8); }
}

extern "C" void kernel_launch(void* const* d_in, const int* in_sizes, int n_in, void* d_out, int out_size, void* d_ws, size_t ws_size, hipStream_t stream) {
    static int grid = 0;
    if (grid == 0) {
        if (n_in != 26 || ws_size < WS_TOTAL + (MK_REP_N ? (size_t)73 * MiB : 0)) { fprintf(stderr, "kernel_launch: unexpected n_in %d / ws %zu (need %zu)\n", n_in, ws_size, (size_t)WS_TOTAL); grid = -1; return; }
        int dev = 0, cus = 0;
        if (hipGetDevice(&dev) != hipSuccess || hipDeviceGetAttribute(&cus, hipDeviceAttributeMultiprocessorCount, dev) != hipSuccess) { grid = -1; return; }
        if (hipFuncSetAttribute((const void*)mk_fwd, hipFuncAttributeMaxDynamicSharedMemorySize, LDS_BYTES) != hipSuccess) { fprintf(stderr, "kernel_launch: hipFuncSetAttribute failed\n"); grid = -1; return; }
        (void)hipGetLastError();
        grid = cus;
    }
    if (grid < 0) return;
    (void)hipMemsetAsync((char*)d_ws + WS_CTL, 0, CTL_ZERO_BYTES, stream);
    Args a{};
    for (int i = 0; i < 26; ++i) a.in[i] = (const float*)d_in[i];
    a.out = (float*)d_out; a.ws = (unsigned char*)d_ws;
#if MK_PER_PHASE
    for (int p = MK_PH_LO; p < MK_PH_HI; ++p) { a.ph_lo = p; a.ph_hi = p + 1; hipLaunchKernelGGL(mk_fwd, dim3(grid), dim3(NWAVES * 64), LDS_BYTES, stream, a); }
#else
    a.ph_lo = MK_PH_LO; a.ph_hi = MK_PH_HI;
    hipLaunchKernelGGL(mk_fwd, dim3(grid), dim3(NWAVES * 64), LDS_BYTES, stream, a);
#endif
}
```

```cpp
#include <hip/hip_runtime.h>
#include <cstdio>

#define LAS __attribute__((address_space(3)))
#define GAS __attribute__((address_space(1)))
typedef unsigned short bf16_t;
typedef short bf16x8 __attribute__((ext_vector_type(8)));
typedef float f32x4 __attribute__((ext_vector_type(4)));
typedef float f32x2 __attribute__((ext_vector_type(2)));
typedef unsigned u32x4 __attribute__((ext_vector_type(4)));
typedef unsigned u32x2 __attribute__((ext_vector_type(2)));

constexpr int D = 1024, MP = 8192, MS = 4096, M = MP + MS, DFF = 2816, TS = 2048, TP = 256;
constexpr float EPS = 1e-6f;
constexpr int NWAVES = 8;
#ifndef MK_PER_PHASE
#define MK_PER_PHASE 0
#endif
#ifndef MK_PH_LO
#define MK_PH_LO 0
#endif
#ifndef MK_PH_HI
#define MK_PH_HI 21
#endif
#ifndef MK_MASK
#define MK_MASK 0xffffffffu
#endif
#define EN(b) (((MK_MASK) >> (b)) & 1u)
#ifndef MK_REP_KIND
#define MK_REP_KIND -1
#endif
#ifndef MK_REP_N
#define MK_REP_N 0
#endif
#ifndef MK_REP_NULL
#define MK_REP_NULL 0
#endif
#ifndef MK_REP_SHORTK
#define MK_REP_SHORTK 0
#endif
#ifndef MK_PREFETCH
#define MK_PREFETCH 1
#endif
#ifndef MK_TP
#define MK_TP 0
#endif
#ifndef MK_TP_PH
#define MK_TP_PH 10
#endif

namespace pg8 {
constexpr int BM = 256, BK = 64, HALF = 128, HTB = HALF * BK * 2, STAGE_BYTES = 8 * HTB, NXCD = 8, WGM = 8;
__host__ __device__ __forceinline__ int lds_byte(int r, int c) { const int st = (r >> 4) * 2 + (c >> 5), rr = r & 15, cc = c & 31, ob = rr * 64 + cc * 2; return st * 1024 + (ob ^ (((ob >> 9) & 1) << 5)); }
__host__ __device__ __forceinline__ void stage_rc(int b, int& R, int& C) { const int st = b / 1024, sb = b % 1024, swz = sb ^ (((sb >> 9) & 1) << 5); R = (st >> 1) * 16 + swz / 64; C = (st & 1) * 32 + (swz % 64) / 2; }
__host__ __device__ __forceinline__ int perm32(int rho) { const int n = rho >> 4, i = rho & 15; return 8 * (i >> 2) + 4 * n + (i & 3); }

struct Unit { int pm, pn, row0; const char* a; const char* b; };
struct Cfg { int lda, ldb, nt; };

__device__ __forceinline__ int lane_id() { return (int)__builtin_amdgcn_mbcnt_hi(~0u, __builtin_amdgcn_mbcnt_lo(~0u, 0u)); }
__device__ __forceinline__ unsigned cvt_pk_bf16(float lo, float hi) { unsigned r; asm volatile("v_cvt_pk_bf16_f32 %0, %1, %2" : "=v"(r) : "v"(lo), "v"(hi)); return r; }

template <int LDA, int LDB, int NT, int ROWS = 256, class Epi, class Sched>
__device__ __forceinline__ void gemm_phase(LAS unsigned char* lds, const Sched& S, const Epi& E, int wid, bool tp_on = false) {
    constexpr Cfg g{LDA, LDB, NT};
    int lane_ = lane_id(); asm volatile("" : "+v"(lane_));
    const int lane = lane_, tid = wid * 64 + lane, wr = wid >> 2, wc = wid & 3, fr = lane & 15, fq = lane >> 4;
    const int nt = g.nt;
    unsigned voffA[2], voffB[2];
#pragma unroll
    for (int i = 0; i < 2; ++i) { int R, C; stage_rc(tid * 16 + i * 8192, R, C); const int Rb = Epi::PERM ? ((R & ~31) + perm32(R & 31)) : R;
        voffA[i] = (unsigned)(R * g.lda + C) * 2u; voffB[i] = (unsigned)(Rb * g.ldb + C) * 2u; }
    unsigned voffA1[2]; voffA1[0] = ROWS == 128 ? 0u : voffA[0]; voffA1[1] = ROWS == 256 ? voffA[1] : 0u;
    const size_t kstep = (size_t)(BK * 2);
    const size_t hstepA = (size_t)HALF * g.lda * 2, hstepB = (size_t)HALF * g.ldb * 2;
    const unsigned ldsw = (unsigned)wid * 1024u;
    constexpr int NM1 = ROWS == 192 ? 2 : ROWS == 128 ? 0 : 4;
    const int aoff = lds_byte(wr * 64 + fr, fq * 8), boff = lds_byte(wc * 32 + fr, fq * 8), aoff1 = ROWS == 192 ? lds_byte(wr * 32 + fr, fq * 8) : aoff;
#define PG8_SA(b, h) (((b) * 2 + (h)) * HTB)
#define PG8_SB(b, h) ((4 + (b) * 2 + (h)) * HTB)
#define PG8_STAGE(bufoff, gbase, voff) do { _Pragma("unroll") for (int _i = 0; _i < 2; ++_i) { unsigned _vo = (voff)[_i]; asm volatile("" : "+v"(_vo)); \
        __builtin_amdgcn_global_load_lds((const unsigned*)((const char*)(gbase) + _vo), (LAS unsigned*)(lds + (bufoff) + ldsw + _i * 8192), 16, 0, 0); } } while (0)
#define PG8_LDA(dst, b, h) do { _Pragma("unroll") for (int m = 0; m < 4; ++m) _Pragma("unroll") for (int k = 0; k < 2; ++k) dst[m][k] = *(const LAS bf16x8*)(lds + PG8_SA(b, h) + aoff + m * 2048 + k * 1024); } while (0)
#define PG8_LDA1(dst, b) do { _Pragma("unroll") for (int m = 0; m < NM1; ++m) _Pragma("unroll") for (int k = 0; k < 2; ++k) dst[m][k] = *(const LAS bf16x8*)(lds + PG8_SA(b, 1) + aoff1 + m * 2048 + k * 1024); } while (0)
#define PG8_LDB(dst, b, h) do { _Pragma("unroll") for (int n = 0; n < 2; ++n) _Pragma("unroll") for (int k = 0; k < 2; ++k) dst[n][k] = *(const LAS bf16x8*)(lds + PG8_SB(b, h) + boff + n * 2048 + k * 1024); } while (0)
#define PG8_MMA(ai, bj, At, Bt) do { __builtin_amdgcn_s_setprio(1); _Pragma("unroll") for (int m = 0; m < 4; ++m) _Pragma("unroll") for (int n = 0; n < 2; ++n) _Pragma("unroll") for (int k = 0; k < 2; ++k) \
        acc[ai][bj][m][n] = __builtin_amdgcn_mfma_f32_16x16x32_bf16(Bt[n][k], At[m][k], acc[ai][bj][m][n], 0, 0, 0); __builtin_amdgcn_s_setprio(0); } while (0)
#define PG8_MMA1(bj, At, Bt) do { __builtin_amdgcn_s_setprio(1); _Pragma("unroll") for (int m = 0; m < NM1; ++m) _Pragma("unroll") for (int n = 0; n < 2; ++n) _Pragma("unroll") for (int k = 0; k < 2; ++k) \
        acc[1][bj][m][n] = __builtin_amdgcn_mfma_f32_16x16x32_bf16(Bt[n][k], At[m][k], acc[1][bj][m][n], 0, 0, 0); __builtin_amdgcn_s_setprio(0); } while (0)
#define PG8_WAIT_V(n) asm volatile("s_waitcnt vmcnt(" #n ")" ::: "memory")
#define PG8_WAIT_L(n) asm volatile("s_waitcnt lgkmcnt(" #n ")" ::: "memory")
#define PG8_BAR __builtin_amdgcn_s_barrier()
#define PG8_SCHED __builtin_amdgcn_sched_barrier(0)
    Unit cur, nxt; int ui = 0;
    if (!S.next(0, cur)) return;
    f32x4 acc[2][2][4][2];
#pragma unroll
    for (int a = 0; a < 2; ++a)
#pragma unroll
        for (int b = 0; b < 2; ++b)
#pragma unroll
            for (int m = 0; m < 4; ++m)
#pragma unroll
                for (int n = 0; n < 2; ++n) acc[a][b][m][n] = (f32x4){0.f, 0.f, 0.f, 0.f};
    bf16x8 At[4][2], B0[2][2], B1[2][2];
    const char* cA = cur.a; const char* cB = cur.b;
    PG8_STAGE(PG8_SB(0, 0), cB, voffB); PG8_STAGE(PG8_SB(0, 1), cB + hstepB, voffB); PG8_STAGE(PG8_SA(0, 0), cA, voffA); PG8_STAGE(PG8_SA(0, 1), cA + hstepA, voffA1);
    if (wr == 1) PG8_BAR;
    PG8_WAIT_V(2); PG8_BAR;
    PG8_STAGE(PG8_SB(1, 0), cB + kstep, voffB); PG8_STAGE(PG8_SA(1, 0), cA + kstep, voffA); PG8_STAGE(PG8_SB(1, 1), cB + hstepB + kstep, voffB);
    PG8_WAIT_V(6); PG8_BAR;
    for (;;) {
        const bool has_next = S.next(ui + 1, nxt);
        const char* nA = has_next ? nxt.a : cA; const char* nB = has_next ? nxt.b : cB;
        for (int t = 0; t < nt; t += 2) {
            const bool last = (t == nt - 2);
            const char* a1 = cA + (size_t)(t + 1) * kstep;
            const char* a2 = last ? nA : cA + (size_t)(t + 2) * kstep; const char* b2 = last ? nB : cB + (size_t)(t + 2) * kstep;
            const char* a3 = a2 + kstep; const char* b3 = b2 + kstep;
            PG8_LDB(B0, 0, 0); PG8_LDB(B1, 0, 1); PG8_SCHED; PG8_LDA(At, 0, 0); PG8_STAGE(PG8_SA(1, 1), a1 + hstepA, voffA1);
            PG8_WAIT_V(8); PG8_WAIT_L(0); PG8_BAR; PG8_MMA(0, 0, At, B0); PG8_MMA(0, 1, At, B1); PG8_BAR; PG8_SCHED;
            PG8_LDA1(At, 0); PG8_STAGE(PG8_SB(0, 0), b2, voffB); PG8_STAGE(PG8_SB(0, 1), b2 + hstepB, voffB); PG8_STAGE(PG8_SA(0, 0), a2, voffA);
            PG8_WAIT_V(8); PG8_WAIT_L(0); PG8_BAR; PG8_MMA1(0, At, B0); PG8_MMA1(1, At, B1); PG8_BAR; PG8_SCHED;
            PG8_LDB(B0, 1, 0); PG8_LDB(B1, 1, 1); PG8_SCHED; PG8_LDA(At, 1, 0); PG8_STAGE(PG8_SA(0, 1), a2 + hstepA, voffA1);
            PG8_WAIT_V(8); PG8_WAIT_L(0); PG8_BAR; PG8_MMA(0, 0, At, B0); PG8_MMA(0, 1, At, B1); PG8_BAR; PG8_SCHED;
            PG8_LDA1(At, 1); PG8_STAGE(PG8_SB(1, 0), b3, voffB); PG8_STAGE(PG8_SB(1, 1), b3 + hstepB, voffB); PG8_STAGE(PG8_SA(1, 0), a3, voffA);
            PG8_WAIT_V(8); PG8_WAIT_L(0); PG8_BAR; PG8_MMA1(0, At, B0); PG8_MMA1(1, At, B1); PG8_BAR; PG8_SCHED;
        }
        if (wr == 0) PG8_BAR;
        if (MK_TP == 2) { const unsigned long long t0_ = __builtin_amdgcn_s_memrealtime(); E(acc, cur, wid, ui); const unsigned long long t1_ = __builtin_amdgcn_s_memrealtime();
            if (wid == 0 && lane == 0 && tp_on) *(volatile LAS unsigned*)(lds + 131072 + 8192 + 320 + 4 * 16) += (unsigned)(t1_ - t0_); }
        else E(acc, cur, wid, ui);
        if (!has_next) break;
#pragma unroll
        for (int a = 0; a < 2; ++a)
#pragma unroll
            for (int b = 0; b < 2; ++b)
#pragma unroll
                for (int m = 0; m < 4; ++m)
#pragma unroll
                    for (int n = 0; n < 2; ++n) acc[a][b][m][n] = (f32x4){0.f, 0.f, 0.f, 0.f};
        cur = nxt; cA = nA; cB = nB; ++ui;
        if (wr == 1) PG8_BAR;
    }
    PG8_WAIT_V(0);
    PG8_BAR;
#undef PG8_SA
#undef PG8_SB
#undef PG8_STAGE
#undef PG8_LDA
#undef PG8_LDA1
#undef PG8_MMA1
#undef PG8_LDB
#undef PG8_MMA
#undef PG8_WAIT_V
#undef PG8_WAIT_L
#undef PG8_BAR
#undef PG8_SCHED
}
}
using pg8::Unit; using pg8::cvt_pk_bf16;

constexpr size_t MiB = 1u << 20;
constexpr size_t WS_CTL = 0, CTL_ZERO_BYTES = 128 * 1024;
constexpr size_t WS_MOD = 1 * MiB;
constexpr size_t WS_ROPE = WS_MOD + 512 * 1024;
constexpr size_t WS_STATS = WS_ROPE + 64 * 1024;
constexpr size_t WS_WQKV = 4 * MiB;
constexpr size_t WS_WO = WS_WQKV + 3 * MiB;
constexpr size_t WS_WSGI = WS_WO + 2 * MiB;
constexpr size_t WS_WSGO = WS_WSGI + 4 * MiB;
constexpr size_t WS_WSCI = WS_WSGO + 2 * MiB;
constexpr size_t WS_WSCO = WS_WSCI + 6 * MiB;
constexpr size_t WS_WFNO = WS_WSCO + 2 * MiB;
constexpr size_t WS_WUP = WS_WFNO + 2 * MiB;
constexpr size_t WUP_BYTES = (size_t)2 * DFF * D * 2;
constexpr size_t WS_WDN = WS_WUP + 4 * WUP_BYTES;
constexpr size_t WDN_BYTES = (size_t)D * DFF * 2;
constexpr size_t WS_WS = WS_WDN + 4 * WDN_BYTES;
constexpr size_t WS_A1 = WS_WS + 256 * 1024;
constexpr size_t WS_A2P = WS_A1 + 256 * 1024;
constexpr size_t WS_A2S = WS_A2P + 256 * 1024;
constexpr size_t WS_CK = WS_A2S + 16 * MiB;
constexpr size_t WS_CVT = WS_CK + 512 * 1024;
constexpr size_t WS_X = WS_CVT + 512 * 1024;
constexpr size_t WS_H = WS_X + (size_t)M * D * 4;
constexpr size_t WS_BIG = WS_H + (size_t)(M + 256) * D * 2;
constexpr size_t WS_END = WS_BIG + 72 * MiB;
constexpr size_t WS_ACT = WS_BIG;
constexpr size_t WS_Q = WS_BIG;
constexpr size_t WS_KB = WS_Q + 24 * MiB;
constexpr size_t WS_VT = WS_KB + 6 * MiB;
constexpr size_t WS_U = WS_BIG;
constexpr size_t WS_V = WS_BIG + 24 * MiB;
constexpr size_t WS_YB = WS_BIG;
constexpr size_t WS_YT = WS_BIG;
static_assert(WS_YB + (size_t)256 * 2 * 16 * 512 * 16 <= WS_END, "yb");
static_assert(WS_ACT + (size_t)M * DFF * 2 <= WS_END, "act");
constexpr size_t WS_H2 = WS_END;
constexpr size_t WS_HN = WS_H2 + (size_t)M * D * 2;
constexpr size_t WS_XS = WS_HN + (size_t)(M + 256) * D * 2;
constexpr size_t WS_TOTAL = WS_XS + (size_t)16 * M * 4 * 4;
constexpr size_t CTL_CNT = 16384;
constexpr size_t CTL_TMO = CTL_CNT + 16 * 64 * 64;

constexpr size_t OUT_NK = (size_t)M * D, OUT_NV = OUT_NK + (size_t)MP * 256;

#define XB_TMO      128
#define XB_XCNT(j)  (256  + 64 * (j))
#define XB_XSUB(j)  (1280 + 64 * (j))
#define XB_XGEN(j)  (2304 + 64 * (j))
#define XB_TOP      3328
#define XB_TOPGEN   3392
#define XCD_BAR_WORDS 3456
#define XB_SPIN_CAP (1u << 22)
__device__ __forceinline__ unsigned xb_ld(unsigned* p)              { return __hip_atomic_load(p, __ATOMIC_RELAXED, __HIP_MEMORY_SCOPE_AGENT); }
__device__ __forceinline__ unsigned xb_add(unsigned* p, unsigned v) { return __hip_atomic_fetch_add(p, v, __ATOMIC_RELAXED, __HIP_MEMORY_SCOPE_AGENT); }
__device__ __forceinline__ unsigned xb_xcc_id() { return (unsigned)__builtin_amdgcn_s_getreg((3 << 11) | 20) & 0xFu; }
#define XB_SPIN(cond, bar) do { unsigned _sp = 0; while (cond) { __builtin_amdgcn_s_sleep(1); \
    if ((++_sp & 255u) == 0u) { if (xb_ld(&(bar)[XB_TMO])) break; if (_sp > XB_SPIN_CAP) { atomicAdd(&(bar)[XB_TMO], 1u); break; } } } } while (0)
struct XcdBarrier { unsigned* bar; unsigned x; volatile LAS unsigned* st; };
__device__ __forceinline__ XcdBarrier xcd_barrier_post(unsigned* bar, volatile LAS unsigned* st, bool leader) {
    XcdBarrier b; b.bar = bar; b.x = xb_xcc_id(); b.st = st;
    if (leader) (void)xb_add(&bar[XB_XCNT(b.x)], 1u);
    return b;
}
__device__ __forceinline__ void xcd_barrier_complete(unsigned* bar, unsigned x, unsigned& nloc, unsigned& nx) {
    const unsigned G = gridDim.x * gridDim.y * gridDim.z;
    unsigned sum, cnt, mine, sp = 0u;
    for (;;) {
        sum = 0u; cnt = 0u; mine = 0u;
#pragma unroll
        for (unsigned j = 0; j < 16; ++j) { const unsigned c = xb_ld(&bar[XB_XCNT(j)]); sum += c; cnt += (c > 0u) ? 1u : 0u; }
        mine = xb_ld(&bar[XB_XCNT(x)]);
        if (sum == G) break;
        __builtin_amdgcn_s_sleep(1);
        if ((++sp & 255u) == 0u) { if (xb_ld(&bar[XB_TMO])) break; if (sp > XB_SPIN_CAP) { atomicAdd(&bar[XB_TMO], 1u); break; } }
    }
    nloc = mine > 0u ? mine : 1u; nx = cnt > 0u ? cnt : 1u;
}
__device__ __forceinline__ void xcd_barrier(const XcdBarrier& b, bool leader) {
    asm volatile("s_waitcnt vmcnt(0)" ::: "memory");
    __syncthreads();
    if (leader) {
        unsigned* bar = b.bar; unsigned bx = b.x; asm volatile("" : "+s"(bx));
        __builtin_amdgcn_s_waitcnt(0);
        unsigned nloc = b.st[0], nx = b.st[1];
        if (nloc == 0u) { xcd_barrier_complete(bar, bx, nloc, nx); b.st[0] = nloc; b.st[1] = nx; }
        const unsigned old = xb_add(&bar[XB_XSUB(bx)], 1u);
        const unsigned gen = old / nloc;
        if (old + 1u == (gen + 1u) * nloc) {
            __builtin_amdgcn_fence(__ATOMIC_RELEASE, "agent");
            asm volatile("s_waitcnt vmcnt(0)" ::: "memory");
            const unsigned og = xb_add(&bar[XB_TOP], 1u);
            const unsigned tg = og / nx;
            if (og + 1u == (tg + 1u) * nx) xb_add(&bar[XB_TOPGEN], 1u);
            else XB_SPIN(xb_ld(&bar[XB_TOPGEN]) == tg, bar);
            __builtin_amdgcn_fence(__ATOMIC_ACQUIRE, "agent");
            xb_add(&bar[XB_XGEN(bx)], 1u);
            asm volatile("s_waitcnt vmcnt(0)" ::: "memory");
        } else {
            XB_SPIN(xb_ld(&bar[XB_XGEN(bx)]) == gen, bar);
            __builtin_amdgcn_fence(__ATOMIC_ACQUIRE, "agent");
            asm volatile("s_waitcnt vmcnt(0)" ::: "memory");
        }
    }
    __syncthreads();
}

#define LDS_WAIT() asm volatile("s_waitcnt lgkmcnt(0)" ::: "memory")
__device__ __forceinline__ unsigned f2bf(float f) { unsigned u = __builtin_bit_cast(unsigned, f); return (u + 0x7fffu + ((u >> 16) & 1u)) >> 16; }
__device__ __forceinline__ unsigned pk2(float lo, float hi) { return f2bf(lo) | (f2bf(hi) << 16); }
__device__ __forceinline__ float bf2f(unsigned short b) { return __builtin_bit_cast(float, (unsigned)b << 16); }
__device__ __forceinline__ float rows_max(float x) {
    auto s = __builtin_amdgcn_permlane16_swap(__float_as_uint(x), __float_as_uint(x), false, false); x = fmaxf(__uint_as_float(s[0]), __uint_as_float(s[1]));
    auto t = __builtin_amdgcn_permlane32_swap(__float_as_uint(x), __float_as_uint(x), false, false); return fmaxf(__uint_as_float(t[0]), __uint_as_float(t[1])); }
__device__ __forceinline__ float rows_sum(float x) {
    auto s = __builtin_amdgcn_permlane16_swap(__float_as_uint(x), __float_as_uint(x), false, false); x = __uint_as_float(s[0]) + __uint_as_float(s[1]);
    auto t = __builtin_amdgcn_permlane32_swap(__float_as_uint(x), __float_as_uint(x), false, false); return __uint_as_float(t[0]) + __uint_as_float(t[1]); }
template <int CTRL> __device__ __forceinline__ float dppx(float v) { return __builtin_bit_cast(float, __builtin_amdgcn_mov_dpp(__builtin_bit_cast(int, v), CTRL, 0xf, 0xf, true)); }
__device__ __forceinline__ float wave_sum(float v) {
    v += dppx<0xB1>(v);
    v += dppx<0x4E>(v);
    v += dppx<0x141>(v);
    v += dppx<0x140>(v);
    return rows_sum(v);
}
__device__ __forceinline__ float fast_exp2(float x) { return __builtin_amdgcn_exp2f(x); }
__device__ __forceinline__ float fast_rcp(float x) { return __builtin_amdgcn_rcpf(x); }
__device__ __forceinline__ float silu_f(float x) { return x * fast_rcp(1.f + fast_exp2(-1.4426950408889634f * x)); }
__device__ __forceinline__ float gelu_f(float x) { const float u = x * (1.f + 0.044715f * x * x); return x * fast_rcp(1.f + fast_exp2(-2.302208198f * u)); }
__device__ __forceinline__ int conv_row0(int pm) { if (pm < 32) return 256 * pm; const int s = (pm - 32) / 9, i = (pm - 32) % 9; return MP + TS * s + 254 * i - 1; }
template <int CTRL> __device__ __forceinline__ float dpp(float v) { return __builtin_bit_cast(float, __builtin_amdgcn_mov_dpp(__builtin_bit_cast(int, v), CTRL, 0xf, 0xf, true)); }
template <int CTRL> __device__ __forceinline__ f32x4 dpp4(f32x4 v) { return (f32x4){dpp<CTRL>(v[0]), dpp<CTRL>(v[1]), dpp<CTRL>(v[2]), dpp<CTRL>(v[3])}; }
#define DPP_ROR1 0x121
#define DPP_ROR15 0x12F

template <int NM, int NN, int CONV, int LDA, int LDB, int ROWS = 256>
struct Order {
    int G, c; const char* A; const char* B;
    __device__ __forceinline__ void init(int G_, int c_, const void* A_, const void* B_) { G = G_; c = c_; A = (const char*)A_; B = (const char*)B_; }
    __device__ __forceinline__ bool next(int i, Unit& u) const {
        constexpr int nwg = NM * NN;
        const int L = i * G + c; if (L >= nwg) return false;
        int wgid = L; { constexpr int q = nwg / pg8::NXCD, r = nwg % pg8::NXCD; const int xcd = wgid % pg8::NXCD, off = wgid / pg8::NXCD; wgid = (xcd < r ? xcd * (q + 1) : r * (q + 1) + (xcd - r) * q) + off; }
        constexpr int nig = pg8::WGM * NN; const int gid = wgid / nig, fm = gid * pg8::WGM, gsz = (NM - fm) < pg8::WGM ? (NM - fm) : pg8::WGM;
        u.pm = fm + ((wgid % nig) % gsz); u.pn = (wgid % nig) / gsz;
        u.row0 = CONV ? conv_row0(u.pm) : ROWS * u.pm;
        u.a = A + (long)u.row0 * (long)(LDA * 2); u.b = B + (size_t)u.pn * (size_t)(256 * LDB * 2); return true;
    }
};

typedef const GAS float* cfp_t;
struct Frame {
    LAS unsigned char* lds; int tid, lane, wave, G, blk;
    const __attribute__((address_space(4))) cfp_t* in; float* out; unsigned char* ws;
};
__device__ __forceinline__ void frame_refresh(Frame& F) {
    int ln = pg8::lane_id(); asm volatile("" : "+v"(ln)); F.lane = ln; F.tid = F.wave * 64 + ln;
}
constexpr int RING_BYTES = 131072, XCH_OFF = RING_BYTES  , MISC_OFF = XCH_OFF + 8192 + 320, LDS_BYTES = 147456;
__device__ __forceinline__ int vec_plain(int pm) { return pm < 32 ? 0 : 1 + (pm - 32) / 8; }
__device__ __forceinline__ int vec_conv(int pm) { return pm < 32 ? 0 : 1 + (pm - 32) / 9; }

__device__ __forceinline__ constexpr int r192_nm(int ai) { return ai ? 2 : 4; }
__device__ __forceinline__ int r192_base(int ai, int wr) { return ai ? 128 + 32 * wr : 64 * wr; }
struct EpiBase {
    unsigned char* ws_; int l, aux;
    __device__ __forceinline__ unsigned char* wsp() const { unsigned long long w = (unsigned long long)ws_; asm volatile("" : "+s"(w)); return (unsigned char*)(GAS unsigned char*)w; }
    __device__ __forceinline__ static const __attribute__((address_space(4))) cfp_t* kargs() { unsigned long long kp = (unsigned long long)__builtin_amdgcn_kernarg_segment_ptr(); asm volatile("" : "+s"(kp)); return (const __attribute__((address_space(4))) cfp_t*)kp; }
    __device__ __forceinline__ static const float* inp(const __attribute__((address_space(4))) cfp_t* ka, int k) { return (const float*)ka[k]; }
    __device__ __forceinline__ static float* outp(const __attribute__((address_space(4))) cfp_t* ka) { return (float*)(GAS float*)ka[26]; }
    __device__ __forceinline__ static LAS float* xch() { extern __shared__ __attribute__((aligned(16))) unsigned char lds_base_[]; return (LAS float*)((LAS unsigned char*)lds_base_ + XCH_OFF); }
};
template <bool FINAL>
struct EpiResNorm : EpiBase {
    static constexpr bool PERM = false;
    static constexpr int TR = 192;
    __device__ __forceinline__ static int nm(int ai) { return ai ? 2 : 4; }
    __device__ __forceinline__ static int rbase(int ai, int wr) { return ai ? 128 + 32 * wr : 64 * wr; }
    __device__ __forceinline__ void operator()(f32x4 (&acc)[2][2][4][2], const Unit& u, int wid, int ) const {
        int lane_ = pg8::lane_id(); asm volatile("" : "+v"(lane_));
        const int lane = lane_, wr = wid >> 2, wc = wid & 3, fr = lane & 15, fq = lane >> 4;
        unsigned char* ws = wsp(); const auto ka = kargs();
        const int isdn = aux & 1, rep = (aux >> 1) & 1, inst = 2 * l + isdn + 8 * rep;
        typedef _Float16 h4 __attribute__((ext_vector_type(4)));
        _Float16* Xr = (_Float16*)(ws + WS_X); _Float16* X = rep ? (_Float16*)(ws + WS_TOTAL) : Xr;
        const bool srcf32 = (!isdn && l == 0);
        const float* modl = (const float*)(ws + WS_MOD) + l * 3 * 6 * D; const int gate_idx = isdn ? 5 : 2;
        const float* gn = FINAL ? inp(ka, 10) : (isdn ? inp(ka, 8) + (l + 1) * D : inp(ka, 9) + l * D);
        const float* modn = isdn ? modl + 3 * 6 * D : modl; const int sh_idx = isdn ? 0 : 3;
        bf16_t* HN = (bf16_t*)(ws + (rep ? WS_TOTAL + 48 * MiB : WS_HN)); float* Y = rep ? (float*)(ws + WS_TOTAL) : outp(ka);
        float* xs = (float*)(ws + WS_XS) + (size_t)inst * M * 4; unsigned* cnt = (unsigned*)(ws + WS_CTL + CTL_CNT) + inst * 64 * 16; unsigned* tmo = (unsigned*)(ws + WS_CTL + CTL_TMO);
        LAS float* L = xch();
        const int col0 = u.pn * 256 + wc * 32 + 4 * fq, tid = wid * 64 + lane;
        LAS float* P = L;
        LAS float* S = L + 1024;
#pragma unroll
        for (int ai = 0; ai < 2; ++ai) {
            const int rb = u.row0 + rbase(ai, wr);
            const int vec = rb < MP ? 0 : 1 + (rb - MP) / TS;
            const float* gate = modl + vec * 6 * D + gate_idx * D;
            const float* src = rb < MP ? inp(ka, 0) + (size_t)rb * D : inp(ka, 1) + (size_t)(rb - MP) * D;
            f32x4 gv[2][2];
#pragma unroll
            for (int bj = 0; bj < 2; ++bj)
#pragma unroll
                for (int n = 0; n < 2; ++n) gv[bj][n] = *(const f32x4*)(gate + col0 + bj * 128 + n * 16);
            f32x4 sv[4][2][2];
#pragma unroll
            for (int m = 0; m < 4; ++m) if (m < nm(ai)) { const size_t ro = (size_t)(16 * m + fr) * D + col0;
#pragma unroll
                for (int bj = 0; bj < 2; ++bj)
#pragma unroll
                    for (int n = 0; n < 2; ++n) { if (srcf32) sv[m][bj][n] = *(const f32x4*)(src + ro + bj * 128 + n * 16);
                        else sv[m][bj][n] = __builtin_convertvector(*(const h4*)(Xr + (size_t)rb * D + ro + bj * 128 + n * 16), f32x4); } }
#pragma unroll
            for (int m = 0; m < 4; ++m) if (m < nm(ai)) { const int r = rbase(ai, wr) + 16 * m + fr; float ss = 0.f;
#pragma unroll
                for (int bj = 0; bj < 2; ++bj)
#pragma unroll
                    for (int n = 0; n < 2; ++n) { const f32x4 x1 = sv[m][bj][n] + gv[bj][n] * acc[ai][bj][m][n]; acc[ai][bj][m][n] = x1;
                        ss += (x1[0] * x1[0] + x1[1] * x1[1]) + (x1[2] * x1[2] + x1[3] * x1[3]); }
                ss = rows_sum(ss);
                if (fq == 0) P[r * 4 + wc] = ss; }
            asm volatile("" ::: "memory"); }
        LDS_WAIT(); __builtin_amdgcn_s_barrier(); asm volatile("" ::: "memory");
        if (tid < TR) { const f32x4 p = *(const LAS f32x4*)(P + tid * 4); const float tot = (p[0] + p[1]) + (p[2] + p[3]);
            __hip_atomic_store(xs + (size_t)(u.row0 + tid) * 4 + u.pn, tot, __ATOMIC_RELAXED, __HIP_MEMORY_SCOPE_AGENT); }
        asm volatile("s_waitcnt vmcnt(0)" ::: "memory");
        if (tid < TR && (tid & 63) == 0) __hip_atomic_fetch_add(cnt + 16 * u.pm, 1u, __ATOMIC_RELAXED, __HIP_MEMORY_SCOPE_AGENT);
        if (!FINAL) {
#pragma unroll
            for (int ai = 0; ai < 2; ++ai)
#pragma unroll
                for (int m = 0; m < 4; ++m) if (m < nm(ai)) { _Float16* xp = X + (size_t)(u.row0 + rbase(ai, wr) + 16 * m + fr) * D + col0;
#pragma unroll
                    for (int bj = 0; bj < 2; ++bj)
#pragma unroll
                        for (int n = 0; n < 2; ++n) *(h4*)(xp + bj * 128 + n * 16) = __builtin_convertvector(acc[ai][bj][m][n], h4); }
        }
        if (tid < 64) { unsigned sp_ = 0;
            while ((unsigned)__builtin_amdgcn_readfirstlane(__hip_atomic_load(cnt + 16 * u.pm, __ATOMIC_RELAXED, __HIP_MEMORY_SCOPE_AGENT)) < 12u) {
                __builtin_amdgcn_s_sleep(1);
                if ((++sp_ & 1023u) == 0u) { if (__hip_atomic_load(tmo, __ATOMIC_RELAXED, __HIP_MEMORY_SCOPE_AGENT)) break; if (sp_ > (1u << 22)) { __hip_atomic_store(tmo, 1u, __ATOMIC_RELAXED, __HIP_MEMORY_SCOPE_AGENT); break; } } }
        }
        asm volatile("s_waitcnt lgkmcnt(0)" ::: "memory"); __builtin_amdgcn_s_barrier(); asm volatile("" ::: "memory");
        if (tid < TR) { const float* sl = xs + (size_t)(u.row0 + tid) * 4; float t = 0.f;
#pragma unroll
            for (int k = 0; k < 4; ++k) t += __hip_atomic_load(sl + k, __ATOMIC_RELAXED, __HIP_MEMORY_SCOPE_AGENT);
            S[tid] = rsqrtf(t * (1.f / D) + EPS); }
        LDS_WAIT(); __builtin_amdgcn_s_barrier(); asm volatile("" ::: "memory");
#pragma unroll
        for (int ai = 0; ai < 2; ++ai) {
            const int rb = u.row0 + rbase(ai, wr); const int vec = rb < MP ? 0 : 1 + (rb - MP) / TS;
            f32x4 gm[2][2], sh[2][2];
#pragma unroll
            for (int bj = 0; bj < 2; ++bj)
#pragma unroll
                for (int n = 0; n < 2; ++n) { const int c = col0 + bj * 128 + n * 16; gm[bj][n] = *(const f32x4*)(gn + c);
                    if (!FINAL) { const float* mv = modn + vec * 6 * D; gm[bj][n] = gm[bj][n] * (1.f + *(const f32x4*)(mv + (sh_idx + 1) * D + c)); sh[bj][n] = *(const f32x4*)(mv + sh_idx * D + c); } }
#pragma unroll
            for (int m = 0; m < 4; ++m) if (m < nm(ai)) { const int r = rbase(ai, wr) + 16 * m + fr; const float rs = S[r];
#pragma unroll
                for (int bj = 0; bj < 2; ++bj)
#pragma unroll
                    for (int n = 0; n < 2; ++n) { const int c = col0 + bj * 128 + n * 16;
                        if (FINAL) { *(f32x4*)(Y + (size_t)(u.row0 + r) * D + c) = acc[ai][bj][m][n] * rs * gm[bj][n]; }
                        else { const f32x4 h = acc[ai][bj][m][n] * rs * gm[bj][n] + sh[bj][n]; u32x2 w; w.x = cvt_pk_bf16(h[0], h[1]); w.y = cvt_pk_bf16(h[2], h[3]); *(u32x2*)(HN + (size_t)(u.row0 + r) * D + c) = w; } } }
        }
    }
};
struct EpiNull : EpiBase {
    static constexpr bool PERM = true;
    __device__ __forceinline__ void operator()(f32x4 (&acc)[2][2][4][2], const Unit& u, int wid, int) const {
        f32x4 s = {0.f, 0.f, 0.f, 0.f};
#pragma unroll
        for (int ai = 0; ai < 2; ++ai)
#pragma unroll
            for (int bj = 0; bj < 2; ++bj)
#pragma unroll
                for (int m = 0; m < 4; ++m)
#pragma unroll
                    for (int n = 0; n < 2; ++n) s += acc[ai][bj][m][n];
        ((f32x4*)(wsp() + WS_TOTAL))[(size_t)(u.pm * 22 + u.pn) * 512 + wid * 64 + pg8::lane_id()] = s;
    }
};
template <int ROWS> struct EpiBf16 : EpiBase {
    static constexpr bool PERM = true;
    __device__ __forceinline__ void operator()(const f32x4 (&acc)[2][2][4][2], const Unit& u, int wid, int ) const {
        int lane_ = pg8::lane_id(); asm volatile("" : "+v"(lane_));
        const int lane = lane_, wr = wid >> 2, wc = wid & 3, fr = lane & 15, fq = lane >> 4; (void)wr; (void)wc; (void)fr; (void)fq;
        bf16_t* O = (bf16_t*)(wsp() + WS_H); constexpr int ldc = D;
        const int col0 = u.pn * 256 + wc * 32 + 8 * fq;
#pragma unroll
        for (int ai = 0; ai < (ROWS == 128 ? 1 : 2); ++ai)
#pragma unroll
            for (int m = 0; m < 4; ++m) { bf16_t* rowp = O + (size_t)(u.row0 + ai * 128 + wr * 64 + m * 16 + fr) * ldc + col0;
#pragma unroll
                for (int bj = 0; bj < 2; ++bj) { const f32x4 v0 = acc[ai][bj][m][0], v1 = acc[ai][bj][m][1];
                    u32x4 w; w.x = cvt_pk_bf16(v0[0], v0[1]); w.y = cvt_pk_bf16(v0[2], v0[3]); w.z = cvt_pk_bf16(v1[0], v1[1]); w.w = cvt_pk_bf16(v1[2], v1[3]);
                    *(u32x4*)(rowp + bj * 128) = w; } }
    }
};
struct EpiQKV : EpiBase {
    static constexpr bool PERM = false;
    __device__ __forceinline__ void operator()(f32x4 (&acc)[2][2][4][2], const Unit& u, int wid, int ) const {
        int lane_ = pg8::lane_id(); asm volatile("" : "+v"(lane_));
        const int lane = lane_, wr = wid >> 2, wc = wid & 3, fr = lane & 15, fq = lane >> 4;
        unsigned char* ws = wsp(); bf16_t* Q = (bf16_t*)(ws + WS_Q); bf16_t* KB = (bf16_t*)(ws + WS_KB); bf16_t* VT = (bf16_t*)(ws + WS_VT); const float* rope = (const float*)(ws + WS_ROPE);
        float* outk = outp(kargs()) + OUT_NK; float* outv = outk + (OUT_NV - OUT_NK);
        const int c0 = wc * 32 + 4 * fq;
#pragma unroll
        for (int ai = 0; ai < 2; ++ai) {
            const int rb = u.row0 + r192_base(ai, wr); const bool samp = rb >= MP;
            if (samp && u.pn <= 4) {
                const int half = wc & 1;
#pragma unroll
                for (int m = 0; m < 4; ++m) if (m < r192_nm(ai)) { const int t = (rb - MP + m * 16 + fr) & (TS - 1); const int pos = half ? (t & 63) : (t >> 6);
                    const f32x4 cs = *(const f32x4*)(rope + pos * 16 + 4 * fq), sn = *(const f32x4*)(rope + 1024 + pos * 16 + 4 * fq);
#pragma unroll
                    for (int bj = 0; bj < 2; ++bj) { const f32x4 x1 = acc[ai][bj][m][0], x2 = acc[ai][bj][m][1]; acc[ai][bj][m][0] = x1 * cs - x2 * sn; acc[ai][bj][m][1] = x2 * cs + x1 * sn; } }
            }
            if (u.pn <= 4) {
                bf16_t* base = u.pn < 4 ? Q + u.pn * 256 : KB; const int ldc = u.pn < 4 ? D : 256;
#pragma unroll
                for (int m = 0; m < 4; ++m) if (m < r192_nm(ai)) { const int row = rb + m * 16 + fr; bf16_t* rowp = base + (size_t)row * ldc + c0;
#pragma unroll
                    for (int bj = 0; bj < 2; ++bj)
#pragma unroll
                        for (int n = 0; n < 2; ++n) { const f32x4 v = acc[ai][bj][m][n]; u32x2 w; w.x = cvt_pk_bf16(v[0], v[1]); w.y = cvt_pk_bf16(v[2], v[3]); *(u32x2*)(rowp + bj * 128 + n * 16) = w;
                            if (u.pn == 4 && !samp) *(f32x4*)(outk + (size_t)row * 256 + c0 + bj * 128 + n * 16) = v; } }
            } else {
                const int T = samp ? TS : TP;
                bf16_t* vt = samp ? VT + (size_t)32 * 65536 + (size_t)((rb - MP) / TS) * 256 * TS : VT + (size_t)(rb / TP) * 65536;
#pragma unroll
                for (int m = 0; m < 4; ++m) if (m < r192_nm(ai)) { const int row = rb + m * 16 + fr; const int t = samp ? ((row - MP) & (TS - 1)) : (row & (TP - 1));
                    unsigned vo = (unsigned)(c0 * T + t); asm volatile("" : "+v"(vo));
#pragma unroll
                    for (int bj = 0; bj < 2; ++bj)
#pragma unroll
                        for (int n = 0; n < 2; ++n) { const f32x4 v = acc[ai][bj][m][n]; const int c = c0 + bj * 128 + n * 16;
#pragma unroll
                            for (int j = 0; j < 4; ++j) vt[vo + (unsigned)((bj * 128 + n * 16 + j) * T)] = (bf16_t)f2bf(v[j]);
                            if (!samp) *(f32x4*)(outv + (size_t)row * 256 + c) = v; } }
            }
        }
    }
};
__device__ __forceinline__ f32x4 conv_m(f32x4 cur, f32x4 pe, f32x4 ne, f32x4 w0, f32x4 w1, f32x4 w2, int fr) {
    const f32x4 up = dpp4<DPP_ROR1>(cur), dn = dpp4<DPP_ROR15>(cur);
    const f32x4 prev = fr > 0 ? up : pe, next = fr < 15 ? dn : ne;
    return w0 * prev + w1 * cur + w2 * next;
}
__device__ __forceinline__ void mask_rows(f32x4 (&acc)[2][2][4][2], const Unit& u, int wr, int fr) {
    if (u.pm < 32) return;
    const int i = (u.pm - 32) % 9; if (i != 0 && i != 8) return;
    const int t0 = 254 * i - 1;
#pragma unroll
    for (int ai = 0; ai < 2; ++ai)
#pragma unroll
        for (int m = 0; m < 4; ++m) { const int t = t0 + ai * 128 + wr * 64 + m * 16 + fr; if (t < 0 || t >= TS) {
#pragma unroll
            for (int bj = 0; bj < 2; ++bj)
#pragma unroll
                for (int n = 0; n < 2; ++n) acc[ai][bj][m][n] = (f32x4){0.f, 0.f, 0.f, 0.f}; } }
}
__device__ __forceinline__ bool row_valid(const Unit& u, int r) {
    if (u.pm < 32) return true;
    const int t = 254 * ((u.pm - 32) % 9) - 1 + r; return r >= 1 && r <= 254 && t >= 0 && t < TS;
}
__device__ __forceinline__ void xch_write(LAS float* X, const f32x4 (&acc)[2][2][4][2], int wr, int wc, int fr, int fq) {
#pragma unroll
    for (int ai = 0; ai < 2; ++ai)
#pragma unroll
        for (int bj = 0; bj < 2; ++bj)
#pragma unroll
            for (int n = 0; n < 2; ++n) { const int col = bj * 128 + wc * 32 + 8 * fq + 4 * n;
                if (fr == 0) *(LAS f32x4*)(X + ((2 * ai + wr) * 2 + 0) * 256 + col) = acc[ai][bj][0][n];
                if (fr == 15) *(LAS f32x4*)(X + ((2 * ai + wr) * 2 + 1) * 256 + col) = acc[ai][bj][3][n]; }
}
__device__ __forceinline__ f32x4 xch_top(const LAS float* X, int b, int col) { return b > 0 ? *(const LAS f32x4*)(X + ((b - 1) * 2 + 1) * 256 + col) : (f32x4){0.f, 0.f, 0.f, 0.f}; }
__device__ __forceinline__ f32x4 xch_bot(const LAS float* X, int b, int col) { return b < 3 ? *(const LAS f32x4*)(X + ((b + 1) * 2 + 0) * 256 + col) : (f32x4){0.f, 0.f, 0.f, 0.f}; }

struct EpiUp : EpiBase {
    static constexpr bool PERM = true;
    __device__ __forceinline__ void operator()(f32x4 (&acc)[2][2][4][2], const Unit& u, int wid, int ) const {
        int lane_ = pg8::lane_id(); asm volatile("" : "+v"(lane_));
        const int lane = lane_, wr = wid >> 2, wc = wid & 3, fr = lane & 15, fq = lane >> 4; (void)wr; (void)wc; (void)fr; (void)fq;
        bf16_t* ACT = (bf16_t*)(wsp() + WS_ACT); const float* cw = inp(kargs(), 24) + (size_t)l * 3 * 2 * DFF; LAS float* X = xch();
        mask_rows(acc, u, wr, fr);
        xch_write(X, acc, wr, wc, fr, fq);
        LDS_WAIT(); __builtin_amdgcn_s_barrier(); asm volatile("" ::: "memory");
        const int chl = wc * 32 + 8 * fq;
#pragma unroll
        for (int n = 0; n < 2; ++n) {
            const int ch = u.pn * 128 + chl + 4 * n;
            f32x4 wg[3], wu[3];
#pragma unroll
            for (int k = 0; k < 3; ++k) { wg[k] = *(const f32x4*)(cw + k * 2 * DFF + ch); wu[k] = *(const f32x4*)(cw + k * 2 * DFF + DFF + ch); }
#pragma unroll
            for (int ai = 0; ai < 2; ++ai) {
                const int b = 2 * ai + wr;
                f32x4 pg = xch_top(X, b, chl + 4 * n), pu = xch_top(X, b, 128 + chl + 4 * n);
#pragma unroll
                for (int m = 0; m < 4; ++m) { const int r = ai * 128 + wr * 64 + m * 16 + fr;
                    const f32x4 vg = acc[ai][0][m][n], vu = acc[ai][1][m][n];
                    const f32x4 ng = m < 3 ? dpp4<DPP_ROR15>(acc[ai][0][m < 3 ? m + 1 : 3][n]) : xch_bot(X, b, chl + 4 * n);
                    const f32x4 nu = m < 3 ? dpp4<DPP_ROR15>(acc[ai][1][m < 3 ? m + 1 : 3][n]) : xch_bot(X, b, 128 + chl + 4 * n);
                    const f32x4 og = conv_m(vg, pg, ng, wg[0], wg[1], wg[2], fr), ou = conv_m(vu, pu, nu, wu[0], wu[1], wu[2], fr);
                    pg = dpp4<DPP_ROR1>(vg); pu = dpp4<DPP_ROR1>(vu);
                    f32x4 a;
#pragma unroll
                    for (int j = 0; j < 4; ++j) a[j] = silu_f(og[j]) * ou[j];
                    if (row_valid(u, r)) { u32x2 w; w.x = cvt_pk_bf16(a[0], a[1]); w.y = cvt_pk_bf16(a[2], a[3]); *(u32x2*)(ACT + (size_t)(u.row0 + r) * DFF + ch) = w; } }
            }
        }
    }
};
struct EpiSgu : EpiBase {
    static constexpr bool PERM = true;
    __device__ __forceinline__ void operator()(f32x4 (&acc)[2][2][4][2], const Unit& u, int wid, int ) const {
        int lane_ = pg8::lane_id(); asm volatile("" : "+v"(lane_));
        const int lane = lane_, wr = wid >> 2, wc = wid & 3, fr = lane & 15, fq = lane >> 4;
        unsigned char* ws = wsp(); bf16_t* U = (bf16_t*)(ws + WS_U); bf16_t* V = (bf16_t*)(ws + WS_V); f32x2* STATS = (f32x2*)(ws + WS_STATS);
        const bool isv = u.pn >= 4; bf16_t* O = isv ? V : U; const int col0 = (u.pn & 3) * 256 + wc * 32 + 8 * fq;
#pragma unroll
        for (int ai = 0; ai < 2; ++ai)
#pragma unroll
            for (int m = 0; m < 4; ++m) if (m < r192_nm(ai)) { const int row = u.row0 + r192_base(ai, wr) + m * 16 + fr; bf16_t* rowp = O + (size_t)row * D + col0; float s1 = 0.f, s2 = 0.f;
#pragma unroll
                for (int bj = 0; bj < 2; ++bj) { f32x4 v0 = acc[ai][bj][m][0], v1 = acc[ai][bj][m][1];
#pragma unroll
                    for (int j = 0; j < 4; ++j) { v0[j] = gelu_f(v0[j]); v1[j] = gelu_f(v1[j]); s1 += v0[j] + v1[j]; s2 += v0[j] * v0[j] + v1[j] * v1[j]; }
                    u32x4 w; w.x = cvt_pk_bf16(v0[0], v0[1]); w.y = cvt_pk_bf16(v0[2], v0[3]); w.z = cvt_pk_bf16(v1[0], v1[1]); w.w = cvt_pk_bf16(v1[2], v1[3]);
                    *(u32x4*)(rowp + bj * 128) = w; }
                if (isv) { s1 = rows_sum(s1); s2 = rows_sum(s2);
                    if (fq == 0) STATS[(size_t)row * 16 + (u.pn - 4) * 4 + wc] = (f32x2){s1, s2}; } }
    }
};
struct EpiSc : EpiBase {
    static constexpr bool PERM = true;
    __device__ __forceinline__ void operator()(f32x4 (&acc)[2][2][4][2], const Unit& u, int wid, int ui) const {
        int lane_ = pg8::lane_id(); asm volatile("" : "+v"(lane_));
        const int lane = lane_, wr = wid >> 2, wc = wid & 3, fr = lane & 15, fq = lane >> 4; (void)wr; (void)wc; (void)fr; (void)fq;
        unsigned char* ws = wsp(); f32x4* YB = (f32x4*)(ws + WS_YB) + (size_t)aux * 2 * 16 * 512; bf16_t* BY = (bf16_t*)(ws + WS_H2); const float* cw = inp(kargs(), 20); LAS float* X = xch();
        const int q = u.pn / 3, s = u.pn % 3, chl = wc * 32 + 8 * fq;
        if (s < 2) {
            mask_rows(acc, u, wr, fr);
#pragma unroll
            for (int ai = 0; ai < 2; ++ai)
#pragma unroll
                for (int m = 0; m < 4; ++m)
#pragma unroll
                    for (int n = 0; n < 2; ++n) acc[ai][0][m][n] = acc[ai][0][m][n] * acc[ai][1][m][n];
            xch_write(X, acc, wr, wc, fr, fq);
            LDS_WAIT(); __builtin_amdgcn_s_barrier(); asm volatile("" ::: "memory");
#pragma unroll
            for (int n = 0; n < 2; ++n) {
                const int ch = q * 256 + s * 128 + chl + 4 * n;
                f32x4 w[3];
#pragma unroll
                for (int k = 0; k < 3; ++k) w[k] = *(const f32x4*)(cw + k * D + ch);
#pragma unroll
                for (int ai = 0; ai < 2; ++ai) { const int b = 2 * ai + wr;
                    f32x4 pp = xch_top(X, b, chl + 4 * n);
#pragma unroll
                    for (int m = 0; m < 4; ++m) { const f32x4 v = acc[ai][0][m][n];
                        const f32x4 nn = m < 3 ? dpp4<DPP_ROR15>(acc[ai][0][m < 3 ? m + 1 : 3][n]) : xch_bot(X, b, chl + 4 * n);
                        const f32x4 o = conv_m(v, pp, nn, w[0], w[1], w[2], fr); pp = dpp4<DPP_ROR1>(v);
                        unsigned yo = (unsigned)((s * 16 + (ai * 4 + m) * 2 + n) * 512) + (unsigned)(wid * 64 + lane); asm volatile("" : "+v"(yo)); YB[yo] = o; } }
            }
        } else {
#pragma unroll
            for (int ai = 0; ai < 2; ++ai) {
                f32x4 y[4][2][2];
#pragma unroll
                for (int m = 0; m < 4; ++m)
#pragma unroll
                    for (int bj = 0; bj < 2; ++bj) { unsigned yo = (unsigned)((bj * 16 + (ai * 4 + m) * 2) * 512) + (unsigned)(wid * 64 + lane); asm volatile("" : "+v"(yo)); y[m][bj][0] = YB[yo]; y[m][bj][1] = YB[yo + 512]; }
#pragma unroll
                for (int m = 0; m < 4; ++m) { const int r = ai * 128 + wr * 64 + m * 16 + fr; const bool ok = row_valid(u, r);
#pragma unroll
                    for (int bj = 0; bj < 2; ++bj) { const f32x4 v0 = acc[ai][bj][m][0] * y[m][bj][0], v1 = acc[ai][bj][m][1] * y[m][bj][1];
                        u32x4 w; w.x = cvt_pk_bf16(v0[0], v0[1]); w.y = cvt_pk_bf16(v0[2], v0[3]); w.z = cvt_pk_bf16(v1[0], v1[1]); w.w = cvt_pk_bf16(v1[2], v1[3]);
                        if (ok) *(u32x4*)(BY + (size_t)(u.row0 + r) * D + q * 256 + bj * 128 + chl) = w; } }
                asm volatile("" ::: "memory"); }
        }
    }
};
struct OrderSc {
    int c; const char* A; const char* B;
    __device__ __forceinline__ bool next(int i, Unit& u) const {
        if (c >= 200 || i >= 3) return false;
        u.pm = c >> 2; u.pn = 3 * (c & 3) + i; u.row0 = conv_row0(u.pm); u.a = A + (long)u.row0 * (D * 2); u.b = B + (size_t)u.pn * 256 * D * 2; return true; }
};
struct EpiFn1 : EpiBase {
    static constexpr bool PERM = true;
    __device__ __forceinline__ void operator()(const f32x4 (&acc)[2][2][4][2], const Unit& u, int wid, int ) const {
        int lane_ = pg8::lane_id(); asm volatile("" : "+v"(lane_));
        const int lane = lane_, wr = wid >> 2, wc = wid & 3, fr = lane & 15, fq = lane >> 4; (void)wr; (void)wc; (void)fr; (void)fq;
        bf16_t* YT = (bf16_t*)(wsp() + WS_YT);
        const int part = u.pm & 1, ch0 = (u.pm >> 1) * 256, tok0 = u.pn * 256;
        bf16_t* base; int T, t0;
        if (tok0 < MP) { T = TP; base = YT + (size_t)(tok0 / TP) * D * 2 * TP; t0 = 0; }
        else { T = TS; base = YT + (size_t)32 * D * 2 * TP + (size_t)((tok0 - MP) / TS) * D * 2 * TS; t0 = (tok0 - MP) % TS; }
        const int c0 = wc * 32 + 8 * fq;
#pragma unroll
        for (int ai = 0; ai < 2; ++ai)
#pragma unroll
            for (int m = 0; m < 4; ++m) { bf16_t* rowp = base + (size_t)(ch0 + ai * 128 + wr * 64 + m * 16 + fr) * 2 * T + part * T + t0 + c0;
#pragma unroll
                for (int bj = 0; bj < 2; ++bj) { const f32x4 v0 = acc[ai][bj][m][0], v1 = acc[ai][bj][m][1];
                    u32x4 w; w.x = cvt_pk_bf16(v0[0], v0[1]); w.y = cvt_pk_bf16(v0[2], v0[3]); w.z = cvt_pk_bf16(v1[0], v1[1]); w.w = cvt_pk_bf16(v1[2], v1[3]);
                    *(u32x4*)(rowp + bj * 128) = w; } }
    }
};
struct OrderFn1 {
    int G, c; const char* A1; const char* H;
    __device__ __forceinline__ bool next(int i, Unit& u) const {
        const int L = i * G + c; if (L >= 384) return false;
        u.pm = L & 7; u.pn = L >> 3; u.row0 = 0; u.a = A1 + (size_t)(u.pm & 1) * 256 * 256 * 2; u.b = H + (size_t)u.pn * 256 * D * 2 + (size_t)(u.pm >> 1) * 512; return true; }
};
struct OrderFn2 {
    int c; int samp; const char* A2; const char* YT;
    __device__ __forceinline__ bool next(int i, Unit& u) const {
        if (i > 0) return false;
        if (samp) { if (c >= 128) return false; const int b = c >> 6, tm = (c >> 2) & 15; u.pm = tm; u.pn = c & 3; u.row0 = MP + b * TS + 128 * tm;
            u.a = A2 + (size_t)tm * 128 * 2 * TS * 2; u.b = YT + (size_t)32 * D * 2 * TP * 2 + (size_t)b * D * 2 * TS * 2 + (size_t)u.pn * 256 * 2 * TS * 2; return true; }
        if (c < 128) return false; const int j = c - 128, s = j >> 2; u.pm = 0; u.pn = j & 3; u.row0 = s * TP;
        u.a = A2; u.b = YT + (size_t)s * D * 2 * TP * 2 + (size_t)u.pn * 256 * 2 * TP * 2; return true; }
};

__device__ __forceinline__ void p0_transpose_item(const float* W, int K, int N, bf16_t* WT, int drow0, LAS float* scr, int kb, int n0, int lane) {
    const int k0 = 64 * kb;
    f32x4 v[8];
#pragma unroll
    for (int i = 0; i < 8; ++i) v[i] = __builtin_nontemporal_load((const f32x4*)(W + (size_t)(k0 + 8 * i + (lane >> 3)) * N + n0 + 4 * (lane & 7)));
#pragma unroll
    for (int i = 0; i < 8; ++i) { LAS float* d = scr + (8 * i + (lane >> 3)) * 33 + 4 * (lane & 7); d[0] = v[i][0]; d[1] = v[i][1]; d[2] = v[i][2]; d[3] = v[i][3]; }
    LDS_WAIT(); asm volatile("" ::: "memory");
    const int c = lane & 7;
#pragma unroll
    for (int j = 0; j < 4; ++j) { const int n = (lane >> 3) + 8 * j; const LAS float* s = scr + (8 * c) * 33 + n;
        u32x4 o; o.x = pk2(s[0 * 33], s[1 * 33]); o.y = pk2(s[2 * 33], s[3 * 33]); o.z = pk2(s[4 * 33], s[5 * 33]); o.w = pk2(s[6 * 33], s[7 * 33]);
        *(u32x4*)(WT + (size_t)(drow0 + n) * K + k0 + 8 * c) = o; }
    LDS_WAIT(); asm volatile("" ::: "memory");
}
__device__ __forceinline__ int map_plain(int n) { return n; }
__device__ __forceinline__ int map_up(int n) { return n < DFF ? 256 * (n >> 7) + (n & 127) : 256 * ((n - DFF) >> 7) + 128 + ((n - DFF) & 127); }
__device__ __forceinline__ int map_sc(int n) {
    if (n < D) return (3 * (n >> 8) + 2) * 256 + (n & 255);
    const int x = n >= 2 * D, ch = n - D - x * D; return (3 * (ch >> 8) + ((ch >> 7) & 1)) * 256 + x * 128 + (ch & 127);
}
__device__ __forceinline__ void p0_tjob(int& it, int NGW, LAS float* scr, int lane, const float* W, bf16_t* WT, int K, int N, int map) {
    const int nblk = N / 32, nitems = (K / 64) * nblk;
    for (; it < nitems; it += NGW) { const int kb = it / nblk, n0 = (it % nblk) * 32; const int dr = map == 0 ? n0 : (map == 1 ? map_up(n0) : map_sc(n0));
        p0_transpose_item(W, K, N, WT, dr, scr, kb, n0, lane); }
    it -= nitems;
}
__device__ __forceinline__ void convert_layer(Frame& F, int l, int b0, int nb) {
    unsigned char* ws = F.ws;
    LAS float* scr = (LAS float*)(F.lds + F.wave * 16384);
    const int gw = (F.blk - b0) * NWAVES + F.wave, NGW = nb * NWAVES;
    int it = gw;
    if (l == 0) { p0_tjob(it, NGW, scr, F.lane, ((const float*)F.in[11]), (bf16_t*)(ws + WS_WQKV), D, 1536, 0);
        p0_tjob(it, NGW, scr, F.lane, ((const float*)F.in[12]), (bf16_t*)(ws + WS_WO), D, D, 0); }
    else if (l == 1) { p0_tjob(it, NGW, scr, F.lane, ((const float*)F.in[14]), (bf16_t*)(ws + WS_WSGI), D, 2048, 0);
        p0_tjob(it, NGW, scr, F.lane, ((const float*)F.in[18]), (bf16_t*)(ws + WS_WSGO), D, D, 0); }
    else if (l == 2) { p0_tjob(it, NGW, scr, F.lane, ((const float*)F.in[19]), (bf16_t*)(ws + WS_WSCI), D, 3072, 2);
        p0_tjob(it, NGW, scr, F.lane, ((const float*)F.in[21]), (bf16_t*)(ws + WS_WSCO), D, D, 0); }
    else p0_tjob(it, NGW, scr, F.lane, ((const float*)F.in[22]), (bf16_t*)(ws + WS_WFNO), D, D, 0);
    p0_tjob(it, NGW, scr, F.lane, ((const float*)F.in[23]) + (size_t)l * D * 2 * DFF, (bf16_t*)(ws + WS_WUP + l * WUP_BYTES), D, 2 * DFF, 1);
    p0_tjob(it, NGW, scr, F.lane, ((const float*)F.in[25]) + (size_t)l * DFF * D, (bf16_t*)(ws + WS_WDN + l * WDN_BYTES), DFF, D, 0);
    const size_t gt = (size_t)(F.blk - b0) * 512 + F.tid, NGT = (size_t)nb * 512;
    if (l == 1) { bf16_t* WSb = (bf16_t*)(ws + WS_WS); for (size_t i = gt; i < 8 * 128 * 128; i += NGT) WSb[i] = (bf16_t)f2bf(((const float*)F.in[16])[i]); }
    if (l == 3) {
        bf16_t* A1 = (bf16_t*)(ws + WS_A1);
        for (size_t i = gt; i < 2 * 256 * 256; i += NGT) { const int part = i >> 16, r = (i >> 8) & 255, k = i & 255; float v = 0.f;
            if ((r >> 7) == (k >> 7)) { const float a = 2.f * (float)(((r & 127) * (k & 127)) & 127) / 128.f; v = (part ? sinpif(a) : cospif(a)) * 0.08838834764831845f; }
            A1[i] = (bf16_t)f2bf(v); }
        bf16_t* A2P = (bf16_t*)(ws + WS_A2P);
        for (size_t i = gt; i < 256 * 512; i += NGT) { const int tp = i >> 9, k = i & 511, t = k & 255; const float a = 2.f * (float)((tp * t) & 255) / 256.f;
            A2P[i] = (bf16_t)f2bf((k < 256 ? cospif(a) : -sinpif(a)) * 0.0625f); }
        __syncthreads();
        LAS bf16_t* tab = (LAS bf16_t*)F.lds;
        for (int j = F.tid; j < 2048; j += 512) { const float a = 2.f * (float)j / 2048.f; tab[j] = (bf16_t)f2bf(cospif(a) * 0.022097086912079608f); tab[2048 + j] = (bf16_t)f2bf(-sinpif(a) * 0.022097086912079608f); }
        __syncthreads();
        bf16_t* A2S = (bf16_t*)(ws + WS_A2S);
        for (size_t i8 = gt; i8 < (size_t)2048 * 4096 / 8; i8 += NGT) { const int tp = (int)(i8 >> 9), k0 = (int)(i8 & 511) * 8, part = k0 >> 11, t0 = k0 & 2047;
            unsigned w[4];
#pragma unroll
            for (int e = 0; e < 4; ++e) { const unsigned lo = tab[part * 2048 + ((tp * (t0 + 2 * e)) & 2047)], hi = tab[part * 2048 + ((tp * (t0 + 2 * e + 1)) & 2047)]; w[e] = lo | (hi << 16); }
            *(u32x4*)(A2S + i8 * 8) = (u32x4){w[0], w[1], w[2], w[3]}; }
        __syncthreads();
    }
}
__device__ __forceinline__ void prefetch_region(Frame& F, const void* p, size_t bytes, int b0, int nb) {
    const size_t gt = (size_t)(F.blk - b0) * 512 + F.tid, NGT = (size_t)nb * 512; unsigned acc = 0;
    for (size_t i = gt * 128; i < bytes; i += NGT * 128) { const u32x4 v = *(const u32x4*)((const char*)p + i); acc += v.x ^ v.w; }
    if (acc == 0x9e3779b9u) *(volatile unsigned*)(F.ws + WS_CTL + CTL_TMO + 64) = acc;
}
__device__ __forceinline__ void mod_items(Frame& F, int lo, int hi, int b0, int nb) {
    unsigned char* ws = F.ws;
    LAS float* sv = (LAS float*)F.lds;
    LAS float* red = sv + 3 * D;
    __syncthreads();
    for (int i = F.tid; i < D; i += 512) { const float a = ((const float*)F.in[5])[i], b = ((const float*)F.in[4])[i], d = ((const float*)F.in[4])[D + i];
        sv[i] = a / (1.f + expf(-a)); sv[D + i] = b / (1.f + expf(-b)); sv[2 * D + i] = d / (1.f + expf(-d)); }
    __syncthreads();
    float* MODp = (float*)(ws + WS_MOD);
    const int kg = F.tid >> 3, cq = F.tid & 7;
    for (int it = lo + F.blk - b0; it < hi; it += nb) {
        const int l = it / 192, n0 = (it % 192) * 32;
        const float* w = ((const float*)F.in[6]) + (size_t)l * D * 6 * D + n0 + 4 * cq;
        f32x4 wv[16];
#pragma unroll
        for (int i = 0; i < 16; ++i) wv[i] = __builtin_nontemporal_load((const f32x4*)(w + (size_t)(kg + 64 * i) * 6 * D));
        f32x4 a[3] = {{0, 0, 0, 0}, {0, 0, 0, 0}, {0, 0, 0, 0}};
#pragma unroll
        for (int i = 0; i < 16; ++i) { const int k = kg + 64 * i; a[0] += sv[k] * wv[i]; a[1] += sv[D + k] * wv[i]; a[2] += sv[2 * D + k] * wv[i]; }
#pragma unroll
        for (int v = 0; v < 3; ++v)
#pragma unroll
            for (int j = 0; j < 4; ++j) { float x = a[v][j]; x += dppx<0x128>(x); a[v][j] = rows_sum(x); }
        if (F.lane < 8) {
#pragma unroll
            for (int v = 0; v < 3; ++v) *(LAS f32x4*)(red + (F.wave * 3 + v) * 32 + 4 * cq) = a[v]; }
        __syncthreads();
        if (F.tid < 96) { const int v = F.tid >> 5, cc = F.tid & 31; float s = 0.f;
#pragma unroll
            for (int g = 0; g < 8; ++g) s += red[(g * 3 + v) * 32 + cc];
            MODp[(l * 3 + v) * 6 * D + n0 + cc] = s + ((const float*)F.in[7])[l * 6 * D + n0 + cc]; }
        __syncthreads();
    }
}
__device__ __forceinline__ void p0_prologue(Frame& F) {
    unsigned char* ws = F.ws;
    mod_items(F, 0, 192, 0, F.G);
    {
        const size_t gt = (size_t)F.blk * 512 + F.tid, NGT = (size_t)F.G * 512;
        bf16_t* CK = (bf16_t*)(ws + WS_CK); bf16_t* CVT = (bf16_t*)(ws + WS_CVT);
        for (size_t i = gt; i < 2 * 512 * 256; i += NGT) { CK[i] = (bf16_t)f2bf(((const float*)F.in[2])[i]);
            const int d = i & 63, kvh = (i >> 6) & 3, j = (i >> 8) & 511, b = i >> 17; CVT[((size_t)(b * 4 + kvh) * 64 + d) * 512 + j] = (bf16_t)f2bf(((const float*)F.in[3])[i]); }
        float* rope = (float*)(ws + WS_ROPE);
        for (size_t i = gt; i < 1024; i += NGT) { const int pos = i >> 4, fi = i & 15; const float ang = (float)pos * powf(10000.f, -(float)fi / 16.f); rope[i] = cosf(ang); rope[1024 + i] = sinf(ang); }
    }
}

__device__ __forceinline__ void norm_phase(Frame& F, const float* src0, const float* src1, const float* g, const float* modl, int sh_idx, bf16_t* H) {
    const int gw = F.blk * NWAVES + F.wave, NGW = F.G * NWAVES;
    f32x4 gv[4];
#pragma unroll
    for (int j = 0; j < 4; ++j) gv[j] = *(const f32x4*)(g + 256 * j + 4 * F.lane);
    for (int row = gw; row < M; row += NGW) {
        const float* xr = row < MP ? src0 + (size_t)row * D : src1 + (size_t)(row - MP) * D;
        const float* mv = modl + (row < MP ? 0 : 1 + (row - MP) / TS) * 6 * D;
        f32x4 v[4]; float s = 0.f;
#pragma unroll
        for (int j = 0; j < 4; ++j) { v[j] = *(const f32x4*)(xr + 256 * j + 4 * F.lane); s += (v[j][0] * v[j][0] + v[j][1] * v[j][1]) + (v[j][2] * v[j][2] + v[j][3] * v[j][3]); }
        const float r = rsqrtf(wave_sum(s) * (1.f / D) + EPS);
#pragma unroll
        for (int j = 0; j < 4; ++j) { const f32x4 sh = *(const f32x4*)(mv + sh_idx * D + 256 * j + 4 * F.lane), sc = *(const f32x4*)(mv + (sh_idx + 1) * D + 256 * j + 4 * F.lane);
            const f32x4 o = v[j] * r * gv[j] * (1.f + sc) + sh;
            u32x2 w; w.x = pk2(o[0], o[1]); w.y = pk2(o[2], o[3]); *(u32x2*)(H + (size_t)row * D + 256 * j + 4 * F.lane) = w; }
    }
}
__device__ __forceinline__ void final_phase(Frame& F, const float* X, const float* g, float* out) {
    const int gw = F.blk * NWAVES + F.wave, NGW = F.G * NWAVES;
    f32x4 gv[4];
#pragma unroll
    for (int j = 0; j < 4; ++j) gv[j] = *(const f32x4*)(g + 256 * j + 4 * F.lane);
    for (int row = gw; row < M; row += NGW) {
        const float* xr = X + (size_t)row * D; f32x4 v[4]; float s = 0.f;
#pragma unroll
        for (int j = 0; j < 4; ++j) { v[j] = *(const f32x4*)(xr + 256 * j + 4 * F.lane); s += (v[j][0] * v[j][0] + v[j][1] * v[j][1]) + (v[j][2] * v[j][2] + v[j][3] * v[j][3]); }
        const float r = rsqrtf(wave_sum(s) * (1.f / D) + EPS);
#pragma unroll
        for (int j = 0; j < 4; ++j) *(f32x4*)(out + (size_t)row * D + 256 * j + 4 * F.lane) = v[j] * r * gv[j];
    }
}

constexpr int ATT_LDK = 144;
constexpr int ATT_TILE_BYTES = 2 * 64 * ATT_LDK;
struct AttTile { const bf16_t* K; const bf16_t* V; int ldk, ldv, k0, mask; };
__device__ __forceinline__ void att_tile_of(int t, bool lat, int nband, int kband0, int qc0, const bf16_t* KBs, const bf16_t* VTs, int T, const bf16_t* CKs, const bf16_t* CVTs, AttTile& o) {
    if (t < nband) { const int k0 = kband0 + 64 * t; o.K = KBs + (size_t)k0 * 256; o.V = VTs + k0; o.ldk = 256; o.ldv = T; o.k0 = k0; const int dk = k0 - qc0; o.mask = lat && (dk < -64 || dk > 64); }
    else { const int k0 = 64 * (t - nband); o.K = CKs + (size_t)k0 * 256; o.V = CVTs + k0; o.ldk = 256; o.ldv = 512; o.k0 = k0; o.mask = 0; }
}
__device__ __forceinline__ void attn_phase(Frame& F, const bf16_t* Q, const bf16_t* KB, const bf16_t* VT, const bf16_t* CK, const bf16_t* CVT, const float* sink, bf16_t* O) {
    const int fr = F.lane & 15, g4 = F.lane >> 4, tid = F.tid;
    const int lrow = tid >> 3, lchunk = tid & 7;
    LAS unsigned char* lds = F.lds;
    for (int it = F.blk; it < 768; it += F.G) {
        const bool lat = it < 256; int kvh, chunk, T, rowbase, b = 0; const bf16_t* vt;
        if (lat) { b = it >> 7; kvh = (it >> 5) & 3; chunk = it & 31; T = TS; rowbase = MP + b * TS; vt = VT + (size_t)32 * 65536 + (size_t)b * 256 * TS; }
        else { const int j = it - 256, s = j >> 4; kvh = (j >> 2) & 3; chunk = j & 3; T = TP; rowbase = s * TP; vt = VT + (size_t)s * 65536; }
        const int h = kvh * 4 + (F.wave & 3), q0 = chunk * 64 + (F.wave >> 2) * 32;
        int kband0 = 0, nband = T / 64;
        if (lat) { int lo = 64 * chunk - 128, hi = 64 * chunk + 192; lo = lo < 0 ? 0 : lo; hi = hi > T ? T : hi; kband0 = lo; nband = (hi - lo) / 64; }
        const int ntile = nband + (lat ? 8 : 0);
        const bf16_t* KBs = KB + (size_t)rowbase * 256 + kvh * 64; const bf16_t* VTs = vt + (size_t)(kvh * 64) * T;
        const bf16_t* CKs = CK + (size_t)b * 512 * 256 + kvh * 64; const bf16_t* CVTs = CVT + (size_t)((b * 4 + kvh) * 64) * 512;
        bf16x8 Qf[2][2];
#pragma unroll
        for (int qg = 0; qg < 2; ++qg)
#pragma unroll
            for (int ds = 0; ds < 2; ++ds) Qf[qg][ds] = *(const bf16x8*)(Q + (size_t)(rowbase + q0 + 16 * qg + fr) * D + h * 64 + 32 * ds + 8 * g4);
        float mrun[2], lrun[2]; f32x4 Oa[2][4];
#pragma unroll
        for (int qg = 0; qg < 2; ++qg) { mrun[qg] = sink[h] * 1.4426950408889634f; lrun[qg] = 1.f;
#pragma unroll
            for (int db = 0; db < 4; ++db) Oa[qg][db] = (f32x4){0.f, 0.f, 0.f, 0.f}; }
        AttTile tl; att_tile_of(0, lat, nband, kband0, 64 * chunk, KBs, VTs, T, CKs, CVTs, tl);
        u32x4 rk = *(const u32x4*)(tl.K + (size_t)lrow * tl.ldk + lchunk * 8), rv = *(const u32x4*)(tl.V + (size_t)lrow * tl.ldv + lchunk * 8);
        __syncthreads();
        *(LAS u32x4*)(lds + lrow * ATT_LDK + lchunk * 16) = rk; *(LAS u32x4*)(lds + 64 * ATT_LDK + lrow * ATT_LDK + lchunk * 16) = rv;
        __syncthreads();
#pragma unroll 1
        for (int t = 0; t < ntile; ++t) {
            const int cur_k0 = tl.k0, cur_mask = tl.mask;
            if (t + 1 < ntile) { att_tile_of(t + 1, lat, nband, kband0, 64 * chunk, KBs, VTs, T, CKs, CVTs, tl);
                rk = *(const u32x4*)(tl.K + (size_t)lrow * tl.ldk + lchunk * 8); rv = *(const u32x4*)(tl.V + (size_t)lrow * tl.ldv + lchunk * 8); }
            const LAS unsigned char* kb_ = lds + (t & 1) * ATT_TILE_BYTES; const LAS unsigned char* vb_ = kb_ + 64 * ATT_LDK;
            {
                bf16x8 Kf[2][2][2], Vf[2][4];
#pragma unroll
                for (int sub = 0; sub < 2; ++sub) {
#pragma unroll
                    for (int kb = 0; kb < 2; ++kb)
#pragma unroll
                        for (int ds = 0; ds < 2; ++ds) Kf[sub][kb][ds] = *(const LAS bf16x8*)(kb_ + (32 * sub + 16 * kb + fr) * ATT_LDK + 64 * ds + 16 * g4);
#pragma unroll
                    for (int db = 0; db < 4; ++db) { const LAS unsigned char* vp = vb_ + (16 * db + fr) * ATT_LDK + 64 * sub + 8 * g4; const u32x2 lo = *(const LAS u32x2*)vp, hi = *(const LAS u32x2*)(vp + 32);
                        Vf[sub][db] = __builtin_bit_cast(bf16x8, (u32x4){lo.x, lo.y, hi.x, hi.y}); }
                }
                const float c = 0.125f * 1.4426950408889634f;
                f32x4 S[2][2][2];
#pragma unroll
                for (int qg = 0; qg < 2; ++qg)
#pragma unroll
                    for (int sub = 0; sub < 2; ++sub)
#pragma unroll
                        for (int kb = 0; kb < 2; ++kb) { S[qg][sub][kb] = __builtin_amdgcn_mfma_f32_16x16x32_bf16(Kf[sub][kb][0], Qf[qg][0], (f32x4){0.f, 0.f, 0.f, 0.f}, 0, 0, 0);
                            S[qg][sub][kb] = __builtin_amdgcn_mfma_f32_16x16x32_bf16(Kf[sub][kb][1], Qf[qg][1], S[qg][sub][kb], 0, 0, 0); }
                float mnew[2], rs[2];
#pragma unroll
                for (int qg = 0; qg < 2; ++qg) {
                    const int qpos = q0 + 16 * qg + fr;
                    if (cur_mask) {
#pragma unroll
                        for (int sub = 0; sub < 2; ++sub)
#pragma unroll
                            for (int kb = 0; kb < 2; ++kb)
#pragma unroll
                                for (int r = 0; r < 4; ++r) { const int d = cur_k0 + 32 * sub + 16 * kb + 4 * g4 + r - qpos; if (d > 128 || d < -128) S[qg][sub][kb][r] = -1e30f; }
                    }
                    float mx = -1e30f;
#pragma unroll
                    for (int sub = 0; sub < 2; ++sub)
#pragma unroll
                        for (int kb = 0; kb < 2; ++kb) mx = fmaxf(fmaxf(mx, fmaxf(S[qg][sub][kb][0], S[qg][sub][kb][1])), fmaxf(S[qg][sub][kb][2], S[qg][sub][kb][3]));
                    mx = rows_max(mx) * c;
                    mnew[qg] = fmaxf(mrun[qg], mx);
                    float r_ = 0.f;
#pragma unroll
                    for (int sub = 0; sub < 2; ++sub)
#pragma unroll
                        for (int kb = 0; kb < 2; ++kb)
#pragma unroll
                            for (int r = 0; r < 4; ++r) { const float p = fast_exp2(__builtin_fmaf(S[qg][sub][kb][r], c, -mnew[qg])); S[qg][sub][kb][r] = p; r_ += p; }
                    rs[qg] = rows_sum(r_);
                }
                if (__builtin_amdgcn_ballot_w64(mnew[0] > mrun[0] || mnew[1] > mrun[1]) != 0ull) {
#pragma unroll
                    for (int qg = 0; qg < 2; ++qg) { const float alpha = fast_exp2(mrun[qg] - mnew[qg]); lrun[qg] *= alpha;
#pragma unroll
                        for (int db = 0; db < 4; ++db) Oa[qg][db] = Oa[qg][db] * alpha; }
                }
#pragma unroll
                for (int qg = 0; qg < 2; ++qg) { lrun[qg] += rs[qg]; mrun[qg] = mnew[qg];
#pragma unroll
                    for (int sub = 0; sub < 2; ++sub) {
                        u32x4 pw; pw.x = cvt_pk_bf16(S[qg][sub][0][0], S[qg][sub][0][1]); pw.y = cvt_pk_bf16(S[qg][sub][0][2], S[qg][sub][0][3]); pw.z = cvt_pk_bf16(S[qg][sub][1][0], S[qg][sub][1][1]); pw.w = cvt_pk_bf16(S[qg][sub][1][2], S[qg][sub][1][3]);
                        const bf16x8 Pf = __builtin_bit_cast(bf16x8, pw);
#pragma unroll
                        for (int db = 0; db < 4; ++db) Oa[qg][db] = __builtin_amdgcn_mfma_f32_16x16x32_bf16(Vf[sub][db], Pf, Oa[qg][db], 0, 0, 0); } }
            }
            if (t + 1 < ntile) { LAS unsigned char* nb = lds + ((t + 1) & 1) * ATT_TILE_BYTES;
                *(LAS u32x4*)(nb + lrow * ATT_LDK + lchunk * 16) = rk; *(LAS u32x4*)(nb + 64 * ATT_LDK + lrow * ATT_LDK + lchunk * 16) = rv; }
            __syncthreads();
        }
#pragma unroll
        for (int qg = 0; qg < 2; ++qg) { const float inv = 1.f / lrun[qg];
#pragma unroll
            for (int db = 0; db < 4; ++db) { const f32x4 o = Oa[qg][db] * inv; u32x2 w; w.x = cvt_pk_bf16(o[0], o[1]); w.y = cvt_pk_bf16(o[2], o[3]);
                *(u32x2*)(O + (size_t)(rowbase + q0 + 16 * qg + fr) * D + h * 64 + 16 * db + 4 * g4) = w; } }
    }
}

__device__ __forceinline__ void sgu_phase(Frame& F, const bf16_t* U, const bf16_t* V, const f32x2* STATS, const float* ln_g, const bf16_t* WSb, const float* b_s, bf16_t* UM) {
    constexpr int LDT = 136;
    LAS bf16_t* LT = (LAS bf16_t*)F.lds;
    LAS f32x2* ST = (LAS f32x2*)(F.lds + 128 * LDT * 2);
    const int fr = F.lane & 15, g4 = F.lane >> 4;
    for (int it = F.blk; it < 768; it += F.G) {
        const int ch = it >> 3, g = it & 7, r0 = ch * 128;
        if (F.tid < 128) { const f32x2* sp = STATS + (size_t)(r0 + F.tid) * 16; float s1 = 0.f, s2 = 0.f;
#pragma unroll
            for (int k = 0; k < 16; ++k) { const f32x2 p = sp[k]; s1 += p.x; s2 += p.y; }
            const float mu = s1 * (1.f / D), var = s2 * (1.f / D) - mu * mu; ST[F.tid] = (f32x2){mu, rsqrtf(fmaxf(var, 0.f) + EPS)}; }
        __syncthreads();
#pragma unroll
        for (int i = 0; i < 4; ++i) { const int q = F.tid + 512 * i, r = q & 127, c8 = (q >> 7) * 8;
            const u32x4 raw = *(const u32x4*)(V + (size_t)(r0 + r) * D + g * 128 + c8); const f32x2 st = ST[r];
            const f32x4 ga = *(const f32x4*)(ln_g + g * 128 + c8), gb = *(const f32x4*)(ln_g + g * 128 + c8 + 4);
            const unsigned rw[4] = {raw.x, raw.y, raw.z, raw.w};
#pragma unroll
            for (int e = 0; e < 8; ++e) { const float x = bf2f((unsigned short)(e & 1 ? rw[e >> 1] >> 16 : rw[e >> 1] & 0xffff)); const float gg = e < 4 ? ga[e & 3] : gb[e & 3];
                LT[(c8 + e) * LDT + r] = (bf16_t)f2bf((x - st.x) * st.y * gg); } }
        __syncthreads();
        f32x4 acc[8];
#pragma unroll
        for (int cb = 0; cb < 8; ++cb) acc[cb] = (f32x4){0.f, 0.f, 0.f, 0.f};
        const int p = 16 * F.wave + fr;
#pragma unroll
        for (int ks = 0; ks < 4; ++ks) { const bf16x8 bw = *(const bf16x8*)(WSb + (size_t)(g * 128 + p) * 128 + 32 * ks + 8 * g4);
#pragma unroll
            for (int cb = 0; cb < 8; ++cb) { const bf16x8 av = *(const LAS bf16x8*)(LT + (16 * cb + fr) * LDT + 32 * ks + 8 * g4); acc[cb] = __builtin_amdgcn_mfma_f32_16x16x32_bf16(av, bw, acc[cb], 0, 0, 0); } }
        const float bsv = b_s[g * 128 + p];
#pragma unroll
        for (int cb = 0; cb < 8; ++cb) { const size_t off = (size_t)(r0 + p) * D + g * 128 + 16 * cb + 4 * g4; const u32x2 uw = *(const u32x2*)(U + off);
            const float u0 = bf2f((unsigned short)(uw.x & 0xffff)), u1 = bf2f((unsigned short)(uw.x >> 16)), u2 = bf2f((unsigned short)(uw.y & 0xffff)), u3 = bf2f((unsigned short)(uw.y >> 16));
            u32x2 w; w.x = cvt_pk_bf16(u0 * (acc[cb][0] + bsv), u1 * (acc[cb][1] + bsv)); w.y = cvt_pk_bf16(u2 * (acc[cb][2] + bsv), u3 * (acc[cb][3] + bsv)); *(u32x2*)(UM + off) = w; }
        __syncthreads();
    }
}

struct Args { const float* in[26]; float* out; unsigned char* ws; int ph_lo, ph_hi; };
__global__ void __launch_bounds__(NWAVES * 64, 2) mk_fwd(const Args args) {
    extern __shared__ __attribute__((aligned(16))) unsigned char lds_raw[];
    Frame F;
    F.lds = (LAS unsigned char*)lds_raw;
    const int wave0 = __builtin_amdgcn_readfirstlane((int)threadIdx.x >> 6);
    F.wave = wave0; F.lane = pg8::lane_id(); F.tid = wave0 * 64 + F.lane;
    const int grid0 = gridDim.x, blk0 = blockIdx.x; F.G = grid0; F.blk = blk0;
    F.in = (const __attribute__((address_space(4))) cfp_t*)__builtin_amdgcn_kernarg_segment_ptr();
    F.out = args.out; F.ws = args.ws;
    unsigned char* ws = args.ws;
    volatile LAS unsigned* MISC = (volatile LAS unsigned*)(F.lds + MISC_OFF);
    if (F.tid < 32) MISC[F.tid] = 0u;
    __syncthreads();
    const int lo = args.ph_lo, hi = args.ph_hi;
    XcdBarrier bar; bar.bar = (unsigned*)(ws + WS_CTL); bar.x = 0; bar.st = nullptr;
    if (hi - lo > 1) bar = xcd_barrier_post((unsigned*)(ws + WS_CTL), MISC + 8, F.tid == 0);
    LAS float* XCH = (LAS float*)(F.lds + XCH_OFF);
#define CASE_BEGIN() { int b_ = blk0, w_ = wave0, g_ = grid0; asm volatile("" : "+s"(b_), "+s"(w_), "+s"(g_)); F.blk = b_; F.wave = w_; F.G = g_; } frame_refresh(F); unsigned long long ws_ = (unsigned long long)args.ws, in_ = (unsigned long long)__builtin_amdgcn_kernarg_segment_ptr(); asm volatile("" : "+s"(ws_), "+s"(in_)); \
        unsigned char* ws = (unsigned char*)(GAS unsigned char*)ws_; F.ws = ws; F.in = (const __attribute__((address_space(4))) cfp_t*)in_; \
        float* X = (float*)(ws + WS_X); bf16_t* H = (bf16_t*)(ws + WS_H); bf16_t* H2 = (bf16_t*)(ws + WS_H2); bf16_t* HN = (bf16_t*)(ws + WS_HN); (void)HN; \
        const float* modl = (const float*)(ws + WS_MOD) + l * 3 * 6 * D; const float* xs0 = l == 0 ? ((const float*)F.in[0]) : X; const float* xs1 = l == 0 ? ((const float*)F.in[1]) : X + (size_t)MP * D; \
        (void)X; (void)H; (void)H2; (void)modl; (void)xs0; (void)xs1
#pragma unroll 1
    for (int ph = lo; ph < hi; ++ph) {
        int l = 0, kind;
        if (ph == 0) kind = 0; else if (ph == 1) kind = 1;
        else { l = ph < 7 ? 0 : ph < 12 ? 1 : ph < 16 ? 2 : 3; const int j = ph - (l == 0 ? 2 : l == 1 ? 7 : l == 2 ? 12 : 16), n = l == 2 ? 1 : 2;
            kind = j < n ? (l == 0 ? 2 + j : l == 1 ? 4 + j : l == 2 ? 6 : 7 + j) : j == n ? 9 : j == n + 1 ? 10 : 11; }
        const int reps = (kind == MK_REP_KIND) ? 1 + MK_REP_N : 1;
        const bool tp_here = MK_TP && ph == MK_TP_PH && blk0 == 0;
        unsigned long long tp_r0 = 0, tp_c0 = 0; if (tp_here) { tp_r0 = __builtin_amdgcn_s_memrealtime(); tp_c0 = __builtin_amdgcn_s_memtime(); }
#pragma unroll 1
        for (int rep = 0; rep < reps; ++rep) {
        if (rep > 0) xcd_barrier(bar, wave0 == 0 && pg8::lane_id() == 0);
        switch (kind) {
        case 0: if (EN(0)) { CASE_BEGIN(); p0_prologue(F); } break;
        case 1: if (EN(1)) { CASE_BEGIN(); norm_phase(F, xs0, xs1, ((const float*)F.in[8]), modl, 0, HN);
                if (rep == 0) convert_layer(F, 0, 0, F.G); } break;
        case 2: if (EN(2)) { CASE_BEGIN(); Order<64, 6, 0, D, D, 192> S; S.init(F.G, F.blk, HN, ws + WS_WQKV);
                EpiQKV E{{ws, l, 0}};
                pg8::gemm_phase<D, D, D / 64, 192>(F.lds, S, E, F.wave, tp_here);
                if (MK_PREFETCH && rep == 0 && F.blk >= 128) { frame_refresh(F); prefetch_region(F, ws + WS_WO, 2 * MiB, 128, F.G - 128); prefetch_region(F, ws + WS_WUP, WUP_BYTES, 128, F.G - 128); } } break;
        case 3: if (EN(3)) { CASE_BEGIN(); attn_phase(F, (const bf16_t*)(ws + WS_Q), (const bf16_t*)(ws + WS_KB), (const bf16_t*)(ws + WS_VT), (const bf16_t*)(ws + WS_CK), (const bf16_t*)(ws + WS_CVT), ((const float*)F.in[13]), H); } break;
        case 4: if (EN(4)) { CASE_BEGIN(); Order<64, 8, 0, D, D, 192> S; S.init(F.G, F.blk, HN, ws + WS_WSGI);
                EpiSgu E{{ws, l, 0}};
                pg8::gemm_phase<D, D, D / 64, 192>(F.lds, S, E, F.wave, tp_here);
                } break;
        case 5: if (EN(5)) { CASE_BEGIN(); sgu_phase(F, (const bf16_t*)(ws + WS_U), (const bf16_t*)(ws + WS_V), (const f32x2*)(ws + WS_STATS), ((const float*)F.in[15]), (const bf16_t*)(ws + WS_WS), ((const float*)F.in[17]), H); } break;
        case 6: if (EN(6)) { CASE_BEGIN(); OrderSc S{F.blk, (const char*)HN, (const char*)(ws + WS_WSCI)};
                EpiSc E{{ws, l, F.blk}};
                pg8::gemm_phase<D, D, D / 64>(F.lds, S, E, F.wave, tp_here);
                if (MK_PREFETCH && rep == 0 && F.blk >= 200) { frame_refresh(F); prefetch_region(F, ws + WS_WSCO, 2 * MiB, 200, F.G - 200); prefetch_region(F, ws + WS_WUP + 2 * WUP_BYTES, WUP_BYTES, 200, F.G - 200); } } break;
        case 7: if (EN(7)) { CASE_BEGIN(); OrderFn1 S{F.G, F.blk, (const char*)(ws + WS_A1), (const char*)HN};
                EpiFn1 E{{ws, l, 0}};
                pg8::gemm_phase<256, D, 4>(F.lds, S, E, F.wave, tp_here);
                if (MK_PREFETCH && F.blk >= 128) { frame_refresh(F); prefetch_region(F, ws + WS_A2S, 16 * MiB, 128, F.G - 128); prefetch_region(F, ws + WS_WUP + 3 * WUP_BYTES, WUP_BYTES, 128, F.G - 128); } } break;
        case 8: if (EN(8)) { CASE_BEGIN();
                if (F.blk < 128) { EpiBf16<128> E{{ws, l, 0}}; OrderFn2 S{F.blk, 1, (const char*)(ws + WS_A2S), (const char*)(ws + WS_YT)}; pg8::gemm_phase<2 * TS, 2 * TS, 2 * TS / 64, 128>(F.lds, S, E, F.wave, tp_here); }
                else { EpiBf16<256> E{{ws, l, 0}}; OrderFn2 S{F.blk, 0, (const char*)(ws + WS_A2P), (const char*)(ws + WS_YT)}; pg8::gemm_phase<2 * TP, 2 * TP, 2 * TP / 64>(F.lds, S, E, F.wave, tp_here);
                    if (MK_PREFETCH) { frame_refresh(F); prefetch_region(F, ws + WS_WFNO, 2 * MiB, 128, F.G - 128); } } } break;
        case 9: if (EN(9)) { CASE_BEGIN(); const bf16_t* mix_in = l == 2 ? H2 : H;
                const bf16_t* wout = (const bf16_t*)(ws + (l == 0 ? WS_WO : l == 1 ? WS_WSGO : l == 2 ? WS_WSCO : WS_WFNO));
                Order<64, 4, 0, D, D, 192> S; S.init(F.G, F.blk, mix_in, wout);
                EpiResNorm<false> E{{ws, l, rep ? 2 : 0}};
                if (MK_REP_SHORTK && MK_REP_KIND == 9 && rep > 0) { pg8::gemm_phase<D, D, 4, 192>(F.lds, S, E, F.wave, tp_here); break; }
                pg8::gemm_phase<D, D, D / 64, 192>(F.lds, S, E, F.wave, tp_here);
                } break;
        case 10: if (EN(11)) { CASE_BEGIN(); Order<50, 22, 1, D, D> S; S.init(F.G, F.blk, HN, ws + WS_WUP + l * WUP_BYTES);
                if (MK_REP_NULL && rep > 0) { EpiNull E{{ws, l, 0}}; pg8::gemm_phase<D, D, D / 64>(F.lds, S, E, F.wave, tp_here); }
                else if (MK_REP_SHORTK && MK_REP_KIND == 10 && rep > 0) { EpiUp E{{ws, l, 0}}; pg8::gemm_phase<D, D, 4>(F.lds, S, E, F.wave, tp_here); }
                else { EpiUp E{{ws, l, 0}};
                pg8::gemm_phase<D, D, D / 64>(F.lds, S, E, F.wave, tp_here); }
                if (rep == 0 && F.blk >= 76) { frame_refresh(F);
                    if (l < 3) { mod_items(F, 192 * (l + 1), 192 * (l + 2), 76, F.G - 76); convert_layer(F, l + 1, 76, F.G - 76); }
                    if (MK_PREFETCH) { prefetch_region(F, ws + WS_WDN + l * WDN_BYTES, WDN_BYTES, 76, F.G - 76); } } } break;
        default: if (EN(12)) { CASE_BEGIN(); Order<64, 4, 0, DFF, DFF, 192> S; S.init(F.G, F.blk, ws + WS_ACT, ws + WS_WDN + l * WDN_BYTES);
                if (l < 3) { EpiResNorm<false> E{{ws, l, 1 | (rep ? 2 : 0)}}; pg8::gemm_phase<DFF, DFF, DFF / 64, 192>(F.lds, S, E, F.wave, tp_here); }
                else { EpiResNorm<true> E{{ws, l, 1 | (rep ? 2 : 0)}}; pg8::gemm_phase<DFF, DFF, DFF / 64, 192>(F.lds, S, E, F.wave, tp_here); } } break;
        }
        }
        if (tp_here && wave0 == 0 && pg8::lane_id() == 0) { const unsigned long long r1 = __builtin_amdgcn_s_memrealtime(), c1 = __builtin_amdgcn_s_memtime();
            if (MK_TP == 1) MISC[16] = (unsigned)(r1 - tp_r0);
            if (MK_TP == 3) MISC[16] = (unsigned)((c1 - tp_c0) * 10ull / (r1 - tp_r0)) * 10u; }
        if (ph + 1 < hi) xcd_barrier(bar, wave0 == 0 && pg8::lane_id() == 0);
    }
    if (MK_TP && blk0 == 0 && wave0 == 0) { const unsigned v = MISC[16] * (MK_TP == 2 ? 4u : 1u); const unsigned long long t0 = __builtin_amdgcn_s_memrealtime();
        while (__builtin_amdgcn_s_memrealtime() - t0 < v) __builtin_amdgcn_s_sleep(8); }
}

extern "C" void kernel_launch(void* const* d_in, const int* in_sizes, int n_in, void* d_out, int out_size, void* d_ws, size_t ws_size, hipStream_t stream) {
    static int grid = 0;
    if (grid == 0) {
        if (n_in != 26 || ws_size < WS_TOTAL + (MK_REP_N ? (size_t)73 * MiB : 0)) { fprintf(stderr, "kernel_launch: unexpected n_in %d / ws %zu (need %zu)\n", n_in, ws_size, (size_t)WS_TOTAL); grid = -1; return; }
        int dev = 0, cus = 0;
        if (hipGetDevice(&dev) != hipSuccess || hipDeviceGetAttribute(&cus, hipDeviceAttributeMultiprocessorCount, dev) != hipSuccess) { grid = -1; return; }
        if (hipFuncSetAttribute((const void*)mk_fwd, hipFuncAttributeMaxDynamicSharedMemorySize, LDS_BYTES) != hipSuccess) { fprintf(stderr, "kernel_launch: hipFuncSetAttribute failed\n"); grid = -1; return; }
        (void)hipGetLastError();
        grid = cus;
    }
    if (grid < 0) return;
    (void)hipMemsetAsync((char*)d_ws + WS_CTL, 0, CTL_ZERO_BYTES, stream);
    Args a{};
    for (int i = 0; i < 26; ++i) a.in[i] = (const float*)d_in[i];
    a.out = (float*)d_out; a.ws = (unsigned char*)d_ws;
#if MK_PER_PHASE
    for (int p = MK_PH_LO; p < MK_PH_HI; ++p) { a.ph_lo = p; a.ph_hi = p + 1; hipLaunchKernelGGL(mk_fwd, dim3(grid), dim3(NWAVES * 64), LDS_BYTES, stream, a); }
#else
    a.ph_lo = MK_PH_LO; a.ph_hi = MK_PH_HI;
    hipLaunchKernelGGL(mk_fwd, dim3(grid), dim3(NWAVES * 64), LDS_BYTES, stream, a);
#endif
}
```

```cpp
#include <hip/hip_runtime.h>
#include <cstdio>

#define LAS __attribute__((address_space(3)))
#define GAS __attribute__((address_space(1)))
typedef unsigned short bf16_t;
typedef short bf16x8 __attribute__((ext_vector_type(8)));
typedef float f32x4 __attribute__((ext_vector_type(4)));
typedef float f32x2 __attribute__((ext_vector_type(2)));
typedef unsigned u32x4 __attribute__((ext_vector_type(4)));
typedef unsigned u32x2 __attribute__((ext_vector_type(2)));

constexpr int D = 1024, MP = 8192, MS = 4096, M = MP + MS, DFF = 2816, TS = 2048, TP = 256;
constexpr float EPS = 1e-6f;
constexpr int NWAVES = 8;
#ifndef MK_PER_PHASE
#define MK_PER_PHASE 0
#endif
#ifndef MK_PH_LO
#define MK_PH_LO 0
#endif
#ifndef MK_PH_HI
#define MK_PH_HI 21
#endif
#ifndef MK_MASK
#define MK_MASK 0xffffffffu
#endif
#define EN(b) (((MK_MASK) >> (b)) & 1u)
#ifndef MK_REP_KIND
#define MK_REP_KIND -1
#endif
#ifndef MK_REP_N
#define MK_REP_N 0
#endif
#ifndef MK_REP_NULL
#define MK_REP_NULL 0
#endif
#ifndef MK_REP_SHORTK
#define MK_REP_SHORTK 0
#endif
#ifndef MK_PREFETCH
#define MK_PREFETCH 1
#endif
#ifndef MK_TP
#define MK_TP 0
#endif
#ifndef MK_TP_PH
#define MK_TP_PH 10
#endif

namespace pg8 {
constexpr int BM = 256, BK = 64, HALF = 128, HTB = HALF * BK * 2, STAGE_BYTES = 8 * HTB, NXCD = 8, WGM = 8;
__host__ __device__ __forceinline__ int lds_byte(int r, int c) { const int st = (r >> 4) * 2 + (c >> 5), rr = r & 15, cc = c & 31, ob = rr * 64 + cc * 2; return st * 1024 + (ob ^ (((ob >> 9) & 1) << 5)); }
__host__ __device__ __forceinline__ void stage_rc(int b, int& R, int& C) { const int st = b / 1024, sb = b % 1024, swz = sb ^ (((sb >> 9) & 1) << 5); R = (st >> 1) * 16 + swz / 64; C = (st & 1) * 32 + (swz % 64) / 2; }
__host__ __device__ __forceinline__ int perm32(int rho) { const int n = rho >> 4, i = rho & 15; return 8 * (i >> 2) + 4 * n + (i & 3); }

struct Unit { int pm, pn, row0; const char* a; const char* b; };
struct Cfg { int lda, ldb, nt; };

__device__ __forceinline__ int lane_id() { return (int)__builtin_amdgcn_mbcnt_hi(~0u, __builtin_amdgcn_mbcnt_lo(~0u, 0u)); }
__device__ __forceinline__ unsigned cvt_pk_bf16(float lo, float hi) { unsigned r; asm volatile("v_cvt_pk_bf16_f32 %0, %1, %2" : "=v"(r) : "v"(lo), "v"(hi)); return r; }

template <int LDA, int LDB, int NT, int ROWS = 256, class Epi, class Sched>
__device__ __forceinline__ void gemm_phase(LAS unsigned char* lds, const Sched& S, const Epi& E, int wid, bool tp_on = false) {
    constexpr Cfg g{LDA, LDB, NT};
    int lane_ = lane_id(); asm volatile("" : "+v"(lane_));
    const int lane = lane_, tid = wid * 64 + lane, wr = wid >> 2, wc = wid & 3, fr = lane & 15, fq = lane >> 4;
    const int nt = g.nt;
    unsigned voffA[2], voffB[2];
#pragma unroll
    for (int i = 0; i < 2; ++i) { int R, C; stage_rc(tid * 16 + i * 8192, R, C); const int Rb = Epi::PERM ? ((R & ~31) + perm32(R & 31)) : R;
        voffA[i] = (unsigned)(R * g.lda + C) * 2u; voffB[i] = (unsigned)(Rb * g.ldb + C) * 2u; }
    unsigned voffA1[2]; voffA1[0] = ROWS == 128 ? 0u : voffA[0]; voffA1[1] = ROWS == 256 ? voffA[1] : 0u;
    const size_t kstep = (size_t)(BK * 2);
    const size_t hstepA = (size_t)HALF * g.lda * 2, hstepB = (size_t)HALF * g.ldb * 2;
    const unsigned ldsw = (unsigned)wid * 1024u;
    constexpr int NM1 = ROWS == 192 ? 2 : ROWS == 128 ? 0 : 4;
    const int aoff = lds_byte(wr * 64 + fr, fq * 8), boff = lds_byte(wc * 32 + fr, fq * 8), aoff1 = ROWS == 192 ? lds_byte(wr * 32 + fr, fq * 8) : aoff;
#define PG8_SA(b, h) (((b) * 2 + (h)) * HTB)
#define PG8_SB(b, h) ((4 + (b) * 2 + (h)) * HTB)
#define PG8_STAGE(bufoff, gbase, voff) do { _Pragma("unroll") for (int _i = 0; _i < 2; ++_i) { unsigned _vo = (voff)[_i]; asm volatile("" : "+v"(_vo)); \
        __builtin_amdgcn_global_load_lds((const unsigned*)((const char*)(gbase) + _vo), (LAS unsigned*)(lds + (bufoff) + ldsw + _i * 8192), 16, 0, 0); } } while (0)
#define PG8_LDA(dst, b, h) do { _Pragma("unroll") for (int m = 0; m < 4; ++m) _Pragma("unroll") for (int k = 0; k < 2; ++k) dst[m][k] = *(const LAS bf16x8*)(lds + PG8_SA(b, h) + aoff + m * 2048 + k * 1024); } while (0)
#define PG8_LDA1(dst, b) do { _Pragma("unroll") for (int m = 0; m < NM1; ++m) _Pragma("unroll") for (int k = 0; k < 2; ++k) dst[m][k] = *(const LAS bf16x8*)(lds + PG8_SA(b, 1) + aoff1 + m * 2048 + k * 1024); } while (0)
#define PG8_LDB(dst, b, h) do { _Pragma("unroll") for (int n = 0; n < 2; ++n) _Pragma("unroll") for (int k = 0; k < 2; ++k) dst[n][k] = *(const LAS bf16x8*)(lds + PG8_SB(b, h) + boff + n * 2048 + k * 1024); } while (0)
#define PG8_MMA(ai, bj, At, Bt) do { __builtin_amdgcn_s_setprio(1); _Pragma("unroll") for (int m = 0; m < 4; ++m) _Pragma("unroll") for (int n = 0; n < 2; ++n) _Pragma("unroll") for (int k = 0; k < 2; ++k) \
        acc[ai][bj][m][n] = __builtin_amdgcn_mfma_f32_16x16x32_bf16(Bt[n][k], At[m][k], acc[ai][bj][m][n], 0, 0, 0); __builtin_amdgcn_s_setprio(0); } while (0)
#define PG8_MMA1(bj, At, Bt) do { __builtin_amdgcn_s_setprio(1); _Pragma("unroll") for (int m = 0; m < NM1; ++m) _Pragma("unroll") for (int n = 0; n < 2; ++n) _Pragma("unroll") for (int k = 0; k < 2; ++k) \
        acc[1][bj][m][n] = __builtin_amdgcn_mfma_f32_16x16x32_bf16(Bt[n][k], At[m][k], acc[1][bj][m][n], 0, 0, 0); __builtin_amdgcn_s_setprio(0); } while (0)
#define PG8_WAIT_V(n) asm volatile("s_waitcnt vmcnt(" #n ")" ::: "memory")
#define PG8_WAIT_L(n) asm volatile("s_waitcnt lgkmcnt(" #n ")" ::: "memory")
#define PG8_BAR __builtin_amdgcn_s_barrier()
#define PG8_SCHED __builtin_amdgcn_sched_barrier(0)
    Unit cur, nxt; int ui = 0;
    if (!S.next(0, cur)) return;
    f32x4 acc[2][2][4][2];
#pragma unroll
    for (int a = 0; a < 2; ++a)
#pragma unroll
        for (int b = 0; b < 2; ++b)
#pragma unroll
            for (int m = 0; m < 4; ++m)
#pragma unroll
                for (int n = 0; n < 2; ++n) acc[a][b][m][n] = (f32x4){0.f, 0.f, 0.f, 0.f};
    bf16x8 At[4][2], B0[2][2], B1[2][2];
    const char* cA = cur.a; const char* cB = cur.b;
    PG8_STAGE(PG8_SB(0, 0), cB, voffB); PG8_STAGE(PG8_SB(0, 1), cB + hstepB, voffB); PG8_STAGE(PG8_SA(0, 0), cA, voffA); PG8_STAGE(PG8_SA(0, 1), cA + hstepA, voffA1);
    if (wr == 1) PG8_BAR;
    PG8_WAIT_V(2); PG8_BAR;
    PG8_STAGE(PG8_SB(1, 0), cB + kstep, voffB); PG8_STAGE(PG8_SA(1, 0), cA + kstep, voffA); PG8_STAGE(PG8_SB(1, 1), cB + hstepB + kstep, voffB);
    PG8_WAIT_V(6); PG8_BAR;
    for (;;) {
        const bool has_next = S.next(ui + 1, nxt);
        const char* nA = has_next ? nxt.a : cA; const char* nB = has_next ? nxt.b : cB;
        for (int t = 0; t < nt; t += 2) {
            const bool last = (t == nt - 2);
            const char* a1 = cA + (size_t)(t + 1) * kstep;
            const char* a2 = last ? nA : cA + (size_t)(t + 2) * kstep; const char* b2 = last ? nB : cB + (size_t)(t + 2) * kstep;
            const char* a3 = a2 + kstep; const char* b3 = b2 + kstep;
            PG8_LDB(B0, 0, 0); PG8_LDB(B1, 0, 1); PG8_SCHED; PG8_LDA(At, 0, 0); PG8_STAGE(PG8_SA(1, 1), a1 + hstepA, voffA1);
            PG8_WAIT_V(8); PG8_WAIT_L(0); PG8_BAR; PG8_MMA(0, 0, At, B0); PG8_MMA(0, 1, At, B1); PG8_BAR; PG8_SCHED;
            PG8_LDA1(At, 0); PG8_STAGE(PG8_SB(0, 0), b2, voffB); PG8_STAGE(PG8_SB(0, 1), b2 + hstepB, voffB); PG8_STAGE(PG8_SA(0, 0), a2, voffA);
            PG8_WAIT_V(8); PG8_WAIT_L(0); PG8_BAR; PG8_MMA1(0, At, B0); PG8_MMA1(1, At, B1); PG8_BAR; PG8_SCHED;
            PG8_LDB(B0, 1, 0); PG8_LDB(B1, 1, 1); PG8_SCHED; PG8_LDA(At, 1, 0); PG8_STAGE(PG8_SA(0, 1), a2 + hstepA, voffA1);
            PG8_WAIT_V(8); PG8_WAIT_L(0); PG8_BAR; PG8_MMA(0, 0, At, B0); PG8_MMA(0, 1, At, B1); PG8_BAR; PG8_SCHED;
            PG8_LDA1(At, 1); PG8_STAGE(PG8_SB(1, 0), b3, voffB); PG8_STAGE(PG8_SB(1, 1), b3 + hstepB, voffB); PG8_STAGE(PG8_SA(1, 0), a3, voffA);
            PG8_WAIT_V(8); PG8_WAIT_L(0); PG8_BAR; PG8_MMA1(0, At, B0); PG8_MMA1(1, At, B1); PG8_BAR; PG8_SCHED;
        }
        if (wr == 0) PG8_BAR;
        if (MK_TP == 2) { const unsigned long long t0_ = __builtin_amdgcn_s_memrealtime(); E(acc, cur, wid, ui); const unsigned long long t1_ = __builtin_amdgcn_s_memrealtime();
            if (wid == 0 && lane == 0 && tp_on) *(volatile LAS unsigned*)(lds + 131072 + 8192 + 320 + 4 * 16) += (unsigned)(t1_ - t0_); }
        else E(acc, cur, wid, ui);
        if (!has_next) break;
#pragma unroll
        for (int a = 0; a < 2; ++a)
#pragma unroll
            for (int b = 0; b < 2; ++b)
#pragma unroll
                for (int m = 0; m < 4; ++m)
#pragma unroll
                    for (int n = 0; n < 2; ++n) acc[a][b][m][n] = (f32x4){0.f, 0.f, 0.f, 0.f};
        cur = nxt; cA = nA; cB = nB; ++ui;
        if (wr == 1) PG8_BAR;
    }
    PG8_WAIT_V(0);
    PG8_BAR;
#undef PG8_SA
#undef PG8_SB
#undef PG8_STAGE
#undef PG8_LDA
#undef PG8_LDA1
#undef PG8_MMA1
#undef PG8_LDB
#undef PG8_MMA
#undef PG8_WAIT_V
#undef PG8_WAIT_L
#undef PG8_BAR
#undef PG8_SCHED
}
}
using pg8::Unit; using pg8::cvt_pk_bf16;

constexpr size_t MiB = 1u << 20;
constexpr size_t WS_CTL = 0, CTL_ZERO_BYTES = 128 * 1024;
constexpr size_t WS_MOD = 1 * MiB;
constexpr size_t WS_ROPE = WS_MOD + 512 * 1024;
constexpr size_t WS_STATS = WS_ROPE + 64 * 1024;
constexpr size_t WS_WQKV = 4 * MiB;
constexpr size_t WS_WO = WS_WQKV + 3 * MiB;
constexpr size_t WS_WSGI = WS_WO + 2 * MiB;
constexpr size_t WS_WSGO = WS_WSGI + 4 * MiB;
constexpr size_t WS_WSCI = WS_WSGO + 2 * MiB;
constexpr size_t WS_WSCO = WS_WSCI + 6 * MiB;
constexpr size_t WS_WFNO = WS_WSCO + 2 * MiB;
constexpr size_t WS_WUP = WS_WFNO + 2 * MiB;
constexpr size_t WUP_BYTES = (size_t)2 * DFF * D * 2;
constexpr size_t WS_WDN = WS_WUP + 4 * WUP_BYTES;
constexpr size_t WDN_BYTES = (size_t)D * DFF * 2;
constexpr size_t WS_WS = WS_WDN + 4 * WDN_BYTES;
constexpr size_t WS_A1 = WS_WS + 256 * 1024;
constexpr size_t WS_A2P = WS_A1 + 256 * 1024;
constexpr size_t WS_A2S = WS_A2P + 256 * 1024;
constexpr size_t WS_CK = WS_A2S + 16 * MiB;
constexpr size_t WS_CVT = WS_CK + 512 * 1024;
constexpr size_t WS_X = WS_CVT + 512 * 1024;
constexpr size_t WS_H = WS_X + (size_t)M * D * 4;
constexpr size_t WS_BIG = WS_H + (size_t)(M + 256) * D * 2;
constexpr size_t WS_END = WS_BIG + 72 * MiB;
constexpr size_t WS_ACT = WS_BIG;
constexpr size_t WS_Q = WS_BIG;
constexpr size_t WS_KB = WS_Q + 24 * MiB;
constexpr size_t WS_VT = WS_KB + 6 * MiB;
constexpr size_t WS_U = WS_BIG;
constexpr size_t WS_V = WS_BIG + 24 * MiB;
constexpr size_t WS_YB = WS_BIG;
constexpr size_t WS_YT = WS_BIG;
static_assert(WS_YB + (size_t)256 * 2 * 16 * 512 * 16 <= WS_END, "yb");
static_assert(WS_ACT + (size_t)M * DFF * 2 <= WS_END, "act");
constexpr size_t WS_H2 = WS_END;
constexpr size_t WS_HN = WS_H2 + (size_t)M * D * 2;
constexpr size_t WS_XS = WS_HN + (size_t)(M + 256) * D * 2;
constexpr size_t WS_TOTAL = WS_XS + (size_t)16 * M * 4 * 4;
constexpr size_t CTL_CNT = 16384;
constexpr size_t CTL_TMO = CTL_CNT + 16 * 64 * 64;

constexpr size_t OUT_NK = (size_t)M * D, OUT_NV = OUT_NK + (size_t)MP * 256;

#define XB_TMO      128
#define XB_XCNT(j)  (256  + 64 * (j))
#define XB_XSUB(j)  (1280 + 64 * (j))
#define XB_XGEN(j)  (2304 + 64 * (j))
#define XB_TOP      3328
#define XB_TOPGEN   3392
#define XCD_BAR_WORDS 3456
#define XB_SPIN_CAP (1u << 22)
__device__ __forceinline__ unsigned xb_ld(unsigned* p)              { return __hip_atomic_load(p, __ATOMIC_RELAXED, __HIP_MEMORY_SCOPE_AGENT); }
__device__ __forceinline__ unsigned xb_add(unsigned* p, unsigned v) { return __hip_atomic_fetch_add(p, v, __ATOMIC_RELAXED, __HIP_MEMORY_SCOPE_AGENT); }
__device__ __forceinline__ unsigned xb_xcc_id() { return (unsigned)__builtin_amdgcn_s_getreg((3 << 11) | 20) & 0xFu; }
#define XB_SPIN(cond, bar) do { unsigned _sp = 0; while (cond) { __builtin_amdgcn_s_sleep(1); \
    if ((++_sp & 255u) == 0u) { if (xb_ld(&(bar)[XB_TMO])) break; if (_sp > XB_SPIN_CAP) { atomicAdd(&(bar)[XB_TMO], 1u); break; } } } } while (0)
struct XcdBarrier { unsigned* bar; unsigned x; volatile LAS unsigned* st; };
__device__ __forceinline__ XcdBarrier xcd_barrier_post(unsigned* bar, volatile LAS unsigned* st, bool leader) {
    XcdBarrier b; b.bar = bar; b.x = xb_xcc_id(); b.st = st;
    if (leader) (void)xb_add(&bar[XB_XCNT(b.x)], 1u);
    return b;
}
__device__ __forceinline__ void xcd_barrier_complete(unsigned* bar, unsigned x, unsigned& nloc, unsigned& nx) {
    const unsigned G = gridDim.x * gridDim.y * gridDim.z;
    unsigned sum, cnt, mine, sp = 0u;
    for (;;) {
        sum = 0u; cnt = 0u; mine = 0u;
#pragma unroll
        for (unsigned j = 0; j < 16; ++j) { const unsigned c = xb_ld(&bar[XB_XCNT(j)]); sum += c; cnt += (c > 0u) ? 1u : 0u; }
        mine = xb_ld(&bar[XB_XCNT(x)]);
        if (sum == G) break;
        __builtin_amdgcn_s_sleep(1);
        if ((++sp & 255u) == 0u) { if (xb_ld(&bar[XB_TMO])) break; if (sp > XB_SPIN_CAP) { atomicAdd(&bar[XB_TMO], 1u); break; } }
    }
    nloc = mine > 0u ? mine : 1u; nx = cnt > 0u ? cnt : 1u;
}
__device__ __forceinline__ void xcd_barrier(const XcdBarrier& b, bool leader) {
    asm volatile("s_waitcnt vmcnt(0)" ::: "memory");
    __syncthreads();
    if (leader) {
        unsigned* bar = b.bar; unsigned bx = b.x; asm volatile("" : "+s"(bx));
        __builtin_amdgcn_s_waitcnt(0);
        unsigned nloc = b.st[0], nx = b.st[1];
        if (nloc == 0u) { xcd_barrier_complete(bar, bx, nloc, nx); b.st[0] = nloc; b.st[1] = nx; }
        const unsigned old = xb_add(&bar[XB_XSUB(bx)], 1u);
        const unsigned gen = old / nloc;
        if (old + 1u == (gen + 1u) * nloc) {
            __builtin_amdgcn_fence(__ATOMIC_RELEASE, "agent");
            asm volatile("s_waitcnt vmcnt(0)" ::: "memory");
            const unsigned og = xb_add(&bar[XB_TOP], 1u);
            const unsigned tg = og / nx;
            if (og + 1u == (tg + 1u) * nx) xb_add(&bar[XB_TOPGEN], 1u);
            else XB_SPIN(xb_ld(&bar[XB_TOPGEN]) == tg, bar);
            __builtin_amdgcn_fence(__ATOMIC_ACQUIRE, "agent");
            xb_add(&bar[XB_XGEN(bx)], 1u);
            asm volatile("s_waitcnt vmcnt(0)" ::: "memory");
        } else {
            XB_SPIN(xb_ld(&bar[XB_XGEN(bx)]) == gen, bar);
            __builtin_amdgcn_fence(__ATOMIC_ACQUIRE, "agent");
            asm volatile("s_waitcnt vmcnt(0)" ::: "memory");
        }
    }
    __syncthreads();
}

#define LDS_WAIT() asm volatile("s_waitcnt lgkmcnt(0)" ::: "memory")
__device__ __forceinline__ unsigned f2bf(float f) { unsigned u = __builtin_bit_cast(unsigned, f); return (u + 0x7fffu + ((u >> 16) & 1u)) >> 16; }
__device__ __forceinline__ unsigned pk2(float lo, float hi) { return f2bf(lo) | (f2bf(hi) << 16); }
__device__ __forceinline__ float bf2f(unsigned short b) { return __builtin_bit_cast(float, (unsigned)b << 16); }
__device__ __forceinline__ float rows_max(float x) {
    auto s = __builtin_amdgcn_permlane16_swap(__float_as_uint(x), __float_as_uint(x), false, false); x = fmaxf(__uint_as_float(s[0]), __uint_as_float(s[1]));
    auto t = __builtin_amdgcn_permlane32_swap(__float_as_uint(x), __float_as_uint(x), false, false); return fmaxf(__uint_as_float(t[0]), __uint_as_float(t[1])); }
__device__ __forceinline__ float rows_sum(float x) {
    auto s = __builtin_amdgcn_permlane16_swap(__float_as_uint(x), __float_as_uint(x), false, false); x = __uint_as_float(s[0]) + __uint_as_float(s[1]);
    auto t = __builtin_amdgcn_permlane32_swap(__float_as_uint(x), __float_as_uint(x), false, false); return __uint_as_float(t[0]) + __uint_as_float(t[1]); }
template <int CTRL> __device__ __forceinline__ float dppx(float v) { return __builtin_bit_cast(float, __builtin_amdgcn_mov_dpp(__builtin_bit_cast(int, v), CTRL, 0xf, 0xf, true)); }
__device__ __forceinline__ float wave_sum(float v) {
    v += dppx<0xB1>(v);
    v += dppx<0x4E>(v);
    v += dppx<0x141>(v);
    v += dppx<0x140>(v);
    return rows_sum(v);
}
__device__ __forceinline__ float fast_exp2(float x) { return __builtin_amdgcn_exp2f(x); }
__device__ __forceinline__ float fast_rcp(float x) { return __builtin_amdgcn_rcpf(x); }
__device__ __forceinline__ float silu_f(float x) { return x * fast_rcp(1.f + fast_exp2(-1.4426950408889634f * x)); }
__device__ __forceinline__ float gelu_f(float x) { const float u = x * (1.f + 0.044715f * x * x); return x * fast_rcp(1.f + fast_exp2(-2.302208198f * u)); }
__device__ __forceinline__ int conv_row0(int pm) { if (pm < 32) return 256 * pm; const int s = (pm - 32) / 9, i = (pm - 32) % 9; return MP + TS * s + 254 * i - 1; }
template <int CTRL> __device__ __forceinline__ float dpp(float v) { return __builtin_bit_cast(float, __builtin_amdgcn_mov_dpp(__builtin_bit_cast(int, v), CTRL, 0xf, 0xf, true)); }
template <int CTRL> __device__ __forceinline__ f32x4 dpp4(f32x4 v) { return (f32x4){dpp<CTRL>(v[0]), dpp<CTRL>(v[1]), dpp<CTRL>(v[2]), dpp<CTRL>(v[3])}; }
#define DPP_ROR1 0x121
#define DPP_ROR15 0x12F

template <int NM, int NN, int CONV, int LDA, int LDB, int ROWS = 256>
struct Order {
    int G, c; const char* A; const char* B;
    __device__ __forceinline__ void init(int G_, int c_, const void* A_, const void* B_) { G = G_; c = c_; A = (const char*)A_; B = (const char*)B_; }
    __device__ __forceinline__ bool next(int i, Unit& u) const {
        constexpr int nwg = NM * NN;
        const int L = i * G + c; if (L >= nwg) return false;
        int wgid = L; { constexpr int q = nwg / pg8::NXCD, r = nwg % pg8::NXCD; const int xcd = wgid % pg8::NXCD, off = wgid / pg8::NXCD; wgid = (xcd < r ? xcd * (q + 1) : r * (q + 1) + (xcd - r) * q) + off; }
        constexpr int nig = pg8::WGM * NN; const int gid = wgid / nig, fm = gid * pg8::WGM, gsz = (NM - fm) < pg8::WGM ? (NM - fm) : pg8::WGM;
        u.pm = fm + ((wgid % nig) % gsz); u.pn = (wgid % nig) / gsz;
        u.row0 = CONV ? conv_row0(u.pm) : ROWS * u.pm;
        u.a = A + (long)u.row0 * (long)(LDA * 2); u.b = B + (size_t)u.pn * (size_t)(256 * LDB * 2); return true;
    }
};

typedef const GAS float* cfp_t;
struct Frame {
    LAS unsigned char* lds; int tid, lane, wave, G, blk;
    const __attribute__((address_space(4))) cfp_t* in; float* out; unsigned char* ws;
};
__device__ __forceinline__ void frame_refresh(Frame& F) {
    int ln = pg8::lane_id(); asm volatile("" : "+v"(ln)); F.lane = ln; F.tid = F.wave * 64 + ln;
}
constexpr int RING_BYTES = 131072, XCH_OFF = RING_BYTES  , MISC_OFF = XCH_OFF + 8192 + 320, LDS_BYTES = 147456;
__device__ __forceinline__ int vec_plain(int pm) { return pm < 32 ? 0 : 1 + (pm - 32) / 8; }
__device__ __forceinline__ int vec_conv(int pm) { return pm < 32 ? 0 : 1 + (pm - 32) / 9; }

__device__ __forceinline__ constexpr int r192_nm(int ai) { return ai ? 2 : 4; }
__device__ __forceinline__ int r192_base(int ai, int wr) { return ai ? 128 + 32 * wr : 64 * wr; }
struct EpiBase {
    unsigned char* ws_; int l, aux;
    __device__ __forceinline__ unsigned char* wsp() const { unsigned long long w = (unsigned long long)ws_; asm volatile("" : "+s"(w)); return (unsigned char*)(GAS unsigned char*)w; }
    __device__ __forceinline__ static const __attribute__((address_space(4))) cfp_t* kargs() { unsigned long long kp = (unsigned long long)__builtin_amdgcn_kernarg_segment_ptr(); asm volatile("" : "+s"(kp)); return (const __attribute__((address_space(4))) cfp_t*)kp; }
    __device__ __forceinline__ static const float* inp(const __attribute__((address_space(4))) cfp_t* ka, int k) { return (const float*)ka[k]; }
    __device__ __forceinline__ static float* outp(const __attribute__((address_space(4))) cfp_t* ka) { return (float*)(GAS float*)ka[26]; }
    __device__ __forceinline__ static LAS float* xch() { extern __shared__ __attribute__((aligned(16))) unsigned char lds_base_[]; return (LAS float*)((LAS unsigned char*)lds_base_ + XCH_OFF); }
};
template <bool FINAL>
struct EpiResNorm : EpiBase {
    static constexpr bool PERM = false;
    static constexpr int TR = 192;
    __device__ __forceinline__ static int nm(int ai) { return ai ? 2 : 4; }
    __device__ __forceinline__ static int rbase(int ai, int wr) { return ai ? 128 + 32 * wr : 64 * wr; }
    __device__ __forceinline__ void operator()(f32x4 (&acc)[2][2][4][2], const Unit& u, int wid, int ) const {
        int lane_ = pg8::lane_id(); asm volatile("" : "+v"(lane_));
        const int lane = lane_, wr = wid >> 2, wc = wid & 3, fr = lane & 15, fq = lane >> 4;
        unsigned char* ws = wsp(); const auto ka = kargs();
        const int isdn = aux & 1, rep = (aux >> 1) & 1, inst = 2 * l + isdn + 8 * rep;
        typedef _Float16 h4 __attribute__((ext_vector_type(4)));
        _Float16* Xr = (_Float16*)(ws + WS_X); _Float16* X = rep ? (_Float16*)(ws + WS_TOTAL) : Xr;
        const bool srcf32 = (!isdn && l == 0);
        const float* modl = (const float*)(ws + WS_MOD) + l * 3 * 6 * D; const int gate_idx = isdn ? 5 : 2;
        const float* gn = FINAL ? inp(ka, 10) : (isdn ? inp(ka, 8) + (l + 1) * D : inp(ka, 9) + l * D);
        const float* modn = isdn ? modl + 3 * 6 * D : modl; const int sh_idx = isdn ? 0 : 3;
        bf16_t* HN = (bf16_t*)(ws + (rep ? WS_TOTAL + 48 * MiB : WS_HN)); float* Y = rep ? (float*)(ws + WS_TOTAL) : outp(ka);
        float* xs = (float*)(ws + WS_XS) + (size_t)inst * M * 4; unsigned* cnt = (unsigned*)(ws + WS_CTL + CTL_CNT) + inst * 64 * 16; unsigned* tmo = (unsigned*)(ws + WS_CTL + CTL_TMO);
        LAS float* L = xch();
        const int col0 = u.pn * 256 + wc * 32 + 4 * fq, tid = wid * 64 + lane;
        LAS float* P = L;
        LAS float* S = L + 1024;
#pragma unroll
        for (int ai = 0; ai < 2; ++ai) {
            const int rb = u.row0 + rbase(ai, wr);
            const int vec = rb < MP ? 0 : 1 + (rb - MP) / TS;
            const float* gate = modl + vec * 6 * D + gate_idx * D;
            const float* src = rb < MP ? inp(ka, 0) + (size_t)rb * D : inp(ka, 1) + (size_t)(rb - MP) * D;
            f32x4 gv[2][2];
#pragma unroll
            for (int bj = 0; bj < 2; ++bj)
#pragma unroll
                for (int n = 0; n < 2; ++n) gv[bj][n] = *(const f32x4*)(gate + col0 + bj * 128 + n * 16);
            f32x4 sv[4][2][2];
#pragma unroll
            for (int m = 0; m < 4; ++m) if (m < nm(ai)) { const size_t ro = (size_t)(16 * m + fr) * D + col0;
#pragma unroll
                for (int bj = 0; bj < 2; ++bj)
#pragma unroll
                    for (int n = 0; n < 2; ++n) { if (srcf32) sv[m][bj][n] = *(const f32x4*)(src + ro + bj * 128 + n * 16);
                        else sv[m][bj][n] = __builtin_convertvector(*(const h4*)(Xr + (size_t)rb * D + ro + bj * 128 + n * 16), f32x4); } }
#pragma unroll
            for (int m = 0; m < 4; ++m) if (m < nm(ai)) { const int r = rbase(ai, wr) + 16 * m + fr; float ss = 0.f;
#pragma unroll
                for (int bj = 0; bj < 2; ++bj)
#pragma unroll
                    for (int n = 0; n < 2; ++n) { const f32x4 x1 = sv[m][bj][n] + gv[bj][n] * acc[ai][bj][m][n]; acc[ai][bj][m][n] = x1;
                        ss += (x1[0] * x1[0] + x1[1] * x1[1]) + (x1[2] * x1[2] + x1[3] * x1[3]); }
                ss = rows_sum(ss);
                if (fq == 0) P[r * 4 + wc] = ss; }
            asm volatile("" ::: "memory"); }
        LDS_WAIT(); __builtin_amdgcn_s_barrier(); asm volatile("" ::: "memory");
        if (tid < TR) { const f32x4 p = *(const LAS f32x4*)(P + tid * 4); const float tot = (p[0] + p[1]) + (p[2] + p[3]);
            __hip_atomic_store(xs + (size_t)(u.row0 + tid) * 4 + u.pn, tot, __ATOMIC_RELAXED, __HIP_MEMORY_SCOPE_AGENT); }
        asm volatile("s_waitcnt vmcnt(0)" ::: "memory");
        if (tid < TR && (tid & 63) == 0) __hip_atomic_fetch_add(cnt + 16 * u.pm, 1u, __ATOMIC_RELAXED, __HIP_MEMORY_SCOPE_AGENT);
        if (!FINAL) {
#pragma unroll
            for (int ai = 0; ai < 2; ++ai)
#pragma unroll
                for (int m = 0; m < 4; ++m) if (m < nm(ai)) { _Float16* xp = X + (size_t)(u.row0 + rbase(ai, wr) + 16 * m + fr) * D + col0;
#pragma unroll
                    for (int bj = 0; bj < 2; ++bj)
#pragma unroll
                        for (int n = 0; n < 2; ++n) *(h4*)(xp + bj * 128 + n * 16) = __builtin_convertvector(acc[ai][bj][m][n], h4); }
        }
        if (tid < 64) { unsigned sp_ = 0;
            while ((unsigned)__builtin_amdgcn_readfirstlane(__hip_atomic_load(cnt + 16 * u.pm, __ATOMIC_RELAXED, __HIP_MEMORY_SCOPE_AGENT)) < 12u) {
                __builtin_amdgcn_s_sleep(1);
                if ((++sp_ & 1023u) == 0u) { if (__hip_atomic_load(tmo, __ATOMIC_RELAXED, __HIP_MEMORY_SCOPE_AGENT)) break; if (sp_ > (1u << 22)) { __hip_atomic_store(tmo, 1u, __ATOMIC_RELAXED, __HIP_MEMORY_SCOPE_AGENT); break; } } }
        }
        asm volatile("s_waitcnt lgkmcnt(0)" ::: "memory"); __builtin_amdgcn_s_barrier(); asm volatile("" ::: "memory");
        if (tid < TR) { const float* sl = xs + (size_t)(u.row0 + tid) * 4; float t = 0.f;
#pragma unroll
            for (int k = 0; k < 4; ++k) t += __hip_atomic_load(sl + k, __ATOMIC_RELAXED, __HIP_MEMORY_SCOPE_AGENT);
            S[tid] = rsqrtf(t * (1.f / D) + EPS); }
        LDS_WAIT(); __builtin_amdgcn_s_barrier(); asm volatile("" ::: "memory");
#pragma unroll
        for (int ai = 0; ai < 2; ++ai) {
            const int rb = u.row0 + rbase(ai, wr); const int vec = rb < MP ? 0 : 1 + (rb - MP) / TS;
            f32x4 gm[2][2], sh[2][2];
#pragma unroll
            for (int bj = 0; bj < 2; ++bj)
#pragma unroll
                for (int n = 0; n < 2; ++n) { const int c = col0 + bj * 128 + n * 16; gm[bj][n] = *(const f32x4*)(gn + c);
                    if (!FINAL) { const float* mv = modn + vec * 6 * D; gm[bj][n] = gm[bj][n] * (1.f + *(const f32x4*)(mv + (sh_idx + 1) * D + c)); sh[bj][n] = *(const f32x4*)(mv + sh_idx * D + c); } }
#pragma unroll
            for (int m = 0; m < 4; ++m) if (m < nm(ai)) { const int r = rbase(ai, wr) + 16 * m + fr; const float rs = S[r];
#pragma unroll
                for (int bj = 0; bj < 2; ++bj)
#pragma unroll
                    for (int n = 0; n < 2; ++n) { const int c = col0 + bj * 128 + n * 16;
                        if (FINAL) { *(f32x4*)(Y + (size_t)(u.row0 + r) * D + c) = acc[ai][bj][m][n] * rs * gm[bj][n]; }
                        else { const f32x4 h = acc[ai][bj][m][n] * rs * gm[bj][n] + sh[bj][n]; u32x2 w; w.x = cvt_pk_bf16(h[0], h[1]); w.y = cvt_pk_bf16(h[2], h[3]); *(u32x2*)(HN + (size_t)(u.row0 + r) * D + c) = w; } } }
        }
    }
};
struct EpiNull : EpiBase {
    static constexpr bool PERM = true;
    __device__ __forceinline__ void operator()(f32x4 (&acc)[2][2][4][2], const Unit& u, int wid, int) const {
        f32x4 s = {0.f, 0.f, 0.f, 0.f};
#pragma unroll
        for (int ai = 0; ai < 2; ++ai)
#pragma unroll
            for (int bj = 0; bj < 2; ++bj)
#pragma unroll
                for (int m = 0; m < 4; ++m)
#pragma unroll
                    for (int n = 0; n < 2; ++n) s += acc[ai][bj][m][n];
        ((f32x4*)(wsp() + WS_TOTAL))[(size_t)(u.pm * 22 + u.pn) * 512 + wid * 64 + pg8::lane_id()] = s;
    }
};
template <int ROWS> struct EpiBf16 : EpiBase {
    static constexpr bool PERM = true;
    __device__ __forceinline__ void operator()(const f32x4 (&acc)[2][2][4][2], const Unit& u, int wid, int ) const {
        int lane_ = pg8::lane_id(); asm volatile("" : "+v"(lane_));
        const int lane = lane_, wr = wid >> 2, wc = wid & 3, fr = lane & 15, fq = lane >> 4; (void)wr; (void)wc; (void)fr; (void)fq;
        bf16_t* O = (bf16_t*)(wsp() + WS_H); constexpr int ldc = D;
        const int col0 = u.pn * 256 + wc * 32 + 8 * fq;
#pragma unroll
        for (int ai = 0; ai < (ROWS == 128 ? 1 : 2); ++ai)
#pragma unroll
            for (int m = 0; m < 4; ++m) { bf16_t* rowp = O + (size_t)(u.row0 + ai * 128 + wr * 64 + m * 16 + fr) * ldc + col0;
#pragma unroll
                for (int bj = 0; bj < 2; ++bj) { const f32x4 v0 = acc[ai][bj][m][0], v1 = acc[ai][bj][m][1];
                    u32x4 w; w.x = cvt_pk_bf16(v0[0], v0[1]); w.y = cvt_pk_bf16(v0[2], v0[3]); w.z = cvt_pk_bf16(v1[0], v1[1]); w.w = cvt_pk_bf16(v1[2], v1[3]);
                    *(u32x4*)(rowp + bj * 128) = w; } }
    }
};
struct EpiQKV : EpiBase {
    static constexpr bool PERM = false;
    __device__ __forceinline__ void operator()(f32x4 (&acc)[2][2][4][2], const Unit& u, int wid, int ) const {
        int lane_ = pg8::lane_id(); asm volatile("" : "+v"(lane_));
        const int lane = lane_, wr = wid >> 2, wc = wid & 3, fr = lane & 15, fq = lane >> 4;
        unsigned char* ws = wsp(); bf16_t* Q = (bf16_t*)(ws + WS_Q); bf16_t* KB = (bf16_t*)(ws + WS_KB); bf16_t* VT = (bf16_t*)(ws + WS_VT); const float* rope = (const float*)(ws + WS_ROPE);
        float* outk = outp(kargs()) + OUT_NK; float* outv = outk + (OUT_NV - OUT_NK);
        const int c0 = wc * 32 + 4 * fq;
#pragma unroll
        for (int ai = 0; ai < 2; ++ai) {
            const int rb = u.row0 + r192_base(ai, wr); const bool samp = rb >= MP;
            if (samp && u.pn <= 4) {
                const int half = wc & 1;
#pragma unroll
                for (int m = 0; m < 4; ++m) if (m < r192_nm(ai)) { const int t = (rb - MP + m * 16 + fr) & (TS - 1); const int pos = half ? (t & 63) : (t >> 6);
                    const f32x4 cs = *(const f32x4*)(rope + pos * 16 + 4 * fq), sn = *(const f32x4*)(rope + 1024 + pos * 16 + 4 * fq);
#pragma unroll
                    for (int bj = 0; bj < 2; ++bj) { const f32x4 x1 = acc[ai][bj][m][0], x2 = acc[ai][bj][m][1]; acc[ai][bj][m][0] = x1 * cs - x2 * sn; acc[ai][bj][m][1] = x2 * cs + x1 * sn; } }
            }
            if (u.pn <= 4) {
                bf16_t* base = u.pn < 4 ? Q + u.pn * 256 : KB; const int ldc = u.pn < 4 ? D : 256;
#pragma unroll
                for (int m = 0; m < 4; ++m) if (m < r192_nm(ai)) { const int row = rb + m * 16 + fr; bf16_t* rowp = base + (size_t)row * ldc + c0;
#pragma unroll
                    for (int bj = 0; bj < 2; ++bj)
#pragma unroll
                        for (int n = 0; n < 2; ++n) { const f32x4 v = acc[ai][bj][m][n]; u32x2 w; w.x = cvt_pk_bf16(v[0], v[1]); w.y = cvt_pk_bf16(v[2], v[3]); *(u32x2*)(rowp + bj * 128 + n * 16) = w;
                            if (u.pn == 4 && !samp) *(f32x4*)(outk + (size_t)row * 256 + c0 + bj * 128 + n * 16) = v; } }
            } else {
                const int T = samp ? TS : TP;
                bf16_t* vt = samp ? VT + (size_t)32 * 65536 + (size_t)((rb - MP) / TS) * 256 * TS : VT + (size_t)(rb / TP) * 65536;
#pragma unroll
                for (int m = 0; m < 4; ++m) if (m < r192_nm(ai)) { const int row = rb + m * 16 + fr; const int t = samp ? ((row - MP) & (TS - 1)) : (row & (TP - 1));
                    unsigned vo = (unsigned)(c0 * T + t); asm volatile("" : "+v"(vo));
#pragma unroll
                    for (int bj = 0; bj < 2; ++bj)
#pragma unroll
                        for (int n = 0; n < 2; ++n) { const f32x4 v = acc[ai][bj][m][n]; const int c = c0 + bj * 128 + n * 16;
#pragma unroll
                            for (int j = 0; j < 4; ++j) vt[vo + (unsigned)((bj * 128 + n * 16 + j) * T)] = (bf16_t)f2bf(v[j]);
                            if (!samp) *(f32x4*)(outv + (size_t)row * 256 + c) = v; } }
            }
        }
    }
};
__device__ __forceinline__ f32x4 conv_m(f32x4 cur, f32x4 pe, f32x4 ne, f32x4 w0, f32x4 w1, f32x4 w2, int fr) {
    const f32x4 up = dpp4<DPP_ROR1>(cur), dn = dpp4<DPP_ROR15>(cur);
    const f32x4 prev = fr > 0 ? up : pe, next = fr < 15 ? dn : ne;
    return w0 * prev + w1 * cur + w2 * next;
}
__device__ __forceinline__ void mask_rows(f32x4 (&acc)[2][2][4][2], const Unit& u, int wr, int fr) {
    if (u.pm < 32) return;
    const int i = (u.pm - 32) % 9; if (i != 0 && i != 8) return;
    const int t0 = 254 * i - 1;
#pragma unroll
    for (int ai = 0; ai < 2; ++ai)
#pragma unroll
        for (int m = 0; m < 4; ++m) { const int t = t0 + ai * 128 + wr * 64 + m * 16 + fr; if (t < 0 || t >= TS) {
#pragma unroll
            for (int bj = 0; bj < 2; ++bj)
#pragma unroll
                for (int n = 0; n < 2; ++n) acc[ai][bj][m][n] = (f32x4){0.f, 0.f, 0.f, 0.f}; } }
}
__device__ __forceinline__ bool row_valid(const Unit& u, int r) {
    if (u.pm < 32) return true;
    const int t = 254 * ((u.pm - 32) % 9) - 1 + r; return r >= 1 && r <= 254 && t >= 0 && t < TS;
}
__device__ __forceinline__ void xch_write(LAS float* X, const f32x4 (&acc)[2][2][4][2], int wr, int wc, int fr, int fq) {
#pragma unroll
    for (int ai = 0; ai < 2; ++ai)
#pragma unroll
        for (int bj = 0; bj < 2; ++bj)
#pragma unroll
            for (int n = 0; n < 2; ++n) { const int col = bj * 128 + wc * 32 + 8 * fq + 4 * n;
                if (fr == 0) *(LAS f32x4*)(X + ((2 * ai + wr) * 2 + 0) * 256 + col) = acc[ai][bj][0][n];
                if (fr == 15) *(LAS f32x4*)(X + ((2 * ai + wr) * 2 + 1) * 256 + col) = acc[ai][bj][3][n]; }
}
__device__ __forceinline__ f32x4 xch_top(const LAS float* X, int b, int col) { return b > 0 ? *(const LAS f32x4*)(X + ((b - 1) * 2 + 1) * 256 + col) : (f32x4){0.f, 0.f, 0.f, 0.f}; }
__device__ __forceinline__ f32x4 xch_bot(const LAS float* X, int b, int col) { return b < 3 ? *(const LAS f32x4*)(X + ((b + 1) * 2 + 0) * 256 + col) : (f32x4){0.f, 0.f, 0.f, 0.f}; }

struct EpiUp : EpiBase {
    static constexpr bool PERM = true;
    __device__ __forceinline__ void operator()(f32x4 (&acc)[2][2][4][2], const Unit& u, int wid, int ) const {
        int lane_ = pg8::lane_id(); asm volatile("" : "+v"(lane_));
        const int lane = lane_, wr = wid >> 2, wc = wid & 3, fr = lane & 15, fq = lane >> 4; (void)wr; (void)wc; (void)fr; (void)fq;
        bf16_t* ACT = (bf16_t*)(wsp() + WS_ACT); const float* cw = inp(kargs(), 24) + (size_t)l * 3 * 2 * DFF; LAS float* X = xch();
        mask_rows(acc, u, wr, fr);
        xch_write(X, acc, wr, wc, fr, fq);
        LDS_WAIT(); __builtin_amdgcn_s_barrier(); asm volatile("" ::: "memory");
        const int chl = wc * 32 + 8 * fq;
        u32x2 pk0[2][4];
#pragma unroll
        for (int n = 0; n < 2; ++n) {
            const int ch = u.pn * 128 + chl + 4 * n;
            f32x4 wg[3], wu[3];
#pragma unroll
            for (int k = 0; k < 3; ++k) { wg[k] = *(const f32x4*)(cw + k * 2 * DFF + ch); wu[k] = *(const f32x4*)(cw + k * 2 * DFF + DFF + ch); }
#pragma unroll
            for (int ai = 0; ai < 2; ++ai) {
                const int b = 2 * ai + wr;
                f32x4 pg = xch_top(X, b, chl + 4 * n), pu = xch_top(X, b, 128 + chl + 4 * n);
#pragma unroll
                for (int m = 0; m < 4; ++m) { const int r = ai * 128 + wr * 64 + m * 16 + fr;
                    const f32x4 vg = acc[ai][0][m][n], vu = acc[ai][1][m][n];
                    const f32x4 ng = m < 3 ? dpp4<DPP_ROR15>(acc[ai][0][m < 3 ? m + 1 : 3][n]) : xch_bot(X, b, chl + 4 * n);
                    const f32x4 nu = m < 3 ? dpp4<DPP_ROR15>(acc[ai][1][m < 3 ? m + 1 : 3][n]) : xch_bot(X, b, 128 + chl + 4 * n);
                    const f32x4 og = conv_m(vg, pg, ng, wg[0], wg[1], wg[2], fr), ou = conv_m(vu, pu, nu, wu[0], wu[1], wu[2], fr);
                    pg = dpp4<DPP_ROR1>(vg); pu = dpp4<DPP_ROR1>(vu);
                    f32x4 a;
#pragma unroll
                    for (int j = 0; j < 4; ++j) a[j] = silu_f(og[j]) * ou[j];
                    u32x2 w; w.x = cvt_pk_bf16(a[0], a[1]); w.y = cvt_pk_bf16(a[2], a[3]);
                    if (n == 0) pk0[ai][m] = w;
                    else if (row_valid(u, r)) *(u32x4*)(ACT + (size_t)(u.row0 + r) * DFF + ch - 4) = (u32x4){pk0[ai][m].x, pk0[ai][m].y, w.x, w.y}; }
            }
        }
    }
};
struct EpiSgu : EpiBase {
    static constexpr bool PERM = true;
    __device__ __forceinline__ void operator()(f32x4 (&acc)[2][2][4][2], const Unit& u, int wid, int ) const {
        int lane_ = pg8::lane_id(); asm volatile("" : "+v"(lane_));
        const int lane = lane_, wr = wid >> 2, wc = wid & 3, fr = lane & 15, fq = lane >> 4;
        unsigned char* ws = wsp(); bf16_t* U = (bf16_t*)(ws + WS_U); bf16_t* V = (bf16_t*)(ws + WS_V); f32x2* STATS = (f32x2*)(ws + WS_STATS);
        const bool isv = u.pn >= 4; bf16_t* O = isv ? V : U; const int col0 = (u.pn & 3) * 256 + wc * 32 + 8 * fq;
#pragma unroll
        for (int ai = 0; ai < 2; ++ai)
#pragma unroll
            for (int m = 0; m < 4; ++m) if (m < r192_nm(ai)) { const int row = u.row0 + r192_base(ai, wr) + m * 16 + fr; bf16_t* rowp = O + (size_t)row * D + col0; float s1 = 0.f, s2 = 0.f;
#pragma unroll
                for (int bj = 0; bj < 2; ++bj) { f32x4 v0 = acc[ai][bj][m][0], v1 = acc[ai][bj][m][1];
#pragma unroll
                    for (int j = 0; j < 4; ++j) { v0[j] = gelu_f(v0[j]); v1[j] = gelu_f(v1[j]); s1 += v0[j] + v1[j]; s2 += v0[j] * v0[j] + v1[j] * v1[j]; }
                    u32x4 w; w.x = cvt_pk_bf16(v0[0], v0[1]); w.y = cvt_pk_bf16(v0[2], v0[3]); w.z = cvt_pk_bf16(v1[0], v1[1]); w.w = cvt_pk_bf16(v1[2], v1[3]);
                    *(u32x4*)(rowp + bj * 128) = w; }
                if (isv) { s1 = rows_sum(s1); s2 = rows_sum(s2);
                    if (fq == 0) STATS[(size_t)row * 16 + (u.pn - 4) * 4 + wc] = (f32x2){s1, s2}; } }
    }
};
struct EpiSc : EpiBase {
    static constexpr bool PERM = true;
    __device__ __forceinline__ void operator()(f32x4 (&acc)[2][2][4][2], const Unit& u, int wid, int ui) const {
        int lane_ = pg8::lane_id(); asm volatile("" : "+v"(lane_));
        const int lane = lane_, wr = wid >> 2, wc = wid & 3, fr = lane & 15, fq = lane >> 4; (void)wr; (void)wc; (void)fr; (void)fq;
        unsigned char* ws = wsp(); f32x4* YB = (f32x4*)(ws + WS_YB) + (size_t)aux * 2 * 16 * 512; bf16_t* BY = (bf16_t*)(ws + WS_H2); const float* cw = inp(kargs(), 20); LAS float* X = xch();
        const int q = u.pn / 3, s = u.pn % 3, chl = wc * 32 + 8 * fq;
        if (s < 2) {
            mask_rows(acc, u, wr, fr);
#pragma unroll
            for (int ai = 0; ai < 2; ++ai)
#pragma unroll
                for (int m = 0; m < 4; ++m)
#pragma unroll
                    for (int n = 0; n < 2; ++n) acc[ai][0][m][n] = acc[ai][0][m][n] * acc[ai][1][m][n];
            xch_write(X, acc, wr, wc, fr, fq);
            LDS_WAIT(); __builtin_amdgcn_s_barrier(); asm volatile("" ::: "memory");
#pragma unroll
            for (int n = 0; n < 2; ++n) {
                const int ch = q * 256 + s * 128 + chl + 4 * n;
                f32x4 w[3];
#pragma unroll
                for (int k = 0; k < 3; ++k) w[k] = *(const f32x4*)(cw + k * D + ch);
#pragma unroll
                for (int ai = 0; ai < 2; ++ai) { const int b = 2 * ai + wr;
                    f32x4 pp = xch_top(X, b, chl + 4 * n);
#pragma unroll
                    for (int m = 0; m < 4; ++m) { const f32x4 v = acc[ai][0][m][n];
                        const f32x4 nn = m < 3 ? dpp4<DPP_ROR15>(acc[ai][0][m < 3 ? m + 1 : 3][n]) : xch_bot(X, b, chl + 4 * n);
                        const f32x4 o = conv_m(v, pp, nn, w[0], w[1], w[2], fr); pp = dpp4<DPP_ROR1>(v);
                        unsigned yo = (unsigned)((s * 16 + (ai * 4 + m) * 2 + n) * 512) + (unsigned)(wid * 64 + lane); asm volatile("" : "+v"(yo)); YB[yo] = o; } }
            }
        } else {
#pragma unroll
            for (int ai = 0; ai < 2; ++ai) {
                f32x4 y[4][2][2];
#pragma unroll
                for (int m = 0; m < 4; ++m)
#pragma unroll
                    for (int bj = 0; bj < 2; ++bj) { unsigned yo = (unsigned)((bj * 16 + (ai * 4 + m) * 2) * 512) + (unsigned)(wid * 64 + lane); asm volatile("" : "+v"(yo)); y[m][bj][0] = YB[yo]; y[m][bj][1] = YB[yo + 512]; }
#pragma unroll
                for (int m = 0; m < 4; ++m) { const int r = ai * 128 + wr * 64 + m * 16 + fr; const bool ok = row_valid(u, r);
#pragma unroll
                    for (int bj = 0; bj < 2; ++bj) { const f32x4 v0 = acc[ai][bj][m][0] * y[m][bj][0], v1 = acc[ai][bj][m][1] * y[m][bj][1];
                        u32x4 w; w.x = cvt_pk_bf16(v0[0], v0[1]); w.y = cvt_pk_bf16(v0[2], v0[3]); w.z = cvt_pk_bf16(v1[0], v1[1]); w.w = cvt_pk_bf16(v1[2], v1[3]);
                        if (ok) *(u32x4*)(BY + (size_t)(u.row0 + r) * D + q * 256 + bj * 128 + chl) = w; } }
                asm volatile("" ::: "memory"); }
        }
    }
};
struct OrderSc {
    int c; const char* A; const char* B;
    __device__ __forceinline__ bool next(int i, Unit& u) const {
        if (c >= 200 || i >= 3) return false;
        u.pm = c >> 2; u.pn = 3 * (c & 3) + i; u.row0 = conv_row0(u.pm); u.a = A + (long)u.row0 * (D * 2); u.b = B + (size_t)u.pn * 256 * D * 2; return true; }
};
struct EpiFn1 : EpiBase {
    static constexpr bool PERM = true;
    __device__ __forceinline__ void operator()(const f32x4 (&acc)[2][2][4][2], const Unit& u, int wid, int ) const {
        int lane_ = pg8::lane_id(); asm volatile("" : "+v"(lane_));
        const int lane = lane_, wr = wid >> 2, wc = wid & 3, fr = lane & 15, fq = lane >> 4; (void)wr; (void)wc; (void)fr; (void)fq;
        bf16_t* YT = (bf16_t*)(wsp() + WS_YT);
        const int part = u.pm & 1, ch0 = (u.pm >> 1) * 256, tok0 = u.pn * 256;
        bf16_t* base; int T, t0;
        if (tok0 < MP) { T = TP; base = YT + (size_t)(tok0 / TP) * D * 2 * TP; t0 = 0; }
        else { T = TS; base = YT + (size_t)32 * D * 2 * TP + (size_t)((tok0 - MP) / TS) * D * 2 * TS; t0 = (tok0 - MP) % TS; }
        const int c0 = wc * 32 + 8 * fq;
#pragma unroll
        for (int ai = 0; ai < 2; ++ai)
#pragma unroll
            for (int m = 0; m < 4; ++m) { bf16_t* rowp = base + (size_t)(ch0 + ai * 128 + wr * 64 + m * 16 + fr) * 2 * T + part * T + t0 + c0;
#pragma unroll
                for (int bj = 0; bj < 2; ++bj) { const f32x4 v0 = acc[ai][bj][m][0], v1 = acc[ai][bj][m][1];
                    u32x4 w; w.x = cvt_pk_bf16(v0[0], v0[1]); w.y = cvt_pk_bf16(v0[2], v0[3]); w.z = cvt_pk_bf16(v1[0], v1[1]); w.w = cvt_pk_bf16(v1[2], v1[3]);
                    *(u32x4*)(rowp + bj * 128) = w; } }
    }
};
struct OrderFn1 {
    int G, c; const char* A1; const char* H;
    __device__ __forceinline__ bool next(int i, Unit& u) const {
        const int L = i * G + c; if (L >= 384) return false;
        u.pm = L & 7; u.pn = L >> 3; u.row0 = 0; u.a = A1 + (size_t)(u.pm & 1) * 256 * 256 * 2; u.b = H + (size_t)u.pn * 256 * D * 2 + (size_t)(u.pm >> 1) * 512; return true; }
};
struct OrderFn2 {
    int c; int samp; const char* A2; const char* YT;
    __device__ __forceinline__ bool next(int i, Unit& u) const {
        if (i > 0) return false;
        if (samp) { if (c >= 128) return false; const int b = c >> 6, tm = (c >> 2) & 15; u.pm = tm; u.pn = c & 3; u.row0 = MP + b * TS + 128 * tm;
            u.a = A2 + (size_t)tm * 128 * 2 * TS * 2; u.b = YT + (size_t)32 * D * 2 * TP * 2 + (size_t)b * D * 2 * TS * 2 + (size_t)u.pn * 256 * 2 * TS * 2; return true; }
        if (c < 128) return false; const int j = c - 128, s = j >> 2; u.pm = 0; u.pn = j & 3; u.row0 = s * TP;
        u.a = A2; u.b = YT + (size_t)s * D * 2 * TP * 2 + (size_t)u.pn * 256 * 2 * TP * 2; return true; }
};

__device__ __forceinline__ void p0_transpose_item(const float* W, int K, int N, bf16_t* WT, int drow0, LAS float* scr, int kb, int n0, int lane) {
    const int k0 = 64 * kb;
    f32x4 v[8];
#pragma unroll
    for (int i = 0; i < 8; ++i) v[i] = __builtin_nontemporal_load((const f32x4*)(W + (size_t)(k0 + 8 * i + (lane >> 3)) * N + n0 + 4 * (lane & 7)));
#pragma unroll
    for (int i = 0; i < 8; ++i) { LAS float* d = scr + (8 * i + (lane >> 3)) * 33 + 4 * (lane & 7); d[0] = v[i][0]; d[1] = v[i][1]; d[2] = v[i][2]; d[3] = v[i][3]; }
    LDS_WAIT(); asm volatile("" ::: "memory");
    const int c = lane & 7;
#pragma unroll
    for (int j = 0; j < 4; ++j) { const int n = (lane >> 3) + 8 * j; const LAS float* s = scr + (8 * c) * 33 + n;
        u32x4 o; o.x = pk2(s[0 * 33], s[1 * 33]); o.y = pk2(s[2 * 33], s[3 * 33]); o.z = pk2(s[4 * 33], s[5 * 33]); o.w = pk2(s[6 * 33], s[7 * 33]);
        *(u32x4*)(WT + (size_t)(drow0 + n) * K + k0 + 8 * c) = o; }
    LDS_WAIT(); asm volatile("" ::: "memory");
}
__device__ __forceinline__ int map_plain(int n) { return n; }
__device__ __forceinline__ int map_up(int n) { return n < DFF ? 256 * (n >> 7) + (n & 127) : 256 * ((n - DFF) >> 7) + 128 + ((n - DFF) & 127); }
__device__ __forceinline__ int map_sc(int n) {
    if (n < D) return (3 * (n >> 8) + 2) * 256 + (n & 255);
    const int x = n >= 2 * D, ch = n - D - x * D; return (3 * (ch >> 8) + ((ch >> 7) & 1)) * 256 + x * 128 + (ch & 127);
}
__device__ __forceinline__ void p0_tjob(int& it, int NGW, LAS float* scr, int lane, const float* W, bf16_t* WT, int K, int N, int map) {
    const int nblk = N / 32, nitems = (K / 64) * nblk;
    for (; it < nitems; it += NGW) { const int kb = it / nblk, n0 = (it % nblk) * 32; const int dr = map == 0 ? n0 : (map == 1 ? map_up(n0) : map_sc(n0));
        p0_transpose_item(W, K, N, WT, dr, scr, kb, n0, lane); }
    it -= nitems;
}
__device__ __forceinline__ void convert_layer(Frame& F, int l, int b0, int nb) {
    unsigned char* ws = F.ws;
    LAS float* scr = (LAS float*)(F.lds + F.wave * 16384);
    const int gw = (F.blk - b0) * NWAVES + F.wave, NGW = nb * NWAVES;
    int it = gw;
    if (l == 0) { p0_tjob(it, NGW, scr, F.lane, ((const float*)F.in[11]), (bf16_t*)(ws + WS_WQKV), D, 1536, 0);
        p0_tjob(it, NGW, scr, F.lane, ((const float*)F.in[12]), (bf16_t*)(ws + WS_WO), D, D, 0); }
    else if (l == 1) { p0_tjob(it, NGW, scr, F.lane, ((const float*)F.in[14]), (bf16_t*)(ws + WS_WSGI), D, 2048, 0);
        p0_tjob(it, NGW, scr, F.lane, ((const float*)F.in[18]), (bf16_t*)(ws + WS_WSGO), D, D, 0); }
    else if (l == 2) { p0_tjob(it, NGW, scr, F.lane, ((const float*)F.in[19]), (bf16_t*)(ws + WS_WSCI), D, 3072, 2);
        p0_tjob(it, NGW, scr, F.lane, ((const float*)F.in[21]), (bf16_t*)(ws + WS_WSCO), D, D, 0); }
    else p0_tjob(it, NGW, scr, F.lane, ((const float*)F.in[22]), (bf16_t*)(ws + WS_WFNO), D, D, 0);
    p0_tjob(it, NGW, scr, F.lane, ((const float*)F.in[23]) + (size_t)l * D * 2 * DFF, (bf16_t*)(ws + WS_WUP + l * WUP_BYTES), D, 2 * DFF, 1);
    p0_tjob(it, NGW, scr, F.lane, ((const float*)F.in[25]) + (size_t)l * DFF * D, (bf16_t*)(ws + WS_WDN + l * WDN_BYTES), DFF, D, 0);
    const size_t gt = (size_t)(F.blk - b0) * 512 + F.tid, NGT = (size_t)nb * 512;
    if (l == 1) { bf16_t* WSb = (bf16_t*)(ws + WS_WS); for (size_t i = gt; i < 8 * 128 * 128; i += NGT) WSb[i] = (bf16_t)f2bf(((const float*)F.in[16])[i]); }
    if (l == 3) {
        bf16_t* A1 = (bf16_t*)(ws + WS_A1);
        for (size_t i = gt; i < 2 * 256 * 256; i += NGT) { const int part = i >> 16, r = (i >> 8) & 255, k = i & 255; float v = 0.f;
            if ((r >> 7) == (k >> 7)) { const float a = 2.f * (float)(((r & 127) * (k & 127)) & 127) / 128.f; v = (part ? sinpif(a) : cospif(a)) * 0.08838834764831845f; }
            A1[i] = (bf16_t)f2bf(v); }
        bf16_t* A2P = (bf16_t*)(ws + WS_A2P);
        for (size_t i = gt; i < 256 * 512; i += NGT) { const int tp = i >> 9, k = i & 511, t = k & 255; const float a = 2.f * (float)((tp * t) & 255) / 256.f;
            A2P[i] = (bf16_t)f2bf((k < 256 ? cospif(a) : -sinpif(a)) * 0.0625f); }
        __syncthreads();
        LAS bf16_t* tab = (LAS bf16_t*)F.lds;
        for (int j = F.tid; j < 2048; j += 512) { const float a = 2.f * (float)j / 2048.f; tab[j] = (bf16_t)f2bf(cospif(a) * 0.022097086912079608f); tab[2048 + j] = (bf16_t)f2bf(-sinpif(a) * 0.022097086912079608f); }
        __syncthreads();
        bf16_t* A2S = (bf16_t*)(ws + WS_A2S);
        for (size_t i8 = gt; i8 < (size_t)2048 * 4096 / 8; i8 += NGT) { const int tp = (int)(i8 >> 9), k0 = (int)(i8 & 511) * 8, part = k0 >> 11, t0 = k0 & 2047;
            unsigned w[4];
#pragma unroll
            for (int e = 0; e < 4; ++e) { const unsigned lo = tab[part * 2048 + ((tp * (t0 + 2 * e)) & 2047)], hi = tab[part * 2048 + ((tp * (t0 + 2 * e + 1)) & 2047)]; w[e] = lo | (hi << 16); }
            *(u32x4*)(A2S + i8 * 8) = (u32x4){w[0], w[1], w[2], w[3]}; }
        __syncthreads();
    }
}
__device__ __forceinline__ void prefetch_region(Frame& F, const void* p, size_t bytes, int b0, int nb) {
    const size_t gt = (size_t)(F.blk - b0) * 512 + F.tid, NGT = (size_t)nb * 512; unsigned acc = 0;
    for (size_t i = gt * 128; i < bytes; i += NGT * 128) { const u32x4 v = *(const u32x4*)((const char*)p + i); acc += v.x ^ v.w; }
    if (acc == 0x9e3779b9u) *(volatile unsigned*)(F.ws + WS_CTL + CTL_TMO + 64) = acc;
}
__device__ __forceinline__ void mod_items(Frame& F, int lo, int hi, int b0, int nb) {
    unsigned char* ws = F.ws;
    LAS float* sv = (LAS float*)F.lds;
    LAS float* red = sv + 3 * D;
    __syncthreads();
    for (int i = F.tid; i < D; i += 512) { const float a = ((const float*)F.in[5])[i], b = ((const float*)F.in[4])[i], d = ((const float*)F.in[4])[D + i];
        sv[i] = a / (1.f + expf(-a)); sv[D + i] = b / (1.f + expf(-b)); sv[2 * D + i] = d / (1.f + expf(-d)); }
    __syncthreads();
    float* MODp = (float*)(ws + WS_MOD);
    const int kg = F.tid >> 3, cq = F.tid & 7;
    for (int it = lo + F.blk - b0; it < hi; it += nb) {
        const int l = it / 192, n0 = (it % 192) * 32;
        const float* w = ((const float*)F.in[6]) + (size_t)l * D * 6 * D + n0 + 4 * cq;
        f32x4 wv[16];
#pragma unroll
        for (int i = 0; i < 16; ++i) wv[i] = __builtin_nontemporal_load((const f32x4*)(w + (size_t)(kg + 64 * i) * 6 * D));
        f32x4 a[3] = {{0, 0, 0, 0}, {0, 0, 0, 0}, {0, 0, 0, 0}};
#pragma unroll
        for (int i = 0; i < 16; ++i) { const int k = kg + 64 * i; a[0] += sv[k] * wv[i]; a[1] += sv[D + k] * wv[i]; a[2] += sv[2 * D + k] * wv[i]; }
#pragma unroll
        for (int v = 0; v < 3; ++v)
#pragma unroll
            for (int j = 0; j < 4; ++j) { float x = a[v][j]; x += dppx<0x128>(x); a[v][j] = rows_sum(x); }
        if (F.lane < 8) {
#pragma unroll
            for (int v = 0; v < 3; ++v) *(LAS f32x4*)(red + (F.wave * 3 + v) * 32 + 4 * cq) = a[v]; }
        __syncthreads();
        if (F.tid < 96) { const int v = F.tid >> 5, cc = F.tid & 31; float s = 0.f;
#pragma unroll
            for (int g = 0; g < 8; ++g) s += red[(g * 3 + v) * 32 + cc];
            MODp[(l * 3 + v) * 6 * D + n0 + cc] = s + ((const float*)F.in[7])[l * 6 * D + n0 + cc]; }
        __syncthreads();
    }
}
__device__ __forceinline__ void p0_prologue(Frame& F) {
    unsigned char* ws = F.ws;
    mod_items(F, 0, 192, 0, F.G);
    {
        const size_t gt = (size_t)F.blk * 512 + F.tid, NGT = (size_t)F.G * 512;
        bf16_t* CK = (bf16_t*)(ws + WS_CK); bf16_t* CVT = (bf16_t*)(ws + WS_CVT);
        for (size_t i = gt; i < 2 * 512 * 256; i += NGT) { CK[i] = (bf16_t)f2bf(((const float*)F.in[2])[i]);
            const int d = i & 63, kvh = (i >> 6) & 3, j = (i >> 8) & 511, b = i >> 17; CVT[((size_t)(b * 4 + kvh) * 64 + d) * 512 + j] = (bf16_t)f2bf(((const float*)F.in[3])[i]); }
        float* rope = (float*)(ws + WS_ROPE);
        for (size_t i = gt; i < 1024; i += NGT) { const int pos = i >> 4, fi = i & 15; const float ang = (float)pos * powf(10000.f, -(float)fi / 16.f); rope[i] = cosf(ang); rope[1024 + i] = sinf(ang); }
    }
}

__device__ __forceinline__ void norm_phase(Frame& F, const float* src0, const float* src1, const float* g, const float* modl, int sh_idx, bf16_t* H) {
    const int gw = F.blk * NWAVES + F.wave, NGW = F.G * NWAVES;
    f32x4 gv[4];
#pragma unroll
    for (int j = 0; j < 4; ++j) gv[j] = *(const f32x4*)(g + 256 * j + 4 * F.lane);
    for (int row = gw; row < M; row += NGW) {
        const float* xr = row < MP ? src0 + (size_t)row * D : src1 + (size_t)(row - MP) * D;
        const float* mv = modl + (row < MP ? 0 : 1 + (row - MP) / TS) * 6 * D;
        f32x4 v[4]; float s = 0.f;
#pragma unroll
        for (int j = 0; j < 4; ++j) { v[j] = *(const f32x4*)(xr + 256 * j + 4 * F.lane); s += (v[j][0] * v[j][0] + v[j][1] * v[j][1]) + (v[j][2] * v[j][2] + v[j][3] * v[j][3]); }
        const float r = rsqrtf(wave_sum(s) * (1.f / D) + EPS);
#pragma unroll
        for (int j = 0; j < 4; ++j) { const f32x4 sh = *(const f32x4*)(mv + sh_idx * D + 256 * j + 4 * F.lane), sc = *(const f32x4*)(mv + (sh_idx + 1) * D + 256 * j + 4 * F.lane);
            const f32x4 o = v[j] * r * gv[j] * (1.f + sc) + sh;
            u32x2 w; w.x = pk2(o[0], o[1]); w.y = pk2(o[2], o[3]); *(u32x2*)(H + (size_t)row * D + 256 * j + 4 * F.lane) = w; }
    }
}
__device__ __forceinline__ void final_phase(Frame& F, const float* X, const float* g, float* out) {
    const int gw = F.blk * NWAVES + F.wave, NGW = F.G * NWAVES;
    f32x4 gv[4];
#pragma unroll
    for (int j = 0; j < 4; ++j) gv[j] = *(const f32x4*)(g + 256 * j + 4 * F.lane);
    for (int row = gw; row < M; row += NGW) {
        const float* xr = X + (size_t)row * D; f32x4 v[4]; float s = 0.f;
#pragma unroll
        for (int j = 0; j < 4; ++j) { v[j] = *(const f32x4*)(xr + 256 * j + 4 * F.lane); s += (v[j][0] * v[j][0] + v[j][1] * v[j][1]) + (v[j][2] * v[j][2] + v[j][3] * v[j][3]); }
        const float r = rsqrtf(wave_sum(s) * (1.f / D) + EPS);
#pragma unroll
        for (int j = 0; j < 4; ++j) *(f32x4*)(out + (size_t)row * D + 256 * j + 4 * F.lane) = v[j] * r * gv[j];
    }
}

constexpr int ATT_LDK = 144;
constexpr int ATT_TILE_BYTES = 2 * 64 * ATT_LDK;
struct AttTile { const bf16_t* K; const bf16_t* V; int ldk, ldv, k0, mask; };
__device__ __forceinline__ void att_tile_of(int t, bool lat, int nband, int kband0, int qc0, const bf16_t* KBs, const bf16_t* VTs, int T, const bf16_t* CKs, const bf16_t* CVTs, AttTile& o) {
    if (t < nband) { const int k0 = kband0 + 64 * t; o.K = KBs + (size_t)k0 * 256; o.V = VTs + k0; o.ldk = 256; o.ldv = T; o.k0 = k0; const int dk = k0 - qc0; o.mask = lat && (dk < -64 || dk > 64); }
    else { const int k0 = 64 * (t - nband); o.K = CKs + (size_t)k0 * 256; o.V = CVTs + k0; o.ldk = 256; o.ldv = 512; o.k0 = k0; o.mask = 0; }
}
__device__ __forceinline__ void attn_phase(Frame& F, const bf16_t* Q, const bf16_t* KB, const bf16_t* VT, const bf16_t* CK, const bf16_t* CVT, const float* sink, bf16_t* O) {
    const int fr = F.lane & 15, g4 = F.lane >> 4, tid = F.tid;
    const int lrow = tid >> 3, lchunk = tid & 7;
    LAS unsigned char* lds = F.lds;
    for (int it = F.blk; it < 768; it += F.G) {
        const bool lat = it < 256; int kvh, chunk, T, rowbase, b = 0; const bf16_t* vt;
        if (lat) { b = it >> 7; kvh = (it >> 5) & 3; chunk = it & 31; T = TS; rowbase = MP + b * TS; vt = VT + (size_t)32 * 65536 + (size_t)b * 256 * TS; }
        else { const int j = it - 256, s = j >> 4; kvh = (j >> 2) & 3; chunk = j & 3; T = TP; rowbase = s * TP; vt = VT + (size_t)s * 65536; }
        const int h = kvh * 4 + (F.wave & 3), q0 = chunk * 64 + (F.wave >> 2) * 32;
        int kband0 = 0, nband = T / 64;
        if (lat) { int lo = 64 * chunk - 128, hi = 64 * chunk + 192; lo = lo < 0 ? 0 : lo; hi = hi > T ? T : hi; kband0 = lo; nband = (hi - lo) / 64; }
        const int ntile = nband + (lat ? 8 : 0);
        const bf16_t* KBs = KB + (size_t)rowbase * 256 + kvh * 64; const bf16_t* VTs = vt + (size_t)(kvh * 64) * T;
        const bf16_t* CKs = CK + (size_t)b * 512 * 256 + kvh * 64; const bf16_t* CVTs = CVT + (size_t)((b * 4 + kvh) * 64) * 512;
        bf16x8 Qf[2][2];
#pragma unroll
        for (int qg = 0; qg < 2; ++qg)
#pragma unroll
            for (int ds = 0; ds < 2; ++ds) Qf[qg][ds] = *(const bf16x8*)(Q + (size_t)(rowbase + q0 + 16 * qg + fr) * D + h * 64 + 32 * ds + 8 * g4);
        float mrun[2], lrun[2]; f32x4 Oa[2][4];
#pragma unroll
        for (int qg = 0; qg < 2; ++qg) { mrun[qg] = sink[h] * 1.4426950408889634f; lrun[qg] = 1.f;
#pragma unroll
            for (int db = 0; db < 4; ++db) Oa[qg][db] = (f32x4){0.f, 0.f, 0.f, 0.f}; }
        AttTile tl; att_tile_of(0, lat, nband, kband0, 64 * chunk, KBs, VTs, T, CKs, CVTs, tl);
        u32x4 rk = *(const u32x4*)(tl.K + (size_t)lrow * tl.ldk + lchunk * 8), rv = *(const u32x4*)(tl.V + (size_t)lrow * tl.ldv + lchunk * 8);
        __syncthreads();
        *(LAS u32x4*)(lds + lrow * ATT_LDK + lchunk * 16) = rk; *(LAS u32x4*)(lds + 64 * ATT_LDK + lrow * ATT_LDK + lchunk * 16) = rv;
        __syncthreads();
#pragma unroll 1
        for (int t = 0; t < ntile; ++t) {
            const int cur_k0 = tl.k0, cur_mask = tl.mask;
            if (t + 1 < ntile) { att_tile_of(t + 1, lat, nband, kband0, 64 * chunk, KBs, VTs, T, CKs, CVTs, tl);
                rk = *(const u32x4*)(tl.K + (size_t)lrow * tl.ldk + lchunk * 8); rv = *(const u32x4*)(tl.V + (size_t)lrow * tl.ldv + lchunk * 8); }
            const LAS unsigned char* kb_ = lds + (t & 1) * ATT_TILE_BYTES; const LAS unsigned char* vb_ = kb_ + 64 * ATT_LDK;
            {
                bf16x8 Kf[2][2][2], Vf[2][4];
#pragma unroll
                for (int sub = 0; sub < 2; ++sub) {
#pragma unroll
                    for (int kb = 0; kb < 2; ++kb)
#pragma unroll
                        for (int ds = 0; ds < 2; ++ds) Kf[sub][kb][ds] = *(const LAS bf16x8*)(kb_ + (32 * sub + 16 * kb + fr) * ATT_LDK + 64 * ds + 16 * g4);
#pragma unroll
                    for (int db = 0; db < 4; ++db) { const LAS unsigned char* vp = vb_ + (16 * db + fr) * ATT_LDK + 64 * sub + 8 * g4; const u32x2 lo = *(const LAS u32x2*)vp, hi = *(const LAS u32x2*)(vp + 32);
                        Vf[sub][db] = __builtin_bit_cast(bf16x8, (u32x4){lo.x, lo.y, hi.x, hi.y}); }
                }
                const float c = 0.125f * 1.4426950408889634f;
                f32x4 S[2][2][2];
#pragma unroll
                for (int qg = 0; qg < 2; ++qg)
#pragma unroll
                    for (int sub = 0; sub < 2; ++sub)
#pragma unroll
                        for (int kb = 0; kb < 2; ++kb) { S[qg][sub][kb] = __builtin_amdgcn_mfma_f32_16x16x32_bf16(Kf[sub][kb][0], Qf[qg][0], (f32x4){0.f, 0.f, 0.f, 0.f}, 0, 0, 0);
                            S[qg][sub][kb] = __builtin_amdgcn_mfma_f32_16x16x32_bf16(Kf[sub][kb][1], Qf[qg][1], S[qg][sub][kb], 0, 0, 0); }
                float mnew[2], rs[2];
#pragma unroll
                for (int qg = 0; qg < 2; ++qg) {
                    const int qpos = q0 + 16 * qg + fr;
                    if (cur_mask) {
#pragma unroll
                        for (int sub = 0; sub < 2; ++sub)
#pragma unroll
                            for (int kb = 0; kb < 2; ++kb)
#pragma unroll
                                for (int r = 0; r < 4; ++r) { const int d = cur_k0 + 32 * sub + 16 * kb + 4 * g4 + r - qpos; if (d > 128 || d < -128) S[qg][sub][kb][r] = -1e30f; }
                    }
                    float mx = -1e30f;
#pragma unroll
                    for (int sub = 0; sub < 2; ++sub)
#pragma unroll
                        for (int kb = 0; kb < 2; ++kb) mx = fmaxf(fmaxf(mx, fmaxf(S[qg][sub][kb][0], S[qg][sub][kb][1])), fmaxf(S[qg][sub][kb][2], S[qg][sub][kb][3]));
                    mx = rows_max(mx) * c;
                    mnew[qg] = fmaxf(mrun[qg], mx);
                    float r_ = 0.f;
#pragma unroll
                    for (int sub = 0; sub < 2; ++sub)
#pragma unroll
                        for (int kb = 0; kb < 2; ++kb)
#pragma unroll
                            for (int r = 0; r < 4; ++r) { const float p = fast_exp2(__builtin_fmaf(S[qg][sub][kb][r], c, -mnew[qg])); S[qg][sub][kb][r] = p; r_ += p; }
                    rs[qg] = rows_sum(r_);
                }
                if (__builtin_amdgcn_ballot_w64(mnew[0] > mrun[0] || mnew[1] > mrun[1]) != 0ull) {
#pragma unroll
                    for (int qg = 0; qg < 2; ++qg) { const float alpha = fast_exp2(mrun[qg] - mnew[qg]); lrun[qg] *= alpha;
#pragma unroll
                        for (int db = 0; db < 4; ++db) Oa[qg][db] = Oa[qg][db] * alpha; }
                }
#pragma unroll
                for (int qg = 0; qg < 2; ++qg) { lrun[qg] += rs[qg]; mrun[qg] = mnew[qg];
#pragma unroll
                    for (int sub = 0; sub < 2; ++sub) {
                        u32x4 pw; pw.x = cvt_pk_bf16(S[qg][sub][0][0], S[qg][sub][0][1]); pw.y = cvt_pk_bf16(S[qg][sub][0][2], S[qg][sub][0][3]); pw.z = cvt_pk_bf16(S[qg][sub][1][0], S[qg][sub][1][1]); pw.w = cvt_pk_bf16(S[qg][sub][1][2], S[qg][sub][1][3]);
                        const bf16x8 Pf = __builtin_bit_cast(bf16x8, pw);
#pragma unroll
                        for (int db = 0; db < 4; ++db) Oa[qg][db] = __builtin_amdgcn_mfma_f32_16x16x32_bf16(Vf[sub][db], Pf, Oa[qg][db], 0, 0, 0); } }
            }
            if (t + 1 < ntile) { LAS unsigned char* nb = lds + ((t + 1) & 1) * ATT_TILE_BYTES;
                *(LAS u32x4*)(nb + lrow * ATT_LDK + lchunk * 16) = rk; *(LAS u32x4*)(nb + 64 * ATT_LDK + lrow * ATT_LDK + lchunk * 16) = rv; }
            __syncthreads();
        }
#pragma unroll
        for (int qg = 0; qg < 2; ++qg) { const float inv = 1.f / lrun[qg];
#pragma unroll
            for (int db = 0; db < 4; ++db) { const f32x4 o = Oa[qg][db] * inv; u32x2 w; w.x = cvt_pk_bf16(o[0], o[1]); w.y = cvt_pk_bf16(o[2], o[3]);
                *(u32x2*)(O + (size_t)(rowbase + q0 + 16 * qg + fr) * D + h * 64 + 16 * db + 4 * g4) = w; } }
    }
}

__device__ __forceinline__ void sgu_phase(Frame& F, const bf16_t* U, const bf16_t* V, const f32x2* STATS, const float* ln_g, const bf16_t* WSb, const float* b_s, bf16_t* UM) {
    constexpr int LDT = 136;
    LAS bf16_t* LT = (LAS bf16_t*)F.lds;
    LAS f32x2* ST = (LAS f32x2*)(F.lds + 128 * LDT * 2);
    const int fr = F.lane & 15, g4 = F.lane >> 4;
    for (int it = F.blk; it < 768; it += F.G) {
        const int ch = it >> 3, g = it & 7, r0 = ch * 128;
        if (F.tid < 128) { const f32x2* sp = STATS + (size_t)(r0 + F.tid) * 16; float s1 = 0.f, s2 = 0.f;
#pragma unroll
            for (int k = 0; k < 16; ++k) { const f32x2 p = sp[k]; s1 += p.x; s2 += p.y; }
            const float mu = s1 * (1.f / D), var = s2 * (1.f / D) - mu * mu; ST[F.tid] = (f32x2){mu, rsqrtf(fmaxf(var, 0.f) + EPS)}; }
        __syncthreads();
#pragma unroll
        for (int i = 0; i < 4; ++i) { const int q = F.tid + 512 * i, r = q & 127, c8 = (q >> 7) * 8;
            const u32x4 raw = *(const u32x4*)(V + (size_t)(r0 + r) * D + g * 128 + c8); const f32x2 st = ST[r];
            const f32x4 ga = *(const f32x4*)(ln_g + g * 128 + c8), gb = *(const f32x4*)(ln_g + g * 128 + c8 + 4);
            const unsigned rw[4] = {raw.x, raw.y, raw.z, raw.w};
#pragma unroll
            for (int e = 0; e < 8; ++e) { const float x = bf2f((unsigned short)(e & 1 ? rw[e >> 1] >> 16 : rw[e >> 1] & 0xffff)); const float gg = e < 4 ? ga[e & 3] : gb[e & 3];
                LT[(c8 + e) * LDT + r] = (bf16_t)f2bf((x - st.x) * st.y * gg); } }
        __syncthreads();
        f32x4 acc[8];
#pragma unroll
        for (int cb = 0; cb < 8; ++cb) acc[cb] = (f32x4){0.f, 0.f, 0.f, 0.f};
        const int p = 16 * F.wave + fr;
#pragma unroll
        for (int ks = 0; ks < 4; ++ks) { const bf16x8 bw = *(const bf16x8*)(WSb + (size_t)(g * 128 + p) * 128 + 32 * ks + 8 * g4);
#pragma unroll
            for (int cb = 0; cb < 8; ++cb) { const bf16x8 av = *(const LAS bf16x8*)(LT + (16 * cb + fr) * LDT + 32 * ks + 8 * g4); acc[cb] = __builtin_amdgcn_mfma_f32_16x16x32_bf16(av, bw, acc[cb], 0, 0, 0); } }
        const float bsv = b_s[g * 128 + p];
#pragma unroll
        for (int cb = 0; cb < 8; ++cb) { const size_t off = (size_t)(r0 + p) * D + g * 128 + 16 * cb + 4 * g4; const u32x2 uw = *(const u32x2*)(U + off);
            const float u0 = bf2f((unsigned short)(uw.x & 0xffff)), u1 = bf2f((unsigned short)(uw.x >> 16)), u2 = bf2f((unsigned short)(uw.y & 0xffff)), u3 = bf2f((unsigned short)(uw.y >> 16));
            u32x2 w; w.x = cvt_pk_bf16(u0 * (acc[cb][0] + bsv), u1 * (acc[cb][1] + bsv)); w.y = cvt_pk_bf16(u2 * (acc[cb][2] + bsv), u3 * (acc[cb][3] + bsv)); *(u32x2*)(UM + off) = w; }
        __syncthreads();
    }
}

struct Args { const float* in[26]; float* out; unsigned char* ws; int ph_lo, ph_hi; };
__global__ void __launch_bounds__(NWAVES * 64, 2) mk_fwd(const Args args) {
    extern __shared__ __attribute__((aligned(16))) unsigned char lds_raw[];
    Frame F;
    F.lds = (LAS unsigned char*)lds_raw;
    const int wave0 = __builtin_amdgcn_readfirstlane((int)threadIdx.x >> 6);
    F.wave = wave0; F.lane = pg8::lane_id(); F.tid = wave0 * 64 + F.lane;
    const int grid0 = gridDim.x, blk0 = blockIdx.x; F.G = grid0; F.blk = blk0;
    F.in = (const __attribute__((address_space(4))) cfp_t*)__builtin_amdgcn_kernarg_segment_ptr();
    F.out = args.out; F.ws = args.ws;
    unsigned char* ws = args.ws;
    volatile LAS unsigned* MISC = (volatile LAS unsigned*)(F.lds + MISC_OFF);
    if (F.tid < 32) MISC[F.tid] = 0u;
    __syncthreads();
    const int lo = args.ph_lo, hi = args.ph_hi;
    XcdBarrier bar; bar.bar = (unsigned*)(ws + WS_CTL); bar.x = 0; bar.st = nullptr;
    if (hi - lo > 1) bar = xcd_barrier_post((unsigned*)(ws + WS_CTL), MISC + 8, F.tid == 0);
    LAS float* XCH = (LAS float*)(F.lds + XCH_OFF);
#define CASE_BEGIN() { int b_ = blk0, w_ = wave0, g_ = grid0; asm volatile("" : "+s"(b_), "+s"(w_), "+s"(g_)); F.blk = b_; F.wave = w_; F.G = g_; } frame_refresh(F); unsigned long long ws_ = (unsigned long long)args.ws, in_ = (unsigned long long)__builtin_amdgcn_kernarg_segment_ptr(); asm volatile("" : "+s"(ws_), "+s"(in_)); \
        unsigned char* ws = (unsigned char*)(GAS unsigned char*)ws_; F.ws = ws; F.in = (const __attribute__((address_space(4))) cfp_t*)in_; \
        float* X = (float*)(ws + WS_X); bf16_t* H = (bf16_t*)(ws + WS_H); bf16_t* H2 = (bf16_t*)(ws + WS_H2); bf16_t* HN = (bf16_t*)(ws + WS_HN); (void)HN; \
        const float* modl = (const float*)(ws + WS_MOD) + l * 3 * 6 * D; const float* xs0 = l == 0 ? ((const float*)F.in[0]) : X; const float* xs1 = l == 0 ? ((const float*)F.in[1]) : X + (size_t)MP * D; \
        (void)X; (void)H; (void)H2; (void)modl; (void)xs0; (void)xs1
#pragma unroll 1
    for (int ph = lo; ph < hi; ++ph) {
        int l = 0, kind;
        if (ph == 0) kind = 0; else if (ph == 1) kind = 1;
        else { l = ph < 7 ? 0 : ph < 12 ? 1 : ph < 16 ? 2 : 3; const int j = ph - (l == 0 ? 2 : l == 1 ? 7 : l == 2 ? 12 : 16), n = l == 2 ? 1 : 2;
            kind = j < n ? (l == 0 ? 2 + j : l == 1 ? 4 + j : l == 2 ? 6 : 7 + j) : j == n ? 9 : j == n + 1 ? 10 : 11; }
        const int reps = (kind == MK_REP_KIND) ? 1 + MK_REP_N : 1;
        const bool tp_here = MK_TP && ph == MK_TP_PH && blk0 == 0;
        unsigned long long tp_r0 = 0, tp_c0 = 0; if (tp_here) { tp_r0 = __builtin_amdgcn_s_memrealtime(); tp_c0 = __builtin_amdgcn_s_memtime(); }
#pragma unroll 1
        for (int rep = 0; rep < reps; ++rep) {
        if (rep > 0) xcd_barrier(bar, wave0 == 0 && pg8::lane_id() == 0);
        switch (kind) {
        case 0: if (EN(0)) { CASE_BEGIN(); p0_prologue(F); } break;
        case 1: if (EN(1)) { CASE_BEGIN(); norm_phase(F, xs0, xs1, ((const float*)F.in[8]), modl, 0, HN);
                if (rep == 0) convert_layer(F, 0, 0, F.G); } break;
        case 2: if (EN(2)) { CASE_BEGIN(); Order<64, 6, 0, D, D, 192> S; S.init(F.G, F.blk, HN, ws + WS_WQKV);
                EpiQKV E{{ws, l, 0}};
                pg8::gemm_phase<D, D, D / 64, 192>(F.lds, S, E, F.wave, tp_here);
                if (MK_PREFETCH && rep == 0 && F.blk >= 128) { frame_refresh(F); prefetch_region(F, ws + WS_WO, 2 * MiB, 128, F.G - 128); prefetch_region(F, ws + WS_WUP, WUP_BYTES, 128, F.G - 128); } } break;
        case 3: if (EN(3)) { CASE_BEGIN(); attn_phase(F, (const bf16_t*)(ws + WS_Q), (const bf16_t*)(ws + WS_KB), (const bf16_t*)(ws + WS_VT), (const bf16_t*)(ws + WS_CK), (const bf16_t*)(ws + WS_CVT), ((const float*)F.in[13]), H); } break;
        case 4: if (EN(4)) { CASE_BEGIN(); Order<64, 8, 0, D, D, 192> S; S.init(F.G, F.blk, HN, ws + WS_WSGI);
                EpiSgu E{{ws, l, 0}};
                pg8::gemm_phase<D, D, D / 64, 192>(F.lds, S, E, F.wave, tp_here);
                } break;
        case 5: if (EN(5)) { CASE_BEGIN(); sgu_phase(F, (const bf16_t*)(ws + WS_U), (const bf16_t*)(ws + WS_V), (const f32x2*)(ws + WS_STATS), ((const float*)F.in[15]), (const bf16_t*)(ws + WS_WS), ((const float*)F.in[17]), H); } break;
        case 6: if (EN(6)) { CASE_BEGIN(); OrderSc S{F.blk, (const char*)HN, (const char*)(ws + WS_WSCI)};
                EpiSc E{{ws, l, F.blk}};
                pg8::gemm_phase<D, D, D / 64>(F.lds, S, E, F.wave, tp_here);
                if (MK_PREFETCH && rep == 0 && F.blk >= 200) { frame_refresh(F); prefetch_region(F, ws + WS_WSCO, 2 * MiB, 200, F.G - 200); prefetch_region(F, ws + WS_WUP + 2 * WUP_BYTES, WUP_BYTES, 200, F.G - 200); } } break;
        case 7: if (EN(7)) { CASE_BEGIN(); OrderFn1 S{F.G, F.blk, (const char*)(ws + WS_A1), (const char*)HN};
                EpiFn1 E{{ws, l, 0}};
                pg8::gemm_phase<256, D, 4>(F.lds, S, E, F.wave, tp_here);
                if (MK_PREFETCH && F.blk >= 128) { frame_refresh(F); prefetch_region(F, ws + WS_A2S, 16 * MiB, 128, F.G - 128); prefetch_region(F, ws + WS_WUP + 3 * WUP_BYTES, WUP_BYTES, 128, F.G - 128); } } break;
        case 8: if (EN(8)) { CASE_BEGIN();
                if (F.blk < 128) { EpiBf16<128> E{{ws, l, 0}}; OrderFn2 S{F.blk, 1, (const char*)(ws + WS_A2S), (const char*)(ws + WS_YT)}; pg8::gemm_phase<2 * TS, 2 * TS, 2 * TS / 64, 128>(F.lds, S, E, F.wave, tp_here); }
                else { EpiBf16<256> E{{ws, l, 0}}; OrderFn2 S{F.blk, 0, (const char*)(ws + WS_A2P), (const char*)(ws + WS_YT)}; pg8::gemm_phase<2 * TP, 2 * TP, 2 * TP / 64>(F.lds, S, E, F.wave, tp_here);
                    if (MK_PREFETCH) { frame_refresh(F); prefetch_region(F, ws + WS_WFNO, 2 * MiB, 128, F.G - 128); } } } break;
        case 9: if (EN(9)) { CASE_BEGIN(); const bf16_t* mix_in = l == 2 ? H2 : H;
                const bf16_t* wout = (const bf16_t*)(ws + (l == 0 ? WS_WO : l == 1 ? WS_WSGO : l == 2 ? WS_WSCO : WS_WFNO));
                Order<64, 4, 0, D, D, 192> S; S.init(F.G, F.blk, mix_in, wout);
                EpiResNorm<false> E{{ws, l, rep ? 2 : 0}};
                if (MK_REP_SHORTK && MK_REP_KIND == 9 && rep > 0) { pg8::gemm_phase<D, D, 4, 192>(F.lds, S, E, F.wave, tp_here); break; }
                pg8::gemm_phase<D, D, D / 64, 192>(F.lds, S, E, F.wave, tp_here);
                } break;
        case 10: if (EN(11)) { CASE_BEGIN(); Order<50, 22, 1, D, D> S; S.init(F.G, F.blk, HN, ws + WS_WUP + l * WUP_BYTES);
                if (MK_REP_NULL && rep > 0) { EpiNull E{{ws, l, 0}}; pg8::gemm_phase<D, D, D / 64>(F.lds, S, E, F.wave, tp_here); }
                else if (MK_REP_SHORTK && MK_REP_KIND == 10 && rep > 0) { EpiUp E{{ws, l, 0}}; pg8::gemm_phase<D, D, 4>(F.lds, S, E, F.wave, tp_here); }
                else { EpiUp E{{ws, l, 0}};
                pg8::gemm_phase<D, D, D / 64>(F.lds, S, E, F.wave, tp_here); }
                if (rep == 0 && F.blk >= 76) { frame_refresh(F);
                    if (l < 3) { mod_items(F, 192 * (l + 1), 192 * (l + 2), 76, F.G - 76); convert_layer(F, l + 1, 76, F.G - 76); }
                    if (MK_PREFETCH) { prefetch_region(F, ws + WS_WDN + l * WDN_BYTES, WDN_BYTES, 76, F.G - 76); } } } break;
        default: if (EN(12)) { CASE_BEGIN(); Order<64, 4, 0, DFF, DFF, 192> S; S.init(F.G, F.blk, ws + WS_ACT, ws + WS_WDN + l * WDN_BYTES);
                if (l < 3) { EpiResNorm<false> E{{ws, l, 1 | (rep ? 2 : 0)}}; pg8::gemm_phase<DFF, DFF, DFF / 64, 192>(F.lds, S, E, F.wave, tp_here); }
                else { EpiResNorm<true> E{{ws, l, 1 | (rep ? 2 : 0)}}; pg8::gemm_phase<DFF, DFF, DFF / 64, 192>(F.lds, S, E, F.wave, tp_here); } } break;
        }
        }
        if (tp_here && wave0 == 0 && pg8::lane_id() == 0) { const unsigned long long r1 = __builtin_amdgcn_s_memrealtime(), c1 = __builtin_amdgcn_s_memtime();
            if (MK_TP == 1) MISC[16] = (unsigned)(r1 - tp_r0);
            if (MK_TP == 3) MISC[16] = (unsigned)((c1 - tp_c0) * 10ull / (r1 - tp_r0)) * 10u; }
        if (ph + 1 < hi) xcd_barrier(bar, wave0 == 0 && pg8::lane_id() == 0);
    }
    if (MK_TP && blk0 == 0 && wave0 == 0) { const unsigned v = MISC[16] * (MK_TP == 2 ? 4u : 1u); const unsigned long long t0 = __builtin_amdgcn_s_memrealtime();
        while (__builtin_amdgcn_s_memrealtime() - t0 < v) __builtin_amdgcn_s_sleep(8); }
}

extern "C" void kernel_launch(void* const* d_in, const int* in_sizes, int n_in, void* d_out, int out_size, void* d_ws, size_t ws_size, hipStream_t stream) {
    static int grid = 0;
    if (grid == 0) {
        if (n_in != 26 || ws_size < WS_TOTAL + (MK_REP_N ? (size_t)73 * MiB : 0)) { fprintf(stderr, "kernel_launch: unexpected n_in %d / ws %zu (need %zu)\n", n_in, ws_size, (size_t)WS_TOTAL); grid = -1; return; }
        int dev = 0, cus = 0;
        if (hipGetDevice(&dev) != hipSuccess || hipDeviceGetAttribute(&cus, hipDeviceAttributeMultiprocessorCount, dev) != hipSuccess) { grid = -1; return; }
        if (hipFuncSetAttribute((const void*)mk_fwd, hipFuncAttributeMaxDynamicSharedMemorySize, LDS_BYTES) != hipSuccess) { fprintf(stderr, "kernel_launch: hipFuncSetAttribute failed\n"); grid = -1; return; }
        (void)hipGetLastError();
        grid = cus;
    }
    if (grid < 0) return;
    (void)hipMemsetAsync((char*)d_ws + WS_CTL, 0, CTL_ZERO_BYTES, stream);
    Args a{};
    for (int i = 0; i < 26; ++i) a.in[i] = (const float*)d_in[i];
    a.out = (float*)d_out; a.ws = (unsigned char*)d_ws;
#if MK_PER_PHASE
    for (int p = MK_PH_LO; p < MK_PH_HI; ++p) { a.ph_lo = p; a.ph_hi = p + 1; hipLaunchKernelGGL(mk_fwd, dim3(grid), dim3(NWAVES * 64), LDS_BYTES, stream, a); }
#else
    a.ph_lo = MK_PH_LO; a.ph_hi = MK_PH_HI;
    hipLaunchKernelGGL(mk_fwd, dim3(grid), dim3(NWAVES * 64), LDS_BYTES, stream, a);
#endif
}
```

```cpp
#include <hip/hip_runtime.h>
#include <cstdio>

#define LAS __attribute__((address_space(3)))
#define GAS __attribute__((address_space(1)))
typedef unsigned short bf16_t;
typedef short bf16x8 __attribute__((ext_vector_type(8)));
typedef float f32x4 __attribute__((ext_vector_type(4)));
typedef float f32x2 __attribute__((ext_vector_type(2)));
typedef unsigned u32x4 __attribute__((ext_vector_type(4)));
typedef unsigned u32x2 __attribute__((ext_vector_type(2)));

constexpr int D = 1024, MP = 8192, MS = 4096, M = MP + MS, DFF = 2816, TS = 2048, TP = 256;
constexpr float EPS = 1e-6f;
constexpr int NWAVES = 8;
#ifndef MK_PER_PHASE
#define MK_PER_PHASE 0
#endif
#ifndef MK_PH_LO
#define MK_PH_LO 0
#endif
#ifndef MK_PH_HI
#define MK_PH_HI 21
#endif
#ifndef MK_MASK
#define MK_MASK 0xffffffffu
#endif
#define EN(b) (((MK_MASK) >> (b)) & 1u)
#ifndef MK_REP_KIND
#define MK_REP_KIND -1
#endif
#ifndef MK_REP_N
#define MK_REP_N 0
#endif
#ifndef MK_REP_NULL
#define MK_REP_NULL 0
#endif
#ifndef MK_REP_SHORTK
#define MK_REP_SHORTK 0
#endif
#ifndef MK_PREFETCH
#define MK_PREFETCH 1
#endif
#ifndef MK_TP
#define MK_TP 0
#endif
#ifndef MK_TP_PH
#define MK_TP_PH 10
#endif

namespace pg8 {
constexpr int BM = 256, BK = 64, HALF = 128, HTB = HALF * BK * 2, STAGE_BYTES = 8 * HTB, NXCD = 8, WGM = 8;
__host__ __device__ __forceinline__ int lds_byte(int r, int c) { const int st = (r >> 4) * 2 + (c >> 5), rr = r & 15, cc = c & 31, ob = rr * 64 + cc * 2; return st * 1024 + (ob ^ (((ob >> 9) & 1) << 5)); }
__host__ __device__ __forceinline__ void stage_rc(int b, int& R, int& C) { const int st = b / 1024, sb = b % 1024, swz = sb ^ (((sb >> 9) & 1) << 5); R = (st >> 1) * 16 + swz / 64; C = (st & 1) * 32 + (swz % 64) / 2; }
__host__ __device__ __forceinline__ int perm32(int rho) { const int n = rho >> 4, i = rho & 15; return 8 * (i >> 2) + 4 * n + (i & 3); }

struct Unit { int pm, pn, row0; const char* a; const char* b; };
struct Cfg { int lda, ldb, nt; };

__device__ __forceinline__ int lane_id() { return (int)__builtin_amdgcn_mbcnt_hi(~0u, __builtin_amdgcn_mbcnt_lo(~0u, 0u)); }
__device__ __forceinline__ unsigned cvt_pk_bf16(float lo, float hi) { unsigned r; asm volatile("v_cvt_pk_bf16_f32 %0, %1, %2" : "=v"(r) : "v"(lo), "v"(hi)); return r; }

template <int LDA, int LDB, int NT, int ROWS = 256, class Epi, class Sched>
__device__ __forceinline__ void gemm_phase(LAS unsigned char* lds, const Sched& S, const Epi& E, int wid, bool tp_on = false) {
    constexpr Cfg g{LDA, LDB, NT};
    int lane_ = lane_id(); asm volatile("" : "+v"(lane_));
    const int lane = lane_, tid = wid * 64 + lane, wr = wid >> 2, wc = wid & 3, fr = lane & 15, fq = lane >> 4;
    const int nt = g.nt;
    unsigned voffA[2], voffB[2];
#pragma unroll
    for (int i = 0; i < 2; ++i) { int R, C; stage_rc(tid * 16 + i * 8192, R, C); const int Rb = Epi::PERM ? ((R & ~31) + perm32(R & 31)) : R;
        voffA[i] = (unsigned)(R * g.lda + C) * 2u; voffB[i] = (unsigned)(Rb * g.ldb + C) * 2u; }
    unsigned voffA1[2]; voffA1[0] = ROWS == 128 ? 0u : voffA[0]; voffA1[1] = ROWS == 256 ? voffA[1] : 0u;
    const size_t kstep = (size_t)(BK * 2);
    const size_t hstepA = (size_t)HALF * g.lda * 2, hstepB = (size_t)HALF * g.ldb * 2;
    const unsigned ldsw = (unsigned)wid * 1024u;
    constexpr int NM1 = ROWS == 192 ? 2 : ROWS == 128 ? 0 : 4;
    const int aoff = lds_byte(wr * 64 + fr, fq * 8), boff = lds_byte(wc * 32 + fr, fq * 8), aoff1 = ROWS == 192 ? lds_byte(wr * 32 + fr, fq * 8) : aoff;
#define PG8_SA(b, h) (((b) * 2 + (h)) * HTB)
#define PG8_SB(b, h) ((4 + (b) * 2 + (h)) * HTB)
#define PG8_STAGE(bufoff, gbase, voff) do { _Pragma("unroll") for (int _i = 0; _i < 2; ++_i) { unsigned _vo = (voff)[_i]; asm volatile("" : "+v"(_vo)); \
        __builtin_amdgcn_global_load_lds((const unsigned*)((const char*)(gbase) + _vo), (LAS unsigned*)(lds + (bufoff) + ldsw + _i * 8192), 16, 0, 0); } } while (0)
#define PG8_LDA(dst, b, h) do { _Pragma("unroll") for (int m = 0; m < 4; ++m) _Pragma("unroll") for (int k = 0; k < 2; ++k) dst[m][k] = *(const LAS bf16x8*)(lds + PG8_SA(b, h) + aoff + m * 2048 + k * 1024); } while (0)
#define PG8_LDA1(dst, b) do { _Pragma("unroll") for (int m = 0; m < NM1; ++m) _Pragma("unroll") for (int k = 0; k < 2; ++k) dst[m][k] = *(const LAS bf16x8*)(lds + PG8_SA(b, 1) + aoff1 + m * 2048 + k * 1024); } while (0)
#define PG8_LDB(dst, b, h) do { _Pragma("unroll") for (int n = 0; n < 2; ++n) _Pragma("unroll") for (int k = 0; k < 2; ++k) dst[n][k] = *(const LAS bf16x8*)(lds + PG8_SB(b, h) + boff + n * 2048 + k * 1024); } while (0)
#define PG8_MMA(ai, bj, At, Bt) do { __builtin_amdgcn_s_setprio(1); _Pragma("unroll") for (int m = 0; m < 4; ++m) _Pragma("unroll") for (int n = 0; n < 2; ++n) _Pragma("unroll") for (int k = 0; k < 2; ++k) \
        acc[ai][bj][m][n] = __builtin_amdgcn_mfma_f32_16x16x32_bf16(Bt[n][k], At[m][k], acc[ai][bj][m][n], 0, 0, 0); __builtin_amdgcn_s_setprio(0); } while (0)
#define PG8_MMA1(bj, At, Bt) do { __builtin_amdgcn_s_setprio(1); _Pragma("unroll") for (int m = 0; m < NM1; ++m) _Pragma("unroll") for (int n = 0; n < 2; ++n) _Pragma("unroll") for (int k = 0; k < 2; ++k) \
        acc[1][bj][m][n] = __builtin_amdgcn_mfma_f32_16x16x32_bf16(Bt[n][k], At[m][k], acc[1][bj][m][n], 0, 0, 0); __builtin_amdgcn_s_setprio(0); } while (0)
#define PG8_WAIT_V(n) asm volatile("s_waitcnt vmcnt(" #n ")" ::: "memory")
#define PG8_WAIT_L(n) asm volatile("s_waitcnt lgkmcnt(" #n ")" ::: "memory")
#define PG8_BAR __builtin_amdgcn_s_barrier()
#define PG8_SCHED __builtin_amdgcn_sched_barrier(0)
    Unit cur, nxt; int ui = 0;
    if (!S.next(0, cur)) return;
    f32x4 acc[2][2][4][2];
#pragma unroll
    for (int a = 0; a < 2; ++a)
#pragma unroll
        for (int b = 0; b < 2; ++b)
#pragma unroll
            for (int m = 0; m < 4; ++m)
#pragma unroll
                for (int n = 0; n < 2; ++n) acc[a][b][m][n] = (f32x4){0.f, 0.f, 0.f, 0.f};
    bf16x8 At[4][2], B0[2][2], B1[2][2];
    const char* cA = cur.a; const char* cB = cur.b;
    PG8_STAGE(PG8_SB(0, 0), cB, voffB); PG8_STAGE(PG8_SB(0, 1), cB + hstepB, voffB); PG8_STAGE(PG8_SA(0, 0), cA, voffA); PG8_STAGE(PG8_SA(0, 1), cA + hstepA, voffA1);
    if (wr == 1) PG8_BAR;
    PG8_WAIT_V(2); PG8_BAR;
    PG8_STAGE(PG8_SB(1, 0), cB + kstep, voffB); PG8_STAGE(PG8_SA(1, 0), cA + kstep, voffA); PG8_STAGE(PG8_SB(1, 1), cB + hstepB + kstep, voffB);
    PG8_WAIT_V(6); PG8_BAR;
    for (;;) {
        const bool has_next = S.next(ui + 1, nxt);
        const char* nA = has_next ? nxt.a : cA; const char* nB = has_next ? nxt.b : cB;
        for (int t = 0; t < nt; t += 2) {
            const bool last = (t == nt - 2);
            const char* a1 = cA + (size_t)(t + 1) * kstep;
            const char* a2 = last ? nA : cA + (size_t)(t + 2) * kstep; const char* b2 = last ? nB : cB + (size_t)(t + 2) * kstep;
            const char* a3 = a2 + kstep; const char* b3 = b2 + kstep;
            PG8_LDB(B0, 0, 0); PG8_LDB(B1, 0, 1); PG8_SCHED; PG8_LDA(At, 0, 0); PG8_STAGE(PG8_SA(1, 1), a1 + hstepA, voffA1);
            PG8_WAIT_V(8); PG8_WAIT_L(0); PG8_BAR; PG8_MMA(0, 0, At, B0); PG8_MMA(0, 1, At, B1); PG8_BAR; PG8_SCHED;
            PG8_LDA1(At, 0); PG8_STAGE(PG8_SB(0, 0), b2, voffB); PG8_STAGE(PG8_SB(0, 1), b2 + hstepB, voffB); PG8_STAGE(PG8_SA(0, 0), a2, voffA);
            PG8_WAIT_V(8); PG8_WAIT_L(0); PG8_BAR; PG8_MMA1(0, At, B0); PG8_MMA1(1, At, B1); PG8_BAR; PG8_SCHED;
            PG8_LDB(B0, 1, 0); PG8_LDB(B1, 1, 1); PG8_SCHED; PG8_LDA(At, 1, 0); PG8_STAGE(PG8_SA(0, 1), a2 + hstepA, voffA1);
            PG8_WAIT_V(8); PG8_WAIT_L(0); PG8_BAR; PG8_MMA(0, 0, At, B0); PG8_MMA(0, 1, At, B1); PG8_BAR; PG8_SCHED;
            PG8_LDA1(At, 1); PG8_STAGE(PG8_SB(1, 0), b3, voffB); PG8_STAGE(PG8_SB(1, 1), b3 + hstepB, voffB); PG8_STAGE(PG8_SA(1, 0), a3, voffA);
            PG8_WAIT_V(8); PG8_WAIT_L(0); PG8_BAR; PG8_MMA1(0, At, B0); PG8_MMA1(1, At, B1); PG8_BAR; PG8_SCHED;
        }
        if (wr == 0) PG8_BAR;
        if (MK_TP == 2) { const unsigned long long t0_ = __builtin_amdgcn_s_memrealtime(); E(acc, cur, wid, ui); const unsigned long long t1_ = __builtin_amdgcn_s_memrealtime();
            if (wid == 0 && lane == 0 && tp_on) *(volatile LAS unsigned*)(lds + 131072 + 8192 + 320 + 4 * 16) += (unsigned)(t1_ - t0_); }
        else E(acc, cur, wid, ui);
        if (!has_next) break;
#pragma unroll
        for (int a = 0; a < 2; ++a)
#pragma unroll
            for (int b = 0; b < 2; ++b)
#pragma unroll
                for (int m = 0; m < 4; ++m)
#pragma unroll
                    for (int n = 0; n < 2; ++n) acc[a][b][m][n] = (f32x4){0.f, 0.f, 0.f, 0.f};
        cur = nxt; cA = nA; cB = nB; ++ui;
        if (wr == 1) PG8_BAR;
    }
    PG8_WAIT_V(0);
    PG8_BAR;
#undef PG8_SA
#undef PG8_SB
#undef PG8_STAGE
#undef PG8_LDA
#undef PG8_LDA1
#undef PG8_MMA1
#undef PG8_LDB
#undef PG8_MMA
#undef PG8_WAIT_V
#undef PG8_WAIT_L
#undef PG8_BAR
#undef PG8_SCHED
}
}
using pg8::Unit; using pg8::cvt_pk_bf16;

constexpr size_t MiB = 1u << 20;
constexpr size_t WS_CTL = 0, CTL_ZERO_BYTES = 128 * 1024;
constexpr size_t WS_MOD = 1 * MiB;
constexpr size_t WS_ROPE = WS_MOD + 512 * 1024;
constexpr size_t WS_STATS = WS_ROPE + 64 * 1024;
constexpr size_t WS_WQKV = 4 * MiB;
constexpr size_t WS_WO = WS_WQKV + 3 * MiB;
constexpr size_t WS_WSGI = WS_WO + 2 * MiB;
constexpr size_t WS_WSGO = WS_WSGI + 4 * MiB;
constexpr size_t WS_WSCI = WS_WSGO + 2 * MiB;
constexpr size_t WS_WSCO = WS_WSCI + 6 * MiB;
constexpr size_t WS_WFNO = WS_WSCO + 2 * MiB;
constexpr size_t WS_WUP = WS_WFNO + 2 * MiB;
constexpr size_t WUP_BYTES = (size_t)2 * DFF * D * 2;
constexpr size_t WS_WDN = WS_WUP + 4 * WUP_BYTES;
constexpr size_t WDN_BYTES = (size_t)D * DFF * 2;
constexpr size_t WS_WS = WS_WDN + 4 * WDN_BYTES;
constexpr size_t WS_A1 = WS_WS + 256 * 1024;
constexpr size_t WS_A2P = WS_A1 + 256 * 1024;
constexpr size_t WS_A2S = WS_A2P + 256 * 1024;
constexpr size_t WS_CK = WS_A2S + 16 * MiB;
constexpr size_t WS_CVT = WS_CK + 512 * 1024;
constexpr size_t WS_X = WS_CVT + 512 * 1024;
constexpr size_t WS_H = WS_X + (size_t)M * D * 4;
constexpr size_t WS_BIG = WS_H + (size_t)(M + 256) * D * 2;
constexpr size_t WS_END = WS_BIG + 72 * MiB;
constexpr size_t WS_ACT = WS_BIG;
constexpr size_t WS_Q = WS_BIG;
constexpr size_t WS_KB = WS_Q + 24 * MiB;
constexpr size_t WS_VT = WS_KB + 6 * MiB;
constexpr size_t WS_U = WS_BIG;
constexpr size_t WS_V = WS_BIG + 24 * MiB;
constexpr size_t WS_YB = WS_BIG;
constexpr size_t WS_YT = WS_BIG;
static_assert(WS_YB + (size_t)256 * 2 * 16 * 512 * 16 <= WS_END, "yb");
static_assert(WS_ACT + (size_t)M * DFF * 2 <= WS_END, "act");
constexpr size_t WS_H2 = WS_END;
constexpr size_t WS_HN = WS_H2 + (size_t)M * D * 2;
constexpr size_t WS_XS = WS_HN + (size_t)(M + 256) * D * 2;
constexpr size_t WS_TOTAL = WS_XS + (size_t)16 * M * 4 * 4;
constexpr size_t CTL_CNT = 16384;
constexpr size_t CTL_TMO = CTL_CNT + 16 * 64 * 64;

constexpr size_t OUT_NK = (size_t)M * D, OUT_NV = OUT_NK + (size_t)MP * 256;

#define XB_TMO      128
#define XB_XCNT(j)  (256  + 64 * (j))
#define XB_XSUB(j)  (1280 + 64 * (j))
#define XB_XGEN(j)  (2304 + 64 * (j))
#define XB_TOP      3328
#define XB_TOPGEN   3392
#define XCD_BAR_WORDS 3456
#define XB_SPIN_CAP (1u << 22)
__device__ __forceinline__ unsigned xb_ld(unsigned* p)              { return __hip_atomic_load(p, __ATOMIC_RELAXED, __HIP_MEMORY_SCOPE_AGENT); }
__device__ __forceinline__ unsigned xb_add(unsigned* p, unsigned v) { return __hip_atomic_fetch_add(p, v, __ATOMIC_RELAXED, __HIP_MEMORY_SCOPE_AGENT); }
__device__ __forceinline__ unsigned xb_xcc_id() { return (unsigned)__builtin_amdgcn_s_getreg((3 << 11) | 20) & 0xFu; }
#define XB_SPIN(cond, bar) do { unsigned _sp = 0; while (cond) { __builtin_amdgcn_s_sleep(1); \
    if ((++_sp & 255u) == 0u) { if (xb_ld(&(bar)[XB_TMO])) break; if (_sp > XB_SPIN_CAP) { atomicAdd(&(bar)[XB_TMO], 1u); break; } } } } while (0)
struct XcdBarrier { unsigned* bar; unsigned x; volatile LAS unsigned* st; };
__device__ __forceinline__ XcdBarrier xcd_barrier_post(unsigned* bar, volatile LAS unsigned* st, bool leader) {
    XcdBarrier b; b.bar = bar; b.x = xb_xcc_id(); b.st = st;
    if (leader) (void)xb_add(&bar[XB_XCNT(b.x)], 1u);
    return b;
}
__device__ __forceinline__ void xcd_barrier_complete(unsigned* bar, unsigned x, unsigned& nloc, unsigned& nx) {
    const unsigned G = gridDim.x * gridDim.y * gridDim.z;
    unsigned sum, cnt, mine, sp = 0u;
    for (;;) {
        sum = 0u; cnt = 0u; mine = 0u;
#pragma unroll
        for (unsigned j = 0; j < 16; ++j) { const unsigned c = xb_ld(&bar[XB_XCNT(j)]); sum += c; cnt += (c > 0u) ? 1u : 0u; }
        mine = xb_ld(&bar[XB_XCNT(x)]);
        if (sum == G) break;
        __builtin_amdgcn_s_sleep(1);
        if ((++sp & 255u) == 0u) { if (xb_ld(&bar[XB_TMO])) break; if (sp > XB_SPIN_CAP) { atomicAdd(&bar[XB_TMO], 1u); break; } }
    }
    nloc = mine > 0u ? mine : 1u; nx = cnt > 0u ? cnt : 1u;
}
__device__ __forceinline__ void xcd_barrier(const XcdBarrier& b, bool leader) {
    asm volatile("s_waitcnt vmcnt(0)" ::: "memory");
    __syncthreads();
    if (leader) {
        unsigned* bar = b.bar; unsigned bx = b.x; asm volatile("" : "+s"(bx));
        __builtin_amdgcn_s_waitcnt(0);
        unsigned nloc = b.st[0], nx = b.st[1];
        if (nloc == 0u) { xcd_barrier_complete(bar, bx, nloc, nx); b.st[0] = nloc; b.st[1] = nx; }
        const unsigned old = xb_add(&bar[XB_XSUB(bx)], 1u);
        const unsigned gen = old / nloc;
        if (old + 1u == (gen + 1u) * nloc) {
            __builtin_amdgcn_fence(__ATOMIC_RELEASE, "agent");
            asm volatile("s_waitcnt vmcnt(0)" ::: "memory");
            const unsigned og = xb_add(&bar[XB_TOP], 1u);
            const unsigned tg = og / nx;
            if (og + 1u == (tg + 1u) * nx) xb_add(&bar[XB_TOPGEN], 1u);
            else XB_SPIN(xb_ld(&bar[XB_TOPGEN]) == tg, bar);
            __builtin_amdgcn_fence(__ATOMIC_ACQUIRE, "agent");
            xb_add(&bar[XB_XGEN(bx)], 1u);
            asm volatile("s_waitcnt vmcnt(0)" ::: "memory");
        } else {
            XB_SPIN(xb_ld(&bar[XB_XGEN(bx)]) == gen, bar);
            __builtin_amdgcn_fence(__ATOMIC_ACQUIRE, "agent");
            asm volatile("s_waitcnt vmcnt(0)" ::: "memory");
        }
    }
    __syncthreads();
}

#define LDS_WAIT() asm volatile("s_waitcnt lgkmcnt(0)" ::: "memory")
__device__ __forceinline__ unsigned f2bf(float f) { unsigned u = __builtin_bit_cast(unsigned, f); return (u + 0x7fffu + ((u >> 16) & 1u)) >> 16; }
__device__ __forceinline__ unsigned pk2(float lo, float hi) { return f2bf(lo) | (f2bf(hi) << 16); }
__device__ __forceinline__ float bf2f(unsigned short b) { return __builtin_bit_cast(float, (unsigned)b << 16); }
__device__ __forceinline__ float rows_max(float x) {
    auto s = __builtin_amdgcn_permlane16_swap(__float_as_uint(x), __float_as_uint(x), false, false); x = fmaxf(__uint_as_float(s[0]), __uint_as_float(s[1]));
    auto t = __builtin_amdgcn_permlane32_swap(__float_as_uint(x), __float_as_uint(x), false, false); return fmaxf(__uint_as_float(t[0]), __uint_as_float(t[1])); }
__device__ __forceinline__ float rows_sum(float x) {
    auto s = __builtin_amdgcn_permlane16_swap(__float_as_uint(x), __float_as_uint(x), false, false); x = __uint_as_float(s[0]) + __uint_as_float(s[1]);
    auto t = __builtin_amdgcn_permlane32_swap(__float_as_uint(x), __float_as_uint(x), false, false); return __uint_as_float(t[0]) + __uint_as_float(t[1]); }
template <int CTRL> __device__ __forceinline__ float dppx(float v) { return __builtin_bit_cast(float, __builtin_amdgcn_mov_dpp(__builtin_bit_cast(int, v), CTRL, 0xf, 0xf, true)); }
__device__ __forceinline__ float wave_sum(float v) {
    v += dppx<0xB1>(v);
    v += dppx<0x4E>(v);
    v += dppx<0x141>(v);
    v += dppx<0x140>(v);
    return rows_sum(v);
}
__device__ __forceinline__ float fast_exp2(float x) { return __builtin_amdgcn_exp2f(x); }
__device__ __forceinline__ float fast_rcp(float x) { return __builtin_amdgcn_rcpf(x); }
__device__ __forceinline__ float silu_f(float x) { return x * fast_rcp(1.f + fast_exp2(-1.4426950408889634f * x)); }
__device__ __forceinline__ float gelu_f(float x) { const float u = x * (1.f + 0.044715f * x * x); return x * fast_rcp(1.f + fast_exp2(-2.302208198f * u)); }
__device__ __forceinline__ int conv_row0(int pm) { if (pm < 32) return 256 * pm; const int s = (pm - 32) / 9, i = (pm - 32) % 9; return MP + TS * s + 254 * i - 1; }
template <int CTRL> __device__ __forceinline__ float dpp(float v) { return __builtin_bit_cast(float, __builtin_amdgcn_mov_dpp(__builtin_bit_cast(int, v), CTRL, 0xf, 0xf, true)); }
template <int CTRL> __device__ __forceinline__ f32x4 dpp4(f32x4 v) { return (f32x4){dpp<CTRL>(v[0]), dpp<CTRL>(v[1]), dpp<CTRL>(v[2]), dpp<CTRL>(v[3])}; }
#define DPP_ROR1 0x121
#define DPP_ROR15 0x12F

template <int NM, int NN, int CONV, int LDA, int LDB, int ROWS = 256>
struct Order {
    int G, c; const char* A; const char* B;
    __device__ __forceinline__ void init(int G_, int c_, const void* A_, const void* B_) { G = G_; c = c_; A = (const char*)A_; B = (const char*)B_; }
    __device__ __forceinline__ bool next(int i, Unit& u) const {
        constexpr int nwg = NM * NN;
        const int L = i * G + c; if (L >= nwg) return false;
        int wgid = L; { constexpr int q = nwg / pg8::NXCD, r = nwg % pg8::NXCD; const int xcd = wgid % pg8::NXCD, off = wgid / pg8::NXCD; wgid = (xcd < r ? xcd * (q + 1) : r * (q + 1) + (xcd - r) * q) + off; }
        constexpr int nig = pg8::WGM * NN; const int gid = wgid / nig, fm = gid * pg8::WGM, gsz = (NM - fm) < pg8::WGM ? (NM - fm) : pg8::WGM;
        u.pm = fm + ((wgid % nig) % gsz); u.pn = (wgid % nig) / gsz;
        u.row0 = CONV ? conv_row0(u.pm) : ROWS * u.pm;
        u.a = A + (long)u.row0 * (long)(LDA * 2); u.b = B + (size_t)u.pn * (size_t)(256 * LDB * 2); return true;
    }
};

typedef const GAS float* cfp_t;
struct Frame {
    LAS unsigned char* lds; int tid, lane, wave, G, blk;
    const __attribute__((address_space(4))) cfp_t* in; float* out; unsigned char* ws;
};
__device__ __forceinline__ void frame_refresh(Frame& F) {
    int ln = pg8::lane_id(); asm volatile("" : "+v"(ln)); F.lane = ln; F.tid = F.wave * 64 + ln;
}
constexpr int RING_BYTES = 131072, XCH_OFF = RING_BYTES  , MISC_OFF = XCH_OFF + 8192 + 320, LDS_BYTES = 147456;
__device__ __forceinline__ int vec_plain(int pm) { return pm < 32 ? 0 : 1 + (pm - 32) / 8; }
__device__ __forceinline__ int vec_conv(int pm) { return pm < 32 ? 0 : 1 + (pm - 32) / 9; }

__device__ __forceinline__ constexpr int r192_nm(int ai) { return ai ? 2 : 4; }
__device__ __forceinline__ int r192_base(int ai, int wr) { return ai ? 128 + 32 * wr : 64 * wr; }
__device__ __forceinline__ u32x4 merge_quads16(u32x2 q0, u32x2 q1) {
    auto a = __builtin_amdgcn_permlane16_swap(q0.x, q1.x, false, false);
    auto b = __builtin_amdgcn_permlane16_swap(q0.y, q1.y, false, false);
    return (u32x4){a[0], b[0], a[1], b[1]};
}
struct EpiBase {
    unsigned char* ws_; int l, aux;
    __device__ __forceinline__ unsigned char* wsp() const { unsigned long long w = (unsigned long long)ws_; asm volatile("" : "+s"(w)); return (unsigned char*)(GAS unsigned char*)w; }
    __device__ __forceinline__ static const __attribute__((address_space(4))) cfp_t* kargs() { unsigned long long kp = (unsigned long long)__builtin_amdgcn_kernarg_segment_ptr(); asm volatile("" : "+s"(kp)); return (const __attribute__((address_space(4))) cfp_t*)kp; }
    __device__ __forceinline__ static const float* inp(const __attribute__((address_space(4))) cfp_t* ka, int k) { return (const float*)ka[k]; }
    __device__ __forceinline__ static float* outp(const __attribute__((address_space(4))) cfp_t* ka) { return (float*)(GAS float*)ka[26]; }
    __device__ __forceinline__ static LAS float* xch() { extern __shared__ __attribute__((aligned(16))) unsigned char lds_base_[]; return (LAS float*)((LAS unsigned char*)lds_base_ + XCH_OFF); }
};
template <bool FINAL>
struct EpiResNorm : EpiBase {
    static constexpr bool PERM = false;
    static constexpr int TR = 192;
    __device__ __forceinline__ static int nm(int ai) { return ai ? 2 : 4; }
    __device__ __forceinline__ static int rbase(int ai, int wr) { return ai ? 128 + 32 * wr : 64 * wr; }
    __device__ __forceinline__ void operator()(f32x4 (&acc)[2][2][4][2], const Unit& u, int wid, int ) const {
        int lane_ = pg8::lane_id(); asm volatile("" : "+v"(lane_));
        const int lane = lane_, wr = wid >> 2, wc = wid & 3, fr = lane & 15, fq = lane >> 4;
        unsigned char* ws = wsp(); const auto ka = kargs();
        const int isdn = aux & 1, rep = (aux >> 1) & 1, inst = 2 * l + isdn + 8 * rep;
        typedef _Float16 h4 __attribute__((ext_vector_type(4)));
        _Float16* Xr = (_Float16*)(ws + WS_X); _Float16* X = rep ? (_Float16*)(ws + WS_TOTAL) : Xr;
        const bool srcf32 = (!isdn && l == 0);
        const float* modl = (const float*)(ws + WS_MOD) + l * 3 * 6 * D; const int gate_idx = isdn ? 5 : 2;
        const float* gn = FINAL ? inp(ka, 10) : (isdn ? inp(ka, 8) + (l + 1) * D : inp(ka, 9) + l * D);
        const float* modn = isdn ? modl + 3 * 6 * D : modl; const int sh_idx = isdn ? 0 : 3;
        bf16_t* HN = (bf16_t*)(ws + (rep ? WS_TOTAL + 48 * MiB : WS_HN)); float* Y = rep ? (float*)(ws + WS_TOTAL) : outp(ka);
        float* xs = (float*)(ws + WS_XS) + (size_t)inst * M * 4; unsigned* cnt = (unsigned*)(ws + WS_CTL + CTL_CNT) + inst * 64 * 16; unsigned* tmo = (unsigned*)(ws + WS_CTL + CTL_TMO);
        LAS float* L = xch();
        const int col0 = u.pn * 256 + wc * 32 + 4 * fq, tid = wid * 64 + lane;
        const int col16 = col0 + ((fq & 1) ? 12 : 0);
        LAS float* P = L;
        LAS float* S = L + 1024;
#pragma unroll
        for (int ai = 0; ai < 2; ++ai) {
            const int rb = u.row0 + rbase(ai, wr);
            const int vec = rb < MP ? 0 : 1 + (rb - MP) / TS;
            const float* gate = modl + vec * 6 * D + gate_idx * D;
            const float* src = rb < MP ? inp(ka, 0) + (size_t)rb * D : inp(ka, 1) + (size_t)(rb - MP) * D;
            f32x4 gv[2][2];
#pragma unroll
            for (int bj = 0; bj < 2; ++bj)
#pragma unroll
                for (int n = 0; n < 2; ++n) gv[bj][n] = *(const f32x4*)(gate + col0 + bj * 128 + n * 16);
            f32x4 sv[4][2][2];
#pragma unroll
            for (int m = 0; m < 4; ++m) if (m < nm(ai)) { const size_t ro = (size_t)(16 * m + fr) * D + col0;
#pragma unroll
                for (int bj = 0; bj < 2; ++bj)
#pragma unroll
                    for (int n = 0; n < 2; ++n) { if (srcf32) sv[m][bj][n] = *(const f32x4*)(src + ro + bj * 128 + n * 16);
                        else sv[m][bj][n] = __builtin_convertvector(*(const h4*)(Xr + (size_t)rb * D + ro + bj * 128 + n * 16), f32x4); } }
#pragma unroll
            for (int m = 0; m < 4; ++m) if (m < nm(ai)) { const int r = rbase(ai, wr) + 16 * m + fr; float ss = 0.f;
#pragma unroll
                for (int bj = 0; bj < 2; ++bj)
#pragma unroll
                    for (int n = 0; n < 2; ++n) { const f32x4 x1 = sv[m][bj][n] + gv[bj][n] * acc[ai][bj][m][n]; acc[ai][bj][m][n] = x1;
                        ss += (x1[0] * x1[0] + x1[1] * x1[1]) + (x1[2] * x1[2] + x1[3] * x1[3]); }
                ss = rows_sum(ss);
                if (fq == 0) P[r * 4 + wc] = ss; }
            asm volatile("" ::: "memory"); }
        LDS_WAIT(); __builtin_amdgcn_s_barrier(); asm volatile("" ::: "memory");
        if (tid < TR) { const f32x4 p = *(const LAS f32x4*)(P + tid * 4); const float tot = (p[0] + p[1]) + (p[2] + p[3]);
            __hip_atomic_store(xs + (size_t)(u.row0 + tid) * 4 + u.pn, tot, __ATOMIC_RELAXED, __HIP_MEMORY_SCOPE_AGENT); }
        asm volatile("s_waitcnt vmcnt(0)" ::: "memory");
        if (tid < TR && (tid & 63) == 0) __hip_atomic_fetch_add(cnt + 16 * u.pm, 1u, __ATOMIC_RELAXED, __HIP_MEMORY_SCOPE_AGENT);
        if (!FINAL) {
#pragma unroll
            for (int ai = 0; ai < 2; ++ai)
#pragma unroll
                for (int m = 0; m < 4; ++m) if (m < nm(ai)) { _Float16* xp = X + (size_t)(u.row0 + rbase(ai, wr) + 16 * m + fr) * D + col16;
#pragma unroll
                    for (int bj = 0; bj < 2; ++bj) { const h4 h0 = __builtin_convertvector(acc[ai][bj][m][0], h4), h1 = __builtin_convertvector(acc[ai][bj][m][1], h4);
                        *(u32x4*)(xp + bj * 128) = merge_quads16(__builtin_bit_cast(u32x2, h0), __builtin_bit_cast(u32x2, h1)); } }
        }
        if (tid < 64) { unsigned sp_ = 0;
            while ((unsigned)__builtin_amdgcn_readfirstlane(__hip_atomic_load(cnt + 16 * u.pm, __ATOMIC_RELAXED, __HIP_MEMORY_SCOPE_AGENT)) < 12u) {
                __builtin_amdgcn_s_sleep(1);
                if ((++sp_ & 1023u) == 0u) { if (__hip_atomic_load(tmo, __ATOMIC_RELAXED, __HIP_MEMORY_SCOPE_AGENT)) break; if (sp_ > (1u << 22)) { __hip_atomic_store(tmo, 1u, __ATOMIC_RELAXED, __HIP_MEMORY_SCOPE_AGENT); break; } } }
        }
        asm volatile("s_waitcnt lgkmcnt(0)" ::: "memory"); __builtin_amdgcn_s_barrier(); asm volatile("" ::: "memory");
        if (tid < TR) { const float* sl = xs + (size_t)(u.row0 + tid) * 4; float t = 0.f;
#pragma unroll
            for (int k = 0; k < 4; ++k) t += __hip_atomic_load(sl + k, __ATOMIC_RELAXED, __HIP_MEMORY_SCOPE_AGENT);
            S[tid] = rsqrtf(t * (1.f / D) + EPS); }
        LDS_WAIT(); __builtin_amdgcn_s_barrier(); asm volatile("" ::: "memory");
#pragma unroll
        for (int ai = 0; ai < 2; ++ai) {
            const int rb = u.row0 + rbase(ai, wr); const int vec = rb < MP ? 0 : 1 + (rb - MP) / TS;
            f32x4 gm[2][2], sh[2][2];
#pragma unroll
            for (int bj = 0; bj < 2; ++bj)
#pragma unroll
                for (int n = 0; n < 2; ++n) { const int c = col0 + bj * 128 + n * 16; gm[bj][n] = *(const f32x4*)(gn + c);
                    if (!FINAL) { const float* mv = modn + vec * 6 * D; gm[bj][n] = gm[bj][n] * (1.f + *(const f32x4*)(mv + (sh_idx + 1) * D + c)); sh[bj][n] = *(const f32x4*)(mv + sh_idx * D + c); } }
#pragma unroll
            for (int m = 0; m < 4; ++m) if (m < nm(ai)) { const int r = rbase(ai, wr) + 16 * m + fr; const float rs = S[r];
#pragma unroll
                for (int bj = 0; bj < 2; ++bj) {
                    if (FINAL) {
#pragma unroll
                        for (int n = 0; n < 2; ++n) *(f32x4*)(Y + (size_t)(u.row0 + r) * D + col0 + bj * 128 + n * 16) = acc[ai][bj][m][n] * rs * gm[bj][n]; }
                    else { const f32x4 h0 = acc[ai][bj][m][0] * rs * gm[bj][0] + sh[bj][0], h1 = acc[ai][bj][m][1] * rs * gm[bj][1] + sh[bj][1];
                        u32x2 w0, w1; w0.x = cvt_pk_bf16(h0[0], h0[1]); w0.y = cvt_pk_bf16(h0[2], h0[3]); w1.x = cvt_pk_bf16(h1[0], h1[1]); w1.y = cvt_pk_bf16(h1[2], h1[3]);
                        *(u32x4*)(HN + (size_t)(u.row0 + r) * D + col16 + bj * 128) = merge_quads16(w0, w1); } } }
        }
    }
};
struct EpiNull : EpiBase {
    static constexpr bool PERM = true;
    __device__ __forceinline__ void operator()(f32x4 (&acc)[2][2][4][2], const Unit& u, int wid, int) const {
        f32x4 s = {0.f, 0.f, 0.f, 0.f};
#pragma unroll
        for (int ai = 0; ai < 2; ++ai)
#pragma unroll
            for (int bj = 0; bj < 2; ++bj)
#pragma unroll
                for (int m = 0; m < 4; ++m)
#pragma unroll
                    for (int n = 0; n < 2; ++n) s += acc[ai][bj][m][n];
        ((f32x4*)(wsp() + WS_TOTAL))[(size_t)(u.pm * 22 + u.pn) * 512 + wid * 64 + pg8::lane_id()] = s;
    }
};
template <int ROWS> struct EpiBf16 : EpiBase {
    static constexpr bool PERM = true;
    __device__ __forceinline__ void operator()(const f32x4 (&acc)[2][2][4][2], const Unit& u, int wid, int ) const {
        int lane_ = pg8::lane_id(); asm volatile("" : "+v"(lane_));
        const int lane = lane_, wr = wid >> 2, wc = wid & 3, fr = lane & 15, fq = lane >> 4; (void)wr; (void)wc; (void)fr; (void)fq;
        bf16_t* O = (bf16_t*)(wsp() + WS_H); constexpr int ldc = D;
        const int col0 = u.pn * 256 + wc * 32 + 8 * fq;
#pragma unroll
        for (int ai = 0; ai < (ROWS == 128 ? 1 : 2); ++ai)
#pragma unroll
            for (int m = 0; m < 4; ++m) { bf16_t* rowp = O + (size_t)(u.row0 + ai * 128 + wr * 64 + m * 16 + fr) * ldc + col0;
#pragma unroll
                for (int bj = 0; bj < 2; ++bj) { const f32x4 v0 = acc[ai][bj][m][0], v1 = acc[ai][bj][m][1];
                    u32x4 w; w.x = cvt_pk_bf16(v0[0], v0[1]); w.y = cvt_pk_bf16(v0[2], v0[3]); w.z = cvt_pk_bf16(v1[0], v1[1]); w.w = cvt_pk_bf16(v1[2], v1[3]);
                    *(u32x4*)(rowp + bj * 128) = w; } }
    }
};
struct EpiQKV : EpiBase {
    static constexpr bool PERM = false;
    __device__ __forceinline__ void operator()(f32x4 (&acc)[2][2][4][2], const Unit& u, int wid, int ) const {
        int lane_ = pg8::lane_id(); asm volatile("" : "+v"(lane_));
        const int lane = lane_, wr = wid >> 2, wc = wid & 3, fr = lane & 15, fq = lane >> 4;
        unsigned char* ws = wsp(); bf16_t* Q = (bf16_t*)(ws + WS_Q); bf16_t* KB = (bf16_t*)(ws + WS_KB); bf16_t* VT = (bf16_t*)(ws + WS_VT); const float* rope = (const float*)(ws + WS_ROPE);
        float* outk = outp(kargs()) + OUT_NK; float* outv = outk + (OUT_NV - OUT_NK);
        const int c0 = wc * 32 + 4 * fq;
#pragma unroll
        for (int ai = 0; ai < 2; ++ai) {
            const int rb = u.row0 + r192_base(ai, wr); const bool samp = rb >= MP;
            if (samp && u.pn <= 4) {
                const int half = wc & 1;
#pragma unroll
                for (int m = 0; m < 4; ++m) if (m < r192_nm(ai)) { const int t = (rb - MP + m * 16 + fr) & (TS - 1); const int pos = half ? (t & 63) : (t >> 6);
                    const f32x4 cs = *(const f32x4*)(rope + pos * 16 + 4 * fq), sn = *(const f32x4*)(rope + 1024 + pos * 16 + 4 * fq);
#pragma unroll
                    for (int bj = 0; bj < 2; ++bj) { const f32x4 x1 = acc[ai][bj][m][0], x2 = acc[ai][bj][m][1]; acc[ai][bj][m][0] = x1 * cs - x2 * sn; acc[ai][bj][m][1] = x2 * cs + x1 * sn; } }
            }
            if (u.pn <= 4) {
                bf16_t* base = u.pn < 4 ? Q + u.pn * 256 : KB; const int ldc = u.pn < 4 ? D : 256;
#pragma unroll
                for (int m = 0; m < 4; ++m) if (m < r192_nm(ai)) { const int row = rb + m * 16 + fr; bf16_t* rowp = base + (size_t)row * ldc + c0;
#pragma unroll
                    for (int bj = 0; bj < 2; ++bj)
#pragma unroll
                        for (int n = 0; n < 2; ++n) { const f32x4 v = acc[ai][bj][m][n]; u32x2 w; w.x = cvt_pk_bf16(v[0], v[1]); w.y = cvt_pk_bf16(v[2], v[3]); *(u32x2*)(rowp + bj * 128 + n * 16) = w;
                            if (u.pn == 4 && !samp) *(f32x4*)(outk + (size_t)row * 256 + c0 + bj * 128 + n * 16) = v; } }
            } else {
                const int T = samp ? TS : TP;
                bf16_t* vt = samp ? VT + (size_t)32 * 65536 + (size_t)((rb - MP) / TS) * 256 * TS : VT + (size_t)(rb / TP) * 65536;
#pragma unroll
                for (int m = 0; m < 4; ++m) if (m < r192_nm(ai)) { const int row = rb + m * 16 + fr; const int t = samp ? ((row - MP) & (TS - 1)) : (row & (TP - 1));
                    unsigned vo = (unsigned)(c0 * T + t); asm volatile("" : "+v"(vo));
#pragma unroll
                    for (int bj = 0; bj < 2; ++bj)
#pragma unroll
                        for (int n = 0; n < 2; ++n) { const f32x4 v = acc[ai][bj][m][n]; const int c = c0 + bj * 128 + n * 16;
#pragma unroll
                            for (int j = 0; j < 4; ++j) vt[vo + (unsigned)((bj * 128 + n * 16 + j) * T)] = (bf16_t)f2bf(v[j]);
                            if (!samp) *(f32x4*)(outv + (size_t)row * 256 + c) = v; } }
            }
        }
    }
};
__device__ __forceinline__ f32x4 conv_m(f32x4 cur, f32x4 pe, f32x4 ne, f32x4 w0, f32x4 w1, f32x4 w2, int fr) {
    const f32x4 up = dpp4<DPP_ROR1>(cur), dn = dpp4<DPP_ROR15>(cur);
    const f32x4 prev = fr > 0 ? up : pe, next = fr < 15 ? dn : ne;
    return w0 * prev + w1 * cur + w2 * next;
}
__device__ __forceinline__ void mask_rows(f32x4 (&acc)[2][2][4][2], const Unit& u, int wr, int fr) {
    if (u.pm < 32) return;
    const int i = (u.pm - 32) % 9; if (i != 0 && i != 8) return;
    const int t0 = 254 * i - 1;
#pragma unroll
    for (int ai = 0; ai < 2; ++ai)
#pragma unroll
        for (int m = 0; m < 4; ++m) { const int t = t0 + ai * 128 + wr * 64 + m * 16 + fr; if (t < 0 || t >= TS) {
#pragma unroll
            for (int bj = 0; bj < 2; ++bj)
#pragma unroll
                for (int n = 0; n < 2; ++n) acc[ai][bj][m][n] = (f32x4){0.f, 0.f, 0.f, 0.f}; } }
}
__device__ __forceinline__ bool row_valid(const Unit& u, int r) {
    if (u.pm < 32) return true;
    const int t = 254 * ((u.pm - 32) % 9) - 1 + r; return r >= 1 && r <= 254 && t >= 0 && t < TS;
}
__device__ __forceinline__ void xch_write(LAS float* X, const f32x4 (&acc)[2][2][4][2], int wr, int wc, int fr, int fq) {
#pragma unroll
    for (int ai = 0; ai < 2; ++ai)
#pragma unroll
        for (int bj = 0; bj < 2; ++bj)
#pragma unroll
            for (int n = 0; n < 2; ++n) { const int col = bj * 128 + wc * 32 + 8 * fq + 4 * n;
                if (fr == 0) *(LAS f32x4*)(X + ((2 * ai + wr) * 2 + 0) * 256 + col) = acc[ai][bj][0][n];
                if (fr == 15) *(LAS f32x4*)(X + ((2 * ai + wr) * 2 + 1) * 256 + col) = acc[ai][bj][3][n]; }
}
__device__ __forceinline__ f32x4 xch_top(const LAS float* X, int b, int col) { return b > 0 ? *(const LAS f32x4*)(X + ((b - 1) * 2 + 1) * 256 + col) : (f32x4){0.f, 0.f, 0.f, 0.f}; }
__device__ __forceinline__ f32x4 xch_bot(const LAS float* X, int b, int col) { return b < 3 ? *(const LAS f32x4*)(X + ((b + 1) * 2 + 0) * 256 + col) : (f32x4){0.f, 0.f, 0.f, 0.f}; }

struct EpiUp : EpiBase {
    static constexpr bool PERM = true;
    __device__ __forceinline__ void operator()(f32x4 (&acc)[2][2][4][2], const Unit& u, int wid, int ) const {
        int lane_ = pg8::lane_id(); asm volatile("" : "+v"(lane_));
        const int lane = lane_, wr = wid >> 2, wc = wid & 3, fr = lane & 15, fq = lane >> 4; (void)wr; (void)wc; (void)fr; (void)fq;
        bf16_t* ACT = (bf16_t*)(wsp() + WS_ACT); const float* cw = inp(kargs(), 24) + (size_t)l * 3 * 2 * DFF; LAS float* X = xch();
        mask_rows(acc, u, wr, fr);
        xch_write(X, acc, wr, wc, fr, fq);
        LDS_WAIT(); __builtin_amdgcn_s_barrier(); asm volatile("" ::: "memory");
        const int chl = wc * 32 + 8 * fq;
        u32x2 pk0[2][4];
#pragma unroll
        for (int n = 0; n < 2; ++n) {
            const int ch = u.pn * 128 + chl + 4 * n;
            f32x4 wg[3], wu[3];
#pragma unroll
            for (int k = 0; k < 3; ++k) { wg[k] = *(const f32x4*)(cw + k * 2 * DFF + ch); wu[k] = *(const f32x4*)(cw + k * 2 * DFF + DFF + ch); }
#pragma unroll
            for (int ai = 0; ai < 2; ++ai) {
                const int b = 2 * ai + wr;
                f32x4 pg = xch_top(X, b, chl + 4 * n), pu = xch_top(X, b, 128 + chl + 4 * n);
#pragma unroll
                for (int m = 0; m < 4; ++m) { const int r = ai * 128 + wr * 64 + m * 16 + fr;
                    const f32x4 vg = acc[ai][0][m][n], vu = acc[ai][1][m][n];
                    const f32x4 ng = m < 3 ? dpp4<DPP_ROR15>(acc[ai][0][m < 3 ? m + 1 : 3][n]) : xch_bot(X, b, chl + 4 * n);
                    const f32x4 nu = m < 3 ? dpp4<DPP_ROR15>(acc[ai][1][m < 3 ? m + 1 : 3][n]) : xch_bot(X, b, 128 + chl + 4 * n);
                    const f32x4 og = conv_m(vg, pg, ng, wg[0], wg[1], wg[2], fr), ou = conv_m(vu, pu, nu, wu[0], wu[1], wu[2], fr);
                    pg = dpp4<DPP_ROR1>(vg); pu = dpp4<DPP_ROR1>(vu);
                    f32x4 a;
#pragma unroll
                    for (int j = 0; j < 4; ++j) a[j] = silu_f(og[j]) * ou[j];
                    u32x2 w; w.x = cvt_pk_bf16(a[0], a[1]); w.y = cvt_pk_bf16(a[2], a[3]);
                    if (n == 0) pk0[ai][m] = w;
                    else if (row_valid(u, r)) *(u32x4*)(ACT + (size_t)(u.row0 + r) * DFF + ch - 4) = (u32x4){pk0[ai][m].x, pk0[ai][m].y, w.x, w.y}; }
            }
        }
    }
};
struct EpiSgu : EpiBase {
    static constexpr bool PERM = true;
    __device__ __forceinline__ void operator()(f32x4 (&acc)[2][2][4][2], const Unit& u, int wid, int ) const {
        int lane_ = pg8::lane_id(); asm volatile("" : "+v"(lane_));
        const int lane = lane_, wr = wid >> 2, wc = wid & 3, fr = lane & 15, fq = lane >> 4;
        unsigned char* ws = wsp(); bf16_t* U = (bf16_t*)(ws + WS_U); bf16_t* V = (bf16_t*)(ws + WS_V); f32x2* STATS = (f32x2*)(ws + WS_STATS);
        const bool isv = u.pn >= 4; bf16_t* O = isv ? V : U; const int col0 = (u.pn & 3) * 256 + wc * 32 + 8 * fq;
#pragma unroll
        for (int ai = 0; ai < 2; ++ai)
#pragma unroll
            for (int m = 0; m < 4; ++m) if (m < r192_nm(ai)) { const int row = u.row0 + r192_base(ai, wr) + m * 16 + fr; bf16_t* rowp = O + (size_t)row * D + col0; float s1 = 0.f, s2 = 0.f;
#pragma unroll
                for (int bj = 0; bj < 2; ++bj) { f32x4 v0 = acc[ai][bj][m][0], v1 = acc[ai][bj][m][1];
#pragma unroll
                    for (int j = 0; j < 4; ++j) { v0[j] = gelu_f(v0[j]); v1[j] = gelu_f(v1[j]); s1 += v0[j] + v1[j]; s2 += v0[j] * v0[j] + v1[j] * v1[j]; }
                    u32x4 w; w.x = cvt_pk_bf16(v0[0], v0[1]); w.y = cvt_pk_bf16(v0[2], v0[3]); w.z = cvt_pk_bf16(v1[0], v1[1]); w.w = cvt_pk_bf16(v1[2], v1[3]);
                    *(u32x4*)(rowp + bj * 128) = w; }
                if (isv) { s1 = rows_sum(s1); s2 = rows_sum(s2);
                    if (fq == 0) STATS[(size_t)row * 16 + (u.pn - 4) * 4 + wc] = (f32x2){s1, s2}; } }
    }
};
struct EpiSc : EpiBase {
    static constexpr bool PERM = true;
    __device__ __forceinline__ void operator()(f32x4 (&acc)[2][2][4][2], const Unit& u, int wid, int ui) const {
        int lane_ = pg8::lane_id(); asm volatile("" : "+v"(lane_));
        const int lane = lane_, wr = wid >> 2, wc = wid & 3, fr = lane & 15, fq = lane >> 4; (void)wr; (void)wc; (void)fr; (void)fq;
        unsigned char* ws = wsp(); f32x4* YB = (f32x4*)(ws + WS_YB) + (size_t)aux * 2 * 16 * 512; bf16_t* BY = (bf16_t*)(ws + WS_H2); const float* cw = inp(kargs(), 20); LAS float* X = xch();
        const int q = u.pn / 3, s = u.pn % 3, chl = wc * 32 + 8 * fq;
        if (s < 2) {
            mask_rows(acc, u, wr, fr);
#pragma unroll
            for (int ai = 0; ai < 2; ++ai)
#pragma unroll
                for (int m = 0; m < 4; ++m)
#pragma unroll
                    for (int n = 0; n < 2; ++n) acc[ai][0][m][n] = acc[ai][0][m][n] * acc[ai][1][m][n];
            xch_write(X, acc, wr, wc, fr, fq);
            LDS_WAIT(); __builtin_amdgcn_s_barrier(); asm volatile("" ::: "memory");
#pragma unroll
            for (int n = 0; n < 2; ++n) {
                const int ch = q * 256 + s * 128 + chl + 4 * n;
                f32x4 w[3];
#pragma unroll
                for (int k = 0; k < 3; ++k) w[k] = *(const f32x4*)(cw + k * D + ch);
#pragma unroll
                for (int ai = 0; ai < 2; ++ai) { const int b = 2 * ai + wr;
                    f32x4 pp = xch_top(X, b, chl + 4 * n);
#pragma unroll
                    for (int m = 0; m < 4; ++m) { const f32x4 v = acc[ai][0][m][n];
                        const f32x4 nn = m < 3 ? dpp4<DPP_ROR15>(acc[ai][0][m < 3 ? m + 1 : 3][n]) : xch_bot(X, b, chl + 4 * n);
                        const f32x4 o = conv_m(v, pp, nn, w[0], w[1], w[2], fr); pp = dpp4<DPP_ROR1>(v);
                        unsigned yo = (unsigned)((s * 16 + (ai * 4 + m) * 2 + n) * 512) + (unsigned)(wid * 64 + lane); asm volatile("" : "+v"(yo)); YB[yo] = o; } }
            }
        } else {
#pragma unroll
            for (int ai = 0; ai < 2; ++ai) {
                f32x4 y[4][2][2];
#pragma unroll
                for (int m = 0; m < 4; ++m)
#pragma unroll
                    for (int bj = 0; bj < 2; ++bj) { unsigned yo = (unsigned)((bj * 16 + (ai * 4 + m) * 2) * 512) + (unsigned)(wid * 64 + lane); asm volatile("" : "+v"(yo)); y[m][bj][0] = YB[yo]; y[m][bj][1] = YB[yo + 512]; }
#pragma unroll
                for (int m = 0; m < 4; ++m) { const int r = ai * 128 + wr * 64 + m * 16 + fr; const bool ok = row_valid(u, r);
#pragma unroll
                    for (int bj = 0; bj < 2; ++bj) { const f32x4 v0 = acc[ai][bj][m][0] * y[m][bj][0], v1 = acc[ai][bj][m][1] * y[m][bj][1];
                        u32x4 w; w.x = cvt_pk_bf16(v0[0], v0[1]); w.y = cvt_pk_bf16(v0[2], v0[3]); w.z = cvt_pk_bf16(v1[0], v1[1]); w.w = cvt_pk_bf16(v1[2], v1[3]);
                        if (ok) *(u32x4*)(BY + (size_t)(u.row0 + r) * D + q * 256 + bj * 128 + chl) = w; } }
                asm volatile("" ::: "memory"); }
        }
    }
};
struct OrderSc {
    int c; const char* A; const char* B;
    __device__ __forceinline__ bool next(int i, Unit& u) const {
        if (c >= 200 || i >= 3) return false;
        u.pm = c >> 2; u.pn = 3 * (c & 3) + i; u.row0 = conv_row0(u.pm); u.a = A + (long)u.row0 * (D * 2); u.b = B + (size_t)u.pn * 256 * D * 2; return true; }
};
struct EpiFn1 : EpiBase {
    static constexpr bool PERM = true;
    __device__ __forceinline__ void operator()(const f32x4 (&acc)[2][2][4][2], const Unit& u, int wid, int ) const {
        int lane_ = pg8::lane_id(); asm volatile("" : "+v"(lane_));
        const int lane = lane_, wr = wid >> 2, wc = wid & 3, fr = lane & 15, fq = lane >> 4; (void)wr; (void)wc; (void)fr; (void)fq;
        bf16_t* YT = (bf16_t*)(wsp() + WS_YT);
        const int part = u.pm & 1, ch0 = (u.pm >> 1) * 256, tok0 = u.pn * 256;
        bf16_t* base; int T, t0;
        if (tok0 < MP) { T = TP; base = YT + (size_t)(tok0 / TP) * D * 2 * TP; t0 = 0; }
        else { T = TS; base = YT + (size_t)32 * D * 2 * TP + (size_t)((tok0 - MP) / TS) * D * 2 * TS; t0 = (tok0 - MP) % TS; }
        const int c0 = wc * 32 + 8 * fq;
#pragma unroll
        for (int ai = 0; ai < 2; ++ai)
#pragma unroll
            for (int m = 0; m < 4; ++m) { bf16_t* rowp = base + (size_t)(ch0 + ai * 128 + wr * 64 + m * 16 + fr) * 2 * T + part * T + t0 + c0;
#pragma unroll
                for (int bj = 0; bj < 2; ++bj) { const f32x4 v0 = acc[ai][bj][m][0], v1 = acc[ai][bj][m][1];
                    u32x4 w; w.x = cvt_pk_bf16(v0[0], v0[1]); w.y = cvt_pk_bf16(v0[2], v0[3]); w.z = cvt_pk_bf16(v1[0], v1[1]); w.w = cvt_pk_bf16(v1[2], v1[3]);
                    *(u32x4*)(rowp + bj * 128) = w; } }
    }
};
struct OrderFn1 {
    int G, c; const char* A1; const char* H;
    __device__ __forceinline__ bool next(int i, Unit& u) const {
        const int L = i * G + c; if (L >= 384) return false;
        u.pm = L & 7; u.pn = L >> 3; u.row0 = 0; u.a = A1 + (size_t)(u.pm & 1) * 256 * 256 * 2; u.b = H + (size_t)u.pn * 256 * D * 2 + (size_t)(u.pm >> 1) * 512; return true; }
};
struct OrderFn2 {
    int c; int samp; const char* A2; const char* YT;
    __device__ __forceinline__ bool next(int i, Unit& u) const {
        if (i > 0) return false;
        if (samp) { if (c >= 128) return false; const int b = c >> 6, tm = (c >> 2) & 15; u.pm = tm; u.pn = c & 3; u.row0 = MP + b * TS + 128 * tm;
            u.a = A2 + (size_t)tm * 128 * 2 * TS * 2; u.b = YT + (size_t)32 * D * 2 * TP * 2 + (size_t)b * D * 2 * TS * 2 + (size_t)u.pn * 256 * 2 * TS * 2; return true; }
        if (c < 128) return false; const int j = c - 128, s = j >> 2; u.pm = 0; u.pn = j & 3; u.row0 = s * TP;
        u.a = A2; u.b = YT + (size_t)s * D * 2 * TP * 2 + (size_t)u.pn * 256 * 2 * TP * 2; return true; }
};

__device__ __forceinline__ void p0_transpose_item(const float* W, int K, int N, bf16_t* WT, int drow0, LAS float* scr, int kb, int n0, int lane) {
    const int k0 = 64 * kb;
    f32x4 v[8];
#pragma unroll
    for (int i = 0; i < 8; ++i) v[i] = __builtin_nontemporal_load((const f32x4*)(W + (size_t)(k0 + 8 * i + (lane >> 3)) * N + n0 + 4 * (lane & 7)));
#pragma unroll
    for (int i = 0; i < 8; ++i) { LAS float* d = scr + (8 * i + (lane >> 3)) * 33 + 4 * (lane & 7); d[0] = v[i][0]; d[1] = v[i][1]; d[2] = v[i][2]; d[3] = v[i][3]; }
    LDS_WAIT(); asm volatile("" ::: "memory");
    const int c = lane & 7;
#pragma unroll
    for (int j = 0; j < 4; ++j) { const int n = (lane >> 3) + 8 * j; const LAS float* s = scr + (8 * c) * 33 + n;
        u32x4 o; o.x = pk2(s[0 * 33], s[1 * 33]); o.y = pk2(s[2 * 33], s[3 * 33]); o.z = pk2(s[4 * 33], s[5 * 33]); o.w = pk2(s[6 * 33], s[7 * 33]);
        *(u32x4*)(WT + (size_t)(drow0 + n) * K + k0 + 8 * c) = o; }
    LDS_WAIT(); asm volatile("" ::: "memory");
}
__device__ __forceinline__ int map_plain(int n) { return n; }
__device__ __forceinline__ int map_up(int n) { return n < DFF ? 256 * (n >> 7) + (n & 127) : 256 * ((n - DFF) >> 7) + 128 + ((n - DFF) & 127); }
__device__ __forceinline__ int map_sc(int n) {
    if (n < D) return (3 * (n >> 8) + 2) * 256 + (n & 255);
    const int x = n >= 2 * D, ch = n - D - x * D; return (3 * (ch >> 8) + ((ch >> 7) & 1)) * 256 + x * 128 + (ch & 127);
}
__device__ __forceinline__ void p0_tjob(int& it, int NGW, LAS float* scr, int lane, const float* W, bf16_t* WT, int K, int N, int map) {
    const int nblk = N / 32, nitems = (K / 64) * nblk;
    for (; it < nitems; it += NGW) { const int kb = it / nblk, n0 = (it % nblk) * 32; const int dr = map == 0 ? n0 : (map == 1 ? map_up(n0) : map_sc(n0));
        p0_transpose_item(W, K, N, WT, dr, scr, kb, n0, lane); }
    it -= nitems;
}
__device__ __forceinline__ void convert_layer(Frame& F, int l, int b0, int nb) {
    unsigned char* ws = F.ws;
    LAS float* scr = (LAS float*)(F.lds + F.wave * 16384);
    const int gw = (F.blk - b0) * NWAVES + F.wave, NGW = nb * NWAVES;
    int it = gw;
    if (l == 0) { p0_tjob(it, NGW, scr, F.lane, ((const float*)F.in[11]), (bf16_t*)(ws + WS_WQKV), D, 1536, 0);
        p0_tjob(it, NGW, scr, F.lane, ((const float*)F.in[12]), (bf16_t*)(ws + WS_WO), D, D, 0); }
    else if (l == 1) { p0_tjob(it, NGW, scr, F.lane, ((const float*)F.in[14]), (bf16_t*)(ws + WS_WSGI), D, 2048, 0);
        p0_tjob(it, NGW, scr, F.lane, ((const float*)F.in[18]), (bf16_t*)(ws + WS_WSGO), D, D, 0); }
    else if (l == 2) { p0_tjob(it, NGW, scr, F.lane, ((const float*)F.in[19]), (bf16_t*)(ws + WS_WSCI), D, 3072, 2);
        p0_tjob(it, NGW, scr, F.lane, ((const float*)F.in[21]), (bf16_t*)(ws + WS_WSCO), D, D, 0); }
    else p0_tjob(it, NGW, scr, F.lane, ((const float*)F.in[22]), (bf16_t*)(ws + WS_WFNO), D, D, 0);
    p0_tjob(it, NGW, scr, F.lane, ((const float*)F.in[23]) + (size_t)l * D * 2 * DFF, (bf16_t*)(ws + WS_WUP + l * WUP_BYTES), D, 2 * DFF, 1);
    p0_tjob(it, NGW, scr, F.lane, ((const float*)F.in[25]) + (size_t)l * DFF * D, (bf16_t*)(ws + WS_WDN + l * WDN_BYTES), DFF, D, 0);
    const size_t gt = (size_t)(F.blk - b0) * 512 + F.tid, NGT = (size_t)nb * 512;
    if (l == 1) { bf16_t* WSb = (bf16_t*)(ws + WS_WS); for (size_t i = gt; i < 8 * 128 * 128; i += NGT) WSb[i] = (bf16_t)f2bf(((const float*)F.in[16])[i]); }
    if (l == 3) {
        bf16_t* A1 = (bf16_t*)(ws + WS_A1);
        for (size_t i = gt; i < 2 * 256 * 256; i += NGT) { const int part = i >> 16, r = (i >> 8) & 255, k = i & 255; float v = 0.f;
            if ((r >> 7) == (k >> 7)) { const float a = 2.f * (float)(((r & 127) * (k & 127)) & 127) / 128.f; v = (part ? sinpif(a) : cospif(a)) * 0.08838834764831845f; }
            A1[i] = (bf16_t)f2bf(v); }
        bf16_t* A2P = (bf16_t*)(ws + WS_A2P);
        for (size_t i = gt; i < 256 * 512; i += NGT) { const int tp = i >> 9, k = i & 511, t = k & 255; const float a = 2.f * (float)((tp * t) & 255) / 256.f;
            A2P[i] = (bf16_t)f2bf((k < 256 ? cospif(a) : -sinpif(a)) * 0.0625f); }
        __syncthreads();
        LAS bf16_t* tab = (LAS bf16_t*)F.lds;
        for (int j = F.tid; j < 2048; j += 512) { const float a = 2.f * (float)j / 2048.f; tab[j] = (bf16_t)f2bf(cospif(a) * 0.022097086912079608f); tab[2048 + j] = (bf16_t)f2bf(-sinpif(a) * 0.022097086912079608f); }
        __syncthreads();
        bf16_t* A2S = (bf16_t*)(ws + WS_A2S);
        for (size_t i8 = gt; i8 < (size_t)2048 * 4096 / 8; i8 += NGT) { const int tp = (int)(i8 >> 9), k0 = (int)(i8 & 511) * 8, part = k0 >> 11, t0 = k0 & 2047;
            unsigned w[4];
#pragma unroll
            for (int e = 0; e < 4; ++e) { const unsigned lo = tab[part * 2048 + ((tp * (t0 + 2 * e)) & 2047)], hi = tab[part * 2048 + ((tp * (t0 + 2 * e + 1)) & 2047)]; w[e] = lo | (hi << 16); }
            *(u32x4*)(A2S + i8 * 8) = (u32x4){w[0], w[1], w[2], w[3]}; }
        __syncthreads();
    }
}
__device__ __forceinline__ void prefetch_region(Frame& F, const void* p, size_t bytes, int b0, int nb) {
    const size_t gt = (size_t)(F.blk - b0) * 512 + F.tid, NGT = (size_t)nb * 512; unsigned acc = 0;
    for (size_t i = gt * 128; i < bytes; i += NGT * 128) { const u32x4 v = *(const u32x4*)((const char*)p + i); acc += v.x ^ v.w; }
    if (acc == 0x9e3779b9u) *(volatile unsigned*)(F.ws + WS_CTL + CTL_TMO + 64) = acc;
}
__device__ __forceinline__ void mod_items(Frame& F, int lo, int hi, int b0, int nb) {
    unsigned char* ws = F.ws;
    LAS float* sv = (LAS float*)F.lds;
    LAS float* red = sv + 3 * D;
    __syncthreads();
    for (int i = F.tid; i < D; i += 512) { const float a = ((const float*)F.in[5])[i], b = ((const float*)F.in[4])[i], d = ((const float*)F.in[4])[D + i];
        sv[i] = a / (1.f + expf(-a)); sv[D + i] = b / (1.f + expf(-b)); sv[2 * D + i] = d / (1.f + expf(-d)); }
    __syncthreads();
    float* MODp = (float*)(ws + WS_MOD);
    const int kg = F.tid >> 3, cq = F.tid & 7;
    for (int it = lo + F.blk - b0; it < hi; it += nb) {
        const int l = it / 192, n0 = (it % 192) * 32;
        const float* w = ((const float*)F.in[6]) + (size_t)l * D * 6 * D + n0 + 4 * cq;
        f32x4 wv[16];
#pragma unroll
        for (int i = 0; i < 16; ++i) wv[i] = __builtin_nontemporal_load((const f32x4*)(w + (size_t)(kg + 64 * i) * 6 * D));
        f32x4 a[3] = {{0, 0, 0, 0}, {0, 0, 0, 0}, {0, 0, 0, 0}};
#pragma unroll
        for (int i = 0; i < 16; ++i) { const int k = kg + 64 * i; a[0] += sv[k] * wv[i]; a[1] += sv[D + k] * wv[i]; a[2] += sv[2 * D + k] * wv[i]; }
#pragma unroll
        for (int v = 0; v < 3; ++v)
#pragma unroll
            for (int j = 0; j < 4; ++j) { float x = a[v][j]; x += dppx<0x128>(x); a[v][j] = rows_sum(x); }
        if (F.lane < 8) {
#pragma unroll
            for (int v = 0; v < 3; ++v) *(LAS f32x4*)(red + (F.wave * 3 + v) * 32 + 4 * cq) = a[v]; }
        __syncthreads();
        if (F.tid < 96) { const int v = F.tid >> 5, cc = F.tid & 31; float s = 0.f;
#pragma unroll
            for (int g = 0; g < 8; ++g) s += red[(g * 3 + v) * 32 + cc];
            MODp[(l * 3 + v) * 6 * D + n0 + cc] = s + ((const float*)F.in[7])[l * 6 * D + n0 + cc]; }
        __syncthreads();
    }
}
__device__ __forceinline__ void p0_prologue(Frame& F) {
    unsigned char* ws = F.ws;
    mod_items(F, 0, 192, 0, F.G);
    {
        const size_t gt = (size_t)F.blk * 512 + F.tid, NGT = (size_t)F.G * 512;
        bf16_t* CK = (bf16_t*)(ws + WS_CK); bf16_t* CVT = (bf16_t*)(ws + WS_CVT);
        for (size_t i = gt; i < 2 * 512 * 256; i += NGT) { CK[i] = (bf16_t)f2bf(((const float*)F.in[2])[i]);
            const int d = i & 63, kvh = (i >> 6) & 3, j = (i >> 8) & 511, b = i >> 17; CVT[((size_t)(b * 4 + kvh) * 64 + d) * 512 + j] = (bf16_t)f2bf(((const float*)F.in[3])[i]); }
        float* rope = (float*)(ws + WS_ROPE);
        for (size_t i = gt; i < 1024; i += NGT) { const int pos = i >> 4, fi = i & 15; const float ang = (float)pos * powf(10000.f, -(float)fi / 16.f); rope[i] = cosf(ang); rope[1024 + i] = sinf(ang); }
    }
}

__device__ __forceinline__ void norm_phase(Frame& F, const float* src0, const float* src1, const float* g, const float* modl, int sh_idx, bf16_t* H) {
    const int gw = F.blk * NWAVES + F.wave, NGW = F.G * NWAVES;
    f32x4 gv[4];
#pragma unroll
    for (int j = 0; j < 4; ++j) gv[j] = *(const f32x4*)(g + 256 * j + 4 * F.lane);
    for (int row = gw; row < M; row += NGW) {
        const float* xr = row < MP ? src0 + (size_t)row * D : src1 + (size_t)(row - MP) * D;
        const float* mv = modl + (row < MP ? 0 : 1 + (row - MP) / TS) * 6 * D;
        f32x4 v[4]; float s = 0.f;
#pragma unroll
        for (int j = 0; j < 4; ++j) { v[j] = *(const f32x4*)(xr + 256 * j + 4 * F.lane); s += (v[j][0] * v[j][0] + v[j][1] * v[j][1]) + (v[j][2] * v[j][2] + v[j][3] * v[j][3]); }
        const float r = rsqrtf(wave_sum(s) * (1.f / D) + EPS);
#pragma unroll
        for (int j = 0; j < 4; ++j) { const f32x4 sh = *(const f32x4*)(mv + sh_idx * D + 256 * j + 4 * F.lane), sc = *(const f32x4*)(mv + (sh_idx + 1) * D + 256 * j + 4 * F.lane);
            const f32x4 o = v[j] * r * gv[j] * (1.f + sc) + sh;
            u32x2 w; w.x = pk2(o[0], o[1]); w.y = pk2(o[2], o[3]); *(u32x2*)(H + (size_t)row * D + 256 * j + 4 * F.lane) = w; }
    }
}
__device__ __forceinline__ void final_phase(Frame& F, const float* X, const float* g, float* out) {
    const int gw = F.blk * NWAVES + F.wave, NGW = F.G * NWAVES;
    f32x4 gv[4];
#pragma unroll
    for (int j = 0; j < 4; ++j) gv[j] = *(const f32x4*)(g + 256 * j + 4 * F.lane);
    for (int row = gw; row < M; row += NGW) {
        const float* xr = X + (size_t)row * D; f32x4 v[4]; float s = 0.f;
#pragma unroll
        for (int j = 0; j < 4; ++j) { v[j] = *(const f32x4*)(xr + 256 * j + 4 * F.lane); s += (v[j][0] * v[j][0] + v[j][1] * v[j][1]) + (v[j][2] * v[j][2] + v[j][3] * v[j][3]); }
        const float r = rsqrtf(wave_sum(s) * (1.f / D) + EPS);
#pragma unroll
        for (int j = 0; j < 4; ++j) *(f32x4*)(out + (size_t)row * D + 256 * j + 4 * F.lane) = v[j] * r * gv[j];
    }
}

constexpr int ATT_LDK = 144;
constexpr int ATT_TILE_BYTES = 2 * 64 * ATT_LDK;
struct AttTile { const bf16_t* K; const bf16_t* V; int ldk, ldv, k0, mask; };
__device__ __forceinline__ void att_tile_of(int t, bool lat, int nband, int kband0, int qc0, const bf16_t* KBs, const bf16_t* VTs, int T, const bf16_t* CKs, const bf16_t* CVTs, AttTile& o) {
    if (t < nband) { const int k0 = kband0 + 64 * t; o.K = KBs + (size_t)k0 * 256; o.V = VTs + k0; o.ldk = 256; o.ldv = T; o.k0 = k0; const int dk = k0 - qc0; o.mask = lat && (dk < -64 || dk > 64); }
    else { const int k0 = 64 * (t - nband); o.K = CKs + (size_t)k0 * 256; o.V = CVTs + k0; o.ldk = 256; o.ldv = 512; o.k0 = k0; o.mask = 0; }
}
__device__ __forceinline__ void attn_phase(Frame& F, const bf16_t* Q, const bf16_t* KB, const bf16_t* VT, const bf16_t* CK, const bf16_t* CVT, const float* sink, bf16_t* O) {
    const int fr = F.lane & 15, g4 = F.lane >> 4, tid = F.tid;
    const int lrow = tid >> 3, lchunk = tid & 7;
    LAS unsigned char* lds = F.lds;
    for (int it = F.blk; it < 768; it += F.G) {
        const bool lat = it < 256; int kvh, chunk, T, rowbase, b = 0; const bf16_t* vt;
        if (lat) { b = it >> 7; kvh = (it >> 5) & 3; chunk = it & 31; T = TS; rowbase = MP + b * TS; vt = VT + (size_t)32 * 65536 + (size_t)b * 256 * TS; }
        else { const int j = it - 256, s = j >> 4; kvh = (j >> 2) & 3; chunk = j & 3; T = TP; rowbase = s * TP; vt = VT + (size_t)s * 65536; }
        const int h = kvh * 4 + (F.wave & 3), q0 = chunk * 64 + (F.wave >> 2) * 32;
        int kband0 = 0, nband = T / 64;
        if (lat) { int lo = 64 * chunk - 128, hi = 64 * chunk + 192; lo = lo < 0 ? 0 : lo; hi = hi > T ? T : hi; kband0 = lo; nband = (hi - lo) / 64; }
        const int ntile = nband + (lat ? 8 : 0);
        const bf16_t* KBs = KB + (size_t)rowbase * 256 + kvh * 64; const bf16_t* VTs = vt + (size_t)(kvh * 64) * T;
        const bf16_t* CKs = CK + (size_t)b * 512 * 256 + kvh * 64; const bf16_t* CVTs = CVT + (size_t)((b * 4 + kvh) * 64) * 512;
        bf16x8 Qf[2][2];
#pragma unroll
        for (int qg = 0; qg < 2; ++qg)
#pragma unroll
            for (int ds = 0; ds < 2; ++ds) Qf[qg][ds] = *(const bf16x8*)(Q + (size_t)(rowbase + q0 + 16 * qg + fr) * D + h * 64 + 32 * ds + 8 * g4);
        float mrun[2], lrun[2]; f32x4 Oa[2][4];
#pragma unroll
        for (int qg = 0; qg < 2; ++qg) { mrun[qg] = sink[h] * 1.4426950408889634f; lrun[qg] = 1.f;
#pragma unroll
            for (int db = 0; db < 4; ++db) Oa[qg][db] = (f32x4){0.f, 0.f, 0.f, 0.f}; }
        AttTile tl; att_tile_of(0, lat, nband, kband0, 64 * chunk, KBs, VTs, T, CKs, CVTs, tl);
        u32x4 rk = *(const u32x4*)(tl.K + (size_t)lrow * tl.ldk + lchunk * 8), rv = *(const u32x4*)(tl.V + (size_t)lrow * tl.ldv + lchunk * 8);
        __syncthreads();
        *(LAS u32x4*)(lds + lrow * ATT_LDK + lchunk * 16) = rk; *(LAS u32x4*)(lds + 64 * ATT_LDK + lrow * ATT_LDK + lchunk * 16) = rv;
        __syncthreads();
#pragma unroll 1
        for (int t = 0; t < ntile; ++t) {
            const int cur_k0 = tl.k0, cur_mask = tl.mask;
            if (t + 1 < ntile) { att_tile_of(t + 1, lat, nband, kband0, 64 * chunk, KBs, VTs, T, CKs, CVTs, tl);
                rk = *(const u32x4*)(tl.K + (size_t)lrow * tl.ldk + lchunk * 8); rv = *(const u32x4*)(tl.V + (size_t)lrow * tl.ldv + lchunk * 8); }
            const LAS unsigned char* kb_ = lds + (t & 1) * ATT_TILE_BYTES; const LAS unsigned char* vb_ = kb_ + 64 * ATT_LDK;
            {
                bf16x8 Kf[2][2][2], Vf[2][4];
#pragma unroll
                for (int sub = 0; sub < 2; ++sub) {
#pragma unroll
                    for (int kb = 0; kb < 2; ++kb)
#pragma unroll
                        for (int ds = 0; ds < 2; ++ds) Kf[sub][kb][ds] = *(const LAS bf16x8*)(kb_ + (32 * sub + 16 * kb + fr) * ATT_LDK + 64 * ds + 16 * g4);
#pragma unroll
                    for (int db = 0; db < 4; ++db) { const LAS unsigned char* vp = vb_ + (16 * db + fr) * ATT_LDK + 64 * sub + 8 * g4; const u32x2 lo = *(const LAS u32x2*)vp, hi = *(const LAS u32x2*)(vp + 32);
                        Vf[sub][db] = __builtin_bit_cast(bf16x8, (u32x4){lo.x, lo.y, hi.x, hi.y}); }
                }
                const float c = 0.125f * 1.4426950408889634f;
                f32x4 S[2][2][2];
#pragma unroll
                for (int qg = 0; qg < 2; ++qg)
#pragma unroll
                    for (int sub = 0; sub < 2; ++sub)
#pragma unroll
                        for (int kb = 0; kb < 2; ++kb) { S[qg][sub][kb] = __builtin_amdgcn_mfma_f32_16x16x32_bf16(Kf[sub][kb][0], Qf[qg][0], (f32x4){0.f, 0.f, 0.f, 0.f}, 0, 0, 0);
                            S[qg][sub][kb] = __builtin_amdgcn_mfma_f32_16x16x32_bf16(Kf[sub][kb][1], Qf[qg][1], S[qg][sub][kb], 0, 0, 0); }
                float mnew[2], rs[2];
#pragma unroll
                for (int qg = 0; qg < 2; ++qg) {
                    const int qpos = q0 + 16 * qg + fr;
                    if (cur_mask) {
#pragma unroll
                        for (int sub = 0; sub < 2; ++sub)
#pragma unroll
                            for (int kb = 0; kb < 2; ++kb)
#pragma unroll
                                for (int r = 0; r < 4; ++r) { const int d = cur_k0 + 32 * sub + 16 * kb + 4 * g4 + r - qpos; if (d > 128 || d < -128) S[qg][sub][kb][r] = -1e30f; }
                    }
                    float mx = -1e30f;
#pragma unroll
                    for (int sub = 0; sub < 2; ++sub)
#pragma unroll
                        for (int kb = 0; kb < 2; ++kb) mx = fmaxf(fmaxf(mx, fmaxf(S[qg][sub][kb][0], S[qg][sub][kb][1])), fmaxf(S[qg][sub][kb][2], S[qg][sub][kb][3]));
                    mx = rows_max(mx) * c;
                    mnew[qg] = fmaxf(mrun[qg], mx);
                    float r_ = 0.f;
#pragma unroll
                    for (int sub = 0; sub < 2; ++sub)
#pragma unroll
                        for (int kb = 0; kb < 2; ++kb)
#pragma unroll
                            for (int r = 0; r < 4; ++r) { const float p = fast_exp2(__builtin_fmaf(S[qg][sub][kb][r], c, -mnew[qg])); S[qg][sub][kb][r] = p; r_ += p; }
                    rs[qg] = rows_sum(r_);
                }
                if (__builtin_amdgcn_ballot_w64(mnew[0] > mrun[0] || mnew[1] > mrun[1]) != 0ull) {
#pragma unroll
                    for (int qg = 0; qg < 2; ++qg) { const float alpha = fast_exp2(mrun[qg] - mnew[qg]); lrun[qg] *= alpha;
#pragma unroll
                        for (int db = 0; db < 4; ++db) Oa[qg][db] = Oa[qg][db] * alpha; }
                }
#pragma unroll
                for (int qg = 0; qg < 2; ++qg) { lrun[qg] += rs[qg]; mrun[qg] = mnew[qg];
#pragma unroll
                    for (int sub = 0; sub < 2; ++sub) {
                        u32x4 pw; pw.x = cvt_pk_bf16(S[qg][sub][0][0], S[qg][sub][0][1]); pw.y = cvt_pk_bf16(S[qg][sub][0][2], S[qg][sub][0][3]); pw.z = cvt_pk_bf16(S[qg][sub][1][0], S[qg][sub][1][1]); pw.w = cvt_pk_bf16(S[qg][sub][1][2], S[qg][sub][1][3]);
                        const bf16x8 Pf = __builtin_bit_cast(bf16x8, pw);
#pragma unroll
                        for (int db = 0; db < 4; ++db) Oa[qg][db] = __builtin_amdgcn_mfma_f32_16x16x32_bf16(Vf[sub][db], Pf, Oa[qg][db], 0, 0, 0); } }
            }
            if (t + 1 < ntile) { LAS unsigned char* nb = lds + ((t + 1) & 1) * ATT_TILE_BYTES;
                *(LAS u32x4*)(nb + lrow * ATT_LDK + lchunk * 16) = rk; *(LAS u32x4*)(nb + 64 * ATT_LDK + lrow * ATT_LDK + lchunk * 16) = rv; }
            __syncthreads();
        }
#pragma unroll
        for (int qg = 0; qg < 2; ++qg) { const float inv = 1.f / lrun[qg];
#pragma unroll
            for (int db = 0; db < 4; ++db) { const f32x4 o = Oa[qg][db] * inv; u32x2 w; w.x = cvt_pk_bf16(o[0], o[1]); w.y = cvt_pk_bf16(o[2], o[3]);
                *(u32x2*)(O + (size_t)(rowbase + q0 + 16 * qg + fr) * D + h * 64 + 16 * db + 4 * g4) = w; } }
    }
}

__device__ __forceinline__ void sgu_phase(Frame& F, const bf16_t* U, const bf16_t* V, const f32x2* STATS, const float* ln_g, const bf16_t* WSb, const float* b_s, bf16_t* UM) {
    constexpr int LDT = 136;
    LAS bf16_t* LT = (LAS bf16_t*)F.lds;
    LAS f32x2* ST = (LAS f32x2*)(F.lds + 128 * LDT * 2);
    const int fr = F.lane & 15, g4 = F.lane >> 4;
    for (int it = F.blk; it < 768; it += F.G) {
        const int ch = it >> 3, g = it & 7, r0 = ch * 128;
        if (F.tid < 128) { const f32x2* sp = STATS + (size_t)(r0 + F.tid) * 16; float s1 = 0.f, s2 = 0.f;
#pragma unroll
            for (int k = 0; k < 16; ++k) { const f32x2 p = sp[k]; s1 += p.x; s2 += p.y; }
            const float mu = s1 * (1.f / D), var = s2 * (1.f / D) - mu * mu; ST[F.tid] = (f32x2){mu, rsqrtf(fmaxf(var, 0.f) + EPS)}; }
        __syncthreads();
#pragma unroll
        for (int i = 0; i < 4; ++i) { const int q = F.tid + 512 * i, r = q & 127, c8 = (q >> 7) * 8;
            const u32x4 raw = *(const u32x4*)(V + (size_t)(r0 + r) * D + g * 128 + c8); const f32x2 st = ST[r];
            const f32x4 ga = *(const f32x4*)(ln_g + g * 128 + c8), gb = *(const f32x4*)(ln_g + g * 128 + c8 + 4);
            const unsigned rw[4] = {raw.x, raw.y, raw.z, raw.w};
#pragma unroll
            for (int e = 0; e < 8; ++e) { const float x = bf2f((unsigned short)(e & 1 ? rw[e >> 1] >> 16 : rw[e >> 1] & 0xffff)); const float gg = e < 4 ? ga[e & 3] : gb[e & 3];
                LT[(c8 + e) * LDT + r] = (bf16_t)f2bf((x - st.x) * st.y * gg); } }
        __syncthreads();
        f32x4 acc[8];
#pragma unroll
        for (int cb = 0; cb < 8; ++cb) acc[cb] = (f32x4){0.f, 0.f, 0.f, 0.f};
        const int p = 16 * F.wave + fr;
#pragma unroll
        for (int ks = 0; ks < 4; ++ks) { const bf16x8 bw = *(const bf16x8*)(WSb + (size_t)(g * 128 + p) * 128 + 32 * ks + 8 * g4);
#pragma unroll
            for (int cb = 0; cb < 8; ++cb) { const bf16x8 av = *(const LAS bf16x8*)(LT + (16 * cb + fr) * LDT + 32 * ks + 8 * g4); acc[cb] = __builtin_amdgcn_mfma_f32_16x16x32_bf16(av, bw, acc[cb], 0, 0, 0); } }
        const float bsv = b_s[g * 128 + p];
#pragma unroll
        for (int cb = 0; cb < 8; ++cb) { const size_t off = (size_t)(r0 + p) * D + g * 128 + 16 * cb + 4 * g4; const u32x2 uw = *(const u32x2*)(U + off);
            const float u0 = bf2f((unsigned short)(uw.x & 0xffff)), u1 = bf2f((unsigned short)(uw.x >> 16)), u2 = bf2f((unsigned short)(uw.y & 0xffff)), u3 = bf2f((unsigned short)(uw.y >> 16));
            u32x2 w; w.x = cvt_pk_bf16(u0 * (acc[cb][0] + bsv), u1 * (acc[cb][1] + bsv)); w.y = cvt_pk_bf16(u2 * (acc[cb][2] + bsv), u3 * (acc[cb][3] + bsv)); *(u32x2*)(UM + off) = w; }
        __syncthreads();
    }
}

struct Args { const float* in[26]; float* out; unsigned char* ws; int ph_lo, ph_hi; };
__global__ void __launch_bounds__(NWAVES * 64, 2) mk_fwd(const Args args) {
    extern __shared__ __attribute__((aligned(16))) unsigned char lds_raw[];
    Frame F;
    F.lds = (LAS unsigned char*)lds_raw;
    const int wave0 = __builtin_amdgcn_readfirstlane((int)threadIdx.x >> 6);
    F.wave = wave0; F.lane = pg8::lane_id(); F.tid = wave0 * 64 + F.lane;
    const int grid0 = gridDim.x, blk0 = blockIdx.x; F.G = grid0; F.blk = blk0;
    F.in = (const __attribute__((address_space(4))) cfp_t*)__builtin_amdgcn_kernarg_segment_ptr();
    F.out = args.out; F.ws = args.ws;
    unsigned char* ws = args.ws;
    volatile LAS unsigned* MISC = (volatile LAS unsigned*)(F.lds + MISC_OFF);
    if (F.tid < 32) MISC[F.tid] = 0u;
    __syncthreads();
    const int lo = args.ph_lo, hi = args.ph_hi;
    XcdBarrier bar; bar.bar = (unsigned*)(ws + WS_CTL); bar.x = 0; bar.st = nullptr;
    if (hi - lo > 1) bar = xcd_barrier_post((unsigned*)(ws + WS_CTL), MISC + 8, F.tid == 0);
    LAS float* XCH = (LAS float*)(F.lds + XCH_OFF);
#define CASE_BEGIN() { int b_ = blk0, w_ = wave0, g_ = grid0; asm volatile("" : "+s"(b_), "+s"(w_), "+s"(g_)); F.blk = b_; F.wave = w_; F.G = g_; } frame_refresh(F); unsigned long long ws_ = (unsigned long long)args.ws, in_ = (unsigned long long)__builtin_amdgcn_kernarg_segment_ptr(); asm volatile("" : "+s"(ws_), "+s"(in_)); \
        unsigned char* ws = (unsigned char*)(GAS unsigned char*)ws_; F.ws = ws; F.in = (const __attribute__((address_space(4))) cfp_t*)in_; \
        float* X = (float*)(ws + WS_X); bf16_t* H = (bf16_t*)(ws + WS_H); bf16_t* H2 = (bf16_t*)(ws + WS_H2); bf16_t* HN = (bf16_t*)(ws + WS_HN); (void)HN; \
        const float* modl = (const float*)(ws + WS_MOD) + l * 3 * 6 * D; const float* xs0 = l == 0 ? ((const float*)F.in[0]) : X; const float* xs1 = l == 0 ? ((const float*)F.in[1]) : X + (size_t)MP * D; \
        (void)X; (void)H; (void)H2; (void)modl; (void)xs0; (void)xs1
#pragma unroll 1
    for (int ph = lo; ph < hi; ++ph) {
        int l = 0, kind;
        if (ph == 0) kind = 0; else if (ph == 1) kind = 1;
        else { l = ph < 7 ? 0 : ph < 12 ? 1 : ph < 16 ? 2 : 3; const int j = ph - (l == 0 ? 2 : l == 1 ? 7 : l == 2 ? 12 : 16), n = l == 2 ? 1 : 2;
            kind = j < n ? (l == 0 ? 2 + j : l == 1 ? 4 + j : l == 2 ? 6 : 7 + j) : j == n ? 9 : j == n + 1 ? 10 : 11; }
        const int reps = (kind == MK_REP_KIND) ? 1 + MK_REP_N : 1;
        const bool tp_here = MK_TP && ph == MK_TP_PH && blk0 == 0;
        unsigned long long tp_r0 = 0, tp_c0 = 0; if (tp_here) { tp_r0 = __builtin_amdgcn_s_memrealtime(); tp_c0 = __builtin_amdgcn_s_memtime(); }
#pragma unroll 1
        for (int rep = 0; rep < reps; ++rep) {
        if (rep > 0) xcd_barrier(bar, wave0 == 0 && pg8::lane_id() == 0);
        switch (kind) {
        case 0: if (EN(0)) { CASE_BEGIN(); p0_prologue(F); } break;
        case 1: if (EN(1)) { CASE_BEGIN(); norm_phase(F, xs0, xs1, ((const float*)F.in[8]), modl, 0, HN);
                if (rep == 0) convert_layer(F, 0, 0, F.G); } break;
        case 2: if (EN(2)) { CASE_BEGIN(); Order<64, 6, 0, D, D, 192> S; S.init(F.G, F.blk, HN, ws + WS_WQKV);
                EpiQKV E{{ws, l, 0}};
                pg8::gemm_phase<D, D, D / 64, 192>(F.lds, S, E, F.wave, tp_here);
                if (MK_PREFETCH && rep == 0 && F.blk >= 128) { frame_refresh(F); prefetch_region(F, ws + WS_WO, 2 * MiB, 128, F.G - 128); prefetch_region(F, ws + WS_WUP, WUP_BYTES, 128, F.G - 128); } } break;
        case 3: if (EN(3)) { CASE_BEGIN(); attn_phase(F, (const bf16_t*)(ws + WS_Q), (const bf16_t*)(ws + WS_KB), (const bf16_t*)(ws + WS_VT), (const bf16_t*)(ws + WS_CK), (const bf16_t*)(ws + WS_CVT), ((const float*)F.in[13]), H); } break;
        case 4: if (EN(4)) { CASE_BEGIN(); Order<64, 8, 0, D, D, 192> S; S.init(F.G, F.blk, HN, ws + WS_WSGI);
                EpiSgu E{{ws, l, 0}};
                pg8::gemm_phase<D, D, D / 64, 192>(F.lds, S, E, F.wave, tp_here);
                } break;
        case 5: if (EN(5)) { CASE_BEGIN(); sgu_phase(F, (const bf16_t*)(ws + WS_U), (const bf16_t*)(ws + WS_V), (const f32x2*)(ws + WS_STATS), ((const float*)F.in[15]), (const bf16_t*)(ws + WS_WS), ((const float*)F.in[17]), H); } break;
        case 6: if (EN(6)) { CASE_BEGIN(); OrderSc S{F.blk, (const char*)HN, (const char*)(ws + WS_WSCI)};
                EpiSc E{{ws, l, F.blk}};
                pg8::gemm_phase<D, D, D / 64>(F.lds, S, E, F.wave, tp_here);
                if (MK_PREFETCH && rep == 0 && F.blk >= 200) { frame_refresh(F); prefetch_region(F, ws + WS_WSCO, 2 * MiB, 200, F.G - 200); prefetch_region(F, ws + WS_WUP + 2 * WUP_BYTES, WUP_BYTES, 200, F.G - 200); } } break;
        case 7: if (EN(7)) { CASE_BEGIN(); OrderFn1 S{F.G, F.blk, (const char*)(ws + WS_A1), (const char*)HN};
                EpiFn1 E{{ws, l, 0}};
                pg8::gemm_phase<256, D, 4>(F.lds, S, E, F.wave, tp_here);
                if (MK_PREFETCH && F.blk >= 128) { frame_refresh(F); prefetch_region(F, ws + WS_A2S, 16 * MiB, 128, F.G - 128); prefetch_region(F, ws + WS_WUP + 3 * WUP_BYTES, WUP_BYTES, 128, F.G - 128); } } break;
        case 8: if (EN(8)) { CASE_BEGIN();
                if (F.blk < 128) { EpiBf16<128> E{{ws, l, 0}}; OrderFn2 S{F.blk, 1, (const char*)(ws + WS_A2S), (const char*)(ws + WS_YT)}; pg8::gemm_phase<2 * TS, 2 * TS, 2 * TS / 64, 128>(F.lds, S, E, F.wave, tp_here); }
                else { EpiBf16<256> E{{ws, l, 0}}; OrderFn2 S{F.blk, 0, (const char*)(ws + WS_A2P), (const char*)(ws + WS_YT)}; pg8::gemm_phase<2 * TP, 2 * TP, 2 * TP / 64>(F.lds, S, E, F.wave, tp_here);
                    if (MK_PREFETCH) { frame_refresh(F); prefetch_region(F, ws + WS_WFNO, 2 * MiB, 128, F.G - 128); } } } break;
        case 9: if (EN(9)) { CASE_BEGIN(); const bf16_t* mix_in = l == 2 ? H2 : H;
                const bf16_t* wout = (const bf16_t*)(ws + (l == 0 ? WS_WO : l == 1 ? WS_WSGO : l == 2 ? WS_WSCO : WS_WFNO));
                Order<64, 4, 0, D, D, 192> S; S.init(F.G, F.blk, mix_in, wout);
                EpiResNorm<false> E{{ws, l, rep ? 2 : 0}};
                if (MK_REP_SHORTK && MK_REP_KIND == 9 && rep > 0) { pg8::gemm_phase<D, D, 4, 192>(F.lds, S, E, F.wave, tp_here); break; }
                pg8::gemm_phase<D, D, D / 64, 192>(F.lds, S, E, F.wave, tp_here);
                } break;
        case 10: if (EN(11)) { CASE_BEGIN(); Order<50, 22, 1, D, D> S; S.init(F.G, F.blk, HN, ws + WS_WUP + l * WUP_BYTES);
                if (MK_REP_NULL && rep > 0) { EpiNull E{{ws, l, 0}}; pg8::gemm_phase<D, D, D / 64>(F.lds, S, E, F.wave, tp_here); }
                else if (MK_REP_SHORTK && MK_REP_KIND == 10 && rep > 0) { EpiUp E{{ws, l, 0}}; pg8::gemm_phase<D, D, 4>(F.lds, S, E, F.wave, tp_here); }
                else { EpiUp E{{ws, l, 0}};
                pg8::gemm_phase<D, D, D / 64>(F.lds, S, E, F.wave, tp_here); }
                if (rep == 0 && F.blk >= 76) { frame_refresh(F);
                    if (l < 3) { mod_items(F, 192 * (l + 1), 192 * (l + 2), 76, F.G - 76); convert_layer(F, l + 1, 76, F.G - 76); }
                    if (MK_PREFETCH) { prefetch_region(F, ws + WS_WDN + l * WDN_BYTES, WDN_BYTES, 76, F.G - 76); } } } break;
        default: if (EN(12)) { CASE_BEGIN(); Order<64, 4, 0, DFF, DFF, 192> S; S.init(F.G, F.blk, ws + WS_ACT, ws + WS_WDN + l * WDN_BYTES);
                if (l < 3) { EpiResNorm<false> E{{ws, l, 1 | (rep ? 2 : 0)}}; pg8::gemm_phase<DFF, DFF, DFF / 64, 192>(F.lds, S, E, F.wave, tp_here); }
                else { EpiResNorm<true> E{{ws, l, 1 | (rep ? 2 : 0)}}; pg8::gemm_phase<DFF, DFF, DFF / 64, 192>(F.lds, S, E, F.wave, tp_here); } } break;
        }
        }
        if (tp_here && wave0 == 0 && pg8::lane_id() == 0) { const unsigned long long r1 = __builtin_amdgcn_s_memrealtime(), c1 = __builtin_amdgcn_s_memtime();
            if (MK_TP == 1) MISC[16] = (unsigned)(r1 - tp_r0);
            if (MK_TP == 3) MISC[16] = (unsigned)((c1 - tp_c0) * 10ull / (r1 - tp_r0)) * 10u; }
        if (ph + 1 < hi) xcd_barrier(bar, wave0 == 0 && pg8::lane_id() == 0);
    }
    if (MK_TP && blk0 == 0 && wave0 == 0) { const unsigned v = MISC[16] * (MK_TP == 2 ? 4u : 1u); const unsigned long long t0 = __builtin_amdgcn_s_memrealtime();
        while (__builtin_amdgcn_s_memrealtime() - t0 < v) __builtin_amdgcn_s_sleep(8); }
}

extern "C" void kernel_launch(void* const* d_in, const int* in_sizes, int n_in, void* d_out, int out_size, void* d_ws, size_t ws_size, hipStream_t stream) {
    static int grid = 0;
    if (grid == 0) {
        if (n_in != 26 || ws_size < WS_TOTAL + (MK_REP_N ? (size_t)73 * MiB : 0)) { fprintf(stderr, "kernel_launch: unexpected n_in %d / ws %zu (need %zu)\n", n_in, ws_size, (size_t)WS_TOTAL); grid = -1; return; }
        int dev = 0, cus = 0;
        if (hipGetDevice(&dev) != hipSuccess || hipDeviceGetAttribute(&cus, hipDeviceAttributeMultiprocessorCount, dev) != hipSuccess) { grid = -1; return; }
        if (hipFuncSetAttribute((const void*)mk_fwd, hipFuncAttributeMaxDynamicSharedMemorySize, LDS_BYTES) != hipSuccess) { fprintf(stderr, "kernel_launch: hipFuncSetAttribute failed\n"); grid = -1; return; }
        (void)hipGetLastError();
        grid = cus;
    }
    if (grid < 0) return;
    (void)hipMemsetAsync((char*)d_ws + WS_CTL, 0, CTL_ZERO_BYTES, stream);
    Args a{};
    for (int i = 0; i < 26; ++i) a.in[i] = (const float*)d_in[i];
    a.out = (float*)d_out; a.ws = (unsigned char*)d_ws;
#if MK_PER_PHASE
    for (int p = MK_PH_LO; p < MK_PH_HI; ++p) { a.ph_lo = p; a.ph_hi = p + 1; hipLaunchKernelGGL(mk_fwd, dim3(grid), dim3(NWAVES * 64), LDS_BYTES, stream, a); }
#else
    a.ph_lo = MK_PH_LO; a.ph_hi = MK_PH_HI;
    hipLaunchKernelGGL(mk_fwd, dim3(grid), dim3(NWAVES * 64), LDS_BYTES, stream, a);
#endif
}
```

```cpp
#include <hip/hip_runtime.h>
#include <cstdio>

#define LAS __attribute__((address_space(3)))
#define GAS __attribute__((address_space(1)))
typedef unsigned short bf16_t;
typedef short bf16x8 __attribute__((ext_vector_type(8)));
typedef float f32x4 __attribute__((ext_vector_type(4)));
typedef float f32x2 __attribute__((ext_vector_type(2)));
typedef unsigned u32x4 __attribute__((ext_vector_type(4)));
typedef unsigned u32x2 __attribute__((ext_vector_type(2)));

constexpr int D = 1024, MP = 8192, MS = 4096, M = MP + MS, DFF = 2816, TS = 2048, TP = 256;
constexpr float EPS = 1e-6f;
constexpr int NWAVES = 8;
#ifndef MK_PER_PHASE
#define MK_PER_PHASE 0
#endif
#ifndef MK_PH_LO
#define MK_PH_LO 0
#endif
#ifndef MK_PH_HI
#define MK_PH_HI 21
#endif
#ifndef MK_MASK
#define MK_MASK 0xffffffffu
#endif
#define EN(b) (((MK_MASK) >> (b)) & 1u)
#ifndef MK_REP_KIND
#define MK_REP_KIND -1
#endif
#ifndef MK_REP_N
#define MK_REP_N 0
#endif
#ifndef MK_REP_NULL
#define MK_REP_NULL 0
#endif
#ifndef MK_REP_SHORTK
#define MK_REP_SHORTK 0
#endif
#ifndef MK_PREFETCH
#define MK_PREFETCH 1
#endif
#ifndef MK_TP
#define MK_TP 0
#endif
#ifndef MK_TP_PH
#define MK_TP_PH 10
#endif

namespace pg8 {
constexpr int BM = 256, BK = 64, HALF = 128, HTB = HALF * BK * 2, STAGE_BYTES = 8 * HTB, NXCD = 8, WGM = 8;
__host__ __device__ __forceinline__ int lds_byte(int r, int c) { const int st = (r >> 4) * 2 + (c >> 5), rr = r & 15, cc = c & 31, ob = rr * 64 + cc * 2; return st * 1024 + (ob ^ (((ob >> 9) & 1) << 5)); }
__host__ __device__ __forceinline__ void stage_rc(int b, int& R, int& C) { const int st = b / 1024, sb = b % 1024, swz = sb ^ (((sb >> 9) & 1) << 5); R = (st >> 1) * 16 + swz / 64; C = (st & 1) * 32 + (swz % 64) / 2; }
__host__ __device__ __forceinline__ int perm32(int rho) { const int n = rho >> 4, i = rho & 15; return 8 * (i >> 2) + 4 * n + (i & 3); }

struct Unit { int pm, pn, row0; const char* a; const char* b; };
struct Cfg { int lda, ldb, nt; };

__device__ __forceinline__ int lane_id() { return (int)__builtin_amdgcn_mbcnt_hi(~0u, __builtin_amdgcn_mbcnt_lo(~0u, 0u)); }
__device__ __forceinline__ unsigned cvt_pk_bf16(float lo, float hi) { unsigned r; asm volatile("v_cvt_pk_bf16_f32 %0, %1, %2" : "=v"(r) : "v"(lo), "v"(hi)); return r; }

template <int LDA, int LDB, int NT, int ROWS = 256, class Epi, class Sched>
__device__ __forceinline__ void gemm_phase(LAS unsigned char* lds, const Sched& S, const Epi& E, int wid, bool tp_on = false) {
    constexpr Cfg g{LDA, LDB, NT};
    int lane_ = lane_id(); asm volatile("" : "+v"(lane_));
    const int lane = lane_, tid = wid * 64 + lane, wr = wid >> 2, wc = wid & 3, fr = lane & 15, fq = lane >> 4;
    const int nt = g.nt;
    unsigned voffA[2], voffB[2];
#pragma unroll
    for (int i = 0; i < 2; ++i) { int R, C; stage_rc(tid * 16 + i * 8192, R, C); const int Rb = Epi::PERM ? ((R & ~31) + perm32(R & 31)) : R;
        voffA[i] = (unsigned)(R * g.lda + C) * 2u; voffB[i] = (unsigned)(Rb * g.ldb + C) * 2u; }
    unsigned voffA1[2]; voffA1[0] = ROWS == 128 ? 0u : voffA[0]; voffA1[1] = ROWS == 256 ? voffA[1] : 0u;
    const size_t kstep = (size_t)(BK * 2);
    const size_t hstepA = (size_t)HALF * g.lda * 2, hstepB = (size_t)HALF * g.ldb * 2;
    const unsigned ldsw = (unsigned)wid * 1024u;
    constexpr int NM1 = ROWS == 192 ? 2 : ROWS == 128 ? 0 : 4;
    const int aoff = lds_byte(wr * 64 + fr, fq * 8), boff = lds_byte(wc * 32 + fr, fq * 8), aoff1 = ROWS == 192 ? lds_byte(wr * 32 + fr, fq * 8) : aoff;
#define PG8_SA(b, h) (((b) * 2 + (h)) * HTB)
#define PG8_SB(b, h) ((4 + (b) * 2 + (h)) * HTB)
#define PG8_STAGE(bufoff, gbase, voff) do { _Pragma("unroll") for (int _i = 0; _i < 2; ++_i) { unsigned _vo = (voff)[_i]; asm volatile("" : "+v"(_vo)); \
        __builtin_amdgcn_global_load_lds((const unsigned*)((const char*)(gbase) + _vo), (LAS unsigned*)(lds + (bufoff) + ldsw + _i * 8192), 16, 0, 0); } } while (0)
#define PG8_LDA(dst, b, h) do { _Pragma("unroll") for (int m = 0; m < 4; ++m) _Pragma("unroll") for (int k = 0; k < 2; ++k) dst[m][k] = *(const LAS bf16x8*)(lds + PG8_SA(b, h) + aoff + m * 2048 + k * 1024); } while (0)
#define PG8_LDA1(dst, b) do { _Pragma("unroll") for (int m = 0; m < NM1; ++m) _Pragma("unroll") for (int k = 0; k < 2; ++k) dst[m][k] = *(const LAS bf16x8*)(lds + PG8_SA(b, 1) + aoff1 + m * 2048 + k * 1024); } while (0)
#define PG8_LDB(dst, b, h) do { _Pragma("unroll") for (int n = 0; n < 2; ++n) _Pragma("unroll") for (int k = 0; k < 2; ++k) dst[n][k] = *(const LAS bf16x8*)(lds + PG8_SB(b, h) + boff + n * 2048 + k * 1024); } while (0)
#define PG8_MMA(ai, bj, At, Bt) do { __builtin_amdgcn_s_setprio(1); _Pragma("unroll") for (int m = 0; m < 4; ++m) _Pragma("unroll") for (int n = 0; n < 2; ++n) _Pragma("unroll") for (int k = 0; k < 2; ++k) \
        acc[ai][bj][m][n] = __builtin_amdgcn_mfma_f32_16x16x32_bf16(Bt[n][k], At[m][k], acc[ai][bj][m][n], 0, 0, 0); __builtin_amdgcn_s_setprio(0); } while (0)
#define PG8_MMA1(bj, At, Bt) do { __builtin_amdgcn_s_setprio(1); _Pragma("unroll") for (int m = 0; m < NM1; ++m) _Pragma("unroll") for (int n = 0; n < 2; ++n) _Pragma("unroll") for (int k = 0; k < 2; ++k) \
        acc[1][bj][m][n] = __builtin_amdgcn_mfma_f32_16x16x32_bf16(Bt[n][k], At[m][k], acc[1][bj][m][n], 0, 0, 0); __builtin_amdgcn_s_setprio(0); } while (0)
#define PG8_WAIT_V(n) asm volatile("s_waitcnt vmcnt(" #n ")" ::: "memory")
#define PG8_WAIT_L(n) asm volatile("s_waitcnt lgkmcnt(" #n ")" ::: "memory")
#define PG8_BAR __builtin_amdgcn_s_barrier()
#define PG8_SCHED __builtin_amdgcn_sched_barrier(0)
    Unit cur, nxt; int ui = 0;
    if (!S.next(0, cur)) return;
    f32x4 acc[2][2][4][2];
#pragma unroll
    for (int a = 0; a < 2; ++a)
#pragma unroll
        for (int b = 0; b < 2; ++b)
#pragma unroll
            for (int m = 0; m < 4; ++m)
#pragma unroll
                for (int n = 0; n < 2; ++n) acc[a][b][m][n] = (f32x4){0.f, 0.f, 0.f, 0.f};
    bf16x8 At[4][2], B0[2][2], B1[2][2];
    const char* cA = cur.a; const char* cB = cur.b;
    PG8_STAGE(PG8_SB(0, 0), cB, voffB); PG8_STAGE(PG8_SB(0, 1), cB + hstepB, voffB); PG8_STAGE(PG8_SA(0, 0), cA, voffA); PG8_STAGE(PG8_SA(0, 1), cA + hstepA, voffA1);
    if (wr == 1) PG8_BAR;
    PG8_WAIT_V(2); PG8_BAR;
    PG8_STAGE(PG8_SB(1, 0), cB + kstep, voffB); PG8_STAGE(PG8_SA(1, 0), cA + kstep, voffA); PG8_STAGE(PG8_SB(1, 1), cB + hstepB + kstep, voffB);
    PG8_WAIT_V(6); PG8_BAR;
    for (;;) {
        const bool has_next = S.next(ui + 1, nxt);
        const char* nA = has_next ? nxt.a : cA; const char* nB = has_next ? nxt.b : cB;
        for (int t = 0; t < nt; t += 2) {
            const bool last = (t == nt - 2);
            const char* a1 = cA + (size_t)(t + 1) * kstep;
            const char* a2 = last ? nA : cA + (size_t)(t + 2) * kstep; const char* b2 = last ? nB : cB + (size_t)(t + 2) * kstep;
            const char* a3 = a2 + kstep; const char* b3 = b2 + kstep;
            PG8_LDB(B0, 0, 0); PG8_LDB(B1, 0, 1); PG8_SCHED; PG8_LDA(At, 0, 0); PG8_STAGE(PG8_SA(1, 1), a1 + hstepA, voffA1);
            PG8_WAIT_V(8); PG8_WAIT_L(0); PG8_BAR; PG8_MMA(0, 0, At, B0); PG8_MMA(0, 1, At, B1); PG8_BAR; PG8_SCHED;
            PG8_LDA1(At, 0); PG8_STAGE(PG8_SB(0, 0), b2, voffB); PG8_STAGE(PG8_SB(0, 1), b2 + hstepB, voffB); PG8_STAGE(PG8_SA(0, 0), a2, voffA);
            PG8_WAIT_V(8); PG8_WAIT_L(0); PG8_BAR; PG8_MMA1(0, At, B0); PG8_MMA1(1, At, B1); PG8_BAR; PG8_SCHED;
            PG8_LDB(B0, 1, 0); PG8_LDB(B1, 1, 1); PG8_SCHED; PG8_LDA(At, 1, 0); PG8_STAGE(PG8_SA(0, 1), a2 + hstepA, voffA1);
            PG8_WAIT_V(8); PG8_WAIT_L(0); PG8_BAR; PG8_MMA(0, 0, At, B0); PG8_MMA(0, 1, At, B1); PG8_BAR; PG8_SCHED;
            PG8_LDA1(At, 1); PG8_STAGE(PG8_SB(1, 0), b3, voffB); PG8_STAGE(PG8_SB(1, 1), b3 + hstepB, voffB); PG8_STAGE(PG8_SA(1, 0), a3, voffA);
            PG8_WAIT_V(8); PG8_WAIT_L(0); PG8_BAR; PG8_MMA1(0, At, B0); PG8_MMA1(1, At, B1); PG8_BAR; PG8_SCHED;
        }
        if (wr == 0) PG8_BAR;
        if (MK_TP == 2) { const unsigned long long t0_ = __builtin_amdgcn_s_memrealtime(); E(acc, cur, wid, ui); const unsigned long long t1_ = __builtin_amdgcn_s_memrealtime();
            if (wid == 0 && lane == 0 && tp_on) *(volatile LAS unsigned*)(lds + 131072 + 8192 + 320 + 4 * 16) += (unsigned)(t1_ - t0_); }
        else E(acc, cur, wid, ui);
        if (!has_next) break;
#pragma unroll
        for (int a = 0; a < 2; ++a)
#pragma unroll
            for (int b = 0; b < 2; ++b)
#pragma unroll
                for (int m = 0; m < 4; ++m)
#pragma unroll
                    for (int n = 0; n < 2; ++n) acc[a][b][m][n] = (f32x4){0.f, 0.f, 0.f, 0.f};
        cur = nxt; cA = nA; cB = nB; ++ui;
        if (wr == 1) PG8_BAR;
    }
    PG8_WAIT_V(0);
    PG8_BAR;
#undef PG8_SA
#undef PG8_SB
#undef PG8_STAGE
#undef PG8_LDA
#undef PG8_LDA1
#undef PG8_MMA1
#undef PG8_LDB
#undef PG8_MMA
#undef PG8_WAIT_V
#undef PG8_WAIT_L
#undef PG8_BAR
#undef PG8_SCHED
}
}
using pg8::Unit; using pg8::cvt_pk_bf16;

constexpr size_t MiB = 1u << 20;
constexpr size_t WS_CTL = 0, CTL_ZERO_BYTES = 128 * 1024;
constexpr size_t WS_MOD = 1 * MiB;
constexpr size_t WS_ROPE = WS_MOD + 512 * 1024;
constexpr size_t WS_STATS = WS_ROPE + 64 * 1024;
constexpr size_t WS_WQKV = 4 * MiB;
constexpr size_t WS_WO = WS_WQKV + 3 * MiB;
constexpr size_t WS_WSGI = WS_WO + 2 * MiB;
constexpr size_t WS_WSGO = WS_WSGI + 4 * MiB;
constexpr size_t WS_WSCI = WS_WSGO + 2 * MiB;
constexpr size_t WS_WSCO = WS_WSCI + 6 * MiB;
constexpr size_t WS_WFNO = WS_WSCO + 2 * MiB;
constexpr size_t WS_WUP = WS_WFNO + 2 * MiB;
constexpr size_t WUP_BYTES = (size_t)2 * DFF * D * 2;
constexpr size_t WS_WDN = WS_WUP + 4 * WUP_BYTES;
constexpr size_t WDN_BYTES = (size_t)D * DFF * 2;
constexpr size_t WS_WS = WS_WDN + 4 * WDN_BYTES;
constexpr size_t WS_A1 = WS_WS + 256 * 1024;
constexpr size_t WS_A2P = WS_A1 + 256 * 1024;
constexpr size_t WS_A2S = WS_A2P + 256 * 1024;
constexpr size_t WS_CK = WS_A2S + 16 * MiB;
constexpr size_t WS_CVT = WS_CK + 512 * 1024;
constexpr size_t WS_X = WS_CVT + 512 * 1024;
constexpr size_t WS_H = WS_X + (size_t)M * D * 4;
constexpr size_t WS_BIG = WS_H + (size_t)(M + 256) * D * 2;
constexpr size_t WS_END = WS_BIG + 72 * MiB;
constexpr size_t WS_ACT = WS_BIG;
constexpr size_t WS_Q = WS_BIG;
constexpr size_t WS_KB = WS_Q + 24 * MiB;
constexpr size_t WS_VT = WS_KB + 6 * MiB;
constexpr size_t WS_U = WS_BIG;
constexpr size_t WS_V = WS_BIG + 24 * MiB;
constexpr size_t WS_YB = WS_BIG;
constexpr size_t WS_YT = WS_BIG;
static_assert(WS_YB + (size_t)256 * 2 * 16 * 512 * 16 <= WS_END, "yb");
static_assert(WS_ACT + (size_t)M * DFF * 2 <= WS_END, "act");
constexpr size_t WS_H2 = WS_END;
constexpr size_t WS_HN = WS_H2 + (size_t)M * D * 2;
constexpr size_t WS_XS = WS_HN + (size_t)(M + 256) * D * 2;
constexpr size_t WS_TOTAL = WS_XS + (size_t)16 * M * 4 * 4;
constexpr size_t CTL_CNT = 16384;
constexpr size_t CTL_TMO = CTL_CNT + 16 * 64 * 64;

constexpr size_t OUT_NK = (size_t)M * D, OUT_NV = OUT_NK + (size_t)MP * 256;

#define XB_TMO      128
#define XB_XCNT(j)  (256  + 64 * (j))
#define XB_XSUB(j)  (1280 + 64 * (j))
#define XB_XGEN(j)  (2304 + 64 * (j))
#define XB_TOP      3328
#define XB_TOPGEN   3392
#define XCD_BAR_WORDS 3456
#define XB_SPIN_CAP (1u << 22)
__device__ __forceinline__ unsigned xb_ld(unsigned* p)              { return __hip_atomic_load(p, __ATOMIC_RELAXED, __HIP_MEMORY_SCOPE_AGENT); }
__device__ __forceinline__ unsigned xb_add(unsigned* p, unsigned v) { return __hip_atomic_fetch_add(p, v, __ATOMIC_RELAXED, __HIP_MEMORY_SCOPE_AGENT); }
__device__ __forceinline__ unsigned xb_xcc_id() { return (unsigned)__builtin_amdgcn_s_getreg((3 << 11) | 20) & 0xFu; }
#define XB_SPIN(cond, bar) do { unsigned _sp = 0; while (cond) { __builtin_amdgcn_s_sleep(1); \
    if ((++_sp & 255u) == 0u) { if (xb_ld(&(bar)[XB_TMO])) break; if (_sp > XB_SPIN_CAP) { atomicAdd(&(bar)[XB_TMO], 1u); break; } } } } while (0)
struct XcdBarrier { unsigned* bar; unsigned x; volatile LAS unsigned* st; };
__device__ __forceinline__ XcdBarrier xcd_barrier_post(unsigned* bar, volatile LAS unsigned* st, bool leader) {
    XcdBarrier b; b.bar = bar; b.x = xb_xcc_id(); b.st = st;
    if (leader) (void)xb_add(&bar[XB_XCNT(b.x)], 1u);
    return b;
}
__device__ __forceinline__ void xcd_barrier_complete(unsigned* bar, unsigned x, unsigned& nloc, unsigned& nx) {
    const unsigned G = gridDim.x * gridDim.y * gridDim.z;
    unsigned sum, cnt, mine, sp = 0u;
    for (;;) {
        sum = 0u; cnt = 0u; mine = 0u;
#pragma unroll
        for (unsigned j = 0; j < 16; ++j) { const unsigned c = xb_ld(&bar[XB_XCNT(j)]); sum += c; cnt += (c > 0u) ? 1u : 0u; }
        mine = xb_ld(&bar[XB_XCNT(x)]);
        if (sum == G) break;
        __builtin_amdgcn_s_sleep(1);
        if ((++sp & 255u) == 0u) { if (xb_ld(&bar[XB_TMO])) break; if (sp > XB_SPIN_CAP) { atomicAdd(&bar[XB_TMO], 1u); break; } }
    }
    nloc = mine > 0u ? mine : 1u; nx = cnt > 0u ? cnt : 1u;
}
__device__ __forceinline__ void xcd_barrier(const XcdBarrier& b, bool leader) {
    asm volatile("s_waitcnt vmcnt(0)" ::: "memory");
    __syncthreads();
    if (leader) {
        unsigned* bar = b.bar; unsigned bx = b.x; asm volatile("" : "+s"(bx));
        __builtin_amdgcn_s_waitcnt(0);
        unsigned nloc = b.st[0], nx = b.st[1];
        if (nloc == 0u) { xcd_barrier_complete(bar, bx, nloc, nx); b.st[0] = nloc; b.st[1] = nx; }
        const unsigned old = xb_add(&bar[XB_XSUB(bx)], 1u);
        const unsigned gen = old / nloc;
        if (old + 1u == (gen + 1u) * nloc) {
            __builtin_amdgcn_fence(__ATOMIC_RELEASE, "agent");
            asm volatile("s_waitcnt vmcnt(0)" ::: "memory");
            const unsigned og = xb_add(&bar[XB_TOP], 1u);
            const unsigned tg = og / nx;
            if (og + 1u == (tg + 1u) * nx) xb_add(&bar[XB_TOPGEN], 1u);
            else XB_SPIN(xb_ld(&bar[XB_TOPGEN]) == tg, bar);
            __builtin_amdgcn_fence(__ATOMIC_ACQUIRE, "agent");
            xb_add(&bar[XB_XGEN(bx)], 1u);
            asm volatile("s_waitcnt vmcnt(0)" ::: "memory");
        } else {
            XB_SPIN(xb_ld(&bar[XB_XGEN(bx)]) == gen, bar);
            __builtin_amdgcn_fence(__ATOMIC_ACQUIRE, "agent");
            asm volatile("s_waitcnt vmcnt(0)" ::: "memory");
        }
    }
    __syncthreads();
}

#define LDS_WAIT() asm volatile("s_waitcnt lgkmcnt(0)" ::: "memory")
__device__ __forceinline__ unsigned f2bf(float f) { unsigned u = __builtin_bit_cast(unsigned, f); return (u + 0x7fffu + ((u >> 16) & 1u)) >> 16; }
__device__ __forceinline__ unsigned pk2(float lo, float hi) { return f2bf(lo) | (f2bf(hi) << 16); }
__device__ __forceinline__ float bf2f(unsigned short b) { return __builtin_bit_cast(float, (unsigned)b << 16); }
__device__ __forceinline__ float rows_max(float x) {
    auto s = __builtin_amdgcn_permlane16_swap(__float_as_uint(x), __float_as_uint(x), false, false); x = fmaxf(__uint_as_float(s[0]), __uint_as_float(s[1]));
    auto t = __builtin_amdgcn_permlane32_swap(__float_as_uint(x), __float_as_uint(x), false, false); return fmaxf(__uint_as_float(t[0]), __uint_as_float(t[1])); }
__device__ __forceinline__ float rows_sum(float x) {
    auto s = __builtin_amdgcn_permlane16_swap(__float_as_uint(x), __float_as_uint(x), false, false); x = __uint_as_float(s[0]) + __uint_as_float(s[1]);
    auto t = __builtin_amdgcn_permlane32_swap(__float_as_uint(x), __float_as_uint(x), false, false); return __uint_as_float(t[0]) + __uint_as_float(t[1]); }
template <int CTRL> __device__ __forceinline__ float dppx(float v) { return __builtin_bit_cast(float, __builtin_amdgcn_mov_dpp(__builtin_bit_cast(int, v), CTRL, 0xf, 0xf, true)); }
__device__ __forceinline__ float wave_sum(float v) {
    v += dppx<0xB1>(v);
    v += dppx<0x4E>(v);
    v += dppx<0x141>(v);
    v += dppx<0x140>(v);
    return rows_sum(v);
}
__device__ __forceinline__ float fast_exp2(float x) { return __builtin_amdgcn_exp2f(x); }
__device__ __forceinline__ float fast_rcp(float x) { return __builtin_amdgcn_rcpf(x); }
__device__ __forceinline__ float silu_f(float x) { return x * fast_rcp(1.f + fast_exp2(-1.4426950408889634f * x)); }
__device__ __forceinline__ float gelu_f(float x) { const float u = x * (1.f + 0.044715f * x * x); return x * fast_rcp(1.f + fast_exp2(-2.302208198f * u)); }
__device__ __forceinline__ int conv_row0(int pm) { if (pm < 32) return 256 * pm; const int s = (pm - 32) / 9, i = (pm - 32) % 9; return MP + TS * s + 254 * i - 1; }
template <int CTRL> __device__ __forceinline__ float dpp(float v) { return __builtin_bit_cast(float, __builtin_amdgcn_mov_dpp(__builtin_bit_cast(int, v), CTRL, 0xf, 0xf, true)); }
template <int CTRL> __device__ __forceinline__ f32x4 dpp4(f32x4 v) { return (f32x4){dpp<CTRL>(v[0]), dpp<CTRL>(v[1]), dpp<CTRL>(v[2]), dpp<CTRL>(v[3])}; }
#define DPP_ROR1 0x121
#define DPP_ROR15 0x12F

template <int NM, int NN, int CONV, int LDA, int LDB, int ROWS = 256>
struct Order {
    int G, c; const char* A; const char* B;
    __device__ __forceinline__ void init(int G_, int c_, const void* A_, const void* B_) { G = G_; c = c_; A = (const char*)A_; B = (const char*)B_; }
    __device__ __forceinline__ bool next(int i, Unit& u) const {
        constexpr int nwg = NM * NN;
        const int L = i * G + c; if (L >= nwg) return false;
        int wgid = L; { constexpr int q = nwg / pg8::NXCD, r = nwg % pg8::NXCD; const int xcd = wgid % pg8::NXCD, off = wgid / pg8::NXCD; wgid = (xcd < r ? xcd * (q + 1) : r * (q + 1) + (xcd - r) * q) + off; }
        constexpr int nig = pg8::WGM * NN; const int gid = wgid / nig, fm = gid * pg8::WGM, gsz = (NM - fm) < pg8::WGM ? (NM - fm) : pg8::WGM;
        u.pm = fm + ((wgid % nig) % gsz); u.pn = (wgid % nig) / gsz;
        u.row0 = CONV ? conv_row0(u.pm) : ROWS * u.pm;
        u.a = A + (long)u.row0 * (long)(LDA * 2); u.b = B + (size_t)u.pn * (size_t)(256 * LDB * 2); return true;
    }
};

typedef const GAS float* cfp_t;
struct Frame {
    LAS unsigned char* lds; int tid, lane, wave, G, blk;
    const __attribute__((address_space(4))) cfp_t* in; float* out; unsigned char* ws;
};
__device__ __forceinline__ void frame_refresh(Frame& F) {
    int ln = pg8::lane_id(); asm volatile("" : "+v"(ln)); F.lane = ln; F.tid = F.wave * 64 + ln;
}
constexpr int RING_BYTES = 131072, XCH_OFF = RING_BYTES  , MISC_OFF = XCH_OFF + 8192 + 320, LDS_BYTES = 147456;
__device__ __forceinline__ int vec_plain(int pm) { return pm < 32 ? 0 : 1 + (pm - 32) / 8; }
__device__ __forceinline__ int vec_conv(int pm) { return pm < 32 ? 0 : 1 + (pm - 32) / 9; }

__device__ __forceinline__ constexpr int r192_nm(int ai) { return ai ? 2 : 4; }
__device__ __forceinline__ int r192_base(int ai, int wr) { return ai ? 128 + 32 * wr : 64 * wr; }
__device__ __forceinline__ u32x4 merge_quads16(u32x2 q0, u32x2 q1) {
    auto a = __builtin_amdgcn_permlane16_swap(q0.x, q1.x, false, false);
    auto b = __builtin_amdgcn_permlane16_swap(q0.y, q1.y, false, false);
    return (u32x4){a[0], b[0], a[1], b[1]};
}
__device__ __forceinline__ void split_quads16(u32x4 r, u32x2& q0, u32x2& q1) {
    auto a = __builtin_amdgcn_permlane16_swap(r.x, r.z, false, false);
    auto b = __builtin_amdgcn_permlane16_swap(r.y, r.w, false, false);
    q0 = (u32x2){a[0], b[0]}; q1 = (u32x2){a[1], b[1]};
}
struct EpiBase {
    unsigned char* ws_; int l, aux;
    __device__ __forceinline__ unsigned char* wsp() const { unsigned long long w = (unsigned long long)ws_; asm volatile("" : "+s"(w)); return (unsigned char*)(GAS unsigned char*)w; }
    __device__ __forceinline__ static const __attribute__((address_space(4))) cfp_t* kargs() { unsigned long long kp = (unsigned long long)__builtin_amdgcn_kernarg_segment_ptr(); asm volatile("" : "+s"(kp)); return (const __attribute__((address_space(4))) cfp_t*)kp; }
    __device__ __forceinline__ static const float* inp(const __attribute__((address_space(4))) cfp_t* ka, int k) { return (const float*)ka[k]; }
    __device__ __forceinline__ static float* outp(const __attribute__((address_space(4))) cfp_t* ka) { return (float*)(GAS float*)ka[26]; }
    __device__ __forceinline__ static LAS float* xch() { extern __shared__ __attribute__((aligned(16))) unsigned char lds_base_[]; return (LAS float*)((LAS unsigned char*)lds_base_ + XCH_OFF); }
};
template <bool FINAL>
struct EpiResNorm : EpiBase {
    static constexpr bool PERM = false;
    static constexpr int TR = 192;
    __device__ __forceinline__ static int nm(int ai) { return ai ? 2 : 4; }
    __device__ __forceinline__ static int rbase(int ai, int wr) { return ai ? 128 + 32 * wr : 64 * wr; }
    __device__ __forceinline__ void operator()(f32x4 (&acc)[2][2][4][2], const Unit& u, int wid, int ) const {
        int lane_ = pg8::lane_id(); asm volatile("" : "+v"(lane_));
        const int lane = lane_, wr = wid >> 2, wc = wid & 3, fr = lane & 15, fq = lane >> 4;
        unsigned char* ws = wsp(); const auto ka = kargs();
        const int isdn = aux & 1, rep = (aux >> 1) & 1, inst = 2 * l + isdn + 8 * rep;
        typedef _Float16 h4 __attribute__((ext_vector_type(4)));
        _Float16* Xr = (_Float16*)(ws + WS_X); _Float16* X = rep ? (_Float16*)(ws + WS_TOTAL) : Xr;
        const bool srcf32 = (!isdn && l == 0);
        const float* modl = (const float*)(ws + WS_MOD) + l * 3 * 6 * D; const int gate_idx = isdn ? 5 : 2;
        const float* gn = FINAL ? inp(ka, 10) : (isdn ? inp(ka, 8) + (l + 1) * D : inp(ka, 9) + l * D);
        const float* modn = isdn ? modl + 3 * 6 * D : modl; const int sh_idx = isdn ? 0 : 3;
        bf16_t* HN = (bf16_t*)(ws + (rep ? WS_TOTAL + 48 * MiB : WS_HN)); float* Y = rep ? (float*)(ws + WS_TOTAL) : outp(ka);
        float* xs = (float*)(ws + WS_XS) + (size_t)inst * M * 4; unsigned* cnt = (unsigned*)(ws + WS_CTL + CTL_CNT) + inst * 64 * 16; unsigned* tmo = (unsigned*)(ws + WS_CTL + CTL_TMO);
        LAS float* L = xch();
        const int col0 = u.pn * 256 + wc * 32 + 4 * fq, tid = wid * 64 + lane;
        const int col16 = col0 + ((fq & 1) ? 12 : 0);
        LAS float* P = L;
        LAS float* S = L + 1024;
#pragma unroll
        for (int ai = 0; ai < 2; ++ai) {
            const int rb = u.row0 + rbase(ai, wr);
            const int vec = rb < MP ? 0 : 1 + (rb - MP) / TS;
            const float* gate = modl + vec * 6 * D + gate_idx * D;
            const float* src = rb < MP ? inp(ka, 0) + (size_t)rb * D : inp(ka, 1) + (size_t)(rb - MP) * D;
            f32x4 gv[2][2];
#pragma unroll
            for (int bj = 0; bj < 2; ++bj)
#pragma unroll
                for (int n = 0; n < 2; ++n) gv[bj][n] = *(const f32x4*)(gate + col0 + bj * 128 + n * 16);
            f32x4 sv[4][2][2];
            u32x4 hv[4][2];
            if (srcf32) {
#pragma unroll
                for (int m = 0; m < 4; ++m) if (m < nm(ai)) { const size_t ro = (size_t)(16 * m + fr) * D + col0;
#pragma unroll
                    for (int bj = 0; bj < 2; ++bj)
#pragma unroll
                        for (int n = 0; n < 2; ++n) sv[m][bj][n] = *(const f32x4*)(src + ro + bj * 128 + n * 16); }
            } else {
#pragma unroll
                for (int m = 0; m < 4; ++m) if (m < nm(ai))
#pragma unroll
                    for (int bj = 0; bj < 2; ++bj) hv[m][bj] = *(const u32x4*)(Xr + (size_t)rb * D + (size_t)(16 * m + fr) * D + col16 + bj * 128);
#pragma unroll
                for (int m = 0; m < 4; ++m) if (m < nm(ai))
#pragma unroll
                    for (int bj = 0; bj < 2; ++bj) { u32x2 q0, q1; split_quads16(hv[m][bj], q0, q1);
                        sv[m][bj][0] = __builtin_convertvector(__builtin_bit_cast(h4, q0), f32x4); sv[m][bj][1] = __builtin_convertvector(__builtin_bit_cast(h4, q1), f32x4); }
            }
#pragma unroll
            for (int m = 0; m < 4; ++m) if (m < nm(ai)) { const int r = rbase(ai, wr) + 16 * m + fr; float ss = 0.f;
#pragma unroll
                for (int bj = 0; bj < 2; ++bj)
#pragma unroll
                    for (int n = 0; n < 2; ++n) { const f32x4 x1 = sv[m][bj][n] + gv[bj][n] * acc[ai][bj][m][n]; acc[ai][bj][m][n] = x1;
                        ss += (x1[0] * x1[0] + x1[1] * x1[1]) + (x1[2] * x1[2] + x1[3] * x1[3]); }
                ss = rows_sum(ss);
                if (fq == 0) P[r * 4 + wc] = ss; }
            asm volatile("" ::: "memory"); }
        LDS_WAIT(); __builtin_amdgcn_s_barrier(); asm volatile("" ::: "memory");
        if (tid < TR) { const f32x4 p = *(const LAS f32x4*)(P + tid * 4); const float tot = (p[0] + p[1]) + (p[2] + p[3]);
            __hip_atomic_store(xs + (size_t)(u.row0 + tid) * 4 + u.pn, tot, __ATOMIC_RELAXED, __HIP_MEMORY_SCOPE_AGENT); }
        asm volatile("s_waitcnt vmcnt(0)" ::: "memory");
        if (tid < TR && (tid & 63) == 0) __hip_atomic_fetch_add(cnt + 16 * u.pm, 1u, __ATOMIC_RELAXED, __HIP_MEMORY_SCOPE_AGENT);
        if (!FINAL) {
#pragma unroll
            for (int ai = 0; ai < 2; ++ai)
#pragma unroll
                for (int m = 0; m < 4; ++m) if (m < nm(ai)) { _Float16* xp = X + (size_t)(u.row0 + rbase(ai, wr) + 16 * m + fr) * D + col16;
#pragma unroll
                    for (int bj = 0; bj < 2; ++bj) { const h4 h0 = __builtin_convertvector(acc[ai][bj][m][0], h4), h1 = __builtin_convertvector(acc[ai][bj][m][1], h4);
                        *(u32x4*)(xp + bj * 128) = merge_quads16(__builtin_bit_cast(u32x2, h0), __builtin_bit_cast(u32x2, h1)); } }
        }
        if (tid < 64) { unsigned sp_ = 0;
            while ((unsigned)__builtin_amdgcn_readfirstlane(__hip_atomic_load(cnt + 16 * u.pm, __ATOMIC_RELAXED, __HIP_MEMORY_SCOPE_AGENT)) < 12u) {
                __builtin_amdgcn_s_sleep(1);
                if ((++sp_ & 1023u) == 0u) { if (__hip_atomic_load(tmo, __ATOMIC_RELAXED, __HIP_MEMORY_SCOPE_AGENT)) break; if (sp_ > (1u << 22)) { __hip_atomic_store(tmo, 1u, __ATOMIC_RELAXED, __HIP_MEMORY_SCOPE_AGENT); break; } } }
        }
        asm volatile("s_waitcnt lgkmcnt(0)" ::: "memory"); __builtin_amdgcn_s_barrier(); asm volatile("" ::: "memory");
        if (tid < TR) { const float* sl = xs + (size_t)(u.row0 + tid) * 4; float t = 0.f;
#pragma unroll
            for (int k = 0; k < 4; ++k) t += __hip_atomic_load(sl + k, __ATOMIC_RELAXED, __HIP_MEMORY_SCOPE_AGENT);
            S[tid] = rsqrtf(t * (1.f / D) + EPS); }
        LDS_WAIT(); __builtin_amdgcn_s_barrier(); asm volatile("" ::: "memory");
#pragma unroll
        for (int ai = 0; ai < 2; ++ai) {
            const int rb = u.row0 + rbase(ai, wr); const int vec = rb < MP ? 0 : 1 + (rb - MP) / TS;
            f32x4 gm[2][2], sh[2][2];
#pragma unroll
            for (int bj = 0; bj < 2; ++bj)
#pragma unroll
                for (int n = 0; n < 2; ++n) { const int c = col0 + bj * 128 + n * 16; gm[bj][n] = *(const f32x4*)(gn + c);
                    if (!FINAL) { const float* mv = modn + vec * 6 * D; gm[bj][n] = gm[bj][n] * (1.f + *(const f32x4*)(mv + (sh_idx + 1) * D + c)); sh[bj][n] = *(const f32x4*)(mv + sh_idx * D + c); } }
#pragma unroll
            for (int m = 0; m < 4; ++m) if (m < nm(ai)) { const int r = rbase(ai, wr) + 16 * m + fr; const float rs = S[r];
#pragma unroll
                for (int bj = 0; bj < 2; ++bj) {
                    if (FINAL) {
#pragma unroll
                        for (int n = 0; n < 2; ++n) *(f32x4*)(Y + (size_t)(u.row0 + r) * D + col0 + bj * 128 + n * 16) = acc[ai][bj][m][n] * rs * gm[bj][n]; }
                    else { const f32x4 h0 = acc[ai][bj][m][0] * rs * gm[bj][0] + sh[bj][0], h1 = acc[ai][bj][m][1] * rs * gm[bj][1] + sh[bj][1];
                        u32x2 w0, w1; w0.x = cvt_pk_bf16(h0[0], h0[1]); w0.y = cvt_pk_bf16(h0[2], h0[3]); w1.x = cvt_pk_bf16(h1[0], h1[1]); w1.y = cvt_pk_bf16(h1[2], h1[3]);
                        *(u32x4*)(HN + (size_t)(u.row0 + r) * D + col16 + bj * 128) = merge_quads16(w0, w1); } } }
        }
    }
};
struct EpiNull : EpiBase {
    static constexpr bool PERM = true;
    __device__ __forceinline__ void operator()(f32x4 (&acc)[2][2][4][2], const Unit& u, int wid, int) const {
        f32x4 s = {0.f, 0.f, 0.f, 0.f};
#pragma unroll
        for (int ai = 0; ai < 2; ++ai)
#pragma unroll
            for (int bj = 0; bj < 2; ++bj)
#pragma unroll
                for (int m = 0; m < 4; ++m)
#pragma unroll
                    for (int n = 0; n < 2; ++n) s += acc[ai][bj][m][n];
        ((f32x4*)(wsp() + WS_TOTAL))[(size_t)(u.pm * 22 + u.pn) * 512 + wid * 64 + pg8::lane_id()] = s;
    }
};
template <int ROWS> struct EpiBf16 : EpiBase {
    static constexpr bool PERM = true;
    __device__ __forceinline__ void operator()(const f32x4 (&acc)[2][2][4][2], const Unit& u, int wid, int ) const {
        int lane_ = pg8::lane_id(); asm volatile("" : "+v"(lane_));
        const int lane = lane_, wr = wid >> 2, wc = wid & 3, fr = lane & 15, fq = lane >> 4; (void)wr; (void)wc; (void)fr; (void)fq;
        bf16_t* O = (bf16_t*)(wsp() + WS_H); constexpr int ldc = D;
        const int col0 = u.pn * 256 + wc * 32 + 8 * fq;
#pragma unroll
        for (int ai = 0; ai < (ROWS == 128 ? 1 : 2); ++ai)
#pragma unroll
            for (int m = 0; m < 4; ++m) { bf16_t* rowp = O + (size_t)(u.row0 + ai * 128 + wr * 64 + m * 16 + fr) * ldc + col0;
#pragma unroll
                for (int bj = 0; bj < 2; ++bj) { const f32x4 v0 = acc[ai][bj][m][0], v1 = acc[ai][bj][m][1];
                    u32x4 w; w.x = cvt_pk_bf16(v0[0], v0[1]); w.y = cvt_pk_bf16(v0[2], v0[3]); w.z = cvt_pk_bf16(v1[0], v1[1]); w.w = cvt_pk_bf16(v1[2], v1[3]);
                    *(u32x4*)(rowp + bj * 128) = w; } }
    }
};
struct EpiQKV : EpiBase {
    static constexpr bool PERM = false;
    __device__ __forceinline__ void operator()(f32x4 (&acc)[2][2][4][2], const Unit& u, int wid, int ) const {
        int lane_ = pg8::lane_id(); asm volatile("" : "+v"(lane_));
        const int lane = lane_, wr = wid >> 2, wc = wid & 3, fr = lane & 15, fq = lane >> 4;
        unsigned char* ws = wsp(); bf16_t* Q = (bf16_t*)(ws + WS_Q); bf16_t* KB = (bf16_t*)(ws + WS_KB); bf16_t* VT = (bf16_t*)(ws + WS_VT); const float* rope = (const float*)(ws + WS_ROPE);
        float* outk = outp(kargs()) + OUT_NK; float* outv = outk + (OUT_NV - OUT_NK);
        const int c0 = wc * 32 + 4 * fq;
#pragma unroll
        for (int ai = 0; ai < 2; ++ai) {
            const int rb = u.row0 + r192_base(ai, wr); const bool samp = rb >= MP;
            if (samp && u.pn <= 4) {
                const int half = wc & 1;
#pragma unroll
                for (int m = 0; m < 4; ++m) if (m < r192_nm(ai)) { const int t = (rb - MP + m * 16 + fr) & (TS - 1); const int pos = half ? (t & 63) : (t >> 6);
                    const f32x4 cs = *(const f32x4*)(rope + pos * 16 + 4 * fq), sn = *(const f32x4*)(rope + 1024 + pos * 16 + 4 * fq);
#pragma unroll
                    for (int bj = 0; bj < 2; ++bj) { const f32x4 x1 = acc[ai][bj][m][0], x2 = acc[ai][bj][m][1]; acc[ai][bj][m][0] = x1 * cs - x2 * sn; acc[ai][bj][m][1] = x2 * cs + x1 * sn; } }
            }
            if (u.pn <= 4) {
                bf16_t* base = u.pn < 4 ? Q + u.pn * 256 : KB; const int ldc = u.pn < 4 ? D : 256;
#pragma unroll
                for (int m = 0; m < 4; ++m) if (m < r192_nm(ai)) { const int row = rb + m * 16 + fr; bf16_t* rowp = base + (size_t)row * ldc + c0 + ((fq & 1) ? 12 : 0);
#pragma unroll
                    for (int bj = 0; bj < 2; ++bj) { u32x2 w[2];
#pragma unroll
                        for (int n = 0; n < 2; ++n) { const f32x4 v = acc[ai][bj][m][n]; w[n].x = cvt_pk_bf16(v[0], v[1]); w[n].y = cvt_pk_bf16(v[2], v[3]);
                            if (u.pn == 4 && !samp) *(f32x4*)(outk + (size_t)row * 256 + c0 + bj * 128 + n * 16) = v; }
                        *(u32x4*)(rowp + bj * 128) = merge_quads16(w[0], w[1]); } }
            } else {
                const int T = samp ? TS : TP;
                bf16_t* vt = samp ? VT + (size_t)32 * 65536 + (size_t)((rb - MP) / TS) * 256 * TS : VT + (size_t)(rb / TP) * 65536;
#pragma unroll
                for (int m = 0; m < 4; ++m) if (m < r192_nm(ai)) { const int row = rb + m * 16 + fr; const int t = samp ? ((row - MP) & (TS - 1)) : (row & (TP - 1));
                    unsigned vo = (unsigned)(c0 * T + t); asm volatile("" : "+v"(vo));
#pragma unroll
                    for (int bj = 0; bj < 2; ++bj)
#pragma unroll
                        for (int n = 0; n < 2; ++n) { const f32x4 v = acc[ai][bj][m][n]; const int c = c0 + bj * 128 + n * 16;
#pragma unroll
                            for (int j = 0; j < 4; ++j) vt[vo + (unsigned)((bj * 128 + n * 16 + j) * T)] = (bf16_t)f2bf(v[j]);
                            if (!samp) *(f32x4*)(outv + (size_t)row * 256 + c) = v; } }
            }
        }
    }
};
__device__ __forceinline__ f32x4 conv_m(f32x4 cur, f32x4 pe, f32x4 ne, f32x4 w0, f32x4 w1, f32x4 w2, int fr) {
    const f32x4 up = dpp4<DPP_ROR1>(cur), dn = dpp4<DPP_ROR15>(cur);
    const f32x4 prev = fr > 0 ? up : pe, next = fr < 15 ? dn : ne;
    return w0 * prev + w1 * cur + w2 * next;
}
__device__ __forceinline__ void mask_rows(f32x4 (&acc)[2][2][4][2], const Unit& u, int wr, int fr) {
    if (u.pm < 32) return;
    const int i = (u.pm - 32) % 9; if (i != 0 && i != 8) return;
    const int t0 = 254 * i - 1;
#pragma unroll
    for (int ai = 0; ai < 2; ++ai)
#pragma unroll
        for (int m = 0; m < 4; ++m) { const int t = t0 + ai * 128 + wr * 64 + m * 16 + fr; if (t < 0 || t >= TS) {
#pragma unroll
            for (int bj = 0; bj < 2; ++bj)
#pragma unroll
                for (int n = 0; n < 2; ++n) acc[ai][bj][m][n] = (f32x4){0.f, 0.f, 0.f, 0.f}; } }
}
__device__ __forceinline__ bool row_valid(const Unit& u, int r) {
    if (u.pm < 32) return true;
    const int t = 254 * ((u.pm - 32) % 9) - 1 + r; return r >= 1 && r <= 254 && t >= 0 && t < TS;
}
__device__ __forceinline__ void xch_write(LAS float* X, const f32x4 (&acc)[2][2][4][2], int wr, int wc, int fr, int fq) {
#pragma unroll
    for (int ai = 0; ai < 2; ++ai)
#pragma unroll
        for (int bj = 0; bj < 2; ++bj)
#pragma unroll
            for (int n = 0; n < 2; ++n) { const int col = bj * 128 + wc * 32 + 8 * fq + 4 * n;
                if (fr == 0) *(LAS f32x4*)(X + ((2 * ai + wr) * 2 + 0) * 256 + col) = acc[ai][bj][0][n];
                if (fr == 15) *(LAS f32x4*)(X + ((2 * ai + wr) * 2 + 1) * 256 + col) = acc[ai][bj][3][n]; }
}
__device__ __forceinline__ f32x4 xch_top(const LAS float* X, int b, int col) { return b > 0 ? *(const LAS f32x4*)(X + ((b - 1) * 2 + 1) * 256 + col) : (f32x4){0.f, 0.f, 0.f, 0.f}; }
__device__ __forceinline__ f32x4 xch_bot(const LAS float* X, int b, int col) { return b < 3 ? *(const LAS f32x4*)(X + ((b + 1) * 2 + 0) * 256 + col) : (f32x4){0.f, 0.f, 0.f, 0.f}; }

struct EpiUp : EpiBase {
    static constexpr bool PERM = true;
    __device__ __forceinline__ void operator()(f32x4 (&acc)[2][2][4][2], const Unit& u, int wid, int ) const {
        int lane_ = pg8::lane_id(); asm volatile("" : "+v"(lane_));
        const int lane = lane_, wr = wid >> 2, wc = wid & 3, fr = lane & 15, fq = lane >> 4; (void)wr; (void)wc; (void)fr; (void)fq;
        bf16_t* ACT = (bf16_t*)(wsp() + WS_ACT); const float* cw = inp(kargs(), 24) + (size_t)l * 3 * 2 * DFF; LAS float* X = xch();
        mask_rows(acc, u, wr, fr);
        xch_write(X, acc, wr, wc, fr, fq);
        LDS_WAIT(); __builtin_amdgcn_s_barrier(); asm volatile("" ::: "memory");
        const int chl = wc * 32 + 8 * fq;
        u32x2 pk0[2][4];
#pragma unroll
        for (int n = 0; n < 2; ++n) {
            const int ch = u.pn * 128 + chl + 4 * n;
            f32x4 wg[3], wu[3];
#pragma unroll
            for (int k = 0; k < 3; ++k) { wg[k] = *(const f32x4*)(cw + k * 2 * DFF + ch); wu[k] = *(const f32x4*)(cw + k * 2 * DFF + DFF + ch); }
#pragma unroll
            for (int ai = 0; ai < 2; ++ai) {
                const int b = 2 * ai + wr;
                f32x4 pg = xch_top(X, b, chl + 4 * n), pu = xch_top(X, b, 128 + chl + 4 * n);
#pragma unroll
                for (int m = 0; m < 4; ++m) { const int r = ai * 128 + wr * 64 + m * 16 + fr;
                    const f32x4 vg = acc[ai][0][m][n], vu = acc[ai][1][m][n];
                    const f32x4 ng = m < 3 ? dpp4<DPP_ROR15>(acc[ai][0][m < 3 ? m + 1 : 3][n]) : xch_bot(X, b, chl + 4 * n);
                    const f32x4 nu = m < 3 ? dpp4<DPP_ROR15>(acc[ai][1][m < 3 ? m + 1 : 3][n]) : xch_bot(X, b, 128 + chl + 4 * n);
                    const f32x4 og = conv_m(vg, pg, ng, wg[0], wg[1], wg[2], fr), ou = conv_m(vu, pu, nu, wu[0], wu[1], wu[2], fr);
                    pg = dpp4<DPP_ROR1>(vg); pu = dpp4<DPP_ROR1>(vu);
                    f32x4 a;
#pragma unroll
                    for (int j = 0; j < 4; ++j) a[j] = silu_f(og[j]) * ou[j];
                    u32x2 w; w.x = cvt_pk_bf16(a[0], a[1]); w.y = cvt_pk_bf16(a[2], a[3]);
                    if (n == 0) pk0[ai][m] = w;
                    else if (row_valid(u, r)) *(u32x4*)(ACT + (size_t)(u.row0 + r) * DFF + ch - 4) = (u32x4){pk0[ai][m].x, pk0[ai][m].y, w.x, w.y}; }
            }
        }
    }
};
struct EpiSgu : EpiBase {
    static constexpr bool PERM = true;
    __device__ __forceinline__ void operator()(f32x4 (&acc)[2][2][4][2], const Unit& u, int wid, int ) const {
        int lane_ = pg8::lane_id(); asm volatile("" : "+v"(lane_));
        const int lane = lane_, wr = wid >> 2, wc = wid & 3, fr = lane & 15, fq = lane >> 4;
        unsigned char* ws = wsp(); bf16_t* U = (bf16_t*)(ws + WS_U); bf16_t* V = (bf16_t*)(ws + WS_V); f32x2* STATS = (f32x2*)(ws + WS_STATS);
        const bool isv = u.pn >= 4; bf16_t* O = isv ? V : U; const int col0 = (u.pn & 3) * 256 + wc * 32 + 8 * fq;
#pragma unroll
        for (int ai = 0; ai < 2; ++ai)
#pragma unroll
            for (int m = 0; m < 4; ++m) if (m < r192_nm(ai)) { const int row = u.row0 + r192_base(ai, wr) + m * 16 + fr; bf16_t* rowp = O + (size_t)row * D + col0; float s1 = 0.f, s2 = 0.f;
#pragma unroll
                for (int bj = 0; bj < 2; ++bj) { f32x4 v0 = acc[ai][bj][m][0], v1 = acc[ai][bj][m][1];
#pragma unroll
                    for (int j = 0; j < 4; ++j) { v0[j] = gelu_f(v0[j]); v1[j] = gelu_f(v1[j]); s1 += v0[j] + v1[j]; s2 += v0[j] * v0[j] + v1[j] * v1[j]; }
                    u32x4 w; w.x = cvt_pk_bf16(v0[0], v0[1]); w.y = cvt_pk_bf16(v0[2], v0[3]); w.z = cvt_pk_bf16(v1[0], v1[1]); w.w = cvt_pk_bf16(v1[2], v1[3]);
                    *(u32x4*)(rowp + bj * 128) = w; }
                if (isv) { s1 = rows_sum(s1); s2 = rows_sum(s2);
                    if (fq == 0) STATS[(size_t)row * 16 + (u.pn - 4) * 4 + wc] = (f32x2){s1, s2}; } }
    }
};
struct EpiSc : EpiBase {
    static constexpr bool PERM = true;
    __device__ __forceinline__ void operator()(f32x4 (&acc)[2][2][4][2], const Unit& u, int wid, int ui) const {
        int lane_ = pg8::lane_id(); asm volatile("" : "+v"(lane_));
        const int lane = lane_, wr = wid >> 2, wc = wid & 3, fr = lane & 15, fq = lane >> 4; (void)wr; (void)wc; (void)fr; (void)fq;
        unsigned char* ws = wsp(); f32x4* YB = (f32x4*)(ws + WS_YB) + (size_t)aux * 2 * 16 * 512; bf16_t* BY = (bf16_t*)(ws + WS_H2); const float* cw = inp(kargs(), 20); LAS float* X = xch();
        const int q = u.pn / 3, s = u.pn % 3, chl = wc * 32 + 8 * fq;
        if (s < 2) {
            mask_rows(acc, u, wr, fr);
#pragma unroll
            for (int ai = 0; ai < 2; ++ai)
#pragma unroll
                for (int m = 0; m < 4; ++m)
#pragma unroll
                    for (int n = 0; n < 2; ++n) acc[ai][0][m][n] = acc[ai][0][m][n] * acc[ai][1][m][n];
            xch_write(X, acc, wr, wc, fr, fq);
            LDS_WAIT(); __builtin_amdgcn_s_barrier(); asm volatile("" ::: "memory");
#pragma unroll
            for (int n = 0; n < 2; ++n) {
                const int ch = q * 256 + s * 128 + chl + 4 * n;
                f32x4 w[3];
#pragma unroll
                for (int k = 0; k < 3; ++k) w[k] = *(const f32x4*)(cw + k * D + ch);
#pragma unroll
                for (int ai = 0; ai < 2; ++ai) { const int b = 2 * ai + wr;
                    f32x4 pp = xch_top(X, b, chl + 4 * n);
#pragma unroll
                    for (int m = 0; m < 4; ++m) { const f32x4 v = acc[ai][0][m][n];
                        const f32x4 nn = m < 3 ? dpp4<DPP_ROR15>(acc[ai][0][m < 3 ? m + 1 : 3][n]) : xch_bot(X, b, chl + 4 * n);
                        const f32x4 o = conv_m(v, pp, nn, w[0], w[1], w[2], fr); pp = dpp4<DPP_ROR1>(v);
                        unsigned yo = (unsigned)((s * 16 + (ai * 4 + m) * 2 + n) * 512) + (unsigned)(wid * 64 + lane); asm volatile("" : "+v"(yo)); YB[yo] = o; } }
            }
        } else {
#pragma unroll
            for (int ai = 0; ai < 2; ++ai) {
                f32x4 y[4][2][2];
#pragma unroll
                for (int m = 0; m < 4; ++m)
#pragma unroll
                    for (int bj = 0; bj < 2; ++bj) { unsigned yo = (unsigned)((bj * 16 + (ai * 4 + m) * 2) * 512) + (unsigned)(wid * 64 + lane); asm volatile("" : "+v"(yo)); y[m][bj][0] = YB[yo]; y[m][bj][1] = YB[yo + 512]; }
#pragma unroll
                for (int m = 0; m < 4; ++m) { const int r = ai * 128 + wr * 64 + m * 16 + fr; const bool ok = row_valid(u, r);
#pragma unroll
                    for (int bj = 0; bj < 2; ++bj) { const f32x4 v0 = acc[ai][bj][m][0] * y[m][bj][0], v1 = acc[ai][bj][m][1] * y[m][bj][1];
                        u32x4 w; w.x = cvt_pk_bf16(v0[0], v0[1]); w.y = cvt_pk_bf16(v0[2], v0[3]); w.z = cvt_pk_bf16(v1[0], v1[1]); w.w = cvt_pk_bf16(v1[2], v1[3]);
                        if (ok) *(u32x4*)(BY + (size_t)(u.row0 + r) * D + q * 256 + bj * 128 + chl) = w; } }
                asm volatile("" ::: "memory"); }
        }
    }
};
struct OrderSc {
    int c; const char* A; const char* B;
    __device__ __forceinline__ bool next(int i, Unit& u) const {
        if (c >= 200 || i >= 3) return false;
        u.pm = c >> 2; u.pn = 3 * (c & 3) + i; u.row0 = conv_row0(u.pm); u.a = A + (long)u.row0 * (D * 2); u.b = B + (size_t)u.pn * 256 * D * 2; return true; }
};
struct EpiFn1 : EpiBase {
    static constexpr bool PERM = true;
    __device__ __forceinline__ void operator()(const f32x4 (&acc)[2][2][4][2], const Unit& u, int wid, int ) const {
        int lane_ = pg8::lane_id(); asm volatile("" : "+v"(lane_));
        const int lane = lane_, wr = wid >> 2, wc = wid & 3, fr = lane & 15, fq = lane >> 4; (void)wr; (void)wc; (void)fr; (void)fq;
        bf16_t* YT = (bf16_t*)(wsp() + WS_YT);
        const int part = u.pm & 1, ch0 = (u.pm >> 1) * 256, tok0 = u.pn * 256;
        bf16_t* base; int T, t0;
        if (tok0 < MP) { T = TP; base = YT + (size_t)(tok0 / TP) * D * 2 * TP; t0 = 0; }
        else { T = TS; base = YT + (size_t)32 * D * 2 * TP + (size_t)((tok0 - MP) / TS) * D * 2 * TS; t0 = (tok0 - MP) % TS; }
        const int c0 = wc * 32 + 8 * fq;
#pragma unroll
        for (int ai = 0; ai < 2; ++ai)
#pragma unroll
            for (int m = 0; m < 4; ++m) { bf16_t* rowp = base + (size_t)(ch0 + ai * 128 + wr * 64 + m * 16 + fr) * 2 * T + part * T + t0 + c0;
#pragma unroll
                for (int bj = 0; bj < 2; ++bj) { const f32x4 v0 = acc[ai][bj][m][0], v1 = acc[ai][bj][m][1];
                    u32x4 w; w.x = cvt_pk_bf16(v0[0], v0[1]); w.y = cvt_pk_bf16(v0[2], v0[3]); w.z = cvt_pk_bf16(v1[0], v1[1]); w.w = cvt_pk_bf16(v1[2], v1[3]);
                    *(u32x4*)(rowp + bj * 128) = w; } }
    }
};
struct OrderFn1 {
    int G, c; const char* A1; const char* H;
    __device__ __forceinline__ bool next(int i, Unit& u) const {
        const int L = i * G + c; if (L >= 384) return false;
        u.pm = L & 7; u.pn = L >> 3; u.row0 = 0; u.a = A1 + (size_t)(u.pm & 1) * 256 * 256 * 2; u.b = H + (size_t)u.pn * 256 * D * 2 + (size_t)(u.pm >> 1) * 512; return true; }
};
struct OrderFn2 {
    int c; int samp; const char* A2; const char* YT;
    __device__ __forceinline__ bool next(int i, Unit& u) const {
        if (i > 0) return false;
        if (samp) { if (c >= 128) return false; const int b = c >> 6, tm = (c >> 2) & 15; u.pm = tm; u.pn = c & 3; u.row0 = MP + b * TS + 128 * tm;
            u.a = A2 + (size_t)tm * 128 * 2 * TS * 2; u.b = YT + (size_t)32 * D * 2 * TP * 2 + (size_t)b * D * 2 * TS * 2 + (size_t)u.pn * 256 * 2 * TS * 2; return true; }
        if (c < 128) return false; const int j = c - 128, s = j >> 2; u.pm = 0; u.pn = j & 3; u.row0 = s * TP;
        u.a = A2; u.b = YT + (size_t)s * D * 2 * TP * 2 + (size_t)u.pn * 256 * 2 * TP * 2; return true; }
};

__device__ __forceinline__ void p0_transpose_item(const float* W, int K, int N, bf16_t* WT, int drow0, LAS float* scr, int kb, int n0, int lane) {
    const int k0 = 64 * kb;
    f32x4 v[8];
#pragma unroll
    for (int i = 0; i < 8; ++i) v[i] = __builtin_nontemporal_load((const f32x4*)(W + (size_t)(k0 + 8 * i + (lane >> 3)) * N + n0 + 4 * (lane & 7)));
#pragma unroll
    for (int i = 0; i < 8; ++i) { LAS float* d = scr + (8 * i + (lane >> 3)) * 33 + 4 * (lane & 7); d[0] = v[i][0]; d[1] = v[i][1]; d[2] = v[i][2]; d[3] = v[i][3]; }
    LDS_WAIT(); asm volatile("" ::: "memory");
    const int c = lane & 7;
#pragma unroll
    for (int j = 0; j < 4; ++j) { const int n = (lane >> 3) + 8 * j; const LAS float* s = scr + (8 * c) * 33 + n;
        u32x4 o; o.x = pk2(s[0 * 33], s[1 * 33]); o.y = pk2(s[2 * 33], s[3 * 33]); o.z = pk2(s[4 * 33], s[5 * 33]); o.w = pk2(s[6 * 33], s[7 * 33]);
        *(u32x4*)(WT + (size_t)(drow0 + n) * K + k0 + 8 * c) = o; }
    LDS_WAIT(); asm volatile("" ::: "memory");
}
__device__ __forceinline__ int map_plain(int n) { return n; }
__device__ __forceinline__ int map_up(int n) { return n < DFF ? 256 * (n >> 7) + (n & 127) : 256 * ((n - DFF) >> 7) + 128 + ((n - DFF) & 127); }
__device__ __forceinline__ int map_sc(int n) {
    if (n < D) return (3 * (n >> 8) + 2) * 256 + (n & 255);
    const int x = n >= 2 * D, ch = n - D - x * D; return (3 * (ch >> 8) + ((ch >> 7) & 1)) * 256 + x * 128 + (ch & 127);
}
__device__ __forceinline__ void p0_tjob(int& it, int NGW, LAS float* scr, int lane, const float* W, bf16_t* WT, int K, int N, int map) {
    const int nblk = N / 32, nitems = (K / 64) * nblk;
    for (; it < nitems; it += NGW) { const int kb = it / nblk, n0 = (it % nblk) * 32; const int dr = map == 0 ? n0 : (map == 1 ? map_up(n0) : map_sc(n0));
        p0_transpose_item(W, K, N, WT, dr, scr, kb, n0, lane); }
    it -= nitems;
}
__device__ __forceinline__ void convert_layer(Frame& F, int l, int b0, int nb) {
    unsigned char* ws = F.ws;
    LAS float* scr = (LAS float*)(F.lds + F.wave * 16384);
    const int gw = (F.blk - b0) * NWAVES + F.wave, NGW = nb * NWAVES;
    int it = gw;
    if (l == 0) { p0_tjob(it, NGW, scr, F.lane, ((const float*)F.in[11]), (bf16_t*)(ws + WS_WQKV), D, 1536, 0);
        p0_tjob(it, NGW, scr, F.lane, ((const float*)F.in[12]), (bf16_t*)(ws + WS_WO), D, D, 0); }
    else if (l == 1) { p0_tjob(it, NGW, scr, F.lane, ((const float*)F.in[14]), (bf16_t*)(ws + WS_WSGI), D, 2048, 0);
        p0_tjob(it, NGW, scr, F.lane, ((const float*)F.in[18]), (bf16_t*)(ws + WS_WSGO), D, D, 0); }
    else if (l == 2) { p0_tjob(it, NGW, scr, F.lane, ((const float*)F.in[19]), (bf16_t*)(ws + WS_WSCI), D, 3072, 2);
        p0_tjob(it, NGW, scr, F.lane, ((const float*)F.in[21]), (bf16_t*)(ws + WS_WSCO), D, D, 0); }
    else p0_tjob(it, NGW, scr, F.lane, ((const float*)F.in[22]), (bf16_t*)(ws + WS_WFNO), D, D, 0);
    p0_tjob(it, NGW, scr, F.lane, ((const float*)F.in[23]) + (size_t)l * D * 2 * DFF, (bf16_t*)(ws + WS_WUP + l * WUP_BYTES), D, 2 * DFF, 1);
    p0_tjob(it, NGW, scr, F.lane, ((const float*)F.in[25]) + (size_t)l * DFF * D, (bf16_t*)(ws + WS_WDN + l * WDN_BYTES), DFF, D, 0);
    const size_t gt = (size_t)(F.blk - b0) * 512 + F.tid, NGT = (size_t)nb * 512;
    if (l == 1) { bf16_t* WSb = (bf16_t*)(ws + WS_WS); for (size_t i = gt; i < 8 * 128 * 128; i += NGT) WSb[i] = (bf16_t)f2bf(((const float*)F.in[16])[i]); }
    if (l == 3) {
        bf16_t* A1 = (bf16_t*)(ws + WS_A1);
        for (size_t i = gt; i < 2 * 256 * 256; i += NGT) { const int part = i >> 16, r = (i >> 8) & 255, k = i & 255; float v = 0.f;
            if ((r >> 7) == (k >> 7)) { const float a = 2.f * (float)(((r & 127) * (k & 127)) & 127) / 128.f; v = (part ? sinpif(a) : cospif(a)) * 0.08838834764831845f; }
            A1[i] = (bf16_t)f2bf(v); }
        bf16_t* A2P = (bf16_t*)(ws + WS_A2P);
        for (size_t i = gt; i < 256 * 512; i += NGT) { const int tp = i >> 9, k = i & 511, t = k & 255; const float a = 2.f * (float)((tp * t) & 255) / 256.f;
            A2P[i] = (bf16_t)f2bf((k < 256 ? cospif(a) : -sinpif(a)) * 0.0625f); }
        __syncthreads();
        LAS bf16_t* tab = (LAS bf16_t*)F.lds;
        for (int j = F.tid; j < 2048; j += 512) { const float a = 2.f * (float)j / 2048.f; tab[j] = (bf16_t)f2bf(cospif(a) * 0.022097086912079608f); tab[2048 + j] = (bf16_t)f2bf(-sinpif(a) * 0.022097086912079608f); }
        __syncthreads();
        bf16_t* A2S = (bf16_t*)(ws + WS_A2S);
        for (size_t i8 = gt; i8 < (size_t)2048 * 4096 / 8; i8 += NGT) { const int tp = (int)(i8 >> 9), k0 = (int)(i8 & 511) * 8, part = k0 >> 11, t0 = k0 & 2047;
            unsigned w[4];
#pragma unroll
            for (int e = 0; e < 4; ++e) { const unsigned lo = tab[part * 2048 + ((tp * (t0 + 2 * e)) & 2047)], hi = tab[part * 2048 + ((tp * (t0 + 2 * e + 1)) & 2047)]; w[e] = lo | (hi << 16); }
            *(u32x4*)(A2S + i8 * 8) = (u32x4){w[0], w[1], w[2], w[3]}; }
        __syncthreads();
    }
}
__device__ __forceinline__ void prefetch_region(Frame& F, const void* p, size_t bytes, int b0, int nb) {
    const size_t gt = (size_t)(F.blk - b0) * 512 + F.tid, NGT = (size_t)nb * 512; unsigned acc = 0;
    for (size_t i = gt * 128; i < bytes; i += NGT * 128) { const u32x4 v = *(const u32x4*)((const char*)p + i); acc += v.x ^ v.w; }
    if (acc == 0x9e3779b9u) *(volatile unsigned*)(F.ws + WS_CTL + CTL_TMO + 64) = acc;
}
__device__ __forceinline__ void mod_items(Frame& F, int lo, int hi, int b0, int nb) {
    unsigned char* ws = F.ws;
    LAS float* sv = (LAS float*)F.lds;
    LAS float* red = sv + 3 * D;
    __syncthreads();
    for (int i = F.tid; i < D; i += 512) { const float a = ((const float*)F.in[5])[i], b = ((const float*)F.in[4])[i], d = ((const float*)F.in[4])[D + i];
        sv[i] = a / (1.f + expf(-a)); sv[D + i] = b / (1.f + expf(-b)); sv[2 * D + i] = d / (1.f + expf(-d)); }
    __syncthreads();
    float* MODp = (float*)(ws + WS_MOD);
    const int kg = F.tid >> 3, cq = F.tid & 7;
    for (int it = lo + F.blk - b0; it < hi; it += nb) {
        const int l = it / 192, n0 = (it % 192) * 32;
        const float* w = ((const float*)F.in[6]) + (size_t)l * D * 6 * D + n0 + 4 * cq;
        f32x4 wv[16];
#pragma unroll
        for (int i = 0; i < 16; ++i) wv[i] = __builtin_nontemporal_load((const f32x4*)(w + (size_t)(kg + 64 * i) * 6 * D));
        f32x4 a[3] = {{0, 0, 0, 0}, {0, 0, 0, 0}, {0, 0, 0, 0}};
#pragma unroll
        for (int i = 0; i < 16; ++i) { const int k = kg + 64 * i; a[0] += sv[k] * wv[i]; a[1] += sv[D + k] * wv[i]; a[2] += sv[2 * D + k] * wv[i]; }
#pragma unroll
        for (int v = 0; v < 3; ++v)
#pragma unroll
            for (int j = 0; j < 4; ++j) { float x = a[v][j]; x += dppx<0x128>(x); a[v][j] = rows_sum(x); }
        if (F.lane < 8) {
#pragma unroll
            for (int v = 0; v < 3; ++v) *(LAS f32x4*)(red + (F.wave * 3 + v) * 32 + 4 * cq) = a[v]; }
        __syncthreads();
        if (F.tid < 96) { const int v = F.tid >> 5, cc = F.tid & 31; float s = 0.f;
#pragma unroll
            for (int g = 0; g < 8; ++g) s += red[(g * 3 + v) * 32 + cc];
            MODp[(l * 3 + v) * 6 * D + n0 + cc] = s + ((const float*)F.in[7])[l * 6 * D + n0 + cc]; }
        __syncthreads();
    }
}
__device__ __forceinline__ void p0_prologue(Frame& F) {
    unsigned char* ws = F.ws;
    mod_items(F, 0, 192, 0, F.G);
    {
        const size_t gt = (size_t)F.blk * 512 + F.tid, NGT = (size_t)F.G * 512;
        bf16_t* CK = (bf16_t*)(ws + WS_CK); bf16_t* CVT = (bf16_t*)(ws + WS_CVT);
        for (size_t i = gt; i < 2 * 512 * 256; i += NGT) { CK[i] = (bf16_t)f2bf(((const float*)F.in[2])[i]);
            const int d = i & 63, kvh = (i >> 6) & 3, j = (i >> 8) & 511, b = i >> 17; CVT[((size_t)(b * 4 + kvh) * 64 + d) * 512 + j] = (bf16_t)f2bf(((const float*)F.in[3])[i]); }
        float* rope = (float*)(ws + WS_ROPE);
        for (size_t i = gt; i < 1024; i += NGT) { const int pos = i >> 4, fi = i & 15; const float ang = (float)pos * powf(10000.f, -(float)fi / 16.f); rope[i] = cosf(ang); rope[1024 + i] = sinf(ang); }
    }
}

__device__ __forceinline__ void norm_phase(Frame& F, const float* src0, const float* src1, const float* g, const float* modl, int sh_idx, bf16_t* H) {
    const int gw = F.blk * NWAVES + F.wave, NGW = F.G * NWAVES;
    f32x4 gv[4];
#pragma unroll
    for (int j = 0; j < 4; ++j) gv[j] = *(const f32x4*)(g + 256 * j + 4 * F.lane);
    for (int row = gw; row < M; row += NGW) {
        const float* xr = row < MP ? src0 + (size_t)row * D : src1 + (size_t)(row - MP) * D;
        const float* mv = modl + (row < MP ? 0 : 1 + (row - MP) / TS) * 6 * D;
        f32x4 v[4]; float s = 0.f;
#pragma unroll
        for (int j = 0; j < 4; ++j) { v[j] = *(const f32x4*)(xr + 256 * j + 4 * F.lane); s += (v[j][0] * v[j][0] + v[j][1] * v[j][1]) + (v[j][2] * v[j][2] + v[j][3] * v[j][3]); }
        const float r = rsqrtf(wave_sum(s) * (1.f / D) + EPS);
#pragma unroll
        for (int j = 0; j < 4; ++j) { const f32x4 sh = *(const f32x4*)(mv + sh_idx * D + 256 * j + 4 * F.lane), sc = *(const f32x4*)(mv + (sh_idx + 1) * D + 256 * j + 4 * F.lane);
            const f32x4 o = v[j] * r * gv[j] * (1.f + sc) + sh;
            u32x2 w; w.x = pk2(o[0], o[1]); w.y = pk2(o[2], o[3]); *(u32x2*)(H + (size_t)row * D + 256 * j + 4 * F.lane) = w; }
    }
}
__device__ __forceinline__ void final_phase(Frame& F, const float* X, const float* g, float* out) {
    const int gw = F.blk * NWAVES + F.wave, NGW = F.G * NWAVES;
    f32x4 gv[4];
#pragma unroll
    for (int j = 0; j < 4; ++j) gv[j] = *(const f32x4*)(g + 256 * j + 4 * F.lane);
    for (int row = gw; row < M; row += NGW) {
        const float* xr = X + (size_t)row * D; f32x4 v[4]; float s = 0.f;
#pragma unroll
        for (int j = 0; j < 4; ++j) { v[j] = *(const f32x4*)(xr + 256 * j + 4 * F.lane); s += (v[j][0] * v[j][0] + v[j][1] * v[j][1]) + (v[j][2] * v[j][2] + v[j][3] * v[j][3]); }
        const float r = rsqrtf(wave_sum(s) * (1.f / D) + EPS);
#pragma unroll
        for (int j = 0; j < 4; ++j) *(f32x4*)(out + (size_t)row * D + 256 * j + 4 * F.lane) = v[j] * r * gv[j];
    }
}

constexpr int ATT_LDK = 144;
constexpr int ATT_TILE_BYTES = 2 * 64 * ATT_LDK;
struct AttTile { const bf16_t* K; const bf16_t* V; int ldk, ldv, k0, mask; };
__device__ __forceinline__ void att_tile_of(int t, bool lat, int nband, int kband0, int qc0, const bf16_t* KBs, const bf16_t* VTs, int T, const bf16_t* CKs, const bf16_t* CVTs, AttTile& o) {
    if (t < nband) { const int k0 = kband0 + 64 * t; o.K = KBs + (size_t)k0 * 256; o.V = VTs + k0; o.ldk = 256; o.ldv = T; o.k0 = k0; const int dk = k0 - qc0; o.mask = lat && (dk < -64 || dk > 64); }
    else { const int k0 = 64 * (t - nband); o.K = CKs + (size_t)k0 * 256; o.V = CVTs + k0; o.ldk = 256; o.ldv = 512; o.k0 = k0; o.mask = 0; }
}
__device__ __forceinline__ void attn_phase(Frame& F, const bf16_t* Q, const bf16_t* KB, const bf16_t* VT, const bf16_t* CK, const bf16_t* CVT, const float* sink, bf16_t* O) {
    const int fr = F.lane & 15, g4 = F.lane >> 4, tid = F.tid;
    const int lrow = tid >> 3, lchunk = tid & 7;
    LAS unsigned char* lds = F.lds;
    for (int it = F.blk; it < 768; it += F.G) {
        const bool lat = it < 256; int kvh, chunk, T, rowbase, b = 0; const bf16_t* vt;
        if (lat) { b = it >> 7; kvh = (it >> 5) & 3; chunk = it & 31; T = TS; rowbase = MP + b * TS; vt = VT + (size_t)32 * 65536 + (size_t)b * 256 * TS; }
        else { const int j = it - 256, s = j >> 4; kvh = (j >> 2) & 3; chunk = j & 3; T = TP; rowbase = s * TP; vt = VT + (size_t)s * 65536; }
        const int h = kvh * 4 + (F.wave & 3), q0 = chunk * 64 + (F.wave >> 2) * 32;
        int kband0 = 0, nband = T / 64;
        if (lat) { int lo = 64 * chunk - 128, hi = 64 * chunk + 192; lo = lo < 0 ? 0 : lo; hi = hi > T ? T : hi; kband0 = lo; nband = (hi - lo) / 64; }
        const int ntile = nband + (lat ? 8 : 0);
        const bf16_t* KBs = KB + (size_t)rowbase * 256 + kvh * 64; const bf16_t* VTs = vt + (size_t)(kvh * 64) * T;
        const bf16_t* CKs = CK + (size_t)b * 512 * 256 + kvh * 64; const bf16_t* CVTs = CVT + (size_t)((b * 4 + kvh) * 64) * 512;
        bf16x8 Qf[2][2];
#pragma unroll
        for (int qg = 0; qg < 2; ++qg)
#pragma unroll
            for (int ds = 0; ds < 2; ++ds) Qf[qg][ds] = *(const bf16x8*)(Q + (size_t)(rowbase + q0 + 16 * qg + fr) * D + h * 64 + 32 * ds + 8 * g4);
        float mrun[2], lrun[2]; f32x4 Oa[2][4];
#pragma unroll
        for (int qg = 0; qg < 2; ++qg) { mrun[qg] = sink[h] * 1.4426950408889634f; lrun[qg] = 1.f;
#pragma unroll
            for (int db = 0; db < 4; ++db) Oa[qg][db] = (f32x4){0.f, 0.f, 0.f, 0.f}; }
        AttTile tl; att_tile_of(0, lat, nband, kband0, 64 * chunk, KBs, VTs, T, CKs, CVTs, tl);
        u32x4 rk = *(const u32x4*)(tl.K + (size_t)lrow * tl.ldk + lchunk * 8), rv = *(const u32x4*)(tl.V + (size_t)lrow * tl.ldv + lchunk * 8);
        __syncthreads();
        *(LAS u32x4*)(lds + lrow * ATT_LDK + lchunk * 16) = rk; *(LAS u32x4*)(lds + 64 * ATT_LDK + lrow * ATT_LDK + lchunk * 16) = rv;
        __syncthreads();
#pragma unroll 1
        for (int t = 0; t < ntile; ++t) {
            const int cur_k0 = tl.k0, cur_mask = tl.mask;
            if (t + 1 < ntile) { att_tile_of(t + 1, lat, nband, kband0, 64 * chunk, KBs, VTs, T, CKs, CVTs, tl);
                rk = *(const u32x4*)(tl.K + (size_t)lrow * tl.ldk + lchunk * 8); rv = *(const u32x4*)(tl.V + (size_t)lrow * tl.ldv + lchunk * 8); }
            const LAS unsigned char* kb_ = lds + (t & 1) * ATT_TILE_BYTES; const LAS unsigned char* vb_ = kb_ + 64 * ATT_LDK;
            {
                bf16x8 Kf[2][2][2], Vf[2][4];
#pragma unroll
                for (int sub = 0; sub < 2; ++sub) {
#pragma unroll
                    for (int kb = 0; kb < 2; ++kb)
#pragma unroll
                        for (int ds = 0; ds < 2; ++ds) Kf[sub][kb][ds] = *(const LAS bf16x8*)(kb_ + (32 * sub + 16 * kb + fr) * ATT_LDK + 64 * ds + 16 * g4);
#pragma unroll
                    for (int db = 0; db < 4; ++db) { const LAS unsigned char* vp = vb_ + (16 * db + fr) * ATT_LDK + 64 * sub + 8 * g4; const u32x2 lo = *(const LAS u32x2*)vp, hi = *(const LAS u32x2*)(vp + 32);
                        Vf[sub][db] = __builtin_bit_cast(bf16x8, (u32x4){lo.x, lo.y, hi.x, hi.y}); }
                }
                const float c = 0.125f * 1.4426950408889634f;
                f32x4 S[2][2][2];
#pragma unroll
                for (int qg = 0; qg < 2; ++qg)
#pragma unroll
                    for (int sub = 0; sub < 2; ++sub)
#pragma unroll
                        for (int kb = 0; kb < 2; ++kb) { S[qg][sub][kb] = __builtin_amdgcn_mfma_f32_16x16x32_bf16(Kf[sub][kb][0], Qf[qg][0], (f32x4){0.f, 0.f, 0.f, 0.f}, 0, 0, 0);
                            S[qg][sub][kb] = __builtin_amdgcn_mfma_f32_16x16x32_bf16(Kf[sub][kb][1], Qf[qg][1], S[qg][sub][kb], 0, 0, 0); }
                float mnew[2], rs[2];
#pragma unroll
                for (int qg = 0; qg < 2; ++qg) {
                    const int qpos = q0 + 16 * qg + fr;
                    if (cur_mask) {
#pragma unroll
                        for (int sub = 0; sub < 2; ++sub)
#pragma unroll
                            for (int kb = 0; kb < 2; ++kb)
#pragma unroll
                                for (int r = 0; r < 4; ++r) { const int d = cur_k0 + 32 * sub + 16 * kb + 4 * g4 + r - qpos; if (d > 128 || d < -128) S[qg][sub][kb][r] = -1e30f; }
                    }
                    float mx = -1e30f;
#pragma unroll
                    for (int sub = 0; sub < 2; ++sub)
#pragma unroll
                        for (int kb = 0; kb < 2; ++kb) mx = fmaxf(fmaxf(mx, fmaxf(S[qg][sub][kb][0], S[qg][sub][kb][1])), fmaxf(S[qg][sub][kb][2], S[qg][sub][kb][3]));
                    mx = rows_max(mx) * c;
                    mnew[qg] = fmaxf(mrun[qg], mx);
                    float r_ = 0.f;
#pragma unroll
                    for (int sub = 0; sub < 2; ++sub)
#pragma unroll
                        for (int kb = 0; kb < 2; ++kb)
#pragma unroll
                            for (int r = 0; r < 4; ++r) { const float p = fast_exp2(__builtin_fmaf(S[qg][sub][kb][r], c, -mnew[qg])); S[qg][sub][kb][r] = p; r_ += p; }
                    rs[qg] = rows_sum(r_);
                }
                if (__builtin_amdgcn_ballot_w64(mnew[0] > mrun[0] || mnew[1] > mrun[1]) != 0ull) {
#pragma unroll
                    for (int qg = 0; qg < 2; ++qg) { const float alpha = fast_exp2(mrun[qg] - mnew[qg]); lrun[qg] *= alpha;
#pragma unroll
                        for (int db = 0; db < 4; ++db) Oa[qg][db] = Oa[qg][db] * alpha; }
                }
#pragma unroll
                for (int qg = 0; qg < 2; ++qg) { lrun[qg] += rs[qg]; mrun[qg] = mnew[qg];
#pragma unroll
                    for (int sub = 0; sub < 2; ++sub) {
                        u32x4 pw; pw.x = cvt_pk_bf16(S[qg][sub][0][0], S[qg][sub][0][1]); pw.y = cvt_pk_bf16(S[qg][sub][0][2], S[qg][sub][0][3]); pw.z = cvt_pk_bf16(S[qg][sub][1][0], S[qg][sub][1][1]); pw.w = cvt_pk_bf16(S[qg][sub][1][2], S[qg][sub][1][3]);
                        const bf16x8 Pf = __builtin_bit_cast(bf16x8, pw);
#pragma unroll
                        for (int db = 0; db < 4; ++db) Oa[qg][db] = __builtin_amdgcn_mfma_f32_16x16x32_bf16(Vf[sub][db], Pf, Oa[qg][db], 0, 0, 0); } }
            }
            if (t + 1 < ntile) { LAS unsigned char* nb = lds + ((t + 1) & 1) * ATT_TILE_BYTES;
                *(LAS u32x4*)(nb + lrow * ATT_LDK + lchunk * 16) = rk; *(LAS u32x4*)(nb + 64 * ATT_LDK + lrow * ATT_LDK + lchunk * 16) = rv; }
            __syncthreads();
        }
#pragma unroll
        for (int qg = 0; qg < 2; ++qg) { const float inv = 1.f / lrun[qg];
#pragma unroll
            for (int dp = 0; dp < 2; ++dp) { u32x2 w[2];
#pragma unroll
                for (int k = 0; k < 2; ++k) { const f32x4 o = Oa[qg][2 * dp + k] * inv; w[k].x = cvt_pk_bf16(o[0], o[1]); w[k].y = cvt_pk_bf16(o[2], o[3]); }
                *(u32x4*)(O + (size_t)(rowbase + q0 + 16 * qg + fr) * D + h * 64 + 32 * dp + 4 * g4 + ((g4 & 1) ? 12 : 0)) = merge_quads16(w[0], w[1]); } }
    }
}

__device__ __forceinline__ void sgu_phase(Frame& F, const bf16_t* U, const bf16_t* V, const f32x2* STATS, const float* ln_g, const bf16_t* WSb, const float* b_s, bf16_t* UM) {
    constexpr int LDT = 136;
    LAS bf16_t* LT = (LAS bf16_t*)F.lds;
    LAS f32x2* ST = (LAS f32x2*)(F.lds + 128 * LDT * 2);
    const int fr = F.lane & 15, g4 = F.lane >> 4;
    for (int it = F.blk; it < 768; it += F.G) {
        const int ch = it >> 3, g = it & 7, r0 = ch * 128;
        if (F.tid < 128) { const f32x2* sp = STATS + (size_t)(r0 + F.tid) * 16; float s1 = 0.f, s2 = 0.f;
#pragma unroll
            for (int k = 0; k < 16; ++k) { const f32x2 p = sp[k]; s1 += p.x; s2 += p.y; }
            const float mu = s1 * (1.f / D), var = s2 * (1.f / D) - mu * mu; ST[F.tid] = (f32x2){mu, rsqrtf(fmaxf(var, 0.f) + EPS)}; }
        __syncthreads();
#pragma unroll
        for (int i = 0; i < 4; ++i) { const int q = F.tid + 512 * i, r = q & 127, c8 = (q >> 7) * 8;
            const u32x4 raw = *(const u32x4*)(V + (size_t)(r0 + r) * D + g * 128 + c8); const f32x2 st = ST[r];
            const f32x4 ga = *(const f32x4*)(ln_g + g * 128 + c8), gb = *(const f32x4*)(ln_g + g * 128 + c8 + 4);
            const unsigned rw[4] = {raw.x, raw.y, raw.z, raw.w};
#pragma unroll
            for (int e = 0; e < 8; ++e) { const float x = bf2f((unsigned short)(e & 1 ? rw[e >> 1] >> 16 : rw[e >> 1] & 0xffff)); const float gg = e < 4 ? ga[e & 3] : gb[e & 3];
                LT[(c8 + e) * LDT + r] = (bf16_t)f2bf((x - st.x) * st.y * gg); } }
        __syncthreads();
        f32x4 acc[8];
#pragma unroll
        for (int cb = 0; cb < 8; ++cb) acc[cb] = (f32x4){0.f, 0.f, 0.f, 0.f};
        const int p = 16 * F.wave + fr;
#pragma unroll
        for (int ks = 0; ks < 4; ++ks) { const bf16x8 bw = *(const bf16x8*)(WSb + (size_t)(g * 128 + p) * 128 + 32 * ks + 8 * g4);
#pragma unroll
            for (int cb = 0; cb < 8; ++cb) { const bf16x8 av = *(const LAS bf16x8*)(LT + (16 * cb + fr) * LDT + 32 * ks + 8 * g4); acc[cb] = __builtin_amdgcn_mfma_f32_16x16x32_bf16(av, bw, acc[cb], 0, 0, 0); } }
        const float bsv = b_s[g * 128 + p];
#pragma unroll
        for (int cb = 0; cb < 8; ++cb) { const size_t off = (size_t)(r0 + p) * D + g * 128 + 16 * cb + 4 * g4; const u32x2 uw = *(const u32x2*)(U + off);
            const float u0 = bf2f((unsigned short)(uw.x & 0xffff)), u1 = bf2f((unsigned short)(uw.x >> 16)), u2 = bf2f((unsigned short)(uw.y & 0xffff)), u3 = bf2f((unsigned short)(uw.y >> 16));
            u32x2 w; w.x = cvt_pk_bf16(u0 * (acc[cb][0] + bsv), u1 * (acc[cb][1] + bsv)); w.y = cvt_pk_bf16(u2 * (acc[cb][2] + bsv), u3 * (acc[cb][3] + bsv)); *(u32x2*)(UM + off) = w; }
        __syncthreads();
    }
}

struct Args { const float* in[26]; float* out; unsigned char* ws; int ph_lo, ph_hi; };
__global__ void __launch_bounds__(NWAVES * 64, 2) mk_fwd(const Args args) {
    extern __shared__ __attribute__((aligned(16))) unsigned char lds_raw[];
    Frame F;
    F.lds = (LAS unsigned char*)lds_raw;
    const int wave0 = __builtin_amdgcn_readfirstlane((int)threadIdx.x >> 6);
    F.wave = wave0; F.lane = pg8::lane_id(); F.tid = wave0 * 64 + F.lane;
    const int grid0 = gridDim.x, blk0 = blockIdx.x; F.G = grid0; F.blk = blk0;
    F.in = (const __attribute__((address_space(4))) cfp_t*)__builtin_amdgcn_kernarg_segment_ptr();
    F.out = args.out; F.ws = args.ws;
    unsigned char* ws = args.ws;
    volatile LAS unsigned* MISC = (volatile LAS unsigned*)(F.lds + MISC_OFF);
    if (F.tid < 32) MISC[F.tid] = 0u;
    __syncthreads();
    const int lo = args.ph_lo, hi = args.ph_hi;
    XcdBarrier bar; bar.bar = (unsigned*)(ws + WS_CTL); bar.x = 0; bar.st = nullptr;
    if (hi - lo > 1) bar = xcd_barrier_post((unsigned*)(ws + WS_CTL), MISC + 8, F.tid == 0);
    LAS float* XCH = (LAS float*)(F.lds + XCH_OFF);
#define CASE_BEGIN() { int b_ = blk0, w_ = wave0, g_ = grid0; asm volatile("" : "+s"(b_), "+s"(w_), "+s"(g_)); F.blk = b_; F.wave = w_; F.G = g_; } frame_refresh(F); unsigned long long ws_ = (unsigned long long)args.ws, in_ = (unsigned long long)__builtin_amdgcn_kernarg_segment_ptr(); asm volatile("" : "+s"(ws_), "+s"(in_)); \
        unsigned char* ws = (unsigned char*)(GAS unsigned char*)ws_; F.ws = ws; F.in = (const __attribute__((address_space(4))) cfp_t*)in_; \
        float* X = (float*)(ws + WS_X); bf16_t* H = (bf16_t*)(ws + WS_H); bf16_t* H2 = (bf16_t*)(ws + WS_H2); bf16_t* HN = (bf16_t*)(ws + WS_HN); (void)HN; \
        const float* modl = (const float*)(ws + WS_MOD) + l * 3 * 6 * D; const float* xs0 = l == 0 ? ((const float*)F.in[0]) : X; const float* xs1 = l == 0 ? ((const float*)F.in[1]) : X + (size_t)MP * D; \
        (void)X; (void)H; (void)H2; (void)modl; (void)xs0; (void)xs1
#pragma unroll 1
    for (int ph = lo; ph < hi; ++ph) {
        int l = 0, kind;
        if (ph == 0) kind = 0; else if (ph == 1) kind = 1;
        else { l = ph < 7 ? 0 : ph < 12 ? 1 : ph < 16 ? 2 : 3; const int j = ph - (l == 0 ? 2 : l == 1 ? 7 : l == 2 ? 12 : 16), n = l == 2 ? 1 : 2;
            kind = j < n ? (l == 0 ? 2 + j : l == 1 ? 4 + j : l == 2 ? 6 : 7 + j) : j == n ? 9 : j == n + 1 ? 10 : 11; }
        const int reps = (kind == MK_REP_KIND) ? 1 + MK_REP_N : 1;
        const bool tp_here = MK_TP && ph == MK_TP_PH && blk0 == 0;
        unsigned long long tp_r0 = 0, tp_c0 = 0; if (tp_here) { tp_r0 = __builtin_amdgcn_s_memrealtime(); tp_c0 = __builtin_amdgcn_s_memtime(); }
#pragma unroll 1
        for (int rep = 0; rep < reps; ++rep) {
        if (rep > 0) xcd_barrier(bar, wave0 == 0 && pg8::lane_id() == 0);
        switch (kind) {
        case 0: if (EN(0)) { CASE_BEGIN(); p0_prologue(F); } break;
        case 1: if (EN(1)) { CASE_BEGIN(); norm_phase(F, xs0, xs1, ((const float*)F.in[8]), modl, 0, HN);
                if (rep == 0) convert_layer(F, 0, 0, F.G); } break;
        case 2: if (EN(2)) { CASE_BEGIN(); Order<64, 6, 0, D, D, 192> S; S.init(F.G, F.blk, HN, ws + WS_WQKV);
                EpiQKV E{{ws, l, 0}};
                pg8::gemm_phase<D, D, D / 64, 192>(F.lds, S, E, F.wave, tp_here);
                if (MK_PREFETCH && rep == 0 && F.blk >= 128) { frame_refresh(F); prefetch_region(F, ws + WS_WO, 2 * MiB, 128, F.G - 128); prefetch_region(F, ws + WS_WUP, WUP_BYTES, 128, F.G - 128); } } break;
        case 3: if (EN(3)) { CASE_BEGIN(); attn_phase(F, (const bf16_t*)(ws + WS_Q), (const bf16_t*)(ws + WS_KB), (const bf16_t*)(ws + WS_VT), (const bf16_t*)(ws + WS_CK), (const bf16_t*)(ws + WS_CVT), ((const float*)F.in[13]), H); } break;
        case 4: if (EN(4)) { CASE_BEGIN(); Order<64, 8, 0, D, D, 192> S; S.init(F.G, F.blk, HN, ws + WS_WSGI);
                EpiSgu E{{ws, l, 0}};
                pg8::gemm_phase<D, D, D / 64, 192>(F.lds, S, E, F.wave, tp_here);
                } break;
        case 5: if (EN(5)) { CASE_BEGIN(); sgu_phase(F, (const bf16_t*)(ws + WS_U), (const bf16_t*)(ws + WS_V), (const f32x2*)(ws + WS_STATS), ((const float*)F.in[15]), (const bf16_t*)(ws + WS_WS), ((const float*)F.in[17]), H); } break;
        case 6: if (EN(6)) { CASE_BEGIN(); OrderSc S{F.blk, (const char*)HN, (const char*)(ws + WS_WSCI)};
                EpiSc E{{ws, l, F.blk}};
                pg8::gemm_phase<D, D, D / 64>(F.lds, S, E, F.wave, tp_here);
                if (MK_PREFETCH && rep == 0 && F.blk >= 200) { frame_refresh(F); prefetch_region(F, ws + WS_WSCO, 2 * MiB, 200, F.G - 200); prefetch_region(F, ws + WS_WUP + 2 * WUP_BYTES, WUP_BYTES, 200, F.G - 200); } } break;
        case 7: if (EN(7)) { CASE_BEGIN(); OrderFn1 S{F.G, F.blk, (const char*)(ws + WS_A1), (const char*)HN};
                EpiFn1 E{{ws, l, 0}};
                pg8::gemm_phase<256, D, 4>(F.lds, S, E, F.wave, tp_here);
                if (MK_PREFETCH && F.blk >= 128) { frame_refresh(F); prefetch_region(F, ws + WS_A2S, 16 * MiB, 128, F.G - 128); prefetch_region(F, ws + WS_WUP + 3 * WUP_BYTES, WUP_BYTES, 128, F.G - 128); } } break;
        case 8: if (EN(8)) { CASE_BEGIN();
                if (F.blk < 128) { EpiBf16<128> E{{ws, l, 0}}; OrderFn2 S{F.blk, 1, (const char*)(ws + WS_A2S), (const char*)(ws + WS_YT)}; pg8::gemm_phase<2 * TS, 2 * TS, 2 * TS / 64, 128>(F.lds, S, E, F.wave, tp_here); }
                else { EpiBf16<256> E{{ws, l, 0}}; OrderFn2 S{F.blk, 0, (const char*)(ws + WS_A2P), (const char*)(ws + WS_YT)}; pg8::gemm_phase<2 * TP, 2 * TP, 2 * TP / 64>(F.lds, S, E, F.wave, tp_here);
                    if (MK_PREFETCH) { frame_refresh(F); prefetch_region(F, ws + WS_WFNO, 2 * MiB, 128, F.G - 128); } } } break;
        case 9: if (EN(9)) { CASE_BEGIN(); const bf16_t* mix_in = l == 2 ? H2 : H;
                const bf16_t* wout = (const bf16_t*)(ws + (l == 0 ? WS_WO : l == 1 ? WS_WSGO : l == 2 ? WS_WSCO : WS_WFNO));
                Order<64, 4, 0, D, D, 192> S; S.init(F.G, F.blk, mix_in, wout);
                EpiResNorm<false> E{{ws, l, rep ? 2 : 0}};
                if (MK_REP_SHORTK && MK_REP_KIND == 9 && rep > 0) { pg8::gemm_phase<D, D, 4, 192>(F.lds, S, E, F.wave, tp_here); break; }
                pg8::gemm_phase<D, D, D / 64, 192>(F.lds, S, E, F.wave, tp_here);
                } break;
        case 10: if (EN(11)) { CASE_BEGIN(); Order<50, 22, 1, D, D> S; S.init(F.G, F.blk, HN, ws + WS_WUP + l * WUP_BYTES);
                if (MK_REP_NULL && rep > 0) { EpiNull E{{ws, l, 0}}; pg8::gemm_phase<D, D, D / 64>(F.lds, S, E, F.wave, tp_here); }
                else if (MK_REP_SHORTK && MK_REP_KIND == 10 && rep > 0) { EpiUp E{{ws, l, 0}}; pg8::gemm_phase<D, D, 4>(F.lds, S, E, F.wave, tp_here); }
                else { EpiUp E{{ws, l, 0}};
                pg8::gemm_phase<D, D, D / 64>(F.lds, S, E, F.wave, tp_here); }
                if (rep == 0 && F.blk >= 76) { frame_refresh(F);
                    if (l < 3) { mod_items(F, 192 * (l + 1), 192 * (l + 2), 76, F.G - 76); convert_layer(F, l + 1, 76, F.G - 76); }
                    if (MK_PREFETCH) { prefetch_region(F, ws + WS_WDN + l * WDN_BYTES, WDN_BYTES, 76, F.G - 76); } } } break;
        default: if (EN(12)) { CASE_BEGIN(); Order<64, 4, 0, DFF, DFF, 192> S; S.init(F.G, F.blk, ws + WS_ACT, ws + WS_WDN + l * WDN_BYTES);
                if (l < 3) { EpiResNorm<false> E{{ws, l, 1 | (rep ? 2 : 0)}}; pg8::gemm_phase<DFF, DFF, DFF / 64, 192>(F.lds, S, E, F.wave, tp_here); }
                else { EpiResNorm<true> E{{ws, l, 1 | (rep ? 2 : 0)}}; pg8::gemm_phase<DFF, DFF, DFF / 64, 192>(F.lds, S, E, F.wave, tp_here); } } break;
        }
        }
        if (tp_here && wave0 == 0 && pg8::lane_id() == 0) { const unsigned long long r1 = __builtin_amdgcn_s_memrealtime(), c1 = __builtin_amdgcn_s_memtime();
            if (MK_TP == 1) MISC[16] = (unsigned)(r1 - tp_r0);
            if (MK_TP == 3) MISC[16] = (unsigned)((c1 - tp_c0) * 10ull / (r1 - tp_r0)) * 10u; }
        if (ph + 1 < hi) xcd_barrier(bar, wave0 == 0 && pg8::lane_id() == 0);
    }
    if (MK_TP && blk0 == 0 && wave0 == 0) { const unsigned v = MISC[16] * (MK_TP == 2 ? 4u : 1u); const unsigned long long t0 = __builtin_amdgcn_s_memrealtime();
        while (__builtin_amdgcn_s_memrealtime() - t0 < v) __builtin_amdgcn_s_sleep(8); }
}

extern "C" void kernel_launch(void* const* d_in, const int* in_sizes, int n_in, void* d_out, int out_size, void* d_ws, size_t ws_size, hipStream_t stream) {
    static int grid = 0;
    if (grid == 0) {
        if (n_in != 26 || ws_size < WS_TOTAL + (MK_REP_N ? (size_t)73 * MiB : 0)) { fprintf(stderr, "kernel_launch: unexpected n_in %d / ws %zu (need %zu)\n", n_in, ws_size, (size_t)WS_TOTAL); grid = -1; return; }
        int dev = 0, cus = 0;
        if (hipGetDevice(&dev) != hipSuccess || hipDeviceGetAttribute(&cus, hipDeviceAttributeMultiprocessorCount, dev) != hipSuccess) { grid = -1; return; }
        if (hipFuncSetAttribute((const void*)mk_fwd, hipFuncAttributeMaxDynamicSharedMemorySize, LDS_BYTES) != hipSuccess) { fprintf(stderr, "kernel_launch: hipFuncSetAttribute failed\n"); grid = -1; return; }
        (void)hipGetLastError();
        grid = cus;
    }
    if (grid < 0) return;
    (void)hipMemsetAsync((char*)d_ws + WS_CTL, 0, CTL_ZERO_BYTES, stream);
    Args a{};
    for (int i = 0; i < 26; ++i) a.in[i] = (const float*)d_in[i];
    a.out = (float*)d_out; a.ws = (unsigned char*)d_ws;
#if MK_PER_PHASE
    for (int p = MK_PH_LO; p < MK_PH_HI; ++p) { a.ph_lo = p; a.ph_hi = p + 1; hipLaunchKernelGGL(mk_fwd, dim3(grid), dim3(NWAVES * 64), LDS_BYTES, stream, a); }
#else
    a.ph_lo = MK_PH_LO; a.ph_hi = MK_PH_HI;
    hipLaunchKernelGGL(mk_fwd, dim3(grid), dim3(NWAVES * 64), LDS_BYTES, stream, a);
#endif
}
```

```cpp
#include <hip/hip_runtime.h>
#include <cstdio>

#define LAS __attribute__((address_space(3)))
#define GAS __attribute__((address_space(1)))
typedef unsigned short bf16_t;
typedef short bf16x8 __attribute__((ext_vector_type(8)));
typedef float f32x4 __attribute__((ext_vector_type(4)));
typedef float f32x2 __attribute__((ext_vector_type(2)));
typedef unsigned u32x4 __attribute__((ext_vector_type(4)));
typedef unsigned u32x2 __attribute__((ext_vector_type(2)));

constexpr int D = 1024, MP = 8192, MS = 4096, M = MP + MS, DFF = 2816, TS = 2048, TP = 256;
constexpr float EPS = 1e-6f;
constexpr int NWAVES = 8;
#ifndef MK_PER_PHASE
#define MK_PER_PHASE 0
#endif
#ifndef MK_PH_LO
#define MK_PH_LO 0
#endif
#ifndef MK_PH_HI
#define MK_PH_HI 21
#endif
#ifndef MK_MASK
#define MK_MASK 0xffffffffu
#endif
#define EN(b) (((MK_MASK) >> (b)) & 1u)
#ifndef MK_REP_KIND
#define MK_REP_KIND -1
#endif
#ifndef MK_REP_N
#define MK_REP_N 0
#endif
#ifndef MK_REP_NULL
#define MK_REP_NULL 0
#endif
#ifndef MK_REP_SHORTK
#define MK_REP_SHORTK 0
#endif
#ifndef MK_PREFETCH
#define MK_PREFETCH 1
#endif
#ifndef MK_TP
#define MK_TP 0
#endif
#ifndef MK_TP_PH
#define MK_TP_PH 10
#endif

namespace pg8 {
constexpr int BM = 256, BK = 64, HALF = 128, HTB = HALF * BK * 2, STAGE_BYTES = 8 * HTB, NXCD = 8, WGM = 8;
__host__ __device__ __forceinline__ int lds_byte(int r, int c) { const int st = (r >> 4) * 2 + (c >> 5), rr = r & 15, cc = c & 31, ob = rr * 64 + cc * 2; return st * 1024 + (ob ^ (((ob >> 9) & 1) << 5)); }
__host__ __device__ __forceinline__ void stage_rc(int b, int& R, int& C) { const int st = b / 1024, sb = b % 1024, swz = sb ^ (((sb >> 9) & 1) << 5); R = (st >> 1) * 16 + swz / 64; C = (st & 1) * 32 + (swz % 64) / 2; }
__host__ __device__ __forceinline__ int perm32(int rho) { const int n = rho >> 4, i = rho & 15; return 8 * (i >> 2) + 4 * n + (i & 3); }

struct Unit { int pm, pn, row0; const char* a; const char* b; };
struct Cfg { int lda, ldb, nt; };

__device__ __forceinline__ int lane_id() { return (int)__builtin_amdgcn_mbcnt_hi(~0u, __builtin_amdgcn_mbcnt_lo(~0u, 0u)); }
__device__ __forceinline__ unsigned cvt_pk_bf16(float lo, float hi) { unsigned r; asm volatile("v_cvt_pk_bf16_f32 %0, %1, %2" : "=v"(r) : "v"(lo), "v"(hi)); return r; }

template <int LDA, int LDB, int NT, int ROWS = 256, class Epi, class Sched>
__device__ __forceinline__ void gemm_phase(LAS unsigned char* lds, const Sched& S, const Epi& E, int wid, bool tp_on = false) {
    constexpr Cfg g{LDA, LDB, NT};
    int lane_ = lane_id(); asm volatile("" : "+v"(lane_));
    const int lane = lane_, tid = wid * 64 + lane, wr = wid >> 2, wc = wid & 3, fr = lane & 15, fq = lane >> 4;
    const int nt = g.nt;
    unsigned voffA[2], voffB[2];
#pragma unroll
    for (int i = 0; i < 2; ++i) { int R, C; stage_rc(tid * 16 + i * 8192, R, C); const int Rb = Epi::PERM ? ((R & ~31) + perm32(R & 31)) : R;
        voffA[i] = (unsigned)(R * g.lda + C) * 2u; voffB[i] = (unsigned)(Rb * g.ldb + C) * 2u; }
    unsigned voffA1[2]; voffA1[0] = ROWS == 128 ? 0u : voffA[0]; voffA1[1] = ROWS == 256 ? voffA[1] : 0u;
    const size_t kstep = (size_t)(BK * 2);
    const size_t hstepA = (size_t)HALF * g.lda * 2, hstepB = (size_t)HALF * g.ldb * 2;
    const unsigned ldsw = (unsigned)wid * 1024u;
    constexpr int NM1 = ROWS == 192 ? 2 : ROWS == 128 ? 0 : 4;
    const int aoff = lds_byte(wr * 64 + fr, fq * 8), boff = lds_byte(wc * 32 + fr, fq * 8), aoff1 = ROWS == 192 ? lds_byte(wr * 32 + fr, fq * 8) : aoff;
#define PG8_SA(b, h) (((b) * 2 + (h)) * HTB)
#define PG8_SB(b, h) ((4 + (b) * 2 + (h)) * HTB)
#define PG8_STAGE(bufoff, gbase, voff) do { _Pragma("unroll") for (int _i = 0; _i < 2; ++_i) { unsigned _vo = (voff)[_i]; asm volatile("" : "+v"(_vo)); \
        __builtin_amdgcn_global_load_lds((const unsigned*)((const char*)(gbase) + _vo), (LAS unsigned*)(lds + (bufoff) + ldsw + _i * 8192), 16, 0, 0); } } while (0)
#define PG8_LDA(dst, b, h) do { _Pragma("unroll") for (int m = 0; m < 4; ++m) _Pragma("unroll") for (int k = 0; k < 2; ++k) dst[m][k] = *(const LAS bf16x8*)(lds + PG8_SA(b, h) + aoff + m * 2048 + k * 1024); } while (0)
#define PG8_LDA1(dst, b) do { _Pragma("unroll") for (int m = 0; m < NM1; ++m) _Pragma("unroll") for (int k = 0; k < 2; ++k) dst[m][k] = *(const LAS bf16x8*)(lds + PG8_SA(b, 1) + aoff1 + m * 2048 + k * 1024); } while (0)
#define PG8_LDB(dst, b, h) do { _Pragma("unroll") for (int n = 0; n < 2; ++n) _Pragma("unroll") for (int k = 0; k < 2; ++k) dst[n][k] = *(const LAS bf16x8*)(lds + PG8_SB(b, h) + boff + n * 2048 + k * 1024); } while (0)
#define PG8_MMA(ai, bj, At, Bt) do { __builtin_amdgcn_s_setprio(1); _Pragma("unroll") for (int m = 0; m < 4; ++m) _Pragma("unroll") for (int n = 0; n < 2; ++n) _Pragma("unroll") for (int k = 0; k < 2; ++k) \
        acc[ai][bj][m][n] = __builtin_amdgcn_mfma_f32_16x16x32_bf16(Bt[n][k], At[m][k], acc[ai][bj][m][n], 0, 0, 0); __builtin_amdgcn_s_setprio(0); } while (0)
#define PG8_MMA1(bj, At, Bt) do { __builtin_amdgcn_s_setprio(1); _Pragma("unroll") for (int m = 0; m < NM1; ++m) _Pragma("unroll") for (int n = 0; n < 2; ++n) _Pragma("unroll") for (int k = 0; k < 2; ++k) \
        acc[1][bj][m][n] = __builtin_amdgcn_mfma_f32_16x16x32_bf16(Bt[n][k], At[m][k], acc[1][bj][m][n], 0, 0, 0); __builtin_amdgcn_s_setprio(0); } while (0)
#define PG8_WAIT_V(n) asm volatile("s_waitcnt vmcnt(" #n ")" ::: "memory")
#define PG8_WAIT_L(n) asm volatile("s_waitcnt lgkmcnt(" #n ")" ::: "memory")
#define PG8_BAR __builtin_amdgcn_s_barrier()
#define PG8_SCHED __builtin_amdgcn_sched_barrier(0)
    Unit cur, nxt; int ui = 0;
    if (!S.next(0, cur)) return;
    f32x4 acc[2][2][4][2];
#pragma unroll
    for (int a = 0; a < 2; ++a)
#pragma unroll
        for (int b = 0; b < 2; ++b)
#pragma unroll
            for (int m = 0; m < 4; ++m)
#pragma unroll
                for (int n = 0; n < 2; ++n) acc[a][b][m][n] = (f32x4){0.f, 0.f, 0.f, 0.f};
    bf16x8 At[4][2], B0[2][2], B1[2][2];
    const char* cA = cur.a; const char* cB = cur.b;
    PG8_STAGE(PG8_SB(0, 0), cB, voffB); PG8_STAGE(PG8_SB(0, 1), cB + hstepB, voffB); PG8_STAGE(PG8_SA(0, 0), cA, voffA); PG8_STAGE(PG8_SA(0, 1), cA + hstepA, voffA1);
    if (wr == 1) PG8_BAR;
    PG8_WAIT_V(2); PG8_BAR;
    PG8_STAGE(PG8_SB(1, 0), cB + kstep, voffB); PG8_STAGE(PG8_SA(1, 0), cA + kstep, voffA); PG8_STAGE(PG8_SB(1, 1), cB + hstepB + kstep, voffB);
    PG8_WAIT_V(6); PG8_BAR;
    for (;;) {
        const bool has_next = S.next(ui + 1, nxt);
        const char* nA = has_next ? nxt.a : cA; const char* nB = has_next ? nxt.b : cB;
        for (int t = 0; t < nt; t += 2) {
            const bool last = (t == nt - 2);
            const char* a1 = cA + (size_t)(t + 1) * kstep;
            const char* a2 = last ? nA : cA + (size_t)(t + 2) * kstep; const char* b2 = last ? nB : cB + (size_t)(t + 2) * kstep;
            const char* a3 = a2 + kstep; const char* b3 = b2 + kstep;
            PG8_LDB(B0, 0, 0); PG8_LDB(B1, 0, 1); PG8_SCHED; PG8_LDA(At, 0, 0); PG8_STAGE(PG8_SA(1, 1), a1 + hstepA, voffA1);
            PG8_WAIT_V(8); PG8_WAIT_L(0); PG8_BAR; PG8_MMA(0, 0, At, B0); PG8_MMA(0, 1, At, B1); PG8_BAR; PG8_SCHED;
            PG8_LDA1(At, 0); PG8_STAGE(PG8_SB(0, 0), b2, voffB); PG8_STAGE(PG8_SB(0, 1), b2 + hstepB, voffB); PG8_STAGE(PG8_SA(0, 0), a2, voffA);
            PG8_WAIT_V(8); PG8_WAIT_L(0); PG8_BAR; PG8_MMA1(0, At, B0); PG8_MMA1(1, At, B1); PG8_BAR; PG8_SCHED;
            PG8_LDB(B0, 1, 0); PG8_LDB(B1, 1, 1); PG8_SCHED; PG8_LDA(At, 1, 0); PG8_STAGE(PG8_SA(0, 1), a2 + hstepA, voffA1);
            PG8_WAIT_V(8); PG8_WAIT_L(0); PG8_BAR; PG8_MMA(0, 0, At, B0); PG8_MMA(0, 1, At, B1); PG8_BAR; PG8_SCHED;
            PG8_LDA1(At, 1); PG8_STAGE(PG8_SB(1, 0), b3, voffB); PG8_STAGE(PG8_SB(1, 1), b3 + hstepB, voffB); PG8_STAGE(PG8_SA(1, 0), a3, voffA);
            PG8_WAIT_V(8); PG8_WAIT_L(0); PG8_BAR; PG8_MMA1(0, At, B0); PG8_MMA1(1, At, B1); PG8_BAR; PG8_SCHED;
        }
        if (wr == 0) PG8_BAR;
        if (MK_TP == 2) { const unsigned long long t0_ = __builtin_amdgcn_s_memrealtime(); E(acc, cur, wid, ui); const unsigned long long t1_ = __builtin_amdgcn_s_memrealtime();
            if (wid == 0 && lane == 0 && tp_on) *(volatile LAS unsigned*)(lds + 131072 + 8192 + 320 + 4 * 16) += (unsigned)(t1_ - t0_); }
        else E(acc, cur, wid, ui);
        if (!has_next) break;
#pragma unroll
        for (int a = 0; a < 2; ++a)
#pragma unroll
            for (int b = 0; b < 2; ++b)
#pragma unroll
                for (int m = 0; m < 4; ++m)
#pragma unroll
                    for (int n = 0; n < 2; ++n) acc[a][b][m][n] = (f32x4){0.f, 0.f, 0.f, 0.f};
        cur = nxt; cA = nA; cB = nB; ++ui;
        if (wr == 1) PG8_BAR;
    }
    PG8_WAIT_V(0);
    PG8_BAR;
#undef PG8_SA
#undef PG8_SB
#undef PG8_STAGE
#undef PG8_LDA
#undef PG8_LDA1
#undef PG8_MMA1
#undef PG8_LDB
#undef PG8_MMA
#undef PG8_WAIT_V
#undef PG8_WAIT_L
#undef PG8_BAR
#undef PG8_SCHED
}
}
using pg8::Unit; using pg8::cvt_pk_bf16;

constexpr size_t MiB = 1u << 20;
constexpr size_t WS_CTL = 0, CTL_ZERO_BYTES = 128 * 1024;
constexpr size_t WS_MOD = 1 * MiB;
constexpr size_t WS_ROPE = WS_MOD + 512 * 1024;
constexpr size_t WS_STATS = WS_ROPE + 64 * 1024;
constexpr size_t WS_WQKV = 4 * MiB;
constexpr size_t WS_WO = WS_WQKV + 3 * MiB;
constexpr size_t WS_WSGI = WS_WO + 2 * MiB;
constexpr size_t WS_WSGO = WS_WSGI + 4 * MiB;
constexpr size_t WS_WSCI = WS_WSGO + 2 * MiB;
constexpr size_t WS_WSCO = WS_WSCI + 6 * MiB;
constexpr size_t WS_WFNO = WS_WSCO + 2 * MiB;
constexpr size_t WS_WUP = WS_WFNO + 2 * MiB;
constexpr size_t WUP_BYTES = (size_t)2 * DFF * D * 2;
constexpr size_t WS_WDN = WS_WUP + 4 * WUP_BYTES;
constexpr size_t WDN_BYTES = (size_t)D * DFF * 2;
constexpr size_t WS_WS = WS_WDN + 4 * WDN_BYTES;
constexpr size_t WS_A1 = WS_WS + 256 * 1024;
constexpr size_t WS_A2P = WS_A1 + 256 * 1024;
constexpr size_t WS_A2S = WS_A2P + 256 * 1024;
constexpr size_t WS_CK = WS_A2S + 16 * MiB;
constexpr size_t WS_CVT = WS_CK + 512 * 1024;
constexpr size_t WS_X = WS_CVT + 512 * 1024;
constexpr size_t WS_H = WS_X + (size_t)M * D * 4;
constexpr size_t WS_BIG = WS_H + (size_t)(M + 256) * D * 2;
constexpr size_t WS_END = WS_BIG + 72 * MiB;
constexpr size_t WS_ACT = WS_BIG;
constexpr size_t WS_Q = WS_BIG;
constexpr size_t WS_KB = WS_Q + 24 * MiB;
constexpr size_t WS_VT = WS_KB + 6 * MiB;
constexpr size_t WS_U = WS_BIG;
constexpr size_t WS_V = WS_BIG + 24 * MiB;
constexpr size_t WS_YB = WS_BIG;
constexpr size_t WS_YT = WS_BIG;
static_assert(WS_YB + (size_t)256 * 2 * 16 * 512 * 16 <= WS_END, "yb");
static_assert(WS_ACT + (size_t)M * DFF * 2 <= WS_END, "act");
constexpr size_t WS_H2 = WS_END;
constexpr size_t WS_HN = WS_H2 + (size_t)M * D * 2;
constexpr size_t WS_XS = WS_HN + (size_t)(M + 256) * D * 2;
constexpr size_t WS_TOTAL = WS_XS + (size_t)16 * M * 4 * 4;
constexpr size_t CTL_CNT = 16384;
constexpr size_t CTL_TMO = CTL_CNT + 16 * 64 * 64;

constexpr size_t OUT_NK = (size_t)M * D, OUT_NV = OUT_NK + (size_t)MP * 256;

#define XB_TMO      128
#define XB_XCNT(j)  (256  + 64 * (j))
#define XB_XSUB(j)  (1280 + 64 * (j))
#define XB_XGEN(j)  (2304 + 64 * (j))
#define XB_TOP      3328
#define XB_TOPGEN   3392
#define XCD_BAR_WORDS 3456
#define XB_SPIN_CAP (1u << 22)
__device__ __forceinline__ unsigned xb_ld(unsigned* p)              { return __hip_atomic_load(p, __ATOMIC_RELAXED, __HIP_MEMORY_SCOPE_AGENT); }
__device__ __forceinline__ unsigned xb_add(unsigned* p, unsigned v) { return __hip_atomic_fetch_add(p, v, __ATOMIC_RELAXED, __HIP_MEMORY_SCOPE_AGENT); }
__device__ __forceinline__ unsigned xb_xcc_id() { return (unsigned)__builtin_amdgcn_s_getreg((3 << 11) | 20) & 0xFu; }
#define XB_SPIN(cond, bar) do { unsigned _sp = 0; while (cond) { __builtin_amdgcn_s_sleep(1); \
    if ((++_sp & 255u) == 0u) { if (xb_ld(&(bar)[XB_TMO])) break; if (_sp > XB_SPIN_CAP) { atomicAdd(&(bar)[XB_TMO], 1u); break; } } } } while (0)
struct XcdBarrier { unsigned* bar; unsigned x; volatile LAS unsigned* st; };
__device__ __forceinline__ XcdBarrier xcd_barrier_post(unsigned* bar, volatile LAS unsigned* st, bool leader) {
    XcdBarrier b; b.bar = bar; b.x = xb_xcc_id(); b.st = st;
    if (leader) (void)xb_add(&bar[XB_XCNT(b.x)], 1u);
    return b;
}
__device__ __forceinline__ void xcd_barrier_complete(unsigned* bar, unsigned x, unsigned& nloc, unsigned& nx) {
    const unsigned G = gridDim.x * gridDim.y * gridDim.z;
    unsigned sum, cnt, mine, sp = 0u;
    for (;;) {
        sum = 0u; cnt = 0u; mine = 0u;
#pragma unroll
        for (unsigned j = 0; j < 16; ++j) { const unsigned c = xb_ld(&bar[XB_XCNT(j)]); sum += c; cnt += (c > 0u) ? 1u : 0u; }
        mine = xb_ld(&bar[XB_XCNT(x)]);
        if (sum == G) break;
        __builtin_amdgcn_s_sleep(1);
        if ((++sp & 255u) == 0u) { if (xb_ld(&bar[XB_TMO])) break; if (sp > XB_SPIN_CAP) { atomicAdd(&bar[XB_TMO], 1u); break; } }
    }
    nloc = mine > 0u ? mine : 1u; nx = cnt > 0u ? cnt : 1u;
}
__device__ __forceinline__ void xcd_barrier(const XcdBarrier& b, bool leader) {
    asm volatile("s_waitcnt vmcnt(0)" ::: "memory");
    __syncthreads();
    if (leader) {
        unsigned* bar = b.bar; unsigned bx = b.x; asm volatile("" : "+s"(bx));
        __builtin_amdgcn_s_waitcnt(0);
        unsigned nloc = b.st[0], nx = b.st[1];
        if (nloc == 0u) { xcd_barrier_complete(bar, bx, nloc, nx); b.st[0] = nloc; b.st[1] = nx; }
        const unsigned old = xb_add(&bar[XB_XSUB(bx)], 1u);
        const unsigned gen = old / nloc;
        if (old + 1u == (gen + 1u) * nloc) {
            __builtin_amdgcn_fence(__ATOMIC_RELEASE, "agent");
            asm volatile("s_waitcnt vmcnt(0)" ::: "memory");
            const unsigned og = xb_add(&bar[XB_TOP], 1u);
            const unsigned tg = og / nx;
            if (og + 1u == (tg + 1u) * nx) xb_add(&bar[XB_TOPGEN], 1u);
            else XB_SPIN(xb_ld(&bar[XB_TOPGEN]) == tg, bar);
            __builtin_amdgcn_fence(__ATOMIC_ACQUIRE, "agent");
            xb_add(&bar[XB_XGEN(bx)], 1u);
            asm volatile("s_waitcnt vmcnt(0)" ::: "memory");
        } else {
            XB_SPIN(xb_ld(&bar[XB_XGEN(bx)]) == gen, bar);
            __builtin_amdgcn_fence(__ATOMIC_ACQUIRE, "agent");
            asm volatile("s_waitcnt vmcnt(0)" ::: "memory");
        }
    }
    __syncthreads();
}

#define LDS_WAIT() asm volatile("s_waitcnt lgkmcnt(0)" ::: "memory")
__device__ __forceinline__ unsigned f2bf(float f) { unsigned u = __builtin_bit_cast(unsigned, f); return (u + 0x7fffu + ((u >> 16) & 1u)) >> 16; }
__device__ __forceinline__ unsigned pk2(float lo, float hi) { return f2bf(lo) | (f2bf(hi) << 16); }
__device__ __forceinline__ float bf2f(unsigned short b) { return __builtin_bit_cast(float, (unsigned)b << 16); }
__device__ __forceinline__ float rows_max(float x) {
    auto s = __builtin_amdgcn_permlane16_swap(__float_as_uint(x), __float_as_uint(x), false, false); x = fmaxf(__uint_as_float(s[0]), __uint_as_float(s[1]));
    auto t = __builtin_amdgcn_permlane32_swap(__float_as_uint(x), __float_as_uint(x), false, false); return fmaxf(__uint_as_float(t[0]), __uint_as_float(t[1])); }
__device__ __forceinline__ float rows_sum(float x) {
    auto s = __builtin_amdgcn_permlane16_swap(__float_as_uint(x), __float_as_uint(x), false, false); x = __uint_as_float(s[0]) + __uint_as_float(s[1]);
    auto t = __builtin_amdgcn_permlane32_swap(__float_as_uint(x), __float_as_uint(x), false, false); return __uint_as_float(t[0]) + __uint_as_float(t[1]); }
template <int CTRL> __device__ __forceinline__ float dppx(float v) { return __builtin_bit_cast(float, __builtin_amdgcn_mov_dpp(__builtin_bit_cast(int, v), CTRL, 0xf, 0xf, true)); }
__device__ __forceinline__ float wave_sum(float v) {
    v += dppx<0xB1>(v);
    v += dppx<0x4E>(v);
    v += dppx<0x141>(v);
    v += dppx<0x140>(v);
    return rows_sum(v);
}
__device__ __forceinline__ float fast_exp2(float x) { return __builtin_amdgcn_exp2f(x); }
__device__ __forceinline__ float fast_rcp(float x) { return __builtin_amdgcn_rcpf(x); }
__device__ __forceinline__ float silu_f(float x) { return x * fast_rcp(1.f + fast_exp2(-1.4426950408889634f * x)); }
__device__ __forceinline__ float gelu_f(float x) { const float u = x * (1.f + 0.044715f * x * x); return x * fast_rcp(1.f + fast_exp2(-2.302208198f * u)); }
__device__ __forceinline__ int conv_row0(int pm) { if (pm < 32) return 256 * pm; const int s = (pm - 32) / 9, i = (pm - 32) % 9; return MP + TS * s + 254 * i - 1; }
template <int CTRL> __device__ __forceinline__ float dpp(float v) { return __builtin_bit_cast(float, __builtin_amdgcn_mov_dpp(__builtin_bit_cast(int, v), CTRL, 0xf, 0xf, true)); }
template <int CTRL> __device__ __forceinline__ f32x4 dpp4(f32x4 v) { return (f32x4){dpp<CTRL>(v[0]), dpp<CTRL>(v[1]), dpp<CTRL>(v[2]), dpp<CTRL>(v[3])}; }
#define DPP_ROR1 0x121
#define DPP_ROR15 0x12F

template <int NM, int NN, int CONV, int LDA, int LDB, int ROWS = 256>
struct Order {
    int G, c; const char* A; const char* B;
    __device__ __forceinline__ void init(int G_, int c_, const void* A_, const void* B_) { G = G_; c = c_; A = (const char*)A_; B = (const char*)B_; }
    __device__ __forceinline__ bool next(int i, Unit& u) const {
        constexpr int nwg = NM * NN;
        const int L = i * G + c; if (L >= nwg) return false;
        int wgid = L; { constexpr int q = nwg / pg8::NXCD, r = nwg % pg8::NXCD; const int xcd = wgid % pg8::NXCD, off = wgid / pg8::NXCD; wgid = (xcd < r ? xcd * (q + 1) : r * (q + 1) + (xcd - r) * q) + off; }
        constexpr int nig = pg8::WGM * NN; const int gid = wgid / nig, fm = gid * pg8::WGM, gsz = (NM - fm) < pg8::WGM ? (NM - fm) : pg8::WGM;
        u.pm = fm + ((wgid % nig) % gsz); u.pn = (wgid % nig) / gsz;
        u.row0 = CONV ? conv_row0(u.pm) : ROWS * u.pm;
        u.a = A + (long)u.row0 * (long)(LDA * 2); u.b = B + (size_t)u.pn * (size_t)(256 * LDB * 2); return true;
    }
};

typedef const GAS float* cfp_t;
struct Frame {
    LAS unsigned char* lds; int tid, lane, wave, G, blk;
    const __attribute__((address_space(4))) cfp_t* in; float* out; unsigned char* ws;
};
__device__ __forceinline__ void frame_refresh(Frame& F) {
    int ln = pg8::lane_id(); asm volatile("" : "+v"(ln)); F.lane = ln; F.tid = F.wave * 64 + ln;
}
constexpr int RING_BYTES = 131072, XCH_OFF = RING_BYTES  , MISC_OFF = XCH_OFF + 8192 + 320, LDS_BYTES = 147456;
__device__ __forceinline__ int vec_plain(int pm) { return pm < 32 ? 0 : 1 + (pm - 32) / 8; }
__device__ __forceinline__ int vec_conv(int pm) { return pm < 32 ? 0 : 1 + (pm - 32) / 9; }

__device__ __forceinline__ constexpr int r192_nm(int ai) { return ai ? 2 : 4; }
__device__ __forceinline__ int r192_base(int ai, int wr) { return ai ? 128 + 32 * wr : 64 * wr; }
__device__ __forceinline__ u32x4 merge_quads16(u32x2 q0, u32x2 q1) {
    auto a = __builtin_amdgcn_permlane16_swap(q0.x, q1.x, false, false);
    auto b = __builtin_amdgcn_permlane16_swap(q0.y, q1.y, false, false);
    return (u32x4){a[0], b[0], a[1], b[1]};
}
__device__ __forceinline__ void split_quads16(u32x4 r, u32x2& q0, u32x2& q1) {
    auto a = __builtin_amdgcn_permlane16_swap(r.x, r.z, false, false);
    auto b = __builtin_amdgcn_permlane16_swap(r.y, r.w, false, false);
    q0 = (u32x2){a[0], b[0]}; q1 = (u32x2){a[1], b[1]};
}
struct EpiBase {
    unsigned char* ws_; int l, aux;
    __device__ __forceinline__ unsigned char* wsp() const { unsigned long long w = (unsigned long long)ws_; asm volatile("" : "+s"(w)); return (unsigned char*)(GAS unsigned char*)w; }
    __device__ __forceinline__ static const __attribute__((address_space(4))) cfp_t* kargs() { unsigned long long kp = (unsigned long long)__builtin_amdgcn_kernarg_segment_ptr(); asm volatile("" : "+s"(kp)); return (const __attribute__((address_space(4))) cfp_t*)kp; }
    __device__ __forceinline__ static const float* inp(const __attribute__((address_space(4))) cfp_t* ka, int k) { return (const float*)ka[k]; }
    __device__ __forceinline__ static float* outp(const __attribute__((address_space(4))) cfp_t* ka) { return (float*)(GAS float*)ka[26]; }
    __device__ __forceinline__ static LAS float* xch() { extern __shared__ __attribute__((aligned(16))) unsigned char lds_base_[]; return (LAS float*)((LAS unsigned char*)lds_base_ + XCH_OFF); }
};
template <bool FINAL>
struct EpiResNorm : EpiBase {
    static constexpr bool PERM = false;
    static constexpr int TR = 192;
    __device__ __forceinline__ static int nm(int ai) { return ai ? 2 : 4; }
    __device__ __forceinline__ static int rbase(int ai, int wr) { return ai ? 128 + 32 * wr : 64 * wr; }
    __device__ __forceinline__ void operator()(f32x4 (&acc)[2][2][4][2], const Unit& u, int wid, int ) const {
        int lane_ = pg8::lane_id(); asm volatile("" : "+v"(lane_));
        const int lane = lane_, wr = wid >> 2, wc = wid & 3, fr = lane & 15, fq = lane >> 4;
        unsigned char* ws = wsp(); const auto ka = kargs();
        const int isdn = aux & 1, rep = (aux >> 1) & 1, inst = 2 * l + isdn + 8 * rep;
        typedef _Float16 h4 __attribute__((ext_vector_type(4)));
        _Float16* Xr = (_Float16*)(ws + WS_X); _Float16* X = rep ? (_Float16*)(ws + WS_TOTAL) : Xr;
        const bool srcf32 = (!isdn && l == 0);
        const float* modl = (const float*)(ws + WS_MOD) + l * 3 * 6 * D; const int gate_idx = isdn ? 5 : 2;
        const float* gn = FINAL ? inp(ka, 10) : (isdn ? inp(ka, 8) + (l + 1) * D : inp(ka, 9) + l * D);
        const float* modn = isdn ? modl + 3 * 6 * D : modl; const int sh_idx = isdn ? 0 : 3;
        bf16_t* HN = (bf16_t*)(ws + (rep ? WS_TOTAL + 48 * MiB : WS_HN)); float* Y = rep ? (float*)(ws + WS_TOTAL) : outp(ka);
        float* xs = (float*)(ws + WS_XS) + (size_t)inst * M * 4; unsigned* cnt = (unsigned*)(ws + WS_CTL + CTL_CNT) + inst * 64 * 16; unsigned* tmo = (unsigned*)(ws + WS_CTL + CTL_TMO);
        LAS float* L = xch();
        const int col0 = u.pn * 256 + wc * 32 + 4 * fq, tid = wid * 64 + lane;
        const int col16 = col0 + ((fq & 1) ? 12 : 0);
        LAS float* P = L;
        LAS float* S = L + 1024;
#pragma unroll
        for (int ai = 0; ai < 2; ++ai) {
            const int rb = u.row0 + rbase(ai, wr);
            const int vec = rb < MP ? 0 : 1 + (rb - MP) / TS;
            const float* gate = modl + vec * 6 * D + gate_idx * D;
            const float* src = rb < MP ? inp(ka, 0) + (size_t)rb * D : inp(ka, 1) + (size_t)(rb - MP) * D;
            f32x4 gv[2][2];
#pragma unroll
            for (int bj = 0; bj < 2; ++bj)
#pragma unroll
                for (int n = 0; n < 2; ++n) gv[bj][n] = *(const f32x4*)(gate + col0 + bj * 128 + n * 16);
            f32x4 sv[4][2][2];
            u32x4 hv[4][2];
            if (srcf32) {
#pragma unroll
                for (int m = 0; m < 4; ++m) if (m < nm(ai)) { const size_t ro = (size_t)(16 * m + fr) * D + col0;
#pragma unroll
                    for (int bj = 0; bj < 2; ++bj)
#pragma unroll
                        for (int n = 0; n < 2; ++n) sv[m][bj][n] = *(const f32x4*)(src + ro + bj * 128 + n * 16); }
            } else {
#pragma unroll
                for (int m = 0; m < 4; ++m) if (m < nm(ai))
#pragma unroll
                    for (int bj = 0; bj < 2; ++bj) hv[m][bj] = *(const u32x4*)(Xr + (size_t)rb * D + (size_t)(16 * m + fr) * D + col16 + bj * 128);
#pragma unroll
                for (int m = 0; m < 4; ++m) if (m < nm(ai))
#pragma unroll
                    for (int bj = 0; bj < 2; ++bj) { u32x2 q0, q1; split_quads16(hv[m][bj], q0, q1);
                        sv[m][bj][0] = __builtin_convertvector(__builtin_bit_cast(h4, q0), f32x4); sv[m][bj][1] = __builtin_convertvector(__builtin_bit_cast(h4, q1), f32x4); }
            }
#pragma unroll
            for (int m = 0; m < 4; ++m) if (m < nm(ai)) { const int r = rbase(ai, wr) + 16 * m + fr; float ss = 0.f;
#pragma unroll
                for (int bj = 0; bj < 2; ++bj)
#pragma unroll
                    for (int n = 0; n < 2; ++n) { const f32x4 x1 = sv[m][bj][n] + gv[bj][n] * acc[ai][bj][m][n]; acc[ai][bj][m][n] = x1;
                        ss += (x1[0] * x1[0] + x1[1] * x1[1]) + (x1[2] * x1[2] + x1[3] * x1[3]); }
                ss = rows_sum(ss);
                if (fq == 0) P[r * 4 + wc] = ss; }
            asm volatile("" ::: "memory"); }
        LDS_WAIT(); __builtin_amdgcn_s_barrier(); asm volatile("" ::: "memory");
        if (tid < TR) { const f32x4 p = *(const LAS f32x4*)(P + tid * 4); const float tot = (p[0] + p[1]) + (p[2] + p[3]);
            __hip_atomic_store(xs + (size_t)(u.row0 + tid) * 4 + u.pn, tot, __ATOMIC_RELAXED, __HIP_MEMORY_SCOPE_AGENT); }
        asm volatile("s_waitcnt vmcnt(0)" ::: "memory");
        if (tid < TR && (tid & 63) == 0) __hip_atomic_fetch_add(cnt + 16 * u.pm, 1u, __ATOMIC_RELAXED, __HIP_MEMORY_SCOPE_AGENT);
        if (!FINAL) {
#pragma unroll
            for (int ai = 0; ai < 2; ++ai)
#pragma unroll
                for (int m = 0; m < 4; ++m) if (m < nm(ai)) { _Float16* xp = X + (size_t)(u.row0 + rbase(ai, wr) + 16 * m + fr) * D + col16;
#pragma unroll
                    for (int bj = 0; bj < 2; ++bj) { const h4 h0 = __builtin_convertvector(acc[ai][bj][m][0], h4), h1 = __builtin_convertvector(acc[ai][bj][m][1], h4);
                        *(u32x4*)(xp + bj * 128) = merge_quads16(__builtin_bit_cast(u32x2, h0), __builtin_bit_cast(u32x2, h1)); } }
        }
        if (tid < 64) { unsigned sp_ = 0;
            while ((unsigned)__builtin_amdgcn_readfirstlane(__hip_atomic_load(cnt + 16 * u.pm, __ATOMIC_RELAXED, __HIP_MEMORY_SCOPE_AGENT)) < 12u) {
                __builtin_amdgcn_s_sleep(1);
                if ((++sp_ & 1023u) == 0u) { if (__hip_atomic_load(tmo, __ATOMIC_RELAXED, __HIP_MEMORY_SCOPE_AGENT)) break; if (sp_ > (1u << 22)) { __hip_atomic_store(tmo, 1u, __ATOMIC_RELAXED, __HIP_MEMORY_SCOPE_AGENT); break; } } }
        }
        asm volatile("s_waitcnt lgkmcnt(0)" ::: "memory"); __builtin_amdgcn_s_barrier(); asm volatile("" ::: "memory");
        if (tid < TR) { const float* sl = xs + (size_t)(u.row0 + tid) * 4; float t = 0.f;
#pragma unroll
            for (int k = 0; k < 4; ++k) t += __hip_atomic_load(sl + k, __ATOMIC_RELAXED, __HIP_MEMORY_SCOPE_AGENT);
            S[tid] = rsqrtf(t * (1.f / D) + EPS); }
        LDS_WAIT(); __builtin_amdgcn_s_barrier(); asm volatile("" ::: "memory");
#pragma unroll
        for (int ai = 0; ai < 2; ++ai) {
            const int rb = u.row0 + rbase(ai, wr); const int vec = rb < MP ? 0 : 1 + (rb - MP) / TS;
            f32x4 gm[2][2], sh[2][2];
#pragma unroll
            for (int bj = 0; bj < 2; ++bj)
#pragma unroll
                for (int n = 0; n < 2; ++n) { const int c = col0 + bj * 128 + n * 16; gm[bj][n] = *(const f32x4*)(gn + c);
                    if (!FINAL) { const float* mv = modn + vec * 6 * D; gm[bj][n] = gm[bj][n] * (1.f + *(const f32x4*)(mv + (sh_idx + 1) * D + c)); sh[bj][n] = *(const f32x4*)(mv + sh_idx * D + c); } }
#pragma unroll
            for (int m = 0; m < 4; ++m) if (m < nm(ai)) { const int r = rbase(ai, wr) + 16 * m + fr; const float rs = S[r];
#pragma unroll
                for (int bj = 0; bj < 2; ++bj) {
                    if (FINAL) {
#pragma unroll
                        for (int n = 0; n < 2; ++n) *(f32x4*)(Y + (size_t)(u.row0 + r) * D + col0 + bj * 128 + n * 16) = acc[ai][bj][m][n] * rs * gm[bj][n]; }
                    else { const f32x4 h0 = acc[ai][bj][m][0] * rs * gm[bj][0] + sh[bj][0], h1 = acc[ai][bj][m][1] * rs * gm[bj][1] + sh[bj][1];
                        u32x2 w0, w1; w0.x = cvt_pk_bf16(h0[0], h0[1]); w0.y = cvt_pk_bf16(h0[2], h0[3]); w1.x = cvt_pk_bf16(h1[0], h1[1]); w1.y = cvt_pk_bf16(h1[2], h1[3]);
                        *(u32x4*)(HN + (size_t)(u.row0 + r) * D + col16 + bj * 128) = merge_quads16(w0, w1); } } }
        }
    }
};
struct EpiNull : EpiBase {
    static constexpr bool PERM = true;
    __device__ __forceinline__ void operator()(f32x4 (&acc)[2][2][4][2], const Unit& u, int wid, int) const {
        f32x4 s = {0.f, 0.f, 0.f, 0.f};
#pragma unroll
        for (int ai = 0; ai < 2; ++ai)
#pragma unroll
            for (int bj = 0; bj < 2; ++bj)
#pragma unroll
                for (int m = 0; m < 4; ++m)
#pragma unroll
                    for (int n = 0; n < 2; ++n) s += acc[ai][bj][m][n];
        ((f32x4*)(wsp() + WS_TOTAL))[(size_t)(u.pm * 22 + u.pn) * 512 + wid * 64 + pg8::lane_id()] = s;
    }
};
template <int ROWS> struct EpiBf16 : EpiBase {
    static constexpr bool PERM = true;
    __device__ __forceinline__ void operator()(const f32x4 (&acc)[2][2][4][2], const Unit& u, int wid, int ) const {
        int lane_ = pg8::lane_id(); asm volatile("" : "+v"(lane_));
        const int lane = lane_, wr = wid >> 2, wc = wid & 3, fr = lane & 15, fq = lane >> 4; (void)wr; (void)wc; (void)fr; (void)fq;
        bf16_t* O = (bf16_t*)(wsp() + WS_H); constexpr int ldc = D;
        const int col0 = u.pn * 256 + wc * 32 + 8 * fq;
#pragma unroll
        for (int ai = 0; ai < (ROWS == 128 ? 1 : 2); ++ai)
#pragma unroll
            for (int m = 0; m < 4; ++m) { bf16_t* rowp = O + (size_t)(u.row0 + ai * 128 + wr * 64 + m * 16 + fr) * ldc + col0;
#pragma unroll
                for (int bj = 0; bj < 2; ++bj) { const f32x4 v0 = acc[ai][bj][m][0], v1 = acc[ai][bj][m][1];
                    u32x4 w; w.x = cvt_pk_bf16(v0[0], v0[1]); w.y = cvt_pk_bf16(v0[2], v0[3]); w.z = cvt_pk_bf16(v1[0], v1[1]); w.w = cvt_pk_bf16(v1[2], v1[3]);
                    *(u32x4*)(rowp + bj * 128) = w; } }
    }
};
struct EpiQKV : EpiBase {
    static constexpr bool PERM = false;
    __device__ __forceinline__ void operator()(f32x4 (&acc)[2][2][4][2], const Unit& u, int wid, int ) const {
        int lane_ = pg8::lane_id(); asm volatile("" : "+v"(lane_));
        const int lane = lane_, wr = wid >> 2, wc = wid & 3, fr = lane & 15, fq = lane >> 4;
        unsigned char* ws = wsp(); bf16_t* Q = (bf16_t*)(ws + WS_Q); bf16_t* KB = (bf16_t*)(ws + WS_KB); bf16_t* VT = (bf16_t*)(ws + WS_VT); const float* rope = (const float*)(ws + WS_ROPE);
        float* outk = outp(kargs()) + OUT_NK; float* outv = outk + (OUT_NV - OUT_NK);
        const int c0 = wc * 32 + 4 * fq;
#pragma unroll
        for (int ai = 0; ai < 2; ++ai) {
            const int rb = u.row0 + r192_base(ai, wr); const bool samp = rb >= MP;
            if (samp && u.pn <= 4) {
                const int half = wc & 1;
#pragma unroll
                for (int m = 0; m < 4; ++m) if (m < r192_nm(ai)) { const int t = (rb - MP + m * 16 + fr) & (TS - 1); const int pos = half ? (t & 63) : (t >> 6);
                    const f32x4 cs = *(const f32x4*)(rope + pos * 16 + 4 * fq), sn = *(const f32x4*)(rope + 1024 + pos * 16 + 4 * fq);
#pragma unroll
                    for (int bj = 0; bj < 2; ++bj) { const f32x4 x1 = acc[ai][bj][m][0], x2 = acc[ai][bj][m][1]; acc[ai][bj][m][0] = x1 * cs - x2 * sn; acc[ai][bj][m][1] = x2 * cs + x1 * sn; } }
            }
            if (u.pn <= 4) {
                bf16_t* base = u.pn < 4 ? Q + u.pn * 256 : KB; const int ldc = u.pn < 4 ? D : 256;
#pragma unroll
                for (int m = 0; m < 4; ++m) if (m < r192_nm(ai)) { const int row = rb + m * 16 + fr; bf16_t* rowp = base + (size_t)row * ldc + c0 + ((fq & 1) ? 12 : 0);
#pragma unroll
                    for (int bj = 0; bj < 2; ++bj) { u32x2 w[2];
#pragma unroll
                        for (int n = 0; n < 2; ++n) { const f32x4 v = acc[ai][bj][m][n]; w[n].x = cvt_pk_bf16(v[0], v[1]); w[n].y = cvt_pk_bf16(v[2], v[3]);
                            if (u.pn == 4 && !samp) *(f32x4*)(outk + (size_t)row * 256 + c0 + bj * 128 + n * 16) = v; }
                        *(u32x4*)(rowp + bj * 128) = merge_quads16(w[0], w[1]); } }
            } else {
                const int T = samp ? TS : TP;
                bf16_t* vt = samp ? VT + (size_t)32 * 65536 + (size_t)((rb - MP) / TS) * 256 * TS : VT + (size_t)(rb / TP) * 65536;
#pragma unroll
                for (int m = 0; m < 4; ++m) if (m < r192_nm(ai)) { const int row = rb + m * 16 + fr; const int t = samp ? ((row - MP) & (TS - 1)) : (row & (TP - 1));
                    const int qb = fr & 3;
                    unsigned vo = (unsigned)((c0 + qb) * T + (t - qb)); asm volatile("" : "+v"(vo));
#pragma unroll
                    for (int bj = 0; bj < 2; ++bj)
#pragma unroll
                        for (int n = 0; n < 2; ++n) { f32x4 v = acc[ai][bj][m][n]; const int c = c0 + bj * 128 + n * 16;
                            if (!samp) *(f32x4*)(outv + (size_t)row * 256 + c) = v;
                            { const float s01 = (qb & 1) ? v[0] : v[1], s23 = (qb & 1) ? v[2] : v[3]; const float r01 = dppx<0xB1>(s01), r23 = dppx<0xB1>(s23);
                              if (qb & 1) { v[0] = r01; v[2] = r23; } else { v[1] = r01; v[3] = r23; } }
                            { const float s02 = (qb & 2) ? v[0] : v[2], s13 = (qb & 2) ? v[1] : v[3]; const float r02 = dppx<0x4E>(s02), r13 = dppx<0x4E>(s13);
                              if (qb & 2) { v[0] = r02; v[1] = r13; } else { v[2] = r02; v[3] = r13; } }
                            u32x2 w; w.x = cvt_pk_bf16(v[0], v[1]); w.y = cvt_pk_bf16(v[2], v[3]);
                            *(u32x2*)(vt + vo + (unsigned)((bj * 128 + n * 16) * T)) = w; } }
            }
        }
    }
};
__device__ __forceinline__ f32x4 conv_m(f32x4 cur, f32x4 pe, f32x4 ne, f32x4 w0, f32x4 w1, f32x4 w2, int fr) {
    const f32x4 up = dpp4<DPP_ROR1>(cur), dn = dpp4<DPP_ROR15>(cur);
    const f32x4 prev = fr > 0 ? up : pe, next = fr < 15 ? dn : ne;
    return w0 * prev + w1 * cur + w2 * next;
}
__device__ __forceinline__ void mask_rows(f32x4 (&acc)[2][2][4][2], const Unit& u, int wr, int fr) {
    if (u.pm < 32) return;
    const int i = (u.pm - 32) % 9; if (i != 0 && i != 8) return;
    const int t0 = 254 * i - 1;
#pragma unroll
    for (int ai = 0; ai < 2; ++ai)
#pragma unroll
        for (int m = 0; m < 4; ++m) { const int t = t0 + ai * 128 + wr * 64 + m * 16 + fr; if (t < 0 || t >= TS) {
#pragma unroll
            for (int bj = 0; bj < 2; ++bj)
#pragma unroll
                for (int n = 0; n < 2; ++n) acc[ai][bj][m][n] = (f32x4){0.f, 0.f, 0.f, 0.f}; } }
}
__device__ __forceinline__ bool row_valid(const Unit& u, int r) {
    if (u.pm < 32) return true;
    const int t = 254 * ((u.pm - 32) % 9) - 1 + r; return r >= 1 && r <= 254 && t >= 0 && t < TS;
}
__device__ __forceinline__ void xch_write(LAS float* X, const f32x4 (&acc)[2][2][4][2], int wr, int wc, int fr, int fq) {
#pragma unroll
    for (int ai = 0; ai < 2; ++ai)
#pragma unroll
        for (int bj = 0; bj < 2; ++bj)
#pragma unroll
            for (int n = 0; n < 2; ++n) { const int col = bj * 128 + wc * 32 + 8 * fq + 4 * n;
                if (fr == 0) *(LAS f32x4*)(X + ((2 * ai + wr) * 2 + 0) * 256 + col) = acc[ai][bj][0][n];
                if (fr == 15) *(LAS f32x4*)(X + ((2 * ai + wr) * 2 + 1) * 256 + col) = acc[ai][bj][3][n]; }
}
__device__ __forceinline__ f32x4 xch_top(const LAS float* X, int b, int col) { return b > 0 ? *(const LAS f32x4*)(X + ((b - 1) * 2 + 1) * 256 + col) : (f32x4){0.f, 0.f, 0.f, 0.f}; }
__device__ __forceinline__ f32x4 xch_bot(const LAS float* X, int b, int col) { return b < 3 ? *(const LAS f32x4*)(X + ((b + 1) * 2 + 0) * 256 + col) : (f32x4){0.f, 0.f, 0.f, 0.f}; }

struct EpiUp : EpiBase {
    static constexpr bool PERM = true;
    __device__ __forceinline__ void operator()(f32x4 (&acc)[2][2][4][2], const Unit& u, int wid, int ) const {
        int lane_ = pg8::lane_id(); asm volatile("" : "+v"(lane_));
        const int lane = lane_, wr = wid >> 2, wc = wid & 3, fr = lane & 15, fq = lane >> 4; (void)wr; (void)wc; (void)fr; (void)fq;
        bf16_t* ACT = (bf16_t*)(wsp() + WS_ACT); const float* cw = inp(kargs(), 24) + (size_t)l * 3 * 2 * DFF; LAS float* X = xch();
        mask_rows(acc, u, wr, fr);
        xch_write(X, acc, wr, wc, fr, fq);
        LDS_WAIT(); __builtin_amdgcn_s_barrier(); asm volatile("" ::: "memory");
        const int chl = wc * 32 + 8 * fq;
        u32x2 pk0[2][4];
#pragma unroll
        for (int n = 0; n < 2; ++n) {
            const int ch = u.pn * 128 + chl + 4 * n;
            f32x4 wg[3], wu[3];
#pragma unroll
            for (int k = 0; k < 3; ++k) { wg[k] = *(const f32x4*)(cw + k * 2 * DFF + ch); wu[k] = *(const f32x4*)(cw + k * 2 * DFF + DFF + ch); }
#pragma unroll
            for (int ai = 0; ai < 2; ++ai) {
                const int b = 2 * ai + wr;
                f32x4 pg = xch_top(X, b, chl + 4 * n), pu = xch_top(X, b, 128 + chl + 4 * n);
#pragma unroll
                for (int m = 0; m < 4; ++m) { const int r = ai * 128 + wr * 64 + m * 16 + fr;
                    const f32x4 vg = acc[ai][0][m][n], vu = acc[ai][1][m][n];
                    const f32x4 ng = m < 3 ? dpp4<DPP_ROR15>(acc[ai][0][m < 3 ? m + 1 : 3][n]) : xch_bot(X, b, chl + 4 * n);
                    const f32x4 nu = m < 3 ? dpp4<DPP_ROR15>(acc[ai][1][m < 3 ? m + 1 : 3][n]) : xch_bot(X, b, 128 + chl + 4 * n);
                    const f32x4 og = conv_m(vg, pg, ng, wg[0], wg[1], wg[2], fr), ou = conv_m(vu, pu, nu, wu[0], wu[1], wu[2], fr);
                    pg = dpp4<DPP_ROR1>(vg); pu = dpp4<DPP_ROR1>(vu);
                    f32x4 a;
#pragma unroll
                    for (int j = 0; j < 4; ++j) a[j] = silu_f(og[j]) * ou[j];
                    u32x2 w; w.x = cvt_pk_bf16(a[0], a[1]); w.y = cvt_pk_bf16(a[2], a[3]);
                    if (n == 0) pk0[ai][m] = w;
                    else if (row_valid(u, r)) *(u32x4*)(ACT + (size_t)(u.row0 + r) * DFF + ch - 4) = (u32x4){pk0[ai][m].x, pk0[ai][m].y, w.x, w.y}; }
            }
        }
    }
};
struct EpiSgu : EpiBase {
    static constexpr bool PERM = true;
    __device__ __forceinline__ void operator()(f32x4 (&acc)[2][2][4][2], const Unit& u, int wid, int ) const {
        int lane_ = pg8::lane_id(); asm volatile("" : "+v"(lane_));
        const int lane = lane_, wr = wid >> 2, wc = wid & 3, fr = lane & 15, fq = lane >> 4;
        unsigned char* ws = wsp(); bf16_t* U = (bf16_t*)(ws + WS_U); bf16_t* V = (bf16_t*)(ws + WS_V); f32x2* STATS = (f32x2*)(ws + WS_STATS);
        const bool isv = u.pn >= 4; bf16_t* O = isv ? V : U; const int col0 = (u.pn & 3) * 256 + wc * 32 + 8 * fq;
#pragma unroll
        for (int ai = 0; ai < 2; ++ai)
#pragma unroll
            for (int m = 0; m < 4; ++m) if (m < r192_nm(ai)) { const int row = u.row0 + r192_base(ai, wr) + m * 16 + fr; bf16_t* rowp = O + (size_t)row * D + col0; float s1 = 0.f, s2 = 0.f;
#pragma unroll
                for (int bj = 0; bj < 2; ++bj) { f32x4 v0 = acc[ai][bj][m][0], v1 = acc[ai][bj][m][1];
#pragma unroll
                    for (int j = 0; j < 4; ++j) { v0[j] = gelu_f(v0[j]); v1[j] = gelu_f(v1[j]); s1 += v0[j] + v1[j]; s2 += v0[j] * v0[j] + v1[j] * v1[j]; }
                    u32x4 w; w.x = cvt_pk_bf16(v0[0], v0[1]); w.y = cvt_pk_bf16(v0[2], v0[3]); w.z = cvt_pk_bf16(v1[0], v1[1]); w.w = cvt_pk_bf16(v1[2], v1[3]);
                    *(u32x4*)(rowp + bj * 128) = w; }
                if (isv) { s1 = rows_sum(s1); s2 = rows_sum(s2);
                    if (fq == 0) STATS[(size_t)row * 16 + (u.pn - 4) * 4 + wc] = (f32x2){s1, s2}; } }
    }
};
struct EpiSc : EpiBase {
    static constexpr bool PERM = true;
    __device__ __forceinline__ void operator()(f32x4 (&acc)[2][2][4][2], const Unit& u, int wid, int ui) const {
        int lane_ = pg8::lane_id(); asm volatile("" : "+v"(lane_));
        const int lane = lane_, wr = wid >> 2, wc = wid & 3, fr = lane & 15, fq = lane >> 4; (void)wr; (void)wc; (void)fr; (void)fq;
        unsigned char* ws = wsp(); f32x4* YB = (f32x4*)(ws + WS_YB) + (size_t)aux * 2 * 16 * 512; bf16_t* BY = (bf16_t*)(ws + WS_H2); const float* cw = inp(kargs(), 20); LAS float* X = xch();
        const int q = u.pn / 3, s = u.pn % 3, chl = wc * 32 + 8 * fq;
        if (s < 2) {
            mask_rows(acc, u, wr, fr);
#pragma unroll
            for (int ai = 0; ai < 2; ++ai)
#pragma unroll
                for (int m = 0; m < 4; ++m)
#pragma unroll
                    for (int n = 0; n < 2; ++n) acc[ai][0][m][n] = acc[ai][0][m][n] * acc[ai][1][m][n];
            xch_write(X, acc, wr, wc, fr, fq);
            LDS_WAIT(); __builtin_amdgcn_s_barrier(); asm volatile("" ::: "memory");
#pragma unroll
            for (int n = 0; n < 2; ++n) {
                const int ch = q * 256 + s * 128 + chl + 4 * n;
                f32x4 w[3];
#pragma unroll
                for (int k = 0; k < 3; ++k) w[k] = *(const f32x4*)(cw + k * D + ch);
#pragma unroll
                for (int ai = 0; ai < 2; ++ai) { const int b = 2 * ai + wr;
                    f32x4 pp = xch_top(X, b, chl + 4 * n);
#pragma unroll
                    for (int m = 0; m < 4; ++m) { const f32x4 v = acc[ai][0][m][n];
                        const f32x4 nn = m < 3 ? dpp4<DPP_ROR15>(acc[ai][0][m < 3 ? m + 1 : 3][n]) : xch_bot(X, b, chl + 4 * n);
                        const f32x4 o = conv_m(v, pp, nn, w[0], w[1], w[2], fr); pp = dpp4<DPP_ROR1>(v);
                        unsigned yo = (unsigned)((s * 16 + (ai * 4 + m) * 2 + n) * 512) + (unsigned)(wid * 64 + lane); asm volatile("" : "+v"(yo)); YB[yo] = o; } }
            }
        } else {
#pragma unroll
            for (int ai = 0; ai < 2; ++ai) {
                f32x4 y[4][2][2];
#pragma unroll
                for (int m = 0; m < 4; ++m)
#pragma unroll
                    for (int bj = 0; bj < 2; ++bj) { unsigned yo = (unsigned)((bj * 16 + (ai * 4 + m) * 2) * 512) + (unsigned)(wid * 64 + lane); asm volatile("" : "+v"(yo)); y[m][bj][0] = YB[yo]; y[m][bj][1] = YB[yo + 512]; }
#pragma unroll
                for (int m = 0; m < 4; ++m) { const int r = ai * 128 + wr * 64 + m * 16 + fr; const bool ok = row_valid(u, r);
#pragma unroll
                    for (int bj = 0; bj < 2; ++bj) { const f32x4 v0 = acc[ai][bj][m][0] * y[m][bj][0], v1 = acc[ai][bj][m][1] * y[m][bj][1];
                        u32x4 w; w.x = cvt_pk_bf16(v0[0], v0[1]); w.y = cvt_pk_bf16(v0[2], v0[3]); w.z = cvt_pk_bf16(v1[0], v1[1]); w.w = cvt_pk_bf16(v1[2], v1[3]);
                        if (ok) *(u32x4*)(BY + (size_t)(u.row0 + r) * D + q * 256 + bj * 128 + chl) = w; } }
                asm volatile("" ::: "memory"); }
        }
    }
};
struct OrderSc {
    int c; const char* A; const char* B;
    __device__ __forceinline__ bool next(int i, Unit& u) const {
        if (c >= 200 || i >= 3) return false;
        u.pm = c >> 2; u.pn = 3 * (c & 3) + i; u.row0 = conv_row0(u.pm); u.a = A + (long)u.row0 * (D * 2); u.b = B + (size_t)u.pn * 256 * D * 2; return true; }
};
struct EpiFn1 : EpiBase {
    static constexpr bool PERM = true;
    __device__ __forceinline__ void operator()(const f32x4 (&acc)[2][2][4][2], const Unit& u, int wid, int ) const {
        int lane_ = pg8::lane_id(); asm volatile("" : "+v"(lane_));
        const int lane = lane_, wr = wid >> 2, wc = wid & 3, fr = lane & 15, fq = lane >> 4; (void)wr; (void)wc; (void)fr; (void)fq;
        bf16_t* YT = (bf16_t*)(wsp() + WS_YT);
        const int part = u.pm & 1, ch0 = (u.pm >> 1) * 256, tok0 = u.pn * 256;
        bf16_t* base; int T, t0;
        if (tok0 < MP) { T = TP; base = YT + (size_t)(tok0 / TP) * D * 2 * TP; t0 = 0; }
        else { T = TS; base = YT + (size_t)32 * D * 2 * TP + (size_t)((tok0 - MP) / TS) * D * 2 * TS; t0 = (tok0 - MP) % TS; }
        const int c0 = wc * 32 + 8 * fq;
#pragma unroll
        for (int ai = 0; ai < 2; ++ai)
#pragma unroll
            for (int m = 0; m < 4; ++m) { bf16_t* rowp = base + (size_t)(ch0 + ai * 128 + wr * 64 + m * 16 + fr) * 2 * T + part * T + t0 + c0;
#pragma unroll
                for (int bj = 0; bj < 2; ++bj) { const f32x4 v0 = acc[ai][bj][m][0], v1 = acc[ai][bj][m][1];
                    u32x4 w; w.x = cvt_pk_bf16(v0[0], v0[1]); w.y = cvt_pk_bf16(v0[2], v0[3]); w.z = cvt_pk_bf16(v1[0], v1[1]); w.w = cvt_pk_bf16(v1[2], v1[3]);
                    *(u32x4*)(rowp + bj * 128) = w; } }
    }
};
struct OrderFn1 {
    int G, c; const char* A1; const char* H;
    __device__ __forceinline__ bool next(int i, Unit& u) const {
        const int L = i * G + c; if (L >= 384) return false;
        u.pm = L & 7; u.pn = L >> 3; u.row0 = 0; u.a = A1 + (size_t)(u.pm & 1) * 256 * 256 * 2; u.b = H + (size_t)u.pn * 256 * D * 2 + (size_t)(u.pm >> 1) * 512; return true; }
};
struct OrderFn2 {
    int c; int samp; const char* A2; const char* YT;
    __device__ __forceinline__ bool next(int i, Unit& u) const {
        if (i > 0) return false;
        if (samp) { if (c >= 128) return false; const int b = c >> 6, tm = (c >> 2) & 15; u.pm = tm; u.pn = c & 3; u.row0 = MP + b * TS + 128 * tm;
            u.a = A2 + (size_t)tm * 128 * 2 * TS * 2; u.b = YT + (size_t)32 * D * 2 * TP * 2 + (size_t)b * D * 2 * TS * 2 + (size_t)u.pn * 256 * 2 * TS * 2; return true; }
        if (c < 128) return false; const int j = c - 128, s = j >> 2; u.pm = 0; u.pn = j & 3; u.row0 = s * TP;
        u.a = A2; u.b = YT + (size_t)s * D * 2 * TP * 2 + (size_t)u.pn * 256 * 2 * TP * 2; return true; }
};

__device__ __forceinline__ void p0_transpose_item(const float* W, int K, int N, bf16_t* WT, int drow0, LAS float* scr, int kb, int n0, int lane) {
    const int k0 = 64 * kb;
    f32x4 v[8];
#pragma unroll
    for (int i = 0; i < 8; ++i) v[i] = __builtin_nontemporal_load((const f32x4*)(W + (size_t)(k0 + 8 * i + (lane >> 3)) * N + n0 + 4 * (lane & 7)));
#pragma unroll
    for (int i = 0; i < 8; ++i) { LAS float* d = scr + (8 * i + (lane >> 3)) * 33 + 4 * (lane & 7); d[0] = v[i][0]; d[1] = v[i][1]; d[2] = v[i][2]; d[3] = v[i][3]; }
    LDS_WAIT(); asm volatile("" ::: "memory");
    const int c = lane & 7;
#pragma unroll
    for (int j = 0; j < 4; ++j) { const int n = (lane >> 3) + 8 * j; const LAS float* s = scr + (8 * c) * 33 + n;
        u32x4 o; o.x = pk2(s[0 * 33], s[1 * 33]); o.y = pk2(s[2 * 33], s[3 * 33]); o.z = pk2(s[4 * 33], s[5 * 33]); o.w = pk2(s[6 * 33], s[7 * 33]);
        *(u32x4*)(WT + (size_t)(drow0 + n) * K + k0 + 8 * c) = o; }
    LDS_WAIT(); asm volatile("" ::: "memory");
}
__device__ __forceinline__ int map_plain(int n) { return n; }
__device__ __forceinline__ int map_up(int n) { return n < DFF ? 256 * (n >> 7) + (n & 127) : 256 * ((n - DFF) >> 7) + 128 + ((n - DFF) & 127); }
__device__ __forceinline__ int map_sc(int n) {
    if (n < D) return (3 * (n >> 8) + 2) * 256 + (n & 255);
    const int x = n >= 2 * D, ch = n - D - x * D; return (3 * (ch >> 8) + ((ch >> 7) & 1)) * 256 + x * 128 + (ch & 127);
}
__device__ __forceinline__ void p0_tjob(int& it, int NGW, LAS float* scr, int lane, const float* W, bf16_t* WT, int K, int N, int map) {
    const int nblk = N / 32, nitems = (K / 64) * nblk;
    for (; it < nitems; it += NGW) { const int kb = it / nblk, n0 = (it % nblk) * 32; const int dr = map == 0 ? n0 : (map == 1 ? map_up(n0) : map_sc(n0));
        p0_transpose_item(W, K, N, WT, dr, scr, kb, n0, lane); }
    it -= nitems;
}
__device__ __forceinline__ void convert_layer(Frame& F, int l, int b0, int nb) {
    unsigned char* ws = F.ws;
    LAS float* scr = (LAS float*)(F.lds + F.wave * 16384);
    const int gw = (F.blk - b0) * NWAVES + F.wave, NGW = nb * NWAVES;
    int it = gw;
    if (l == 0) { p0_tjob(it, NGW, scr, F.lane, ((const float*)F.in[11]), (bf16_t*)(ws + WS_WQKV), D, 1536, 0);
        p0_tjob(it, NGW, scr, F.lane, ((const float*)F.in[12]), (bf16_t*)(ws + WS_WO), D, D, 0); }
    else if (l == 1) { p0_tjob(it, NGW, scr, F.lane, ((const float*)F.in[14]), (bf16_t*)(ws + WS_WSGI), D, 2048, 0);
        p0_tjob(it, NGW, scr, F.lane, ((const float*)F.in[18]), (bf16_t*)(ws + WS_WSGO), D, D, 0); }
    else if (l == 2) { p0_tjob(it, NGW, scr, F.lane, ((const float*)F.in[19]), (bf16_t*)(ws + WS_WSCI), D, 3072, 2);
        p0_tjob(it, NGW, scr, F.lane, ((const float*)F.in[21]), (bf16_t*)(ws + WS_WSCO), D, D, 0); }
    else p0_tjob(it, NGW, scr, F.lane, ((const float*)F.in[22]), (bf16_t*)(ws + WS_WFNO), D, D, 0);
    p0_tjob(it, NGW, scr, F.lane, ((const float*)F.in[23]) + (size_t)l * D * 2 * DFF, (bf16_t*)(ws + WS_WUP + l * WUP_BYTES), D, 2 * DFF, 1);
    p0_tjob(it, NGW, scr, F.lane, ((const float*)F.in[25]) + (size_t)l * DFF * D, (bf16_t*)(ws + WS_WDN + l * WDN_BYTES), DFF, D, 0);
    const size_t gt = (size_t)(F.blk - b0) * 512 + F.tid, NGT = (size_t)nb * 512;
    if (l == 1) { bf16_t* WSb = (bf16_t*)(ws + WS_WS); for (size_t i = gt; i < 8 * 128 * 128; i += NGT) WSb[i] = (bf16_t)f2bf(((const float*)F.in[16])[i]); }
    if (l == 3) {
        bf16_t* A1 = (bf16_t*)(ws + WS_A1);
        for (size_t i = gt; i < 2 * 256 * 256; i += NGT) { const int part = i >> 16, r = (i >> 8) & 255, k = i & 255; float v = 0.f;
            if ((r >> 7) == (k >> 7)) { const float a = 2.f * (float)(((r & 127) * (k & 127)) & 127) / 128.f; v = (part ? sinpif(a) : cospif(a)) * 0.08838834764831845f; }
            A1[i] = (bf16_t)f2bf(v); }
        bf16_t* A2P = (bf16_t*)(ws + WS_A2P);
        for (size_t i = gt; i < 256 * 512; i += NGT) { const int tp = i >> 9, k = i & 511, t = k & 255; const float a = 2.f * (float)((tp * t) & 255) / 256.f;
            A2P[i] = (bf16_t)f2bf((k < 256 ? cospif(a) : -sinpif(a)) * 0.0625f); }
        __syncthreads();
        LAS bf16_t* tab = (LAS bf16_t*)F.lds;
        for (int j = F.tid; j < 2048; j += 512) { const float a = 2.f * (float)j / 2048.f; tab[j] = (bf16_t)f2bf(cospif(a) * 0.022097086912079608f); tab[2048 + j] = (bf16_t)f2bf(-sinpif(a) * 0.022097086912079608f); }
        __syncthreads();
        bf16_t* A2S = (bf16_t*)(ws + WS_A2S);
        for (size_t i8 = gt; i8 < (size_t)2048 * 4096 / 8; i8 += NGT) { const int tp = (int)(i8 >> 9), k0 = (int)(i8 & 511) * 8, part = k0 >> 11, t0 = k0 & 2047;
            unsigned w[4];
#pragma unroll
            for (int e = 0; e < 4; ++e) { const unsigned lo = tab[part * 2048 + ((tp * (t0 + 2 * e)) & 2047)], hi = tab[part * 2048 + ((tp * (t0 + 2 * e + 1)) & 2047)]; w[e] = lo | (hi << 16); }
            *(u32x4*)(A2S + i8 * 8) = (u32x4){w[0], w[1], w[2], w[3]}; }
        __syncthreads();
    }
}
__device__ __forceinline__ void prefetch_region(Frame& F, const void* p, size_t bytes, int b0, int nb) {
    const size_t gt = (size_t)(F.blk - b0) * 512 + F.tid, NGT = (size_t)nb * 512; unsigned acc = 0;
    for (size_t i = gt * 128; i < bytes; i += NGT * 128) { const u32x4 v = *(const u32x4*)((const char*)p + i); acc += v.x ^ v.w; }
    if (acc == 0x9e3779b9u) *(volatile unsigned*)(F.ws + WS_CTL + CTL_TMO + 64) = acc;
}
__device__ __forceinline__ void mod_items(Frame& F, int lo, int hi, int b0, int nb) {
    unsigned char* ws = F.ws;
    LAS float* sv = (LAS float*)F.lds;
    LAS float* red = sv + 3 * D;
    __syncthreads();
    for (int i = F.tid; i < D; i += 512) { const float a = ((const float*)F.in[5])[i], b = ((const float*)F.in[4])[i], d = ((const float*)F.in[4])[D + i];
        sv[i] = a / (1.f + expf(-a)); sv[D + i] = b / (1.f + expf(-b)); sv[2 * D + i] = d / (1.f + expf(-d)); }
    __syncthreads();
    float* MODp = (float*)(ws + WS_MOD);
    const int kg = F.tid >> 3, cq = F.tid & 7;
    for (int it = lo + F.blk - b0; it < hi; it += nb) {
        const int l = it / 192, n0 = (it % 192) * 32;
        const float* w = ((const float*)F.in[6]) + (size_t)l * D * 6 * D + n0 + 4 * cq;
        f32x4 wv[16];
#pragma unroll
        for (int i = 0; i < 16; ++i) wv[i] = __builtin_nontemporal_load((const f32x4*)(w + (size_t)(kg + 64 * i) * 6 * D));
        f32x4 a[3] = {{0, 0, 0, 0}, {0, 0, 0, 0}, {0, 0, 0, 0}};
#pragma unroll
        for (int i = 0; i < 16; ++i) { const int k = kg + 64 * i; a[0] += sv[k] * wv[i]; a[1] += sv[D + k] * wv[i]; a[2] += sv[2 * D + k] * wv[i]; }
#pragma unroll
        for (int v = 0; v < 3; ++v)
#pragma unroll
            for (int j = 0; j < 4; ++j) { float x = a[v][j]; x += dppx<0x128>(x); a[v][j] = rows_sum(x); }
        if (F.lane < 8) {
#pragma unroll
            for (int v = 0; v < 3; ++v) *(LAS f32x4*)(red + (F.wave * 3 + v) * 32 + 4 * cq) = a[v]; }
        __syncthreads();
        if (F.tid < 96) { const int v = F.tid >> 5, cc = F.tid & 31; float s = 0.f;
#pragma unroll
            for (int g = 0; g < 8; ++g) s += red[(g * 3 + v) * 32 + cc];
            MODp[(l * 3 + v) * 6 * D + n0 + cc] = s + ((const float*)F.in[7])[l * 6 * D + n0 + cc]; }
        __syncthreads();
    }
}
__device__ __forceinline__ void p0_prologue(Frame& F) {
    unsigned char* ws = F.ws;
    mod_items(F, 0, 192, 0, F.G);
    {
        const size_t gt = (size_t)F.blk * 512 + F.tid, NGT = (size_t)F.G * 512;
        bf16_t* CK = (bf16_t*)(ws + WS_CK); bf16_t* CVT = (bf16_t*)(ws + WS_CVT);
        for (size_t i = gt; i < 2 * 512 * 256; i += NGT) { CK[i] = (bf16_t)f2bf(((const float*)F.in[2])[i]);
            const int d = i & 63, kvh = (i >> 6) & 3, j = (i >> 8) & 511, b = i >> 17; CVT[((size_t)(b * 4 + kvh) * 64 + d) * 512 + j] = (bf16_t)f2bf(((const float*)F.in[3])[i]); }
        float* rope = (float*)(ws + WS_ROPE);
        for (size_t i = gt; i < 1024; i += NGT) { const int pos = i >> 4, fi = i & 15; const float ang = (float)pos * powf(10000.f, -(float)fi / 16.f); rope[i] = cosf(ang); rope[1024 + i] = sinf(ang); }
    }
}

__device__ __forceinline__ void norm_phase(Frame& F, const float* src0, const float* src1, const float* g, const float* modl, int sh_idx, bf16_t* H) {
    const int gw = F.blk * NWAVES + F.wave, NGW = F.G * NWAVES;
    f32x4 gv[2][2];
#pragma unroll
    for (int h = 0; h < 2; ++h)
#pragma unroll
        for (int k = 0; k < 2; ++k) gv[h][k] = *(const f32x4*)(g + 512 * h + 8 * F.lane + 4 * k);
    for (int row = gw; row < M; row += NGW) {
        const float* xr = row < MP ? src0 + (size_t)row * D : src1 + (size_t)(row - MP) * D;
        const float* mv = modl + (row < MP ? 0 : 1 + (row - MP) / TS) * 6 * D;
        f32x4 v[2][2]; float s = 0.f;
#pragma unroll
        for (int h = 0; h < 2; ++h)
#pragma unroll
            for (int k = 0; k < 2; ++k) { v[h][k] = *(const f32x4*)(xr + 512 * h + 8 * F.lane + 4 * k); s += (v[h][k][0] * v[h][k][0] + v[h][k][1] * v[h][k][1]) + (v[h][k][2] * v[h][k][2] + v[h][k][3] * v[h][k][3]); }
        const float r = rsqrtf(wave_sum(s) * (1.f / D) + EPS);
#pragma unroll
        for (int h = 0; h < 2; ++h) { f32x4 o[2];
#pragma unroll
            for (int k = 0; k < 2; ++k) { const int c = 512 * h + 8 * F.lane + 4 * k; const f32x4 sh = *(const f32x4*)(mv + sh_idx * D + c), sc = *(const f32x4*)(mv + (sh_idx + 1) * D + c);
                o[k] = v[h][k] * r * gv[h][k] * (1.f + sc) + sh; }
            u32x4 w; w.x = pk2(o[0][0], o[0][1]); w.y = pk2(o[0][2], o[0][3]); w.z = pk2(o[1][0], o[1][1]); w.w = pk2(o[1][2], o[1][3]);
            *(u32x4*)(H + (size_t)row * D + 512 * h + 8 * F.lane) = w; }
    }
}
__device__ __forceinline__ void final_phase(Frame& F, const float* X, const float* g, float* out) {
    const int gw = F.blk * NWAVES + F.wave, NGW = F.G * NWAVES;
    f32x4 gv[4];
#pragma unroll
    for (int j = 0; j < 4; ++j) gv[j] = *(const f32x4*)(g + 256 * j + 4 * F.lane);
    for (int row = gw; row < M; row += NGW) {
        const float* xr = X + (size_t)row * D; f32x4 v[4]; float s = 0.f;
#pragma unroll
        for (int j = 0; j < 4; ++j) { v[j] = *(const f32x4*)(xr + 256 * j + 4 * F.lane); s += (v[j][0] * v[j][0] + v[j][1] * v[j][1]) + (v[j][2] * v[j][2] + v[j][3] * v[j][3]); }
        const float r = rsqrtf(wave_sum(s) * (1.f / D) + EPS);
#pragma unroll
        for (int j = 0; j < 4; ++j) *(f32x4*)(out + (size_t)row * D + 256 * j + 4 * F.lane) = v[j] * r * gv[j];
    }
}

constexpr int ATT_LDK = 144;
constexpr int ATT_TILE_BYTES = 2 * 64 * ATT_LDK;
struct AttTile { const bf16_t* K; const bf16_t* V; int ldk, ldv, k0, mask; };
__device__ __forceinline__ void att_tile_of(int t, bool lat, int nband, int kband0, int qc0, const bf16_t* KBs, const bf16_t* VTs, int T, const bf16_t* CKs, const bf16_t* CVTs, AttTile& o) {
    if (t < nband) { const int k0 = kband0 + 64 * t; o.K = KBs + (size_t)k0 * 256; o.V = VTs + k0; o.ldk = 256; o.ldv = T; o.k0 = k0; const int dk = k0 - qc0; o.mask = lat && (dk < -64 || dk > 64); }
    else { const int k0 = 64 * (t - nband); o.K = CKs + (size_t)k0 * 256; o.V = CVTs + k0; o.ldk = 256; o.ldv = 512; o.k0 = k0; o.mask = 0; }
}
__device__ __forceinline__ void attn_phase(Frame& F, const bf16_t* Q, const bf16_t* KB, const bf16_t* VT, const bf16_t* CK, const bf16_t* CVT, const float* sink, bf16_t* O) {
    const int fr = F.lane & 15, g4 = F.lane >> 4, tid = F.tid;
    const int lrow = tid >> 3, lchunk = tid & 7;
    LAS unsigned char* lds = F.lds;
    for (int it = F.blk; it < 768; it += F.G) {
        const bool lat = it < 256; int kvh, chunk, T, rowbase, b = 0; const bf16_t* vt;
        if (lat) { b = it >> 7; kvh = (it >> 5) & 3; chunk = it & 31; T = TS; rowbase = MP + b * TS; vt = VT + (size_t)32 * 65536 + (size_t)b * 256 * TS; }
        else { const int j = it - 256, s = j >> 4; kvh = (j >> 2) & 3; chunk = j & 3; T = TP; rowbase = s * TP; vt = VT + (size_t)s * 65536; }
        const int h = kvh * 4 + (F.wave & 3), q0 = chunk * 64 + (F.wave >> 2) * 32;
        int kband0 = 0, nband = T / 64;
        if (lat) { int lo = 64 * chunk - 128, hi = 64 * chunk + 192; lo = lo < 0 ? 0 : lo; hi = hi > T ? T : hi; kband0 = lo; nband = (hi - lo) / 64; }
        const int ntile = nband + (lat ? 8 : 0);
        const bf16_t* KBs = KB + (size_t)rowbase * 256 + kvh * 64; const bf16_t* VTs = vt + (size_t)(kvh * 64) * T;
        const bf16_t* CKs = CK + (size_t)b * 512 * 256 + kvh * 64; const bf16_t* CVTs = CVT + (size_t)((b * 4 + kvh) * 64) * 512;
        bf16x8 Qf[2][2];
#pragma unroll
        for (int qg = 0; qg < 2; ++qg)
#pragma unroll
            for (int ds = 0; ds < 2; ++ds) Qf[qg][ds] = *(const bf16x8*)(Q + (size_t)(rowbase + q0 + 16 * qg + fr) * D + h * 64 + 32 * ds + 8 * g4);
        float mrun[2], lrun[2]; f32x4 Oa[2][4];
#pragma unroll
        for (int qg = 0; qg < 2; ++qg) { mrun[qg] = sink[h] * 1.4426950408889634f; lrun[qg] = 1.f;
#pragma unroll
            for (int db = 0; db < 4; ++db) Oa[qg][db] = (f32x4){0.f, 0.f, 0.f, 0.f}; }
        AttTile tl; att_tile_of(0, lat, nband, kband0, 64 * chunk, KBs, VTs, T, CKs, CVTs, tl);
        u32x4 rk = *(const u32x4*)(tl.K + (size_t)lrow * tl.ldk + lchunk * 8), rv = *(const u32x4*)(tl.V + (size_t)lrow * tl.ldv + lchunk * 8);
        __syncthreads();
        *(LAS u32x4*)(lds + lrow * ATT_LDK + lchunk * 16) = rk; *(LAS u32x4*)(lds + 64 * ATT_LDK + lrow * ATT_LDK + lchunk * 16) = rv;
        __syncthreads();
#pragma unroll 1
        for (int t = 0; t < ntile; ++t) {
            const int cur_k0 = tl.k0, cur_mask = tl.mask;
            if (t + 1 < ntile) { att_tile_of(t + 1, lat, nband, kband0, 64 * chunk, KBs, VTs, T, CKs, CVTs, tl);
                rk = *(const u32x4*)(tl.K + (size_t)lrow * tl.ldk + lchunk * 8); rv = *(const u32x4*)(tl.V + (size_t)lrow * tl.ldv + lchunk * 8); }
            const LAS unsigned char* kb_ = lds + (t & 1) * ATT_TILE_BYTES; const LAS unsigned char* vb_ = kb_ + 64 * ATT_LDK;
            {
                bf16x8 Kf[2][2][2], Vf[2][4];
#pragma unroll
                for (int sub = 0; sub < 2; ++sub) {
#pragma unroll
                    for (int kb = 0; kb < 2; ++kb)
#pragma unroll
                        for (int ds = 0; ds < 2; ++ds) Kf[sub][kb][ds] = *(const LAS bf16x8*)(kb_ + (32 * sub + 16 * kb + fr) * ATT_LDK + 64 * ds + 16 * g4);
#pragma unroll
                    for (int db = 0; db < 4; ++db) { const LAS unsigned char* vp = vb_ + (16 * db + fr) * ATT_LDK + 64 * sub + 8 * g4; const u32x2 lo = *(const LAS u32x2*)vp, hi = *(const LAS u32x2*)(vp + 32);
                        Vf[sub][db] = __builtin_bit_cast(bf16x8, (u32x4){lo.x, lo.y, hi.x, hi.y}); }
                }
                const float c = 0.125f * 1.4426950408889634f;
                f32x4 S[2][2][2];
#pragma unroll
                for (int qg = 0; qg < 2; ++qg)
#pragma unroll
                    for (int sub = 0; sub < 2; ++sub)
#pragma unroll
                        for (int kb = 0; kb < 2; ++kb) { S[qg][sub][kb] = __builtin_amdgcn_mfma_f32_16x16x32_bf16(Kf[sub][kb][0], Qf[qg][0], (f32x4){0.f, 0.f, 0.f, 0.f}, 0, 0, 0);
                            S[qg][sub][kb] = __builtin_amdgcn_mfma_f32_16x16x32_bf16(Kf[sub][kb][1], Qf[qg][1], S[qg][sub][kb], 0, 0, 0); }
                float mnew[2], rs[2];
#pragma unroll
                for (int qg = 0; qg < 2; ++qg) {
                    const int qpos = q0 + 16 * qg + fr;
                    if (cur_mask) {
#pragma unroll
                        for (int sub = 0; sub < 2; ++sub)
#pragma unroll
                            for (int kb = 0; kb < 2; ++kb)
#pragma unroll
                                for (int r = 0; r < 4; ++r) { const int d = cur_k0 + 32 * sub + 16 * kb + 4 * g4 + r - qpos; if (d > 128 || d < -128) S[qg][sub][kb][r] = -1e30f; }
                    }
                    float mx = -1e30f;
#pragma unroll
                    for (int sub = 0; sub < 2; ++sub)
#pragma unroll
                        for (int kb = 0; kb < 2; ++kb) mx = fmaxf(fmaxf(mx, fmaxf(S[qg][sub][kb][0], S[qg][sub][kb][1])), fmaxf(S[qg][sub][kb][2], S[qg][sub][kb][3]));
                    mx = rows_max(mx) * c;
                    mnew[qg] = fmaxf(mrun[qg], mx);
                    float r_ = 0.f;
#pragma unroll
                    for (int sub = 0; sub < 2; ++sub)
#pragma unroll
                        for (int kb = 0; kb < 2; ++kb)
#pragma unroll
                            for (int r = 0; r < 4; ++r) { const float p = fast_exp2(__builtin_fmaf(S[qg][sub][kb][r], c, -mnew[qg])); S[qg][sub][kb][r] = p; r_ += p; }
                    rs[qg] = rows_sum(r_);
                }
                if (__builtin_amdgcn_ballot_w64(mnew[0] > mrun[0] || mnew[1] > mrun[1]) != 0ull) {
#pragma unroll
                    for (int qg = 0; qg < 2; ++qg) { const float alpha = fast_exp2(mrun[qg] - mnew[qg]); lrun[qg] *= alpha;
#pragma unroll
                        for (int db = 0; db < 4; ++db) Oa[qg][db] = Oa[qg][db] * alpha; }
                }
#pragma unroll
                for (int qg = 0; qg < 2; ++qg) { lrun[qg] += rs[qg]; mrun[qg] = mnew[qg];
#pragma unroll
                    for (int sub = 0; sub < 2; ++sub) {
                        u32x4 pw; pw.x = cvt_pk_bf16(S[qg][sub][0][0], S[qg][sub][0][1]); pw.y = cvt_pk_bf16(S[qg][sub][0][2], S[qg][sub][0][3]); pw.z = cvt_pk_bf16(S[qg][sub][1][0], S[qg][sub][1][1]); pw.w = cvt_pk_bf16(S[qg][sub][1][2], S[qg][sub][1][3]);
                        const bf16x8 Pf = __builtin_bit_cast(bf16x8, pw);
#pragma unroll
                        for (int db = 0; db < 4; ++db) Oa[qg][db] = __builtin_amdgcn_mfma_f32_16x16x32_bf16(Vf[sub][db], Pf, Oa[qg][db], 0, 0, 0); } }
            }
            if (t + 1 < ntile) { LAS unsigned char* nb = lds + ((t + 1) & 1) * ATT_TILE_BYTES;
                *(LAS u32x4*)(nb + lrow * ATT_LDK + lchunk * 16) = rk; *(LAS u32x4*)(nb + 64 * ATT_LDK + lrow * ATT_LDK + lchunk * 16) = rv; }
            __syncthreads();
        }
#pragma unroll
        for (int qg = 0; qg < 2; ++qg) { const float inv = 1.f / lrun[qg];
#pragma unroll
            for (int dp = 0; dp < 2; ++dp) { u32x2 w[2];
#pragma unroll
                for (int k = 0; k < 2; ++k) { const f32x4 o = Oa[qg][2 * dp + k] * inv; w[k].x = cvt_pk_bf16(o[0], o[1]); w[k].y = cvt_pk_bf16(o[2], o[3]); }
                *(u32x4*)(O + (size_t)(rowbase + q0 + 16 * qg + fr) * D + h * 64 + 32 * dp + 4 * g4 + ((g4 & 1) ? 12 : 0)) = merge_quads16(w[0], w[1]); } }
    }
}

__device__ __forceinline__ void sgu_phase(Frame& F, const bf16_t* U, const bf16_t* V, const f32x2* STATS, const float* ln_g, const bf16_t* WSb, const float* b_s, bf16_t* UM) {
    constexpr int LDT = 136;
    LAS bf16_t* LT = (LAS bf16_t*)F.lds;
    LAS f32x2* ST = (LAS f32x2*)(F.lds + 128 * LDT * 2);
    const int fr = F.lane & 15, g4 = F.lane >> 4;
    for (int it = F.blk; it < 768; it += F.G) {
        const int ch = it >> 3, g = it & 7, r0 = ch * 128;
        if (F.tid < 128) { const f32x2* sp = STATS + (size_t)(r0 + F.tid) * 16; float s1 = 0.f, s2 = 0.f;
#pragma unroll
            for (int k = 0; k < 16; ++k) { const f32x2 p = sp[k]; s1 += p.x; s2 += p.y; }
            const float mu = s1 * (1.f / D), var = s2 * (1.f / D) - mu * mu; ST[F.tid] = (f32x2){mu, rsqrtf(fmaxf(var, 0.f) + EPS)}; }
        __syncthreads();
#pragma unroll
        for (int i = 0; i < 4; ++i) { const int q = F.tid + 512 * i, r = q & 127, c8 = (q >> 7) * 8;
            const u32x4 raw = *(const u32x4*)(V + (size_t)(r0 + r) * D + g * 128 + c8); const f32x2 st = ST[r];
            const f32x4 ga = *(const f32x4*)(ln_g + g * 128 + c8), gb = *(const f32x4*)(ln_g + g * 128 + c8 + 4);
            const unsigned rw[4] = {raw.x, raw.y, raw.z, raw.w};
#pragma unroll
            for (int e = 0; e < 8; ++e) { const float x = bf2f((unsigned short)(e & 1 ? rw[e >> 1] >> 16 : rw[e >> 1] & 0xffff)); const float gg = e < 4 ? ga[e & 3] : gb[e & 3];
                LT[(c8 + e) * LDT + r] = (bf16_t)f2bf((x - st.x) * st.y * gg); } }
        __syncthreads();
        f32x4 acc[8];
#pragma unroll
        for (int cb = 0; cb < 8; ++cb) acc[cb] = (f32x4){0.f, 0.f, 0.f, 0.f};
        const int p = 16 * F.wave + fr;
#pragma unroll
        for (int ks = 0; ks < 4; ++ks) { const bf16x8 bw = *(const bf16x8*)(WSb + (size_t)(g * 128 + p) * 128 + 32 * ks + 8 * g4);
#pragma unroll
            for (int cb = 0; cb < 8; ++cb) { const bf16x8 av = *(const LAS bf16x8*)(LT + (16 * cb + fr) * LDT + 32 * ks + 8 * g4); acc[cb] = __builtin_amdgcn_mfma_f32_16x16x32_bf16(av, bw, acc[cb], 0, 0, 0); } }
        const float bsv = b_s[g * 128 + p];
#pragma unroll
        for (int cp = 0; cp < 4; ++cp) {
            const size_t off = (size_t)(r0 + p) * D + g * 128 + 32 * cp + 4 * g4 + ((g4 & 1) ? 12 : 0);
            u32x2 uq[2]; split_quads16(*(const u32x4*)(U + off), uq[0], uq[1]);
            u32x2 w[2];
#pragma unroll
            for (int k = 0; k < 2; ++k) { const f32x4 a = acc[2 * cp + k];
                const float u0 = bf2f((unsigned short)(uq[k].x & 0xffff)), u1 = bf2f((unsigned short)(uq[k].x >> 16)), u2 = bf2f((unsigned short)(uq[k].y & 0xffff)), u3 = bf2f((unsigned short)(uq[k].y >> 16));
                w[k].x = cvt_pk_bf16(u0 * (a[0] + bsv), u1 * (a[1] + bsv)); w[k].y = cvt_pk_bf16(u2 * (a[2] + bsv), u3 * (a[3] + bsv)); }
            *(u32x4*)(UM + off) = merge_quads16(w[0], w[1]); }
        __syncthreads();
    }
}

struct Args { const float* in[26]; float* out; unsigned char* ws; int ph_lo, ph_hi; };
__global__ void __launch_bounds__(NWAVES * 64, 2) mk_fwd(const Args args) {
    extern __shared__ __attribute__((aligned(16))) unsigned char lds_raw[];
    Frame F;
    F.lds = (LAS unsigned char*)lds_raw;
    const int wave0 = __builtin_amdgcn_readfirstlane((int)threadIdx.x >> 6);
    F.wave = wave0; F.lane = pg8::lane_id(); F.tid = wave0 * 64 + F.lane;
    const int grid0 = gridDim.x, blk0 = blockIdx.x; F.G = grid0; F.blk = blk0;
    F.in = (const __attribute__((address_space(4))) cfp_t*)__builtin_amdgcn_kernarg_segment_ptr();
    F.out = args.out; F.ws = args.ws;
    unsigned char* ws = args.ws;
    volatile LAS unsigned* MISC = (volatile LAS unsigned*)(F.lds + MISC_OFF);
    if (F.tid < 32) MISC[F.tid] = 0u;
    __syncthreads();
    const int lo = args.ph_lo, hi = args.ph_hi;
    XcdBarrier bar; bar.bar = (unsigned*)(ws + WS_CTL); bar.x = 0; bar.st = nullptr;
    if (hi - lo > 1) bar = xcd_barrier_post((unsigned*)(ws + WS_CTL), MISC + 8, F.tid == 0);
    LAS float* XCH = (LAS float*)(F.lds + XCH_OFF);
#define CASE_BEGIN() { int b_ = blk0, w_ = wave0, g_ = grid0; asm volatile("" : "+s"(b_), "+s"(w_), "+s"(g_)); F.blk = b_; F.wave = w_; F.G = g_; } frame_refresh(F); unsigned long long ws_ = (unsigned long long)args.ws, in_ = (unsigned long long)__builtin_amdgcn_kernarg_segment_ptr(); asm volatile("" : "+s"(ws_), "+s"(in_)); \
        unsigned char* ws = (unsigned char*)(GAS unsigned char*)ws_; F.ws = ws; F.in = (const __attribute__((address_space(4))) cfp_t*)in_; \
        float* X = (float*)(ws + WS_X); bf16_t* H = (bf16_t*)(ws + WS_H); bf16_t* H2 = (bf16_t*)(ws + WS_H2); bf16_t* HN = (bf16_t*)(ws + WS_HN); (void)HN; \
        const float* modl = (const float*)(ws + WS_MOD) + l * 3 * 6 * D; const float* xs0 = l == 0 ? ((const float*)F.in[0]) : X; const float* xs1 = l == 0 ? ((const float*)F.in[1]) : X + (size_t)MP * D; \
        (void)X; (void)H; (void)H2; (void)modl; (void)xs0; (void)xs1
#pragma unroll 1
    for (int ph = lo; ph < hi; ++ph) {
        int l = 0, kind;
        if (ph == 0) kind = 0; else if (ph == 1) kind = 1;
        else { l = ph < 7 ? 0 : ph < 12 ? 1 : ph < 16 ? 2 : 3; const int j = ph - (l == 0 ? 2 : l == 1 ? 7 : l == 2 ? 12 : 16), n = l == 2 ? 1 : 2;
            kind = j < n ? (l == 0 ? 2 + j : l == 1 ? 4 + j : l == 2 ? 6 : 7 + j) : j == n ? 9 : j == n + 1 ? 10 : 11; }
        const int reps = (kind == MK_REP_KIND) ? 1 + MK_REP_N : 1;
        const bool tp_here = MK_TP && ph == MK_TP_PH && blk0 == 0;
        unsigned long long tp_r0 = 0, tp_c0 = 0; if (tp_here) { tp_r0 = __builtin_amdgcn_s_memrealtime(); tp_c0 = __builtin_amdgcn_s_memtime(); }
#pragma unroll 1
        for (int rep = 0; rep < reps; ++rep) {
        if (rep > 0) xcd_barrier(bar, wave0 == 0 && pg8::lane_id() == 0);
        switch (kind) {
        case 0: if (EN(0)) { CASE_BEGIN(); p0_prologue(F); } break;
        case 1: if (EN(1)) { CASE_BEGIN(); norm_phase(F, xs0, xs1, ((const float*)F.in[8]), modl, 0, HN);
                if (rep == 0) convert_layer(F, 0, 0, F.G); } break;
        case 2: if (EN(2)) { CASE_BEGIN(); Order<64, 6, 0, D, D, 192> S; S.init(F.G, F.blk, HN, ws + WS_WQKV);
                EpiQKV E{{ws, l, 0}};
                pg8::gemm_phase<D, D, D / 64, 192>(F.lds, S, E, F.wave, tp_here);
                if (MK_PREFETCH && rep == 0 && F.blk >= 128) { frame_refresh(F); prefetch_region(F, ws + WS_WO, 2 * MiB, 128, F.G - 128); prefetch_region(F, ws + WS_WUP, WUP_BYTES, 128, F.G - 128); } } break;
        case 3: if (EN(3)) { CASE_BEGIN(); attn_phase(F, (const bf16_t*)(ws + WS_Q), (const bf16_t*)(ws + WS_KB), (const bf16_t*)(ws + WS_VT), (const bf16_t*)(ws + WS_CK), (const bf16_t*)(ws + WS_CVT), ((const float*)F.in[13]), H); } break;
        case 4: if (EN(4)) { CASE_BEGIN(); Order<64, 8, 0, D, D, 192> S; S.init(F.G, F.blk, HN, ws + WS_WSGI);
                EpiSgu E{{ws, l, 0}};
                pg8::gemm_phase<D, D, D / 64, 192>(F.lds, S, E, F.wave, tp_here);
                } break;
        case 5: if (EN(5)) { CASE_BEGIN(); sgu_phase(F, (const bf16_t*)(ws + WS_U), (const bf16_t*)(ws + WS_V), (const f32x2*)(ws + WS_STATS), ((const float*)F.in[15]), (const bf16_t*)(ws + WS_WS), ((const float*)F.in[17]), H); } break;
        case 6: if (EN(6)) { CASE_BEGIN(); OrderSc S{F.blk, (const char*)HN, (const char*)(ws + WS_WSCI)};
                EpiSc E{{ws, l, F.blk}};
                pg8::gemm_phase<D, D, D / 64>(F.lds, S, E, F.wave, tp_here);
                if (MK_PREFETCH && rep == 0 && F.blk >= 200) { frame_refresh(F); prefetch_region(F, ws + WS_WSCO, 2 * MiB, 200, F.G - 200); prefetch_region(F, ws + WS_WUP + 2 * WUP_BYTES, WUP_BYTES, 200, F.G - 200); } } break;
        case 7: if (EN(7)) { CASE_BEGIN(); OrderFn1 S{F.G, F.blk, (const char*)(ws + WS_A1), (const char*)HN};
                EpiFn1 E{{ws, l, 0}};
                pg8::gemm_phase<256, D, 4>(F.lds, S, E, F.wave, tp_here);
                if (MK_PREFETCH && F.blk >= 128) { frame_refresh(F); prefetch_region(F, ws + WS_A2S, 16 * MiB, 128, F.G - 128); prefetch_region(F, ws + WS_WUP + 3 * WUP_BYTES, WUP_BYTES, 128, F.G - 128); } } break;
        case 8: if (EN(8)) { CASE_BEGIN();
                if (F.blk < 128) { EpiBf16<128> E{{ws, l, 0}}; OrderFn2 S{F.blk, 1, (const char*)(ws + WS_A2S), (const char*)(ws + WS_YT)}; pg8::gemm_phase<2 * TS, 2 * TS, 2 * TS / 64, 128>(F.lds, S, E, F.wave, tp_here); }
                else { EpiBf16<256> E{{ws, l, 0}}; OrderFn2 S{F.blk, 0, (const char*)(ws + WS_A2P), (const char*)(ws + WS_YT)}; pg8::gemm_phase<2 * TP, 2 * TP, 2 * TP / 64>(F.lds, S, E, F.wave, tp_here);
                    if (MK_PREFETCH) { frame_refresh(F); prefetch_region(F, ws + WS_WFNO, 2 * MiB, 128, F.G - 128); } } } break;
        case 9: if (EN(9)) { CASE_BEGIN(); const bf16_t* mix_in = l == 2 ? H2 : H;
                const bf16_t* wout = (const bf16_t*)(ws + (l == 0 ? WS_WO : l == 1 ? WS_WSGO : l == 2 ? WS_WSCO : WS_WFNO));
                Order<64, 4, 0, D, D, 192> S; S.init(F.G, F.blk, mix_in, wout);
                EpiResNorm<false> E{{ws, l, rep ? 2 : 0}};
                if (MK_REP_SHORTK && MK_REP_KIND == 9 && rep > 0) { pg8::gemm_phase<D, D, 4, 192>(F.lds, S, E, F.wave, tp_here); break; }
                pg8::gemm_phase<D, D, D / 64, 192>(F.lds, S, E, F.wave, tp_here);
                } break;
        case 10: if (EN(11)) { CASE_BEGIN(); Order<50, 22, 1, D, D> S; S.init(F.G, F.blk, HN, ws + WS_WUP + l * WUP_BYTES);
                if (MK_REP_NULL && rep > 0) { EpiNull E{{ws, l, 0}}; pg8::gemm_phase<D, D, D / 64>(F.lds, S, E, F.wave, tp_here); }
                else if (MK_REP_SHORTK && MK_REP_KIND == 10 && rep > 0) { EpiUp E{{ws, l, 0}}; pg8::gemm_phase<D, D, 4>(F.lds, S, E, F.wave, tp_here); }
                else { EpiUp E{{ws, l, 0}};
                pg8::gemm_phase<D, D, D / 64>(F.lds, S, E, F.wave, tp_here); }
                if (rep == 0 && F.blk >= 76) { frame_refresh(F);
                    if (l < 3) { mod_items(F, 192 * (l + 1), 192 * (l + 2), 76, F.G - 76); convert_layer(F, l + 1, 76, F.G - 76); }
                    if (MK_PREFETCH) { prefetch_region(F, ws + WS_WDN + l * WDN_BYTES, WDN_BYTES, 76, F.G - 76); } } } break;
        default: if (EN(12)) { CASE_BEGIN(); Order<64, 4, 0, DFF, DFF, 192> S; S.init(F.G, F.blk, ws + WS_ACT, ws + WS_WDN + l * WDN_BYTES);
                if (l < 3) { EpiResNorm<false> E{{ws, l, 1 | (rep ? 2 : 0)}}; pg8::gemm_phase<DFF, DFF, DFF / 64, 192>(F.lds, S, E, F.wave, tp_here); }
                else { EpiResNorm<true> E{{ws, l, 1 | (rep ? 2 : 0)}}; pg8::gemm_phase<DFF, DFF, DFF / 64, 192>(F.lds, S, E, F.wave, tp_here); } } break;
        }
        }
        if (tp_here && wave0 == 0 && pg8::lane_id() == 0) { const unsigned long long r1 = __builtin_amdgcn_s_memrealtime(), c1 = __builtin_amdgcn_s_memtime();
            if (MK_TP == 1) MISC[16] = (unsigned)(r1 - tp_r0);
            if (MK_TP == 3) MISC[16] = (unsigned)((c1 - tp_c0) * 10ull / (r1 - tp_r0)) * 10u; }
        if (ph + 1 < hi) xcd_barrier(bar, wave0 == 0 && pg8::lane_id() == 0);
    }
    if (MK_TP && blk0 == 0 && wave0 == 0) { const unsigned v = MISC[16] * (MK_TP == 2 ? 4u : 1u); const unsigned long long t0 = __builtin_amdgcn_s_memrealtime();
        while (__builtin_amdgcn_s_memrealtime() - t0 < v) __builtin_amdgcn_s_sleep(8); }
}

extern "C" void kernel_launch(void* const* d_in, const int* in_sizes, int n_in, void* d_out, int out_size, void* d_ws, size_t ws_size, hipStream_t stream) {
    static int grid = 0;
    if (grid == 0) {
        if (n_in != 26 || ws_size < WS_TOTAL + (MK_REP_N ? (size_t)73 * MiB : 0)) { fprintf(stderr, "kernel_launch: unexpected n_in %d / ws %zu (need %zu)\n", n_in, ws_size, (size_t)WS_TOTAL); grid = -1; return; }
        int dev = 0, cus = 0;
        if (hipGetDevice(&dev) != hipSuccess || hipDeviceGetAttribute(&cus, hipDeviceAttributeMultiprocessorCount, dev) != hipSuccess) { grid = -1; return; }
        if (hipFuncSetAttribute((const void*)mk_fwd, hipFuncAttributeMaxDynamicSharedMemorySize, LDS_BYTES) != hipSuccess) { fprintf(stderr, "kernel_launch: hipFuncSetAttribute failed\n"); grid = -1; return; }
        (void)hipGetLastError();
        grid = cus;
    }
    if (grid < 0) return;
    (void)hipMemsetAsync((char*)d_ws + WS_CTL, 0, CTL_ZERO_BYTES, stream);
    Args a{};
    for (int i = 0; i < 26; ++i) a.in[i] = (const float*)d_in[i];
    a.out = (float*)d_out; a.ws = (unsigned char*)d_ws;
#if MK_PER_PHASE
    for (int p = MK_PH_LO; p < MK_PH_HI; ++p) { a.ph_lo = p; a.ph_hi = p + 1; hipLaunchKernelGGL(mk_fwd, dim3(grid), dim3(NWAVES * 64), LDS_BYTES, stream, a); }
#else
    a.ph_lo = MK_PH_LO; a.ph_hi = MK_PH_HI;
    hipLaunchKernelGGL(mk_fwd, dim3(grid), dim3(NWAVES * 64), LDS_BYTES, stream, a);
#endif
}
```

```cpp
#include <hip/hip_runtime.h>
#include <cstdio>

#define LAS __attribute__((address_space(3)))
#define GAS __attribute__((address_space(1)))
typedef unsigned short bf16_t;
typedef short bf16x8 __attribute__((ext_vector_type(8)));
typedef float f32x4 __attribute__((ext_vector_type(4)));
typedef float f32x2 __attribute__((ext_vector_type(2)));
typedef unsigned u32x4 __attribute__((ext_vector_type(4)));
typedef unsigned u32x2 __attribute__((ext_vector_type(2)));

constexpr int D = 1024, MP = 8192, MS = 4096, M = MP + MS, DFF = 2816, TS = 2048, TP = 256;
constexpr float EPS = 1e-6f;
constexpr int NWAVES = 8;
#ifndef MK_PER_PHASE
#define MK_PER_PHASE 0
#endif
#ifndef MK_PH_LO
#define MK_PH_LO 0
#endif
#ifndef MK_PH_HI
#define MK_PH_HI 21
#endif
#ifndef MK_MASK
#define MK_MASK 0xffffffffu
#endif
#define EN(b) (((MK_MASK) >> (b)) & 1u)
#ifndef MK_REP_KIND
#define MK_REP_KIND -1
#endif
#ifndef MK_REP_N
#define MK_REP_N 0
#endif
#ifndef MK_REP_NULL
#define MK_REP_NULL 0
#endif
#ifndef MK_REP_SHORTK
#define MK_REP_SHORTK 0
#endif
#ifndef MK_PREFETCH
#define MK_PREFETCH 1
#endif
#ifndef MK_PRE
#define MK_PRE 1
#endif
#ifndef MK_EPF
#define MK_EPF 0
#endif
#ifndef MK_PFD
#define MK_PFD 8
#endif
#ifndef MK_TP_SEG
#define MK_TP_SEG 1
#endif
#define TP_STAMP(k) do { if (MK_TP == 4 && MK_TP_SEG == (k) && wid == 0 && lane == 0) { volatile LAS unsigned* m_ = (volatile LAS unsigned*)((LAS unsigned char*)xch() - XCH_OFF + MISC_OFF); \
    m_[17] = (unsigned)__builtin_amdgcn_s_memrealtime() - m_[18]; } } while (0)
#ifndef MK_TP
#define MK_TP 0
#endif
#ifndef MK_TP_PH
#define MK_TP_PH 10
#endif

namespace pg8 {
constexpr int BM = 256, BK = 64, HALF = 128, HTB = HALF * BK * 2, STAGE_BYTES = 8 * HTB, NXCD = 8, WGM = 8;
__host__ __device__ __forceinline__ int lds_byte(int r, int c) { const int st = (r >> 4) * 2 + (c >> 5), rr = r & 15, cc = c & 31, ob = rr * 64 + cc * 2; return st * 1024 + (ob ^ (((ob >> 9) & 1) << 5)); }
__host__ __device__ __forceinline__ void stage_rc(int b, int& R, int& C) { const int st = b / 1024, sb = b % 1024, swz = sb ^ (((sb >> 9) & 1) << 5); R = (st >> 1) * 16 + swz / 64; C = (st & 1) * 32 + (swz % 64) / 2; }
__host__ __device__ __forceinline__ int perm32(int rho) { const int n = rho >> 4, i = rho & 15; return 8 * (i >> 2) + 4 * n + (i & 3); }

__host__ __device__ __forceinline__ constexpr int pre_slot(int k) {
    return ((k >> 1) == 0 ? 4 : (k >> 1) == 1 ? 5 : (k >> 1) == 2 ? 0 : (k >> 1) == 3 ? 1 : (k >> 1) == 4 ? 6 : 7) * (HALF * BK * 2) + (k & 1) * 8192; }
struct Unit { int pm, pn, row0; const char* a; const char* b; };
struct Cfg { int lda, ldb, nt; };

__device__ __forceinline__ int lane_id() { return (int)__builtin_amdgcn_mbcnt_hi(~0u, __builtin_amdgcn_mbcnt_lo(~0u, 0u)); }
__device__ __forceinline__ unsigned cvt_pk_bf16(float lo, float hi) { unsigned r; asm volatile("v_cvt_pk_bf16_f32 %0, %1, %2" : "=v"(r) : "v"(lo), "v"(hi)); return r; }

template <int LDA, int LDB, int NT, int ROWS = 256, class Epi, class Sched>
__device__ __forceinline__ void gemm_phase(LAS unsigned char* lds, const Sched& S, const Epi& E, int wid, bool tp_on = false) {
    constexpr Cfg g{LDA, LDB, NT};
    int lane_ = lane_id(); asm volatile("" : "+v"(lane_));
    const int lane = lane_, tid = wid * 64 + lane, wr = wid >> 2, wc = wid & 3, fr = lane & 15, fq = lane >> 4;
    const int nt = g.nt;
    unsigned voffA[2], voffB[2];
#pragma unroll
    for (int i = 0; i < 2; ++i) { int R, C; stage_rc(tid * 16 + i * 8192, R, C); const int Rb = Epi::PERM ? ((R & ~31) + perm32(R & 31)) : R;
        voffA[i] = (unsigned)(R * g.lda + C) * 2u; voffB[i] = (unsigned)(Rb * g.ldb + C) * 2u; }
    unsigned voffA1[2]; voffA1[0] = ROWS == 128 ? 0u : voffA[0]; voffA1[1] = ROWS == 256 ? voffA[1] : 0u;
    const size_t kstep = (size_t)(BK * 2);
    const size_t hstepA = (size_t)HALF * g.lda * 2, hstepB = (size_t)HALF * g.ldb * 2;
    const unsigned ldsw = (unsigned)wid * 1024u;
    constexpr int NM1 = ROWS == 192 ? 2 : ROWS == 128 ? 0 : 4;
    const int aoff = lds_byte(wr * 64 + fr, fq * 8), boff = lds_byte(wc * 32 + fr, fq * 8), aoff1 = ROWS == 192 ? lds_byte(wr * 32 + fr, fq * 8) : aoff;
#define PG8_SA(b, h) (((b) * 2 + (h)) * HTB)
#define PG8_SB(b, h) ((4 + (b) * 2 + (h)) * HTB)
#define PG8_STAGE(bufoff, gbase, voff) do { _Pragma("unroll") for (int _i = 0; _i < 2; ++_i) { unsigned _vo = (voff)[_i]; asm volatile("" : "+v"(_vo)); \
        __builtin_amdgcn_global_load_lds((const unsigned*)((const char*)(gbase) + _vo), (LAS unsigned*)(lds + (bufoff) + ldsw + _i * 8192), 16, 0, 0); } } while (0)
#define PG8_LDA(dst, b, h) do { _Pragma("unroll") for (int m = 0; m < 4; ++m) _Pragma("unroll") for (int k = 0; k < 2; ++k) dst[m][k] = *(const LAS bf16x8*)(lds + PG8_SA(b, h) + aoff + m * 2048 + k * 1024); } while (0)
#define PG8_LDA1(dst, b) do { _Pragma("unroll") for (int m = 0; m < NM1; ++m) _Pragma("unroll") for (int k = 0; k < 2; ++k) dst[m][k] = *(const LAS bf16x8*)(lds + PG8_SA(b, 1) + aoff1 + m * 2048 + k * 1024); } while (0)
#define PG8_LDB(dst, b, h) do { _Pragma("unroll") for (int n = 0; n < 2; ++n) _Pragma("unroll") for (int k = 0; k < 2; ++k) dst[n][k] = *(const LAS bf16x8*)(lds + PG8_SB(b, h) + boff + n * 2048 + k * 1024); } while (0)
#define PG8_MMA(ai, bj, At, Bt) do { __builtin_amdgcn_s_setprio(1); _Pragma("unroll") for (int m = 0; m < 4; ++m) _Pragma("unroll") for (int n = 0; n < 2; ++n) _Pragma("unroll") for (int k = 0; k < 2; ++k) \
        acc[ai][bj][m][n] = __builtin_amdgcn_mfma_f32_16x16x32_bf16(Bt[n][k], At[m][k], acc[ai][bj][m][n], 0, 0, 0); __builtin_amdgcn_s_setprio(0); } while (0)
#define PG8_MMA1(bj, At, Bt) do { __builtin_amdgcn_s_setprio(1); _Pragma("unroll") for (int m = 0; m < NM1; ++m) _Pragma("unroll") for (int n = 0; n < 2; ++n) _Pragma("unroll") for (int k = 0; k < 2; ++k) \
        acc[1][bj][m][n] = __builtin_amdgcn_mfma_f32_16x16x32_bf16(Bt[n][k], At[m][k], acc[1][bj][m][n], 0, 0, 0); __builtin_amdgcn_s_setprio(0); } while (0)
#define PG8_WAIT_V(n) asm volatile("s_waitcnt vmcnt(" #n ")" ::: "memory")
#define PG8_WAIT_L(n) asm volatile("s_waitcnt lgkmcnt(" #n ")" ::: "memory")
#define PG8_BAR __builtin_amdgcn_s_barrier()
#define PG8_SCHED __builtin_amdgcn_sched_barrier(0)
    Unit cur, nxt; int ui = 0;
    if (!S.next(0, cur)) return;
    f32x4 acc[2][2][4][2];
#pragma unroll
    for (int a = 0; a < 2; ++a)
#pragma unroll
        for (int b = 0; b < 2; ++b)
#pragma unroll
            for (int m = 0; m < 4; ++m)
#pragma unroll
                for (int n = 0; n < 2; ++n) acc[a][b][m][n] = (f32x4){0.f, 0.f, 0.f, 0.f};
    bf16x8 At[4][2], B0[2][2], B1[2][2];
    constexpr int NPRE = (Epi::NPRE > 0 && MK_PRE) ? Epi::NPRE : 0;
    bool have_pre = false;
    const char* cA = cur.a; const char* cB = cur.b;
    PG8_STAGE(PG8_SB(0, 0), cB, voffB); PG8_STAGE(PG8_SB(0, 1), cB + hstepB, voffB); PG8_STAGE(PG8_SA(0, 0), cA, voffA); PG8_STAGE(PG8_SA(0, 1), cA + hstepA, voffA1);
    if (wr == 1) PG8_BAR;
    PG8_WAIT_V(2); PG8_BAR;
    PG8_STAGE(PG8_SB(1, 0), cB + kstep, voffB); PG8_STAGE(PG8_SA(1, 0), cA + kstep, voffA); PG8_STAGE(PG8_SB(1, 1), cB + hstepB + kstep, voffB);
    PG8_WAIT_V(6); PG8_BAR;
    for (;;) {
        const bool has_next = S.next(ui + 1, nxt);
        const char* nA = has_next ? nxt.a : cA; const char* nB = has_next ? nxt.b : cB;
        for (int t = 0; t < nt; t += 2) {
            const bool last = (t == nt - 2);
            if (Epi::PFD > 0 && MK_EPF && t == nt - Epi::PFD) E.prefetch(lds, cur, wid);
            const char* a1 = cA + (size_t)(t + 1) * kstep;
            const char* a2 = last ? nA : cA + (size_t)(t + 2) * kstep; const char* b2 = last ? nB : cB + (size_t)(t + 2) * kstep;
            const char* a3 = a2 + kstep; const char* b3 = b2 + kstep;
            const bool tail = NPRE > 0 && last && !has_next && E.can_preload();
            const char* pB00 = b2; const char* pB01 = b2 + hstepB; const char* pA00 = a2; const char* pA01 = a2 + hstepA;
            const char* pB10 = b3; const char* pB11 = b3 + hstepB; const char* pA10 = a3;
            PG8_LDB(B0, 0, 0); PG8_LDB(B1, 0, 1); PG8_SCHED; PG8_LDA(At, 0, 0); PG8_STAGE(PG8_SA(1, 1), a1 + hstepA, voffA1);
            PG8_WAIT_V(8); PG8_WAIT_L(0); PG8_BAR; PG8_MMA(0, 0, At, B0); PG8_MMA(0, 1, At, B1); PG8_BAR; PG8_SCHED;
            if (NPRE > 0 && tail) { const unsigned pvo = E.pre_vo(cur, wid);
                voffB[0] = voffA[0] = voffA1[0] = pvo; voffB[1] = voffA[1] = voffA1[1] = pvo + 256u;
                pB00 = E.pre_base(cur, wid, 0); pB01 = E.pre_base(cur, wid, 2); pA00 = E.pre_base(cur, wid, 4); pA01 = E.pre_base(cur, wid, 6);
                pB10 = E.pre_base(cur, wid, 8); pB11 = E.pre_base(cur, wid, 10); pA10 = pB11; have_pre = true; }
            PG8_LDA1(At, 0); PG8_STAGE(PG8_SB(0, 0), pB00, voffB); PG8_STAGE(PG8_SB(0, 1), pB01, voffB); PG8_STAGE(PG8_SA(0, 0), pA00, voffA);
            PG8_WAIT_V(8); PG8_WAIT_L(0); PG8_BAR; PG8_MMA1(0, At, B0); PG8_MMA1(1, At, B1); PG8_BAR; PG8_SCHED;
            PG8_LDB(B0, 1, 0); PG8_LDB(B1, 1, 1); PG8_SCHED; PG8_LDA(At, 1, 0); PG8_STAGE(PG8_SA(0, 1), pA01, voffA1);
            PG8_WAIT_V(8); PG8_WAIT_L(0); PG8_BAR; PG8_MMA(0, 0, At, B0); PG8_MMA(0, 1, At, B1); PG8_BAR; PG8_SCHED;
            PG8_LDA1(At, 1); PG8_STAGE(PG8_SB(1, 0), pB10, voffB); PG8_STAGE(PG8_SB(1, 1), pB11, voffB); PG8_STAGE(PG8_SA(1, 0), pA10, voffA);
            if (!(NPRE > 0 && tail)) PG8_WAIT_V(8);
            PG8_WAIT_L(0); PG8_BAR; PG8_MMA1(0, At, B0); PG8_MMA1(1, At, B1); PG8_BAR; PG8_SCHED;
        }
        if (wr == 0) PG8_BAR;
        if (MK_TP == 4) { if (wid == 0 && lane == 0) { const unsigned long long t0_ = __builtin_amdgcn_s_memrealtime(); *(volatile LAS unsigned*)(lds + 131072 + 8192 + 320 + 4 * 18) = (unsigned)t0_; }
            if constexpr (NPRE > 0) E.run(acc, cur, wid, ui, have_pre); else E(acc, cur, wid, ui);
            if (wid == 0 && lane == 0 && tp_on) *(volatile LAS unsigned*)(lds + 131072 + 8192 + 320 + 4 * 16) += *(volatile LAS unsigned*)(lds + 131072 + 8192 + 320 + 4 * 17); }
        else if (MK_TP == 2) { const unsigned long long t0_ = __builtin_amdgcn_s_memrealtime(); if constexpr (NPRE > 0) E.run(acc, cur, wid, ui, have_pre); else E(acc, cur, wid, ui); const unsigned long long t1_ = __builtin_amdgcn_s_memrealtime();
            if (wid == 0 && lane == 0 && tp_on) *(volatile LAS unsigned*)(lds + 131072 + 8192 + 320 + 4 * 16) += (unsigned)(t1_ - t0_); }
        else { if constexpr (NPRE > 0) E.run(acc, cur, wid, ui, have_pre); else E(acc, cur, wid, ui); }
        if (!has_next) break;
#pragma unroll
        for (int a = 0; a < 2; ++a)
#pragma unroll
            for (int b = 0; b < 2; ++b)
#pragma unroll
                for (int m = 0; m < 4; ++m)
#pragma unroll
                    for (int n = 0; n < 2; ++n) acc[a][b][m][n] = (f32x4){0.f, 0.f, 0.f, 0.f};
        cur = nxt; cA = nA; cB = nB; ++ui;
        if (wr == 1) PG8_BAR;
    }
    PG8_WAIT_V(0);
    PG8_BAR;
#undef PG8_SA
#undef PG8_SB
#undef PG8_STAGE
#undef PG8_LDA
#undef PG8_LDA1
#undef PG8_MMA1
#undef PG8_LDB
#undef PG8_MMA
#undef PG8_WAIT_V
#undef PG8_WAIT_L
#undef PG8_BAR
#undef PG8_SCHED
}
}
using pg8::Unit; using pg8::cvt_pk_bf16;

constexpr size_t MiB = 1u << 20;
constexpr size_t WS_CTL = 0, CTL_ZERO_BYTES = 128 * 1024;
constexpr size_t WS_MOD = 1 * MiB;
constexpr size_t WS_ROPE = WS_MOD + 512 * 1024;
constexpr size_t WS_STATS = WS_ROPE + 64 * 1024;
constexpr size_t WS_WQKV = 4 * MiB;
constexpr size_t WS_WO = WS_WQKV + 3 * MiB;
constexpr size_t WS_WSGI = WS_WO + 2 * MiB;
constexpr size_t WS_WSGO = WS_WSGI + 4 * MiB;
constexpr size_t WS_WSCI = WS_WSGO + 2 * MiB;
constexpr size_t WS_WSCO = WS_WSCI + 6 * MiB;
constexpr size_t WS_WFNO = WS_WSCO + 2 * MiB;
constexpr size_t WS_WUP = WS_WFNO + 2 * MiB;
constexpr size_t WUP_BYTES = (size_t)2 * DFF * D * 2;
constexpr size_t WS_WDN = WS_WUP + 4 * WUP_BYTES;
constexpr size_t WDN_BYTES = (size_t)D * DFF * 2;
constexpr size_t WS_WS = WS_WDN + 4 * WDN_BYTES;
constexpr size_t WS_A1 = WS_WS + 256 * 1024;
constexpr size_t WS_A2P = WS_A1 + 256 * 1024;
constexpr size_t WS_A2S = WS_A2P + 256 * 1024;
constexpr size_t WS_CK = WS_A2S + 16 * MiB;
constexpr size_t WS_CVT = WS_CK + 512 * 1024;
constexpr size_t WS_X = WS_CVT + 512 * 1024;
constexpr size_t WS_H = WS_X + (size_t)M * D * 4;
constexpr size_t WS_BIG = WS_H + (size_t)(M + 256) * D * 2;
constexpr size_t WS_END = WS_BIG + 72 * MiB;
constexpr size_t WS_ACT = WS_BIG;
constexpr size_t WS_Q = WS_BIG;
constexpr size_t WS_KB = WS_Q + 24 * MiB;
constexpr size_t WS_VT = WS_KB + 6 * MiB;
constexpr size_t WS_U = WS_BIG;
constexpr size_t WS_V = WS_BIG + 24 * MiB;
constexpr size_t WS_YB = WS_BIG;
constexpr size_t WS_YT = WS_BIG;
static_assert(WS_YB + (size_t)256 * 2 * 16 * 512 * 16 <= WS_END, "yb");
static_assert(WS_ACT + (size_t)M * DFF * 2 <= WS_END, "act");
constexpr size_t WS_H2 = WS_END;
constexpr size_t WS_HN = WS_H2 + (size_t)M * D * 2;
constexpr size_t WS_XS = WS_HN + (size_t)(M + 256) * D * 2;
constexpr size_t WS_TOTAL = WS_XS + (size_t)16 * M * 4 * 4;
constexpr size_t CTL_CNT = 16384;
constexpr size_t CTL_TMO = CTL_CNT + 16 * 64 * 64;

constexpr size_t OUT_NK = (size_t)M * D, OUT_NV = OUT_NK + (size_t)MP * 256;

#define XB_TMO      128
#define XB_XCNT(j)  (256  + 64 * (j))
#define XB_XSUB(j)  (1280 + 64 * (j))
#define XB_XGEN(j)  (2304 + 64 * (j))
#define XB_TOP      3328
#define XB_TOPGEN   3392
#define XCD_BAR_WORDS 3456
#define XB_SPIN_CAP (1u << 22)
__device__ __forceinline__ unsigned xb_ld(unsigned* p)              { return __hip_atomic_load(p, __ATOMIC_RELAXED, __HIP_MEMORY_SCOPE_AGENT); }
__device__ __forceinline__ unsigned xb_add(unsigned* p, unsigned v) { return __hip_atomic_fetch_add(p, v, __ATOMIC_RELAXED, __HIP_MEMORY_SCOPE_AGENT); }
__device__ __forceinline__ unsigned xb_xcc_id() { return (unsigned)__builtin_amdgcn_s_getreg((3 << 11) | 20) & 0xFu; }
#define XB_SPIN(cond, bar) do { unsigned _sp = 0; while (cond) { __builtin_amdgcn_s_sleep(1); \
    if ((++_sp & 255u) == 0u) { if (xb_ld(&(bar)[XB_TMO])) break; if (_sp > XB_SPIN_CAP) { atomicAdd(&(bar)[XB_TMO], 1u); break; } } } } while (0)
struct XcdBarrier { unsigned* bar; unsigned x; volatile LAS unsigned* st; };
__device__ __forceinline__ XcdBarrier xcd_barrier_post(unsigned* bar, volatile LAS unsigned* st, bool leader) {
    XcdBarrier b; b.bar = bar; b.x = xb_xcc_id(); b.st = st;
    if (leader) (void)xb_add(&bar[XB_XCNT(b.x)], 1u);
    return b;
}
__device__ __forceinline__ void xcd_barrier_complete(unsigned* bar, unsigned x, unsigned& nloc, unsigned& nx) {
    const unsigned G = gridDim.x * gridDim.y * gridDim.z;
    unsigned sum, cnt, mine, sp = 0u;
    for (;;) {
        sum = 0u; cnt = 0u; mine = 0u;
#pragma unroll
        for (unsigned j = 0; j < 16; ++j) { const unsigned c = xb_ld(&bar[XB_XCNT(j)]); sum += c; cnt += (c > 0u) ? 1u : 0u; }
        mine = xb_ld(&bar[XB_XCNT(x)]);
        if (sum == G) break;
        __builtin_amdgcn_s_sleep(1);
        if ((++sp & 255u) == 0u) { if (xb_ld(&bar[XB_TMO])) break; if (sp > XB_SPIN_CAP) { atomicAdd(&bar[XB_TMO], 1u); break; } }
    }
    nloc = mine > 0u ? mine : 1u; nx = cnt > 0u ? cnt : 1u;
}
__device__ __forceinline__ void xcd_barrier(const XcdBarrier& b, bool leader) {
    asm volatile("s_waitcnt vmcnt(0)" ::: "memory");
    __syncthreads();
    if (leader) {
        unsigned* bar = b.bar; unsigned bx = b.x; asm volatile("" : "+s"(bx));
        __builtin_amdgcn_s_waitcnt(0);
        unsigned nloc = b.st[0], nx = b.st[1];
        if (nloc == 0u) { xcd_barrier_complete(bar, bx, nloc, nx); b.st[0] = nloc; b.st[1] = nx; }
        const unsigned old = xb_add(&bar[XB_XSUB(bx)], 1u);
        const unsigned gen = old / nloc;
        if (old + 1u == (gen + 1u) * nloc) {
            __builtin_amdgcn_fence(__ATOMIC_RELEASE, "agent");
            asm volatile("s_waitcnt vmcnt(0)" ::: "memory");
            const unsigned og = xb_add(&bar[XB_TOP], 1u);
            const unsigned tg = og / nx;
            if (og + 1u == (tg + 1u) * nx) xb_add(&bar[XB_TOPGEN], 1u);
            else XB_SPIN(xb_ld(&bar[XB_TOPGEN]) == tg, bar);
            __builtin_amdgcn_fence(__ATOMIC_ACQUIRE, "agent");
            xb_add(&bar[XB_XGEN(bx)], 1u);
            asm volatile("s_waitcnt vmcnt(0)" ::: "memory");
        } else {
            XB_SPIN(xb_ld(&bar[XB_XGEN(bx)]) == gen, bar);
            __builtin_amdgcn_fence(__ATOMIC_ACQUIRE, "agent");
            asm volatile("s_waitcnt vmcnt(0)" ::: "memory");
        }
    }
    __syncthreads();
}

#define LDS_WAIT() asm volatile("s_waitcnt lgkmcnt(0)" ::: "memory")
__device__ __forceinline__ unsigned f2bf(float f) { unsigned u = __builtin_bit_cast(unsigned, f); return (u + 0x7fffu + ((u >> 16) & 1u)) >> 16; }
__device__ __forceinline__ unsigned pk2(float lo, float hi) { return f2bf(lo) | (f2bf(hi) << 16); }
__device__ __forceinline__ float bf2f(unsigned short b) { return __builtin_bit_cast(float, (unsigned)b << 16); }
__device__ __forceinline__ float rows_max(float x) {
    auto s = __builtin_amdgcn_permlane16_swap(__float_as_uint(x), __float_as_uint(x), false, false); x = fmaxf(__uint_as_float(s[0]), __uint_as_float(s[1]));
    auto t = __builtin_amdgcn_permlane32_swap(__float_as_uint(x), __float_as_uint(x), false, false); return fmaxf(__uint_as_float(t[0]), __uint_as_float(t[1])); }
__device__ __forceinline__ float rows_sum(float x) {
    auto s = __builtin_amdgcn_permlane16_swap(__float_as_uint(x), __float_as_uint(x), false, false); x = __uint_as_float(s[0]) + __uint_as_float(s[1]);
    auto t = __builtin_amdgcn_permlane32_swap(__float_as_uint(x), __float_as_uint(x), false, false); return __uint_as_float(t[0]) + __uint_as_float(t[1]); }
template <int CTRL> __device__ __forceinline__ float dppx(float v) { return __builtin_bit_cast(float, __builtin_amdgcn_mov_dpp(__builtin_bit_cast(int, v), CTRL, 0xf, 0xf, true)); }
__device__ __forceinline__ float wave_sum(float v) {
    v += dppx<0xB1>(v);
    v += dppx<0x4E>(v);
    v += dppx<0x141>(v);
    v += dppx<0x140>(v);
    return rows_sum(v);
}
__device__ __forceinline__ float fast_exp2(float x) { return __builtin_amdgcn_exp2f(x); }
__device__ __forceinline__ float fast_rcp(float x) { return __builtin_amdgcn_rcpf(x); }
__device__ __forceinline__ float silu_f(float x) { return x * fast_rcp(1.f + fast_exp2(-1.4426950408889634f * x)); }
__device__ __forceinline__ float gelu_f(float x) { const float u = x * (1.f + 0.044715f * x * x); return x * fast_rcp(1.f + fast_exp2(-2.302208198f * u)); }
__device__ __forceinline__ int conv_row0(int pm) { if (pm < 32) return 256 * pm; const int s = (pm - 32) / 9, i = (pm - 32) % 9; return MP + TS * s + 254 * i - 1; }
template <int CTRL> __device__ __forceinline__ float dpp(float v) { return __builtin_bit_cast(float, __builtin_amdgcn_mov_dpp(__builtin_bit_cast(int, v), CTRL, 0xf, 0xf, true)); }
template <int CTRL> __device__ __forceinline__ f32x4 dpp4(f32x4 v) { return (f32x4){dpp<CTRL>(v[0]), dpp<CTRL>(v[1]), dpp<CTRL>(v[2]), dpp<CTRL>(v[3])}; }
#define DPP_ROR1 0x121
#define DPP_ROR15 0x12F

template <int NM, int NN, int CONV, int LDA, int LDB, int ROWS = 256>
struct Order {
    int G, c; const char* A; const char* B;
    __device__ __forceinline__ void init(int G_, int c_, const void* A_, const void* B_) { G = G_; c = c_; A = (const char*)A_; B = (const char*)B_; }
    __device__ __forceinline__ bool next(int i, Unit& u) const {
        constexpr int nwg = NM * NN;
        const int L = i * G + c; if (L >= nwg) return false;
        int wgid = L; { constexpr int q = nwg / pg8::NXCD, r = nwg % pg8::NXCD; const int xcd = wgid % pg8::NXCD, off = wgid / pg8::NXCD; wgid = (xcd < r ? xcd * (q + 1) : r * (q + 1) + (xcd - r) * q) + off; }
        constexpr int nig = pg8::WGM * NN; const int gid = wgid / nig, fm = gid * pg8::WGM, gsz = (NM - fm) < pg8::WGM ? (NM - fm) : pg8::WGM;
        u.pm = fm + ((wgid % nig) % gsz); u.pn = (wgid % nig) / gsz;
        u.row0 = CONV ? conv_row0(u.pm) : ROWS * u.pm;
        u.a = A + (long)u.row0 * (long)(LDA * 2); u.b = B + (size_t)u.pn * (size_t)(256 * LDB * 2); return true;
    }
};

typedef const GAS float* cfp_t;
struct Frame {
    LAS unsigned char* lds; int tid, lane, wave, G, blk;
    const __attribute__((address_space(4))) cfp_t* in; float* out; unsigned char* ws;
};
__device__ __forceinline__ void frame_refresh(Frame& F) {
    int ln = pg8::lane_id(); asm volatile("" : "+v"(ln)); F.lane = ln; F.tid = F.wave * 64 + ln;
}
constexpr int RING_BYTES = 131072, XCH_OFF = RING_BYTES  , MISC_OFF = XCH_OFF + 8192 + 320, LDS_BYTES = 147456;
__device__ __forceinline__ int vec_plain(int pm) { return pm < 32 ? 0 : 1 + (pm - 32) / 8; }
__device__ __forceinline__ int vec_conv(int pm) { return pm < 32 ? 0 : 1 + (pm - 32) / 9; }

__device__ __forceinline__ constexpr int r192_nm(int ai) { return ai ? 2 : 4; }
__device__ __forceinline__ int r192_base(int ai, int wr) { return ai ? 128 + 32 * wr : 64 * wr; }
__device__ __forceinline__ u32x4 merge_quads16(u32x2 q0, u32x2 q1) {
    auto a = __builtin_amdgcn_permlane16_swap(q0.x, q1.x, false, false);
    auto b = __builtin_amdgcn_permlane16_swap(q0.y, q1.y, false, false);
    return (u32x4){a[0], b[0], a[1], b[1]};
}
__device__ __forceinline__ void split_quads16(u32x4 r, u32x2& q0, u32x2& q1) {
    auto a = __builtin_amdgcn_permlane16_swap(r.x, r.z, false, false);
    auto b = __builtin_amdgcn_permlane16_swap(r.y, r.w, false, false);
    q0 = (u32x2){a[0], b[0]}; q1 = (u32x2){a[1], b[1]};
}
constexpr int PF_LDS_OFF = 143360;
struct EpiBase {
    unsigned char* ws_; int l, aux;
    static constexpr int NPRE = 0;
    static constexpr int PFD = 0;
    __device__ __forceinline__ void prefetch(LAS unsigned char*, const Unit&, int) const {}
    __device__ __forceinline__ bool can_preload() const { return false; }
    __device__ __forceinline__ unsigned pre_vo(const Unit&, int) const { return 0u; }
    __device__ __forceinline__ const char* pre_base(const Unit&, int, int) const { return nullptr; }
    __device__ __forceinline__ unsigned char* wsp() const { unsigned long long w = (unsigned long long)ws_; asm volatile("" : "+s"(w)); return (unsigned char*)(GAS unsigned char*)w; }
    __device__ __forceinline__ static const __attribute__((address_space(4))) cfp_t* kargs() { unsigned long long kp = (unsigned long long)__builtin_amdgcn_kernarg_segment_ptr(); asm volatile("" : "+s"(kp)); return (const __attribute__((address_space(4))) cfp_t*)kp; }
    __device__ __forceinline__ static const float* inp(const __attribute__((address_space(4))) cfp_t* ka, int k) { return (const float*)ka[k]; }
    __device__ __forceinline__ static float* outp(const __attribute__((address_space(4))) cfp_t* ka) { return (float*)(GAS float*)ka[26]; }
    __device__ __forceinline__ static LAS float* xch() { extern __shared__ __attribute__((aligned(16))) unsigned char lds_base_[]; return (LAS float*)((LAS unsigned char*)lds_base_ + XCH_OFF); }
};
template <bool FINAL>
struct EpiResNorm : EpiBase {
    static constexpr bool PERM = false;
    static constexpr int TR = 192;
    static constexpr int PFD = MK_PFD;
    __device__ __forceinline__ void prefetch(LAS unsigned char* lds, const Unit& u, int wid) const {
        int lane_ = pg8::lane_id(); asm volatile("" : "+v"(lane_));
        const int isdn = aux & 1; const bool srcf32 = (!isdn && l == 0);
        LAS unsigned* dump = (LAS unsigned*)(lds + PF_LDS_OFF + wid * 256);
        if (!srcf32) {
            const char* base = (const char*)(wsp() + WS_X) + ((size_t)u.row0 * D + u.pn * 256) * 2;
            unsigned vo = (unsigned)((lane_ >> 2) * (D * 2) + (lane_ & 3) * 128); asm volatile("" : "+v"(vo));
#pragma unroll
            for (int i = 0; i < 2; ++i) { const int g = wid + 8 * i; if (g < 12) __builtin_amdgcn_global_load_lds((const unsigned*)(base + (size_t)g * 16 * D * 2 + vo), dump, 4, 0, 0); }
        } else {
            const auto ka = kargs();
            unsigned vo = (unsigned)((lane_ >> 3) * (D * 4) + (lane_ & 7) * 128); asm volatile("" : "+v"(vo));
#pragma unroll
            for (int i = 0; i < 3; ++i) { const int g = wid + 8 * i; const int rb = u.row0 + 8 * g;
                const char* base = (const char*)(rb < MP ? inp(ka, 0) + (size_t)rb * D : inp(ka, 1) + (size_t)(rb - MP) * D) + u.pn * 1024;
                __builtin_amdgcn_global_load_lds((const unsigned*)(base + vo), dump, 4, 0, 0); }
        }
    }
    __device__ __forceinline__ static int nm(int ai) { return ai ? 2 : 4; }
    __device__ __forceinline__ static int rbase(int ai, int wr) { return ai ? 128 + 32 * wr : 64 * wr; }
    static constexpr int NPRE = 12;
    __device__ __forceinline__ bool can_preload() const { return !((aux & 1) == 0 && l == 0); }
    __device__ __forceinline__ unsigned pre_vo(const Unit& u, int wid) const {
        int lane_ = pg8::lane_id(); asm volatile("" : "+v"(lane_));
        const int wc = wid & 3, fr = lane_ & 15, fq = lane_ >> 4;
        unsigned vo = (unsigned)((fr * D + wc * 32 + 4 * fq + ((fq & 1) ? 12 : 0)) * 2); asm volatile("" : "+v"(vo)); return vo;
    }
    __device__ __forceinline__ const char* pre_base(const Unit& u, int wid, int k) const { const int ai = k >> 3, m = (k & 7) >> 1, bj = k & 1;
        return (const char*)(wsp() + WS_X) + ((size_t)(u.row0 + rbase(ai, wid >> 2) + 16 * m) * D + u.pn * 256 + bj * 128) * 2; }
    __device__ __forceinline__ void operator()(f32x4 (&acc)[2][2][4][2], const Unit& u, int wid, int ui) const { run(acc, u, wid, ui, false); }
    __device__ __forceinline__ void run(f32x4 (&acc)[2][2][4][2], const Unit& u, int wid, int, bool have_pre) const {
        int lane_ = pg8::lane_id(); asm volatile("" : "+v"(lane_));
        const int lane = lane_, wr = wid >> 2, wc = wid & 3, fr = lane & 15, fq = lane >> 4;
        unsigned char* ws = wsp(); const auto ka = kargs();
        const int isdn = aux & 1, rep = (aux >> 1) & 1, inst = 2 * l + isdn + 8 * rep;
        typedef _Float16 h4 __attribute__((ext_vector_type(4)));
        _Float16* Xr = (_Float16*)(ws + WS_X); _Float16* X = rep ? (_Float16*)(ws + WS_TOTAL) : Xr;
        const bool srcf32 = (!isdn && l == 0);
        const float* modl = (const float*)(ws + WS_MOD) + l * 3 * 6 * D; const int gate_idx = isdn ? 5 : 2;
        const float* gn = FINAL ? inp(ka, 10) : (isdn ? inp(ka, 8) + (l + 1) * D : inp(ka, 9) + l * D);
        const float* modn = isdn ? modl + 3 * 6 * D : modl; const int sh_idx = isdn ? 0 : 3;
        bf16_t* HN = (bf16_t*)(ws + (rep ? WS_TOTAL + 48 * MiB : WS_HN)); float* Y = rep ? (float*)(ws + WS_TOTAL) : outp(ka);
        float* xs = (float*)(ws + WS_XS) + (size_t)inst * M * 4; unsigned* cnt = (unsigned*)(ws + WS_CTL + CTL_CNT) + inst * 64 * 16; unsigned* tmo = (unsigned*)(ws + WS_CTL + CTL_TMO);
        LAS float* L = xch();
        const int col0 = u.pn * 256 + wc * 32 + 4 * fq, tid = wid * 64 + lane;
        const int col16 = col0 + ((fq & 1) ? 12 : 0);
        LAS float* P = L;
        LAS float* S = L + 1024;
        u32x4 pre[12];
        if (!srcf32) {
            if (have_pre) { asm volatile("s_waitcnt vmcnt(0)" ::: "memory");
                const LAS unsigned char* pk = (const LAS unsigned char*)L - XCH_OFF + wid * 1024 + lane * 16;
#pragma unroll
                for (int k = 0; k < 12; ++k) pre[k] = *(const LAS u32x4*)(pk + pg8::pre_slot(k)); }
            else { const unsigned vo = pre_vo(u, wid);
#pragma unroll
                for (int k = 0; k < 12; ++k) pre[k] = *(const u32x4*)(pre_base(u, wid, k) + vo); }
        }
#pragma unroll
        for (int ai = 0; ai < 2; ++ai) {
            const int rb = u.row0 + rbase(ai, wr);
            const int vec = rb < MP ? 0 : 1 + (rb - MP) / TS;
            const float* gate = modl + vec * 6 * D + gate_idx * D;
            const float* src = rb < MP ? inp(ka, 0) + (size_t)rb * D : inp(ka, 1) + (size_t)(rb - MP) * D;
            f32x4 gv[2][2];
#pragma unroll
            for (int bj = 0; bj < 2; ++bj)
#pragma unroll
                for (int n = 0; n < 2; ++n) gv[bj][n] = *(const f32x4*)(gate + col0 + bj * 128 + n * 16);
            f32x4 sv[4][2][2];
            u32x4 hv[4][2];
            if (srcf32) {
#pragma unroll
                for (int m = 0; m < 4; ++m) if (m < nm(ai)) { const size_t ro = (size_t)(16 * m + fr) * D + col0;
#pragma unroll
                    for (int bj = 0; bj < 2; ++bj)
#pragma unroll
                        for (int n = 0; n < 2; ++n) sv[m][bj][n] = *(const f32x4*)(src + ro + bj * 128 + n * 16); }
            } else {
#pragma unroll
                for (int m = 0; m < 4; ++m) if (m < nm(ai))
#pragma unroll
                    for (int bj = 0; bj < 2; ++bj) hv[m][bj] = pre[8 * ai + 2 * m + bj];
#pragma unroll
                for (int m = 0; m < 4; ++m) if (m < nm(ai))
#pragma unroll
                    for (int bj = 0; bj < 2; ++bj) { u32x2 q0, q1; split_quads16(hv[m][bj], q0, q1);
                        sv[m][bj][0] = __builtin_convertvector(__builtin_bit_cast(h4, q0), f32x4); sv[m][bj][1] = __builtin_convertvector(__builtin_bit_cast(h4, q1), f32x4); }
            }
#pragma unroll
            for (int m = 0; m < 4; ++m) if (m < nm(ai)) { const int r = rbase(ai, wr) + 16 * m + fr; float ss = 0.f;
#pragma unroll
                for (int bj = 0; bj < 2; ++bj)
#pragma unroll
                    for (int n = 0; n < 2; ++n) { const f32x4 x1 = sv[m][bj][n] + gv[bj][n] * acc[ai][bj][m][n]; acc[ai][bj][m][n] = x1;
                        ss += (x1[0] * x1[0] + x1[1] * x1[1]) + (x1[2] * x1[2] + x1[3] * x1[3]); }
                ss = rows_sum(ss);
                if (fq == 0) P[r * 4 + wc] = ss; }
            asm volatile("" ::: "memory"); }
        TP_STAMP(1);
        LDS_WAIT(); __builtin_amdgcn_s_barrier(); asm volatile("" ::: "memory");
        if (tid < TR) { const f32x4 p = *(const LAS f32x4*)(P + tid * 4); const float tot = (p[0] + p[1]) + (p[2] + p[3]);
            __hip_atomic_store(xs + (size_t)(u.row0 + tid) * 4 + u.pn, tot, __ATOMIC_RELAXED, __HIP_MEMORY_SCOPE_AGENT); }
        asm volatile("s_waitcnt vmcnt(0)" ::: "memory");
        if (tid < TR && (tid & 63) == 0) __hip_atomic_fetch_add(cnt + 16 * u.pm, 1u, __ATOMIC_RELAXED, __HIP_MEMORY_SCOPE_AGENT);
        TP_STAMP(2);
        if (!FINAL) {
#pragma unroll
            for (int ai = 0; ai < 2; ++ai)
#pragma unroll
                for (int m = 0; m < 4; ++m) if (m < nm(ai)) { _Float16* xp = X + (size_t)(u.row0 + rbase(ai, wr) + 16 * m + fr) * D + col16;
#pragma unroll
                    for (int bj = 0; bj < 2; ++bj) { const h4 h0 = __builtin_convertvector(acc[ai][bj][m][0], h4), h1 = __builtin_convertvector(acc[ai][bj][m][1], h4);
                        *(u32x4*)(xp + bj * 128) = merge_quads16(__builtin_bit_cast(u32x2, h0), __builtin_bit_cast(u32x2, h1)); } }
        }
        TP_STAMP(3);
        if (tid < 64) { unsigned sp_ = 0;
            while ((unsigned)__builtin_amdgcn_readfirstlane(__hip_atomic_load(cnt + 16 * u.pm, __ATOMIC_RELAXED, __HIP_MEMORY_SCOPE_AGENT)) < 12u) {
                __builtin_amdgcn_s_sleep(1);
                if ((++sp_ & 1023u) == 0u) { if (__hip_atomic_load(tmo, __ATOMIC_RELAXED, __HIP_MEMORY_SCOPE_AGENT)) break; if (sp_ > (1u << 22)) { __hip_atomic_store(tmo, 1u, __ATOMIC_RELAXED, __HIP_MEMORY_SCOPE_AGENT); break; } } }
        }
        TP_STAMP(4);
        asm volatile("s_waitcnt lgkmcnt(0)" ::: "memory"); __builtin_amdgcn_s_barrier(); asm volatile("" ::: "memory");
        if (tid < TR) { const float* sl = xs + (size_t)(u.row0 + tid) * 4; float t = 0.f;
#pragma unroll
            for (int k = 0; k < 4; ++k) t += __hip_atomic_load(sl + k, __ATOMIC_RELAXED, __HIP_MEMORY_SCOPE_AGENT);
            S[tid] = rsqrtf(t * (1.f / D) + EPS); }
        LDS_WAIT(); __builtin_amdgcn_s_barrier(); asm volatile("" ::: "memory");
        TP_STAMP(5);
#pragma unroll
        for (int ai = 0; ai < 2; ++ai) {
            const int rb = u.row0 + rbase(ai, wr); const int vec = rb < MP ? 0 : 1 + (rb - MP) / TS;
            f32x4 gm[2][2], sh[2][2];
#pragma unroll
            for (int bj = 0; bj < 2; ++bj)
#pragma unroll
                for (int n = 0; n < 2; ++n) { const int c = col0 + bj * 128 + n * 16; gm[bj][n] = *(const f32x4*)(gn + c);
                    if (!FINAL) { const float* mv = modn + vec * 6 * D; gm[bj][n] = gm[bj][n] * (1.f + *(const f32x4*)(mv + (sh_idx + 1) * D + c)); sh[bj][n] = *(const f32x4*)(mv + sh_idx * D + c); } }
#pragma unroll
            for (int m = 0; m < 4; ++m) if (m < nm(ai)) { const int r = rbase(ai, wr) + 16 * m + fr; const float rs = S[r];
#pragma unroll
                for (int bj = 0; bj < 2; ++bj) {
                    if (FINAL) {
#pragma unroll
                        for (int n = 0; n < 2; ++n) *(f32x4*)(Y + (size_t)(u.row0 + r) * D + col0 + bj * 128 + n * 16) = acc[ai][bj][m][n] * rs * gm[bj][n]; }
                    else { const f32x4 h0 = acc[ai][bj][m][0] * rs * gm[bj][0] + sh[bj][0], h1 = acc[ai][bj][m][1] * rs * gm[bj][1] + sh[bj][1];
                        u32x2 w0, w1; w0.x = cvt_pk_bf16(h0[0], h0[1]); w0.y = cvt_pk_bf16(h0[2], h0[3]); w1.x = cvt_pk_bf16(h1[0], h1[1]); w1.y = cvt_pk_bf16(h1[2], h1[3]);
                        *(u32x4*)(HN + (size_t)(u.row0 + r) * D + col16 + bj * 128) = merge_quads16(w0, w1); } } }
        }
    }
};
struct EpiNull : EpiBase {
    static constexpr bool PERM = true;
    __device__ __forceinline__ void operator()(f32x4 (&acc)[2][2][4][2], const Unit& u, int wid, int) const {
        f32x4 s = {0.f, 0.f, 0.f, 0.f};
#pragma unroll
        for (int ai = 0; ai < 2; ++ai)
#pragma unroll
            for (int bj = 0; bj < 2; ++bj)
#pragma unroll
                for (int m = 0; m < 4; ++m)
#pragma unroll
                    for (int n = 0; n < 2; ++n) s += acc[ai][bj][m][n];
        ((f32x4*)(wsp() + WS_TOTAL))[(size_t)(u.pm * 22 + u.pn) * 512 + wid * 64 + pg8::lane_id()] = s;
    }
};
template <int ROWS> struct EpiBf16 : EpiBase {
    static constexpr bool PERM = true;
    __device__ __forceinline__ void operator()(const f32x4 (&acc)[2][2][4][2], const Unit& u, int wid, int ) const {
        int lane_ = pg8::lane_id(); asm volatile("" : "+v"(lane_));
        const int lane = lane_, wr = wid >> 2, wc = wid & 3, fr = lane & 15, fq = lane >> 4; (void)wr; (void)wc; (void)fr; (void)fq;
        bf16_t* O = (bf16_t*)(wsp() + WS_H); constexpr int ldc = D;
        const int col0 = u.pn * 256 + wc * 32 + 8 * fq;
#pragma unroll
        for (int ai = 0; ai < (ROWS == 128 ? 1 : 2); ++ai)
#pragma unroll
            for (int m = 0; m < 4; ++m) { bf16_t* rowp = O + (size_t)(u.row0 + ai * 128 + wr * 64 + m * 16 + fr) * ldc + col0;
#pragma unroll
                for (int bj = 0; bj < 2; ++bj) { const f32x4 v0 = acc[ai][bj][m][0], v1 = acc[ai][bj][m][1];
                    u32x4 w; w.x = cvt_pk_bf16(v0[0], v0[1]); w.y = cvt_pk_bf16(v0[2], v0[3]); w.z = cvt_pk_bf16(v1[0], v1[1]); w.w = cvt_pk_bf16(v1[2], v1[3]);
                    *(u32x4*)(rowp + bj * 128) = w; } }
    }
};
struct EpiQKV : EpiBase {
    static constexpr bool PERM = false;
    __device__ __forceinline__ void operator()(f32x4 (&acc)[2][2][4][2], const Unit& u, int wid, int ) const {
        int lane_ = pg8::lane_id(); asm volatile("" : "+v"(lane_));
        const int lane = lane_, wr = wid >> 2, wc = wid & 3, fr = lane & 15, fq = lane >> 4;
        unsigned char* ws = wsp(); bf16_t* Q = (bf16_t*)(ws + WS_Q); bf16_t* KB = (bf16_t*)(ws + WS_KB); bf16_t* VT = (bf16_t*)(ws + WS_VT); const float* rope = (const float*)(ws + WS_ROPE);
        float* outk = outp(kargs()) + OUT_NK; float* outv = outk + (OUT_NV - OUT_NK);
        const int c0 = wc * 32 + 4 * fq;
#pragma unroll
        for (int ai = 0; ai < 2; ++ai) {
            const int rb = u.row0 + r192_base(ai, wr); const bool samp = rb >= MP;
            if (samp && u.pn <= 4) {
                const int half = wc & 1;
#pragma unroll
                for (int m = 0; m < 4; ++m) if (m < r192_nm(ai)) { const int t = (rb - MP + m * 16 + fr) & (TS - 1); const int pos = half ? (t & 63) : (t >> 6);
                    const f32x4 cs = *(const f32x4*)(rope + pos * 16 + 4 * fq), sn = *(const f32x4*)(rope + 1024 + pos * 16 + 4 * fq);
#pragma unroll
                    for (int bj = 0; bj < 2; ++bj) { const f32x4 x1 = acc[ai][bj][m][0], x2 = acc[ai][bj][m][1]; acc[ai][bj][m][0] = x1 * cs - x2 * sn; acc[ai][bj][m][1] = x2 * cs + x1 * sn; } }
            }
            if (u.pn <= 4) {
                bf16_t* base = u.pn < 4 ? Q + u.pn * 256 : KB; const int ldc = u.pn < 4 ? D : 256;
#pragma unroll
                for (int m = 0; m < 4; ++m) if (m < r192_nm(ai)) { const int row = rb + m * 16 + fr; bf16_t* rowp = base + (size_t)row * ldc + c0 + ((fq & 1) ? 12 : 0);
#pragma unroll
                    for (int bj = 0; bj < 2; ++bj) { u32x2 w[2];
#pragma unroll
                        for (int n = 0; n < 2; ++n) { const f32x4 v = acc[ai][bj][m][n]; w[n].x = cvt_pk_bf16(v[0], v[1]); w[n].y = cvt_pk_bf16(v[2], v[3]);
                            if (u.pn == 4 && !samp) *(f32x4*)(outk + (size_t)row * 256 + c0 + bj * 128 + n * 16) = v; }
                        *(u32x4*)(rowp + bj * 128) = merge_quads16(w[0], w[1]); } }
            } else {
                const int T = samp ? TS : TP;
                bf16_t* vt = samp ? VT + (size_t)32 * 65536 + (size_t)((rb - MP) / TS) * 256 * TS : VT + (size_t)(rb / TP) * 65536;
#pragma unroll
                for (int m = 0; m < 4; ++m) if (m < r192_nm(ai)) { const int row = rb + m * 16 + fr; const int t = samp ? ((row - MP) & (TS - 1)) : (row & (TP - 1));
                    const int qb = fr & 3;
                    unsigned vo = (unsigned)((c0 + qb) * T + (t - qb)); asm volatile("" : "+v"(vo));
#pragma unroll
                    for (int bj = 0; bj < 2; ++bj)
#pragma unroll
                        for (int n = 0; n < 2; ++n) { f32x4 v = acc[ai][bj][m][n]; const int c = c0 + bj * 128 + n * 16;
                            if (!samp) *(f32x4*)(outv + (size_t)row * 256 + c) = v;
                            { const float s01 = (qb & 1) ? v[0] : v[1], s23 = (qb & 1) ? v[2] : v[3]; const float r01 = dppx<0xB1>(s01), r23 = dppx<0xB1>(s23);
                              if (qb & 1) { v[0] = r01; v[2] = r23; } else { v[1] = r01; v[3] = r23; } }
                            { const float s02 = (qb & 2) ? v[0] : v[2], s13 = (qb & 2) ? v[1] : v[3]; const float r02 = dppx<0x4E>(s02), r13 = dppx<0x4E>(s13);
                              if (qb & 2) { v[0] = r02; v[1] = r13; } else { v[2] = r02; v[3] = r13; } }
                            u32x2 w; w.x = cvt_pk_bf16(v[0], v[1]); w.y = cvt_pk_bf16(v[2], v[3]);
                            *(u32x2*)(vt + vo + (unsigned)((bj * 128 + n * 16) * T)) = w; } }
            }
        }
    }
};
__device__ __forceinline__ f32x4 conv_m(f32x4 cur, f32x4 pe, f32x4 ne, f32x4 w0, f32x4 w1, f32x4 w2, int fr) {
    const f32x4 up = dpp4<DPP_ROR1>(cur), dn = dpp4<DPP_ROR15>(cur);
    const f32x4 prev = fr > 0 ? up : pe, next = fr < 15 ? dn : ne;
    return w0 * prev + w1 * cur + w2 * next;
}
__device__ __forceinline__ void mask_rows(f32x4 (&acc)[2][2][4][2], const Unit& u, int wr, int fr) {
    if (u.pm < 32) return;
    const int i = (u.pm - 32) % 9; if (i != 0 && i != 8) return;
    const int t0 = 254 * i - 1;
#pragma unroll
    for (int ai = 0; ai < 2; ++ai)
#pragma unroll
        for (int m = 0; m < 4; ++m) { const int t = t0 + ai * 128 + wr * 64 + m * 16 + fr; if (t < 0 || t >= TS) {
#pragma unroll
            for (int bj = 0; bj < 2; ++bj)
#pragma unroll
                for (int n = 0; n < 2; ++n) acc[ai][bj][m][n] = (f32x4){0.f, 0.f, 0.f, 0.f}; } }
}
__device__ __forceinline__ bool row_valid(const Unit& u, int r) {
    if (u.pm < 32) return true;
    const int t = 254 * ((u.pm - 32) % 9) - 1 + r; return r >= 1 && r <= 254 && t >= 0 && t < TS;
}
__device__ __forceinline__ void xch_write(LAS float* X, const f32x4 (&acc)[2][2][4][2], int wr, int wc, int fr, int fq) {
#pragma unroll
    for (int ai = 0; ai < 2; ++ai)
#pragma unroll
        for (int bj = 0; bj < 2; ++bj)
#pragma unroll
            for (int n = 0; n < 2; ++n) { const int col = bj * 128 + wc * 32 + 8 * fq + 4 * n;
                if (fr == 0) *(LAS f32x4*)(X + ((2 * ai + wr) * 2 + 0) * 256 + col) = acc[ai][bj][0][n];
                if (fr == 15) *(LAS f32x4*)(X + ((2 * ai + wr) * 2 + 1) * 256 + col) = acc[ai][bj][3][n]; }
}
__device__ __forceinline__ f32x4 xch_top(const LAS float* X, int b, int col) { return b > 0 ? *(const LAS f32x4*)(X + ((b - 1) * 2 + 1) * 256 + col) : (f32x4){0.f, 0.f, 0.f, 0.f}; }
__device__ __forceinline__ f32x4 xch_bot(const LAS float* X, int b, int col) { return b < 3 ? *(const LAS f32x4*)(X + ((b + 1) * 2 + 0) * 256 + col) : (f32x4){0.f, 0.f, 0.f, 0.f}; }

struct EpiUp : EpiBase {
    static constexpr bool PERM = true;
    __device__ __forceinline__ void operator()(f32x4 (&acc)[2][2][4][2], const Unit& u, int wid, int ) const {
        int lane_ = pg8::lane_id(); asm volatile("" : "+v"(lane_));
        const int lane = lane_, wr = wid >> 2, wc = wid & 3, fr = lane & 15, fq = lane >> 4; (void)wr; (void)wc; (void)fr; (void)fq;
        bf16_t* ACT = (bf16_t*)(wsp() + WS_ACT); const float* cw = inp(kargs(), 24) + (size_t)l * 3 * 2 * DFF; LAS float* X = xch();
        mask_rows(acc, u, wr, fr);
        xch_write(X, acc, wr, wc, fr, fq);
        LDS_WAIT(); __builtin_amdgcn_s_barrier(); asm volatile("" ::: "memory");
        const int chl = wc * 32 + 8 * fq;
        u32x2 pk0[2][4];
#pragma unroll
        for (int n = 0; n < 2; ++n) {
            const int ch = u.pn * 128 + chl + 4 * n;
            f32x4 wg[3], wu[3];
#pragma unroll
            for (int k = 0; k < 3; ++k) { wg[k] = *(const f32x4*)(cw + k * 2 * DFF + ch); wu[k] = *(const f32x4*)(cw + k * 2 * DFF + DFF + ch); }
#pragma unroll
            for (int ai = 0; ai < 2; ++ai) {
                const int b = 2 * ai + wr;
                f32x4 pg = xch_top(X, b, chl + 4 * n), pu = xch_top(X, b, 128 + chl + 4 * n);
#pragma unroll
                for (int m = 0; m < 4; ++m) { const int r = ai * 128 + wr * 64 + m * 16 + fr;
                    const f32x4 vg = acc[ai][0][m][n], vu = acc[ai][1][m][n];
                    const f32x4 ng = m < 3 ? dpp4<DPP_ROR15>(acc[ai][0][m < 3 ? m + 1 : 3][n]) : xch_bot(X, b, chl + 4 * n);
                    const f32x4 nu = m < 3 ? dpp4<DPP_ROR15>(acc[ai][1][m < 3 ? m + 1 : 3][n]) : xch_bot(X, b, 128 + chl + 4 * n);
                    const f32x4 og = conv_m(vg, pg, ng, wg[0], wg[1], wg[2], fr), ou = conv_m(vu, pu, nu, wu[0], wu[1], wu[2], fr);
                    pg = dpp4<DPP_ROR1>(vg); pu = dpp4<DPP_ROR1>(vu);
                    f32x4 a;
#pragma unroll
                    for (int j = 0; j < 4; ++j) a[j] = silu_f(og[j]) * ou[j];
                    u32x2 w; w.x = cvt_pk_bf16(a[0], a[1]); w.y = cvt_pk_bf16(a[2], a[3]);
                    if (n == 0) pk0[ai][m] = w;
                    else if (row_valid(u, r)) *(u32x4*)(ACT + (size_t)(u.row0 + r) * DFF + ch - 4) = (u32x4){pk0[ai][m].x, pk0[ai][m].y, w.x, w.y}; }
            }
        }
    }
};
struct EpiSgu : EpiBase {
    static constexpr bool PERM = true;
    __device__ __forceinline__ void operator()(f32x4 (&acc)[2][2][4][2], const Unit& u, int wid, int ) const {
        int lane_ = pg8::lane_id(); asm volatile("" : "+v"(lane_));
        const int lane = lane_, wr = wid >> 2, wc = wid & 3, fr = lane & 15, fq = lane >> 4;
        unsigned char* ws = wsp(); bf16_t* U = (bf16_t*)(ws + WS_U); bf16_t* V = (bf16_t*)(ws + WS_V); f32x2* STATS = (f32x2*)(ws + WS_STATS);
        const bool isv = u.pn >= 4; bf16_t* O = isv ? V : U; const int col0 = (u.pn & 3) * 256 + wc * 32 + 8 * fq;
#pragma unroll
        for (int ai = 0; ai < 2; ++ai)
#pragma unroll
            for (int m = 0; m < 4; ++m) if (m < r192_nm(ai)) { const int row = u.row0 + r192_base(ai, wr) + m * 16 + fr; bf16_t* rowp = O + (size_t)row * D + col0; float s1 = 0.f, s2 = 0.f;
#pragma unroll
                for (int bj = 0; bj < 2; ++bj) { f32x4 v0 = acc[ai][bj][m][0], v1 = acc[ai][bj][m][1];
#pragma unroll
                    for (int j = 0; j < 4; ++j) { v0[j] = gelu_f(v0[j]); v1[j] = gelu_f(v1[j]); s1 += v0[j] + v1[j]; s2 += v0[j] * v0[j] + v1[j] * v1[j]; }
                    u32x4 w; w.x = cvt_pk_bf16(v0[0], v0[1]); w.y = cvt_pk_bf16(v0[2], v0[3]); w.z = cvt_pk_bf16(v1[0], v1[1]); w.w = cvt_pk_bf16(v1[2], v1[3]);
                    *(u32x4*)(rowp + bj * 128) = w; }
                if (isv) { s1 = rows_sum(s1); s2 = rows_sum(s2);
                    if (fq == 0) STATS[(size_t)row * 16 + (u.pn - 4) * 4 + wc] = (f32x2){s1, s2}; } }
    }
};
struct EpiSc : EpiBase {
    static constexpr bool PERM = true;
    __device__ __forceinline__ void operator()(f32x4 (&acc)[2][2][4][2], const Unit& u, int wid, int ui) const {
        int lane_ = pg8::lane_id(); asm volatile("" : "+v"(lane_));
        const int lane = lane_, wr = wid >> 2, wc = wid & 3, fr = lane & 15, fq = lane >> 4; (void)wr; (void)wc; (void)fr; (void)fq;
        unsigned char* ws = wsp(); f32x4* YB = (f32x4*)(ws + WS_YB) + (size_t)aux * 2 * 16 * 512; bf16_t* BY = (bf16_t*)(ws + WS_H2); const float* cw = inp(kargs(), 20); LAS float* X = xch();
        const int q = u.pn / 3, s = u.pn % 3, chl = wc * 32 + 8 * fq;
        if (s < 2) {
            mask_rows(acc, u, wr, fr);
#pragma unroll
            for (int ai = 0; ai < 2; ++ai)
#pragma unroll
                for (int m = 0; m < 4; ++m)
#pragma unroll
                    for (int n = 0; n < 2; ++n) acc[ai][0][m][n] = acc[ai][0][m][n] * acc[ai][1][m][n];
            xch_write(X, acc, wr, wc, fr, fq);
            LDS_WAIT(); __builtin_amdgcn_s_barrier(); asm volatile("" ::: "memory");
#pragma unroll
            for (int n = 0; n < 2; ++n) {
                const int ch = q * 256 + s * 128 + chl + 4 * n;
                f32x4 w[3];
#pragma unroll
                for (int k = 0; k < 3; ++k) w[k] = *(const f32x4*)(cw + k * D + ch);
#pragma unroll
                for (int ai = 0; ai < 2; ++ai) { const int b = 2 * ai + wr;
                    f32x4 pp = xch_top(X, b, chl + 4 * n);
#pragma unroll
                    for (int m = 0; m < 4; ++m) { const f32x4 v = acc[ai][0][m][n];
                        const f32x4 nn = m < 3 ? dpp4<DPP_ROR15>(acc[ai][0][m < 3 ? m + 1 : 3][n]) : xch_bot(X, b, chl + 4 * n);
                        const f32x4 o = conv_m(v, pp, nn, w[0], w[1], w[2], fr); pp = dpp4<DPP_ROR1>(v);
                        unsigned yo = (unsigned)((s * 16 + (ai * 4 + m) * 2 + n) * 512) + (unsigned)(wid * 64 + lane); asm volatile("" : "+v"(yo)); YB[yo] = o; } }
            }
        } else {
#pragma unroll
            for (int ai = 0; ai < 2; ++ai) {
                f32x4 y[4][2][2];
#pragma unroll
                for (int m = 0; m < 4; ++m)
#pragma unroll
                    for (int bj = 0; bj < 2; ++bj) { unsigned yo = (unsigned)((bj * 16 + (ai * 4 + m) * 2) * 512) + (unsigned)(wid * 64 + lane); asm volatile("" : "+v"(yo)); y[m][bj][0] = YB[yo]; y[m][bj][1] = YB[yo + 512]; }
#pragma unroll
                for (int m = 0; m < 4; ++m) { const int r = ai * 128 + wr * 64 + m * 16 + fr; const bool ok = row_valid(u, r);
#pragma unroll
                    for (int bj = 0; bj < 2; ++bj) { const f32x4 v0 = acc[ai][bj][m][0] * y[m][bj][0], v1 = acc[ai][bj][m][1] * y[m][bj][1];
                        u32x4 w; w.x = cvt_pk_bf16(v0[0], v0[1]); w.y = cvt_pk_bf16(v0[2], v0[3]); w.z = cvt_pk_bf16(v1[0], v1[1]); w.w = cvt_pk_bf16(v1[2], v1[3]);
                        if (ok) *(u32x4*)(BY + (size_t)(u.row0 + r) * D + q * 256 + bj * 128 + chl) = w; } }
                asm volatile("" ::: "memory"); }
        }
    }
};
struct OrderSc {
    int c; const char* A; const char* B;
    __device__ __forceinline__ bool next(int i, Unit& u) const {
        if (c >= 200 || i >= 3) return false;
        u.pm = c >> 2; u.pn = 3 * (c & 3) + i; u.row0 = conv_row0(u.pm); u.a = A + (long)u.row0 * (D * 2); u.b = B + (size_t)u.pn * 256 * D * 2; return true; }
};
struct EpiFn1 : EpiBase {
    static constexpr bool PERM = true;
    __device__ __forceinline__ void operator()(const f32x4 (&acc)[2][2][4][2], const Unit& u, int wid, int ) const {
        int lane_ = pg8::lane_id(); asm volatile("" : "+v"(lane_));
        const int lane = lane_, wr = wid >> 2, wc = wid & 3, fr = lane & 15, fq = lane >> 4; (void)wr; (void)wc; (void)fr; (void)fq;
        bf16_t* YT = (bf16_t*)(wsp() + WS_YT);
        const int part = u.pm & 1, ch0 = (u.pm >> 1) * 256, tok0 = u.pn * 256;
        bf16_t* base; int T, t0;
        if (tok0 < MP) { T = TP; base = YT + (size_t)(tok0 / TP) * D * 2 * TP; t0 = 0; }
        else { T = TS; base = YT + (size_t)32 * D * 2 * TP + (size_t)((tok0 - MP) / TS) * D * 2 * TS; t0 = (tok0 - MP) % TS; }
        const int c0 = wc * 32 + 8 * fq;
#pragma unroll
        for (int ai = 0; ai < 2; ++ai)
#pragma unroll
            for (int m = 0; m < 4; ++m) { bf16_t* rowp = base + (size_t)(ch0 + ai * 128 + wr * 64 + m * 16 + fr) * 2 * T + part * T + t0 + c0;
#pragma unroll
                for (int bj = 0; bj < 2; ++bj) { const f32x4 v0 = acc[ai][bj][m][0], v1 = acc[ai][bj][m][1];
                    u32x4 w; w.x = cvt_pk_bf16(v0[0], v0[1]); w.y = cvt_pk_bf16(v0[2], v0[3]); w.z = cvt_pk_bf16(v1[0], v1[1]); w.w = cvt_pk_bf16(v1[2], v1[3]);
                    *(u32x4*)(rowp + bj * 128) = w; } }
    }
};
struct OrderFn1 {
    int G, c; const char* A1; const char* H;
    __device__ __forceinline__ bool next(int i, Unit& u) const {
        const int L = i * G + c; if (L >= 384) return false;
        u.pm = L & 7; u.pn = L >> 3; u.row0 = 0; u.a = A1 + (size_t)(u.pm & 1) * 256 * 256 * 2; u.b = H + (size_t)u.pn * 256 * D * 2 + (size_t)(u.pm >> 1) * 512; return true; }
};
struct OrderFn2 {
    int c; int samp; const char* A2; const char* YT;
    __device__ __forceinline__ bool next(int i, Unit& u) const {
        if (i > 0) return false;
        if (samp) { if (c >= 128) return false; const int b = c >> 6, tm = (c >> 2) & 15; u.pm = tm; u.pn = c & 3; u.row0 = MP + b * TS + 128 * tm;
            u.a = A2 + (size_t)tm * 128 * 2 * TS * 2; u.b = YT + (size_t)32 * D * 2 * TP * 2 + (size_t)b * D * 2 * TS * 2 + (size_t)u.pn * 256 * 2 * TS * 2; return true; }
        if (c < 128) return false; const int j = c - 128, s = j >> 2; u.pm = 0; u.pn = j & 3; u.row0 = s * TP;
        u.a = A2; u.b = YT + (size_t)s * D * 2 * TP * 2 + (size_t)u.pn * 256 * 2 * TP * 2; return true; }
};

__device__ __forceinline__ void p0_transpose_item(const float* W, int K, int N, bf16_t* WT, int drow0, LAS float* scr, int kb, int n0, int lane) {
    const int k0 = 64 * kb;
    f32x4 v[8];
#pragma unroll
    for (int i = 0; i < 8; ++i) v[i] = __builtin_nontemporal_load((const f32x4*)(W + (size_t)(k0 + 8 * i + (lane >> 3)) * N + n0 + 4 * (lane & 7)));
#pragma unroll
    for (int i = 0; i < 8; ++i) { LAS float* d = scr + (8 * i + (lane >> 3)) * 33 + 4 * (lane & 7); d[0] = v[i][0]; d[1] = v[i][1]; d[2] = v[i][2]; d[3] = v[i][3]; }
    LDS_WAIT(); asm volatile("" ::: "memory");
    const int c = lane & 7;
#pragma unroll
    for (int j = 0; j < 4; ++j) { const int n = (lane >> 3) + 8 * j; const LAS float* s = scr + (8 * c) * 33 + n;
        u32x4 o; o.x = pk2(s[0 * 33], s[1 * 33]); o.y = pk2(s[2 * 33], s[3 * 33]); o.z = pk2(s[4 * 33], s[5 * 33]); o.w = pk2(s[6 * 33], s[7 * 33]);
        *(u32x4*)(WT + (size_t)(drow0 + n) * K + k0 + 8 * c) = o; }
    LDS_WAIT(); asm volatile("" ::: "memory");
}
__device__ __forceinline__ int map_plain(int n) { return n; }
__device__ __forceinline__ int map_up(int n) { return n < DFF ? 256 * (n >> 7) + (n & 127) : 256 * ((n - DFF) >> 7) + 128 + ((n - DFF) & 127); }
__device__ __forceinline__ int map_sc(int n) {
    if (n < D) return (3 * (n >> 8) + 2) * 256 + (n & 255);
    const int x = n >= 2 * D, ch = n - D - x * D; return (3 * (ch >> 8) + ((ch >> 7) & 1)) * 256 + x * 128 + (ch & 127);
}
__device__ __forceinline__ void p0_tjob(int& it, int NGW, LAS float* scr, int lane, const float* W, bf16_t* WT, int K, int N, int map) {
    const int nblk = N / 32, nitems = (K / 64) * nblk;
    for (; it < nitems; it += NGW) { const int kb = it / nblk, n0 = (it % nblk) * 32; const int dr = map == 0 ? n0 : (map == 1 ? map_up(n0) : map_sc(n0));
        p0_transpose_item(W, K, N, WT, dr, scr, kb, n0, lane); }
    it -= nitems;
}
__device__ __forceinline__ void convert_layer(Frame& F, int l, int b0, int nb) {
    unsigned char* ws = F.ws;
    LAS float* scr = (LAS float*)(F.lds + F.wave * 16384);
    const int gw = (F.blk - b0) * NWAVES + F.wave, NGW = nb * NWAVES;
    int it = gw;
    if (l == 0) { p0_tjob(it, NGW, scr, F.lane, ((const float*)F.in[11]), (bf16_t*)(ws + WS_WQKV), D, 1536, 0);
        p0_tjob(it, NGW, scr, F.lane, ((const float*)F.in[12]), (bf16_t*)(ws + WS_WO), D, D, 0); }
    else if (l == 1) { p0_tjob(it, NGW, scr, F.lane, ((const float*)F.in[14]), (bf16_t*)(ws + WS_WSGI), D, 2048, 0);
        p0_tjob(it, NGW, scr, F.lane, ((const float*)F.in[18]), (bf16_t*)(ws + WS_WSGO), D, D, 0); }
    else if (l == 2) { p0_tjob(it, NGW, scr, F.lane, ((const float*)F.in[19]), (bf16_t*)(ws + WS_WSCI), D, 3072, 2);
        p0_tjob(it, NGW, scr, F.lane, ((const float*)F.in[21]), (bf16_t*)(ws + WS_WSCO), D, D, 0); }
    else p0_tjob(it, NGW, scr, F.lane, ((const float*)F.in[22]), (bf16_t*)(ws + WS_WFNO), D, D, 0);
    p0_tjob(it, NGW, scr, F.lane, ((const float*)F.in[23]) + (size_t)l * D * 2 * DFF, (bf16_t*)(ws + WS_WUP + l * WUP_BYTES), D, 2 * DFF, 1);
    p0_tjob(it, NGW, scr, F.lane, ((const float*)F.in[25]) + (size_t)l * DFF * D, (bf16_t*)(ws + WS_WDN + l * WDN_BYTES), DFF, D, 0);
    const size_t gt = (size_t)(F.blk - b0) * 512 + F.tid, NGT = (size_t)nb * 512;
    if (l == 1) { bf16_t* WSb = (bf16_t*)(ws + WS_WS); for (size_t i = gt; i < 8 * 128 * 128; i += NGT) WSb[i] = (bf16_t)f2bf(((const float*)F.in[16])[i]); }
    if (l == 3) {
        bf16_t* A1 = (bf16_t*)(ws + WS_A1);
        for (size_t i = gt; i < 2 * 256 * 256; i += NGT) { const int part = i >> 16, r = (i >> 8) & 255, k = i & 255; float v = 0.f;
            if ((r >> 7) == (k >> 7)) { const float a = 2.f * (float)(((r & 127) * (k & 127)) & 127) / 128.f; v = (part ? sinpif(a) : cospif(a)) * 0.08838834764831845f; }
            A1[i] = (bf16_t)f2bf(v); }
        bf16_t* A2P = (bf16_t*)(ws + WS_A2P);
        for (size_t i = gt; i < 256 * 512; i += NGT) { const int tp = i >> 9, k = i & 511, t = k & 255; const float a = 2.f * (float)((tp * t) & 255) / 256.f;
            A2P[i] = (bf16_t)f2bf((k < 256 ? cospif(a) : -sinpif(a)) * 0.0625f); }
        __syncthreads();
        LAS bf16_t* tab = (LAS bf16_t*)F.lds;
        for (int j = F.tid; j < 2048; j += 512) { const float a = 2.f * (float)j / 2048.f; tab[j] = (bf16_t)f2bf(cospif(a) * 0.022097086912079608f); tab[2048 + j] = (bf16_t)f2bf(-sinpif(a) * 0.022097086912079608f); }
        __syncthreads();
        bf16_t* A2S = (bf16_t*)(ws + WS_A2S);
        for (size_t i8 = gt; i8 < (size_t)2048 * 4096 / 8; i8 += NGT) { const int tp = (int)(i8 >> 9), k0 = (int)(i8 & 511) * 8, part = k0 >> 11, t0 = k0 & 2047;
            unsigned w[4];
#pragma unroll
            for (int e = 0; e < 4; ++e) { const unsigned lo = tab[part * 2048 + ((tp * (t0 + 2 * e)) & 2047)], hi = tab[part * 2048 + ((tp * (t0 + 2 * e + 1)) & 2047)]; w[e] = lo | (hi << 16); }
            *(u32x4*)(A2S + i8 * 8) = (u32x4){w[0], w[1], w[2], w[3]}; }
        __syncthreads();
    }
}
__device__ __forceinline__ void prefetch_region(Frame& F, const void* p, size_t bytes, int b0, int nb) {
    const size_t gt = (size_t)(F.blk - b0) * 512 + F.tid, NGT = (size_t)nb * 512; unsigned acc = 0;
    for (size_t i = gt * 128; i < bytes; i += NGT * 128) { const u32x4 v = *(const u32x4*)((const char*)p + i); acc += v.x ^ v.w; }
    if (acc == 0x9e3779b9u) *(volatile unsigned*)(F.ws + WS_CTL + CTL_TMO + 64) = acc;
}
__device__ __forceinline__ void mod_items(Frame& F, int lo, int hi, int b0, int nb) {
    unsigned char* ws = F.ws;
    LAS float* sv = (LAS float*)F.lds;
    LAS float* red = sv + 3 * D;
    __syncthreads();
    for (int i = F.tid; i < D; i += 512) { const float a = ((const float*)F.in[5])[i], b = ((const float*)F.in[4])[i], d = ((const float*)F.in[4])[D + i];
        sv[i] = a / (1.f + expf(-a)); sv[D + i] = b / (1.f + expf(-b)); sv[2 * D + i] = d / (1.f + expf(-d)); }
    __syncthreads();
    float* MODp = (float*)(ws + WS_MOD);
    const int kg = F.tid >> 3, cq = F.tid & 7;
    for (int it = lo + F.blk - b0; it < hi; it += nb) {
        const int l = it / 192, n0 = (it % 192) * 32;
        const float* w = ((const float*)F.in[6]) + (size_t)l * D * 6 * D + n0 + 4 * cq;
        f32x4 wv[16];
#pragma unroll
        for (int i = 0; i < 16; ++i) wv[i] = __builtin_nontemporal_load((const f32x4*)(w + (size_t)(kg + 64 * i) * 6 * D));
        f32x4 a[3] = {{0, 0, 0, 0}, {0, 0, 0, 0}, {0, 0, 0, 0}};
#pragma unroll
        for (int i = 0; i < 16; ++i) { const int k = kg + 64 * i; a[0] += sv[k] * wv[i]; a[1] += sv[D + k] * wv[i]; a[2] += sv[2 * D + k] * wv[i]; }
#pragma unroll
        for (int v = 0; v < 3; ++v)
#pragma unroll
            for (int j = 0; j < 4; ++j) { float x = a[v][j]; x += dppx<0x128>(x); a[v][j] = rows_sum(x); }
        if (F.lane < 8) {
#pragma unroll
            for (int v = 0; v < 3; ++v) *(LAS f32x4*)(red + (F.wave * 3 + v) * 32 + 4 * cq) = a[v]; }
        __syncthreads();
        if (F.tid < 96) { const int v = F.tid >> 5, cc = F.tid & 31; float s = 0.f;
#pragma unroll
            for (int g = 0; g < 8; ++g) s += red[(g * 3 + v) * 32 + cc];
            MODp[(l * 3 + v) * 6 * D + n0 + cc] = s + ((const float*)F.in[7])[l * 6 * D + n0 + cc]; }
        __syncthreads();
    }
}
__device__ __forceinline__ void p0_prologue(Frame& F) {
    unsigned char* ws = F.ws;
    mod_items(F, 0, 192, 0, F.G);
    {
        const size_t gt = (size_t)F.blk * 512 + F.tid, NGT = (size_t)F.G * 512;
        bf16_t* CK = (bf16_t*)(ws + WS_CK); bf16_t* CVT = (bf16_t*)(ws + WS_CVT);
        for (size_t i = gt; i < 2 * 512 * 256; i += NGT) { CK[i] = (bf16_t)f2bf(((const float*)F.in[2])[i]);
            const int d = i & 63, kvh = (i >> 6) & 3, j = (i >> 8) & 511, b = i >> 17; CVT[((size_t)(b * 4 + kvh) * 64 + d) * 512 + j] = (bf16_t)f2bf(((const float*)F.in[3])[i]); }
        float* rope = (float*)(ws + WS_ROPE);
        for (size_t i = gt; i < 1024; i += NGT) { const int pos = i >> 4, fi = i & 15; const float ang = (float)pos * powf(10000.f, -(float)fi / 16.f); rope[i] = cosf(ang); rope[1024 + i] = sinf(ang); }
    }
}

__device__ __forceinline__ void norm_phase(Frame& F, const float* src0, const float* src1, const float* g, const float* modl, int sh_idx, bf16_t* H) {
    const int gw = F.blk * NWAVES + F.wave, NGW = F.G * NWAVES;
    f32x4 gv[2][2];
#pragma unroll
    for (int h = 0; h < 2; ++h)
#pragma unroll
        for (int k = 0; k < 2; ++k) gv[h][k] = *(const f32x4*)(g + 512 * h + 8 * F.lane + 4 * k);
    for (int row = gw; row < M; row += NGW) {
        const float* xr = row < MP ? src0 + (size_t)row * D : src1 + (size_t)(row - MP) * D;
        const float* mv = modl + (row < MP ? 0 : 1 + (row - MP) / TS) * 6 * D;
        f32x4 v[2][2]; float s = 0.f;
#pragma unroll
        for (int h = 0; h < 2; ++h)
#pragma unroll
            for (int k = 0; k < 2; ++k) { v[h][k] = *(const f32x4*)(xr + 512 * h + 8 * F.lane + 4 * k); s += (v[h][k][0] * v[h][k][0] + v[h][k][1] * v[h][k][1]) + (v[h][k][2] * v[h][k][2] + v[h][k][3] * v[h][k][3]); }
        const float r = rsqrtf(wave_sum(s) * (1.f / D) + EPS);
#pragma unroll
        for (int h = 0; h < 2; ++h) { f32x4 o[2];
#pragma unroll
            for (int k = 0; k < 2; ++k) { const int c = 512 * h + 8 * F.lane + 4 * k; const f32x4 sh = *(const f32x4*)(mv + sh_idx * D + c), sc = *(const f32x4*)(mv + (sh_idx + 1) * D + c);
                o[k] = v[h][k] * r * gv[h][k] * (1.f + sc) + sh; }
            u32x4 w; w.x = pk2(o[0][0], o[0][1]); w.y = pk2(o[0][2], o[0][3]); w.z = pk2(o[1][0], o[1][1]); w.w = pk2(o[1][2], o[1][3]);
            *(u32x4*)(H + (size_t)row * D + 512 * h + 8 * F.lane) = w; }
    }
}
__device__ __forceinline__ void final_phase(Frame& F, const float* X, const float* g, float* out) {
    const int gw = F.blk * NWAVES + F.wave, NGW = F.G * NWAVES;
    f32x4 gv[4];
#pragma unroll
    for (int j = 0; j < 4; ++j) gv[j] = *(const f32x4*)(g + 256 * j + 4 * F.lane);
    for (int row = gw; row < M; row += NGW) {
        const float* xr = X + (size_t)row * D; f32x4 v[4]; float s = 0.f;
#pragma unroll
        for (int j = 0; j < 4; ++j) { v[j] = *(const f32x4*)(xr + 256 * j + 4 * F.lane); s += (v[j][0] * v[j][0] + v[j][1] * v[j][1]) + (v[j][2] * v[j][2] + v[j][3] * v[j][3]); }
        const float r = rsqrtf(wave_sum(s) * (1.f / D) + EPS);
#pragma unroll
        for (int j = 0; j < 4; ++j) *(f32x4*)(out + (size_t)row * D + 256 * j + 4 * F.lane) = v[j] * r * gv[j];
    }
}

constexpr int ATT_LDK = 144;
constexpr int ATT_TILE_BYTES = 2 * 64 * ATT_LDK;
struct AttTile { const bf16_t* K; const bf16_t* V; int ldk, ldv, k0, mask; };
__device__ __forceinline__ void att_tile_of(int t, bool lat, int nband, int kband0, int qc0, const bf16_t* KBs, const bf16_t* VTs, int T, const bf16_t* CKs, const bf16_t* CVTs, AttTile& o) {
    if (t < nband) { const int k0 = kband0 + 64 * t; o.K = KBs + (size_t)k0 * 256; o.V = VTs + k0; o.ldk = 256; o.ldv = T; o.k0 = k0; const int dk = k0 - qc0; o.mask = lat && (dk < -64 || dk > 64); }
    else { const int k0 = 64 * (t - nband); o.K = CKs + (size_t)k0 * 256; o.V = CVTs + k0; o.ldk = 256; o.ldv = 512; o.k0 = k0; o.mask = 0; }
}
__device__ __forceinline__ void attn_phase(Frame& F, const bf16_t* Q, const bf16_t* KB, const bf16_t* VT, const bf16_t* CK, const bf16_t* CVT, const float* sink, bf16_t* O) {
    const int fr = F.lane & 15, g4 = F.lane >> 4, tid = F.tid;
    const int lrow = tid >> 3, lchunk = tid & 7;
    LAS unsigned char* lds = F.lds;
    for (int it = F.blk; it < 768; it += F.G) {
        const bool lat = it < 256; int kvh, chunk, T, rowbase, b = 0; const bf16_t* vt;
        if (lat) { b = it >> 7; kvh = (it >> 5) & 3; chunk = it & 31; T = TS; rowbase = MP + b * TS; vt = VT + (size_t)32 * 65536 + (size_t)b * 256 * TS; }
        else { const int j = it - 256, s = j >> 4; kvh = (j >> 2) & 3; chunk = j & 3; T = TP; rowbase = s * TP; vt = VT + (size_t)s * 65536; }
        const int h = kvh * 4 + (F.wave & 3), q0 = chunk * 64 + (F.wave >> 2) * 32;
        int kband0 = 0, nband = T / 64;
        if (lat) { int lo = 64 * chunk - 128, hi = 64 * chunk + 192; lo = lo < 0 ? 0 : lo; hi = hi > T ? T : hi; kband0 = lo; nband = (hi - lo) / 64; }
        const int ntile = nband + (lat ? 8 : 0);
        const bf16_t* KBs = KB + (size_t)rowbase * 256 + kvh * 64; const bf16_t* VTs = vt + (size_t)(kvh * 64) * T;
        const bf16_t* CKs = CK + (size_t)b * 512 * 256 + kvh * 64; const bf16_t* CVTs = CVT + (size_t)((b * 4 + kvh) * 64) * 512;
        bf16x8 Qf[2][2];
#pragma unroll
        for (int qg = 0; qg < 2; ++qg)
#pragma unroll
            for (int ds = 0; ds < 2; ++ds) Qf[qg][ds] = *(const bf16x8*)(Q + (size_t)(rowbase + q0 + 16 * qg + fr) * D + h * 64 + 32 * ds + 8 * g4);
        float mrun[2], lrun[2]; f32x4 Oa[2][4];
#pragma unroll
        for (int qg = 0; qg < 2; ++qg) { mrun[qg] = sink[h] * 1.4426950408889634f; lrun[qg] = 1.f;
#pragma unroll
            for (int db = 0; db < 4; ++db) Oa[qg][db] = (f32x4){0.f, 0.f, 0.f, 0.f}; }
        AttTile tl; att_tile_of(0, lat, nband, kband0, 64 * chunk, KBs, VTs, T, CKs, CVTs, tl);
        u32x4 rk = *(const u32x4*)(tl.K + (size_t)lrow * tl.ldk + lchunk * 8), rv = *(const u32x4*)(tl.V + (size_t)lrow * tl.ldv + lchunk * 8);
        __syncthreads();
        *(LAS u32x4*)(lds + lrow * ATT_LDK + lchunk * 16) = rk; *(LAS u32x4*)(lds + 64 * ATT_LDK + lrow * ATT_LDK + lchunk * 16) = rv;
        __syncthreads();
#pragma unroll 1
        for (int t = 0; t < ntile; ++t) {
            const int cur_k0 = tl.k0, cur_mask = tl.mask;
            if (t + 1 < ntile) { att_tile_of(t + 1, lat, nband, kband0, 64 * chunk, KBs, VTs, T, CKs, CVTs, tl);
                rk = *(const u32x4*)(tl.K + (size_t)lrow * tl.ldk + lchunk * 8); rv = *(const u32x4*)(tl.V + (size_t)lrow * tl.ldv + lchunk * 8); }
            const LAS unsigned char* kb_ = lds + (t & 1) * ATT_TILE_BYTES; const LAS unsigned char* vb_ = kb_ + 64 * ATT_LDK;
            {
                bf16x8 Kf[2][2][2], Vf[2][4];
#pragma unroll
                for (int sub = 0; sub < 2; ++sub) {
#pragma unroll
                    for (int kb = 0; kb < 2; ++kb)
#pragma unroll
                        for (int ds = 0; ds < 2; ++ds) Kf[sub][kb][ds] = *(const LAS bf16x8*)(kb_ + (32 * sub + 16 * kb + fr) * ATT_LDK + 64 * ds + 16 * g4);
#pragma unroll
                    for (int db = 0; db < 4; ++db) { const LAS unsigned char* vp = vb_ + (16 * db + fr) * ATT_LDK + 64 * sub + 8 * g4; const u32x2 lo = *(const LAS u32x2*)vp, hi = *(const LAS u32x2*)(vp + 32);
                        Vf[sub][db] = __builtin_bit_cast(bf16x8, (u32x4){lo.x, lo.y, hi.x, hi.y}); }
                }
                const float c = 0.125f * 1.4426950408889634f;
                f32x4 S[2][2][2];
#pragma unroll
                for (int qg = 0; qg < 2; ++qg)
#pragma unroll
                    for (int sub = 0; sub < 2; ++sub)
#pragma unroll
                        for (int kb = 0; kb < 2; ++kb) { S[qg][sub][kb] = __builtin_amdgcn_mfma_f32_16x16x32_bf16(Kf[sub][kb][0], Qf[qg][0], (f32x4){0.f, 0.f, 0.f, 0.f}, 0, 0, 0);
                            S[qg][sub][kb] = __builtin_amdgcn_mfma_f32_16x16x32_bf16(Kf[sub][kb][1], Qf[qg][1], S[qg][sub][kb], 0, 0, 0); }
                float mnew[2], rs[2];
#pragma unroll
                for (int qg = 0; qg < 2; ++qg) {
                    const int qpos = q0 + 16 * qg + fr;
                    if (cur_mask) {
#pragma unroll
                        for (int sub = 0; sub < 2; ++sub)
#pragma unroll
                            for (int kb = 0; kb < 2; ++kb)
#pragma unroll
                                for (int r = 0; r < 4; ++r) { const int d = cur_k0 + 32 * sub + 16 * kb + 4 * g4 + r - qpos; if (d > 128 || d < -128) S[qg][sub][kb][r] = -1e30f; }
                    }
                    float mx = -1e30f;
#pragma unroll
                    for (int sub = 0; sub < 2; ++sub)
#pragma unroll
                        for (int kb = 0; kb < 2; ++kb) mx = fmaxf(fmaxf(mx, fmaxf(S[qg][sub][kb][0], S[qg][sub][kb][1])), fmaxf(S[qg][sub][kb][2], S[qg][sub][kb][3]));
                    mx = rows_max(mx) * c;
                    mnew[qg] = fmaxf(mrun[qg], mx);
                    float r_ = 0.f;
#pragma unroll
                    for (int sub = 0; sub < 2; ++sub)
#pragma unroll
                        for (int kb = 0; kb < 2; ++kb)
#pragma unroll
                            for (int r = 0; r < 4; ++r) { const float p = fast_exp2(__builtin_fmaf(S[qg][sub][kb][r], c, -mnew[qg])); S[qg][sub][kb][r] = p; r_ += p; }
                    rs[qg] = rows_sum(r_);
                }
                if (__builtin_amdgcn_ballot_w64(mnew[0] > mrun[0] || mnew[1] > mrun[1]) != 0ull) {
#pragma unroll
                    for (int qg = 0; qg < 2; ++qg) { const float alpha = fast_exp2(mrun[qg] - mnew[qg]); lrun[qg] *= alpha;
#pragma unroll
                        for (int db = 0; db < 4; ++db) Oa[qg][db] = Oa[qg][db] * alpha; }
                }
#pragma unroll
                for (int qg = 0; qg < 2; ++qg) { lrun[qg] += rs[qg]; mrun[qg] = mnew[qg];
#pragma unroll
                    for (int sub = 0; sub < 2; ++sub) {
                        u32x4 pw; pw.x = cvt_pk_bf16(S[qg][sub][0][0], S[qg][sub][0][1]); pw.y = cvt_pk_bf16(S[qg][sub][0][2], S[qg][sub][0][3]); pw.z = cvt_pk_bf16(S[qg][sub][1][0], S[qg][sub][1][1]); pw.w = cvt_pk_bf16(S[qg][sub][1][2], S[qg][sub][1][3]);
                        const bf16x8 Pf = __builtin_bit_cast(bf16x8, pw);
#pragma unroll
                        for (int db = 0; db < 4; ++db) Oa[qg][db] = __builtin_amdgcn_mfma_f32_16x16x32_bf16(Vf[sub][db], Pf, Oa[qg][db], 0, 0, 0); } }
            }
            if (t + 1 < ntile) { LAS unsigned char* nb = lds + ((t + 1) & 1) * ATT_TILE_BYTES;
                *(LAS u32x4*)(nb + lrow * ATT_LDK + lchunk * 16) = rk; *(LAS u32x4*)(nb + 64 * ATT_LDK + lrow * ATT_LDK + lchunk * 16) = rv; }
            __syncthreads();
        }
#pragma unroll
        for (int qg = 0; qg < 2; ++qg) { const float inv = 1.f / lrun[qg];
#pragma unroll
            for (int dp = 0; dp < 2; ++dp) { u32x2 w[2];
#pragma unroll
                for (int k = 0; k < 2; ++k) { const f32x4 o = Oa[qg][2 * dp + k] * inv; w[k].x = cvt_pk_bf16(o[0], o[1]); w[k].y = cvt_pk_bf16(o[2], o[3]); }
                *(u32x4*)(O + (size_t)(rowbase + q0 + 16 * qg + fr) * D + h * 64 + 32 * dp + 4 * g4 + ((g4 & 1) ? 12 : 0)) = merge_quads16(w[0], w[1]); } }
    }
}

__device__ __forceinline__ void sgu_phase(Frame& F, const bf16_t* U, const bf16_t* V, const f32x2* STATS, const float* ln_g, const bf16_t* WSb, const float* b_s, bf16_t* UM) {
    constexpr int LDT = 136;
    LAS bf16_t* LT = (LAS bf16_t*)F.lds;
    LAS f32x2* ST = (LAS f32x2*)(F.lds + 128 * LDT * 2);
    const int fr = F.lane & 15, g4 = F.lane >> 4;
    for (int it = F.blk; it < 768; it += F.G) {
        const int ch = it >> 3, g = it & 7, r0 = ch * 128;
        if (F.tid < 128) { const f32x2* sp = STATS + (size_t)(r0 + F.tid) * 16; float s1 = 0.f, s2 = 0.f;
#pragma unroll
            for (int k = 0; k < 16; ++k) { const f32x2 p = sp[k]; s1 += p.x; s2 += p.y; }
            const float mu = s1 * (1.f / D), var = s2 * (1.f / D) - mu * mu; ST[F.tid] = (f32x2){mu, rsqrtf(fmaxf(var, 0.f) + EPS)}; }
        __syncthreads();
#pragma unroll
        for (int i = 0; i < 4; ++i) { const int q = F.tid + 512 * i, r = q & 127, c8 = (q >> 7) * 8;
            const u32x4 raw = *(const u32x4*)(V + (size_t)(r0 + r) * D + g * 128 + c8); const f32x2 st = ST[r];
            const f32x4 ga = *(const f32x4*)(ln_g + g * 128 + c8), gb = *(const f32x4*)(ln_g + g * 128 + c8 + 4);
            const unsigned rw[4] = {raw.x, raw.y, raw.z, raw.w};
#pragma unroll
            for (int e = 0; e < 8; ++e) { const float x = bf2f((unsigned short)(e & 1 ? rw[e >> 1] >> 16 : rw[e >> 1] & 0xffff)); const float gg = e < 4 ? ga[e & 3] : gb[e & 3];
                LT[(c8 + e) * LDT + r] = (bf16_t)f2bf((x - st.x) * st.y * gg); } }
        __syncthreads();
        f32x4 acc[8];
#pragma unroll
        for (int cb = 0; cb < 8; ++cb) acc[cb] = (f32x4){0.f, 0.f, 0.f, 0.f};
        const int p = 16 * F.wave + fr;
#pragma unroll
        for (int ks = 0; ks < 4; ++ks) { const bf16x8 bw = *(const bf16x8*)(WSb + (size_t)(g * 128 + p) * 128 + 32 * ks + 8 * g4);
#pragma unroll
            for (int cb = 0; cb < 8; ++cb) { const bf16x8 av = *(const LAS bf16x8*)(LT + (16 * cb + fr) * LDT + 32 * ks + 8 * g4); acc[cb] = __builtin_amdgcn_mfma_f32_16x16x32_bf16(av, bw, acc[cb], 0, 0, 0); } }
        const float bsv = b_s[g * 128 + p];
#pragma unroll
        for (int cp = 0; cp < 4; ++cp) {
            const size_t off = (size_t)(r0 + p) * D + g * 128 + 32 * cp + 4 * g4 + ((g4 & 1) ? 12 : 0);
            u32x2 uq[2]; split_quads16(*(const u32x4*)(U + off), uq[0], uq[1]);
            u32x2 w[2];
#pragma unroll
            for (int k = 0; k < 2; ++k) { const f32x4 a = acc[2 * cp + k];
                const float u0 = bf2f((unsigned short)(uq[k].x & 0xffff)), u1 = bf2f((unsigned short)(uq[k].x >> 16)), u2 = bf2f((unsigned short)(uq[k].y & 0xffff)), u3 = bf2f((unsigned short)(uq[k].y >> 16));
                w[k].x = cvt_pk_bf16(u0 * (a[0] + bsv), u1 * (a[1] + bsv)); w[k].y = cvt_pk_bf16(u2 * (a[2] + bsv), u3 * (a[3] + bsv)); }
            *(u32x4*)(UM + off) = merge_quads16(w[0], w[1]); }
        __syncthreads();
    }
}

struct Args { const float* in[26]; float* out; unsigned char* ws; int ph_lo, ph_hi; };
__global__ void __launch_bounds__(NWAVES * 64, 2) mk_fwd(const Args args) {
    extern __shared__ __attribute__((aligned(16))) unsigned char lds_raw[];
    Frame F;
    F.lds = (LAS unsigned char*)lds_raw;
    const int wave0 = __builtin_amdgcn_readfirstlane((int)threadIdx.x >> 6);
    F.wave = wave0; F.lane = pg8::lane_id(); F.tid = wave0 * 64 + F.lane;
    const int grid0 = gridDim.x, blk0 = blockIdx.x; F.G = grid0; F.blk = blk0;
    F.in = (const __attribute__((address_space(4))) cfp_t*)__builtin_amdgcn_kernarg_segment_ptr();
    F.out = args.out; F.ws = args.ws;
    unsigned char* ws = args.ws;
    volatile LAS unsigned* MISC = (volatile LAS unsigned*)(F.lds + MISC_OFF);
    if (F.tid < 32) MISC[F.tid] = 0u;
    __syncthreads();
    const int lo = args.ph_lo, hi = args.ph_hi;
    XcdBarrier bar; bar.bar = (unsigned*)(ws + WS_CTL); bar.x = 0; bar.st = nullptr;
    if (hi - lo > 1) bar = xcd_barrier_post((unsigned*)(ws + WS_CTL), MISC + 8, F.tid == 0);
    LAS float* XCH = (LAS float*)(F.lds + XCH_OFF);
#define CASE_BEGIN() { int b_ = blk0, w_ = wave0, g_ = grid0; asm volatile("" : "+s"(b_), "+s"(w_), "+s"(g_)); F.blk = b_; F.wave = w_; F.G = g_; } frame_refresh(F); unsigned long long ws_ = (unsigned long long)args.ws, in_ = (unsigned long long)__builtin_amdgcn_kernarg_segment_ptr(); asm volatile("" : "+s"(ws_), "+s"(in_)); \
        unsigned char* ws = (unsigned char*)(GAS unsigned char*)ws_; F.ws = ws; F.in = (const __attribute__((address_space(4))) cfp_t*)in_; \
        float* X = (float*)(ws + WS_X); bf16_t* H = (bf16_t*)(ws + WS_H); bf16_t* H2 = (bf16_t*)(ws + WS_H2); bf16_t* HN = (bf16_t*)(ws + WS_HN); (void)HN; \
        const float* modl = (const float*)(ws + WS_MOD) + l * 3 * 6 * D; const float* xs0 = l == 0 ? ((const float*)F.in[0]) : X; const float* xs1 = l == 0 ? ((const float*)F.in[1]) : X + (size_t)MP * D; \
        (void)X; (void)H; (void)H2; (void)modl; (void)xs0; (void)xs1
#pragma unroll 1
    for (int ph = lo; ph < hi; ++ph) {
        int l = 0, kind;
        if (ph == 0) kind = 0; else if (ph == 1) kind = 1;
        else { l = ph < 7 ? 0 : ph < 12 ? 1 : ph < 16 ? 2 : 3; const int j = ph - (l == 0 ? 2 : l == 1 ? 7 : l == 2 ? 12 : 16), n = l == 2 ? 1 : 2;
            kind = j < n ? (l == 0 ? 2 + j : l == 1 ? 4 + j : l == 2 ? 6 : 7 + j) : j == n ? 9 : j == n + 1 ? 10 : 11; }
        const int reps = (kind == MK_REP_KIND) ? 1 + MK_REP_N : 1;
        const bool tp_here = MK_TP && ph == MK_TP_PH && blk0 == 0;
        unsigned long long tp_r0 = 0, tp_c0 = 0; if (tp_here) { tp_r0 = __builtin_amdgcn_s_memrealtime(); tp_c0 = __builtin_amdgcn_s_memtime(); }
#pragma unroll 1
        for (int rep = 0; rep < reps; ++rep) {
        if (rep > 0) xcd_barrier(bar, wave0 == 0 && pg8::lane_id() == 0);
        switch (kind) {
        case 0: if (EN(0)) { CASE_BEGIN(); p0_prologue(F); } break;
        case 1: if (EN(1)) { CASE_BEGIN(); norm_phase(F, xs0, xs1, ((const float*)F.in[8]), modl, 0, HN);
                if (rep == 0) convert_layer(F, 0, 0, F.G); } break;
        case 2: if (EN(2)) { CASE_BEGIN(); Order<64, 6, 0, D, D, 192> S; S.init(F.G, F.blk, HN, ws + WS_WQKV);
                EpiQKV E{{ws, l, 0}};
                pg8::gemm_phase<D, D, D / 64, 192>(F.lds, S, E, F.wave, tp_here);
                if (MK_PREFETCH && rep == 0 && F.blk >= 128) { frame_refresh(F); prefetch_region(F, ws + WS_WO, 2 * MiB, 128, F.G - 128); prefetch_region(F, ws + WS_WUP, WUP_BYTES, 128, F.G - 128); } } break;
        case 3: if (EN(3)) { CASE_BEGIN(); attn_phase(F, (const bf16_t*)(ws + WS_Q), (const bf16_t*)(ws + WS_KB), (const bf16_t*)(ws + WS_VT), (const bf16_t*)(ws + WS_CK), (const bf16_t*)(ws + WS_CVT), ((const float*)F.in[13]), H); } break;
        case 4: if (EN(4)) { CASE_BEGIN(); Order<64, 8, 0, D, D, 192> S; S.init(F.G, F.blk, HN, ws + WS_WSGI);
                EpiSgu E{{ws, l, 0}};
                pg8::gemm_phase<D, D, D / 64, 192>(F.lds, S, E, F.wave, tp_here);
                } break;
        case 5: if (EN(5)) { CASE_BEGIN(); sgu_phase(F, (const bf16_t*)(ws + WS_U), (const bf16_t*)(ws + WS_V), (const f32x2*)(ws + WS_STATS), ((const float*)F.in[15]), (const bf16_t*)(ws + WS_WS), ((const float*)F.in[17]), H); } break;
        case 6: if (EN(6)) { CASE_BEGIN(); OrderSc S{F.blk, (const char*)HN, (const char*)(ws + WS_WSCI)};
                EpiSc E{{ws, l, F.blk}};
                pg8::gemm_phase<D, D, D / 64>(F.lds, S, E, F.wave, tp_here);
                if (MK_PREFETCH && rep == 0 && F.blk >= 200) { frame_refresh(F); prefetch_region(F, ws + WS_WSCO, 2 * MiB, 200, F.G - 200); prefetch_region(F, ws + WS_WUP + 2 * WUP_BYTES, WUP_BYTES, 200, F.G - 200); } } break;
        case 7: if (EN(7)) { CASE_BEGIN(); OrderFn1 S{F.G, F.blk, (const char*)(ws + WS_A1), (const char*)HN};
                EpiFn1 E{{ws, l, 0}};
                pg8::gemm_phase<256, D, 4>(F.lds, S, E, F.wave, tp_here);
                if (MK_PREFETCH && F.blk >= 128) { frame_refresh(F); prefetch_region(F, ws + WS_A2S, 16 * MiB, 128, F.G - 128); prefetch_region(F, ws + WS_WUP + 3 * WUP_BYTES, WUP_BYTES, 128, F.G - 128); } } break;
        case 8: if (EN(8)) { CASE_BEGIN();
                if (F.blk < 128) { EpiBf16<128> E{{ws, l, 0}}; OrderFn2 S{F.blk, 1, (const char*)(ws + WS_A2S), (const char*)(ws + WS_YT)}; pg8::gemm_phase<2 * TS, 2 * TS, 2 * TS / 64, 128>(F.lds, S, E, F.wave, tp_here); }
                else { EpiBf16<256> E{{ws, l, 0}}; OrderFn2 S{F.blk, 0, (const char*)(ws + WS_A2P), (const char*)(ws + WS_YT)}; pg8::gemm_phase<2 * TP, 2 * TP, 2 * TP / 64>(F.lds, S, E, F.wave, tp_here);
                    if (MK_PREFETCH) { frame_refresh(F); prefetch_region(F, ws + WS_WFNO, 2 * MiB, 128, F.G - 128); } } } break;
        case 9: if (EN(9)) { CASE_BEGIN(); const bf16_t* mix_in = l == 2 ? H2 : H;
                const bf16_t* wout = (const bf16_t*)(ws + (l == 0 ? WS_WO : l == 1 ? WS_WSGO : l == 2 ? WS_WSCO : WS_WFNO));
                Order<64, 4, 0, D, D, 192> S; S.init(F.G, F.blk, mix_in, wout);
                EpiResNorm<false> E{{ws, l, rep ? 2 : 0}};
                if (MK_REP_SHORTK && MK_REP_KIND == 9 && rep > 0) { pg8::gemm_phase<D, D, 4, 192>(F.lds, S, E, F.wave, tp_here); break; }
                pg8::gemm_phase<D, D, D / 64, 192>(F.lds, S, E, F.wave, tp_here);
                } break;
        case 10: if (EN(11)) { CASE_BEGIN(); Order<50, 22, 1, D, D> S; S.init(F.G, F.blk, HN, ws + WS_WUP + l * WUP_BYTES);
                if (MK_REP_NULL && rep > 0) { EpiNull E{{ws, l, 0}}; pg8::gemm_phase<D, D, D / 64>(F.lds, S, E, F.wave, tp_here); }
                else if (MK_REP_SHORTK && MK_REP_KIND == 10 && rep > 0) { EpiUp E{{ws, l, 0}}; pg8::gemm_phase<D, D, 4>(F.lds, S, E, F.wave, tp_here); }
                else { EpiUp E{{ws, l, 0}};
                pg8::gemm_phase<D, D, D / 64>(F.lds, S, E, F.wave, tp_here); }
                if (rep == 0 && F.blk >= 76) { frame_refresh(F);
                    if (l < 3) { mod_items(F, 192 * (l + 1), 192 * (l + 2), 76, F.G - 76); convert_layer(F, l + 1, 76, F.G - 76); }
                    if (MK_PREFETCH) { prefetch_region(F, ws + WS_WDN + l * WDN_BYTES, WDN_BYTES, 76, F.G - 76); } } } break;
        default: if (EN(12)) { CASE_BEGIN(); Order<64, 4, 0, DFF, DFF, 192> S; S.init(F.G, F.blk, ws + WS_ACT, ws + WS_WDN + l * WDN_BYTES);
                if (l < 3) { EpiResNorm<false> E{{ws, l, 1 | (rep ? 2 : 0)}}; pg8::gemm_phase<DFF, DFF, DFF / 64, 192>(F.lds, S, E, F.wave, tp_here); }
                else { EpiResNorm<true> E{{ws, l, 1 | (rep ? 2 : 0)}}; pg8::gemm_phase<DFF, DFF, DFF / 64, 192>(F.lds, S, E, F.wave, tp_here); } } break;
        }
        }
        if (tp_here && wave0 == 0 && pg8::lane_id() == 0) { const unsigned long long r1 = __builtin_amdgcn_s_memrealtime(), c1 = __builtin_amdgcn_s_memtime();
            if (MK_TP == 1) MISC[16] = (unsigned)(r1 - tp_r0);
            if (MK_TP == 3) MISC[16] = (unsigned)((c1 - tp_c0) * 10ull / (r1 - tp_r0)) * 10u; }
        if (ph + 1 < hi) xcd_barrier(bar, wave0 == 0 && pg8::lane_id() == 0);
    }
    if (MK_TP && blk0 == 0 && wave0 == 0) { const unsigned v = MISC[16] * ((MK_TP == 2 || MK_TP == 4) ? 4u : 1u); const unsigned long long t0 = __builtin_amdgcn_s_memrealtime();
        while (__builtin_amdgcn_s_memrealtime() - t0 < v) __builtin_amdgcn_s_sleep(8); }
}

extern "C" void kernel_launch(void* const* d_in, const int* in_sizes, int n_in, void* d_out, int out_size, void* d_ws, size_t ws_size, hipStream_t stream) {
    static int grid = 0;
    if (grid == 0) {
        if (n_in != 26 || ws_size < WS_TOTAL + (MK_REP_N ? (size_t)73 * MiB : 0)) { fprintf(stderr, "kernel_launch: unexpected n_in %d / ws %zu (need %zu)\n", n_in, ws_size, (size_t)WS_TOTAL); grid = -1; return; }
        int dev = 0, cus = 0;
        if (hipGetDevice(&dev) != hipSuccess || hipDeviceGetAttribute(&cus, hipDeviceAttributeMultiprocessorCount, dev) != hipSuccess) { grid = -1; return; }
        if (hipFuncSetAttribute((const void*)mk_fwd, hipFuncAttributeMaxDynamicSharedMemorySize, LDS_BYTES) != hipSuccess) { fprintf(stderr, "kernel_launch: hipFuncSetAttribute failed\n"); grid = -1; return; }
        (void)hipGetLastError();
        grid = cus;
    }
    if (grid < 0) return;
    (void)hipMemsetAsync((char*)d_ws + WS_CTL, 0, CTL_ZERO_BYTES, stream);
    Args a{};
    for (int i = 0; i < 26; ++i) a.in[i] = (const float*)d_in[i];
    a.out = (float*)d_out; a.ws = (unsigned char*)d_ws;
#if MK_PER_PHASE
    for (int p = MK_PH_LO; p < MK_PH_HI; ++p) { a.ph_lo = p; a.ph_hi = p + 1; hipLaunchKernelGGL(mk_fwd, dim3(grid), dim3(NWAVES * 64), LDS_BYTES, stream, a); }
#else
    a.ph_lo = MK_PH_LO; a.ph_hi = MK_PH_HI;
    hipLaunchKernelGGL(mk_fwd, dim3(grid), dim3(NWAVES * 64), LDS_BYTES, stream, a);
#endif
}
```
